# Optimizing an MI355X kernel written in HIP

```python
import jax, jax.numpy as jnp
from jax import lax
import numpy as np

D_MODEL = 1024
BATCH = 16
SEQ = 2048
DEPTH = 2

CTX_LEN = 256
GRID_W = 64
EPS = 1e-6
NEG_INF = -1e30
NA_HEADS = 8
NA_HEAD_DIM = 64
NA_WIDTH = NA_HEADS * NA_HEAD_DIM
WIN_H = 8
WIN_W = 16
Q_COLS = 16
K_COLS = Q_COLS + WIN_W
SC_WIDTH = D_MODEL - NA_WIDTH
SC_CONV = 3
LRU_WIDTH = D_MODEL
LRU_BLOCKS = 4
LRU_BLOCK = LRU_WIDTH // LRU_BLOCKS
LRU_CONV = 4
LRU_C = 8.0
N_EXPERTS = 32
TOP_K = 4
D_EXPERT = D_MODEL
SWIGLU_LIMIT = 7.0
SWIGLU_ALPHA = 1.702
EXPERT_BLOCK = 256

kernel_name = "hybrid_natten_shortconv_rglru_moe_prefix_ctx"


def rms_norm(x, g):
    x32 = x.astype(jnp.float32)
    y = x32 * lax.rsqrt(jnp.mean(x32 * x32, axis=-1, keepdims=True) + EPS)
    return (y * g.astype(jnp.float32)).astype(x.dtype)


def modulate(h, shift, scale):
    return h * (1 + scale) + shift


def depthwise_conv(x, w, b):
    k = w.shape[0]
    left = (k - 1) // 2
    t = x.shape[1]
    xp = jnp.pad(x, ((0, 0), (left, k - 1 - left), (0, 0)))
    return sum(xp[:, j:j + t] * w[j] for j in range(k)) + b


def heads(t):
    return t.reshape(t.shape[:-1] + (NA_HEADS, NA_HEAD_DIM))


def na_static(rows):
    kh = min(WIN_H, rows)
    r = np.arange(rows)
    r0 = np.clip(r - kh // 2, 0, rows - kh)
    dr_idx = r0[:, None] + np.arange(kh)[None] - r[:, None] + WIN_H - 1
    ncb = GRID_W // Q_COLS
    kc0 = np.clip(np.arange(ncb) * Q_COLS - WIN_W // 2, 0, GRID_W - K_COLS)
    band = kc0[:, None] + np.arange(K_COLS)[None]
    qc = np.arange(ncb)[:, None] * Q_COLS + np.arange(Q_COLS)[None]
    c0 = np.clip(qc - WIN_W // 2, 0, GRID_W - WIN_W)[..., None]
    kcol = band[:, None, :]
    valid = (kcol >= c0) & (kcol < c0 + WIN_W)
    dc_idx = np.clip(kcol - qc[..., None] + WIN_W - 1, 0, 2 * WIN_W - 2)
    return kh, r0.astype(np.int32), dr_idx, band, valid, dc_idx


def neighbourhood_attention(q, k, v, kc, vc, rpb):
    b_, t = q.shape[:2]
    rows = t // GRID_W
    ncb = GRID_W // Q_COLS
    kh, r0, dr_idx, band, valid, dc_idx = na_static(rows)
    grid = lambda a: a.reshape(b_, rows, GRID_W, NA_HEADS, NA_HEAD_DIM)
    q, k, v = grid(q), grid(k), grid(v)
    bias = rpb[:, dr_idx[:, :, None, None, None], dc_idx[None, None]]
    bias = jnp.where(valid[None, None, None], bias.astype(jnp.float32), NEG_INF)
    bias = bias.transpose(1, 0, 3, 4, 2, 5).reshape(rows, NA_HEADS, ncb, Q_COLS, kh * K_COLS)
    r0 = jnp.asarray(r0)
    n_lat = kh * K_COLS

    def row_block(args):
        r, bias_r = args
        q_r = lax.dynamic_index_in_dim(q, r, axis=1, keepdims=False)
        q_r = q_r.reshape(b_, ncb, Q_COLS, NA_HEADS, NA_HEAD_DIM)
        k_rows = lax.dynamic_slice_in_dim(k, r0[r], kh, axis=1)
        v_rows = lax.dynamic_slice_in_dim(v, r0[r], kh, axis=1)
        k_band = k_rows[:, :, band]
        v_band = v_rows[:, :, band]
        s_lat = jnp.einsum('bnqhd,binchd->bhnqic', q_r, k_band).astype(jnp.float32)
        s_lat = s_lat.reshape(b_, NA_HEADS, ncb, Q_COLS, n_lat) + bias_r
        s_ctx = jnp.einsum('bnqhd,blhd->bhnql', q_r, kc).astype(jnp.float32)
        p = jax.nn.softmax(jnp.concatenate([s_lat, s_ctx], axis=-1), axis=-1).astype(v.dtype)
        p_lat = p[..., :n_lat].reshape(b_, NA_HEADS, ncb, Q_COLS, kh, K_COLS)
        o = (jnp.einsum('bhnqic,binchd->bnqhd', p_lat, v_band)
             + jnp.einsum('bhnql,blhd->bnqhd', p[..., n_lat:], vc))
        return o.reshape(b_, GRID_W, NA_WIDTH)

    out = lax.map(row_block, (jnp.arange(rows), bias))
    return out.transpose(1, 0, 2, 3).reshape(b_, t, NA_WIDTH)


def context_attention(qc, kc, vc):
    s = jnp.einsum('blhd,bmhd->bhlm', qc, kc).astype(jnp.float32)
    p = jax.nn.softmax(s, axis=-1).astype(vc.dtype)
    o = jnp.einsum('bhlm,bmhd->blhd', p, vc)
    return o.reshape(o.shape[0], o.shape[1], NA_WIDTH)


def even_mixer(h, hc, w_in, w_out, q_g, k_g, rpb, conv_w, conv_b, need_ctx):
    cuts = [NA_WIDTH, 2 * NA_WIDTH, 3 * NA_WIDTH, 3 * NA_WIDTH + SC_WIDTH, 3 * NA_WIDTH + 2 * SC_WIDTH]
    q_scale = NA_HEAD_DIM ** -0.5
    q, k, v, bg, cg, xin = jnp.split(h @ w_in, cuts, axis=-1)
    q = rms_norm(heads(q), q_g) * q_scale
    k = rms_norm(heads(k), k_g)
    if need_ctx:
        qc, kc, vc, bgc, cgc, xinc = jnp.split(hc @ w_in, cuts, axis=-1)
    else:
        kc, vc = jnp.split(hc @ w_in[:, NA_WIDTH:3 * NA_WIDTH], 2, axis=-1)
    kc = rms_norm(heads(kc), k_g)
    vc = heads(vc)
    o_a = neighbourhood_attention(q, k, heads(v), kc, vc, rpb)
    o_b = bg * depthwise_conv(cg * xin, conv_w, conv_b)
    y = jnp.concatenate([o_a, o_b], axis=-1) @ w_out
    if not need_ctx:
        return y, None
    oc_a = context_attention(rms_norm(heads(qc), q_g) * q_scale, kc, vc)
    oc_b = bgc * depthwise_conv(cgc * xinc, conv_w, conv_b)
    yc = jnp.concatenate([oc_a, oc_b], axis=-1) @ w_out
    return y, yc


def block_diag(u, w, b):
    b_, t, _ = u.shape
    ub = u.reshape(b_, t, LRU_BLOCKS, LRU_BLOCK)
    return jnp.einsum('bthi,hij->bthj', ub, w).reshape(b_, t, LRU_WIDTH) + b


def rglru_coeffs(u, wa, ba, wx, bx, lam):
    r = jax.nn.sigmoid(block_diag(u, wa, ba).astype(jnp.float32))
    i = jax.nn.sigmoid(block_diag(u, wx, bx).astype(jnp.float32))
    log_a = LRU_C * r * jax.nn.log_sigmoid(lam.astype(jnp.float32))
    a = jnp.exp(log_a)
    mult = jnp.sqrt(-jnp.expm1(2.0 * log_a))
    return a, mult * i * u.astype(jnp.float32)


def linear_scan(a, b, h0, reverse):
    idx = -1 if reverse else 0
    b = b.at[:, idx].add(a[:, idx] * h0)

    def combine(e1, e2):
        a1, b1 = e1
        a2, b2 = e2
        return a1 * a2, a2 * b1 + b2

    _, h = lax.associative_scan(combine, (a, b), axis=1, reverse=reverse)
    return h


def odd_mixer(h, hc, w_in, w_out, conv_w, conv_b, fwd, bwd, need_ctx):
    gate, u = jnp.split(h @ w_in, 2, axis=-1)
    u = depthwise_conv(u, conv_w, conv_b)
    if need_ctx:
        gate_c, uc = jnp.split(hc @ w_in, 2, axis=-1)
    else:
        uc = hc @ w_in[:, LRU_WIDTH:]
    uc = depthwise_conv(uc, conv_w, conv_b)
    zeros = jnp.zeros((h.shape[0], LRU_WIDTH), jnp.float32)
    a_c, b_c = rglru_coeffs(uc, *fwd)
    hc_f = linear_scan(a_c, b_c, zeros, False)
    a_l, b_l = rglru_coeffs(u, *fwd)
    h_f = linear_scan(a_l, b_l, hc_f[:, -1], False)
    a_c, b_c = rglru_coeffs(uc, *bwd)
    hc_b = linear_scan(a_c, b_c, zeros, True)
    a_l, b_l = rglru_coeffs(u, *bwd)
    h_b = linear_scan(a_l, b_l, hc_b[:, 0], True)
    y = ((h_f + h_b).astype(h.dtype) * jax.nn.gelu(gate)) @ w_out
    if not need_ctx:
        return y, None
    yc = ((hc_f + hc_b).astype(hc.dtype) * jax.nn.gelu(gate_c)) @ w_out
    return y, yc


def moe(x, w_r, b_r, wg, bg, wu, bu, wd, bd):
    n = x.shape[0]
    logits = (x @ w_r + b_r).astype(jnp.float32)
    top_v, top_i = lax.top_k(logits, TOP_K)
    gates = jax.nn.softmax(top_v, axis=-1).astype(x.dtype)
    nk = n * TOP_K
    e_flat = top_i.reshape(-1)
    tok_flat = jnp.arange(nk, dtype=jnp.int32) // TOP_K
    order = jnp.argsort(e_flat)
    e_sorted = e_flat[order]
    counts = jnp.bincount(e_flat, length=N_EXPERTS)
    padded = (counts + EXPERT_BLOCK - 1) // EXPERT_BLOCK * EXPERT_BLOCK
    starts = jnp.cumsum(counts) - counts
    pends = jnp.cumsum(padded)
    dest = (pends - padded)[e_sorted] + jnp.arange(nk, dtype=jnp.int32) - starts[e_sorted]
    n_blocks = -(-nk // EXPERT_BLOCK) + N_EXPERTS
    n_slots = n_blocks * EXPERT_BLOCK
    slot_tok = jnp.zeros((n_slots,), jnp.int32).at[dest].set(tok_flat[order])
    slot_w = jnp.zeros((n_slots,), x.dtype).at[dest].set(gates.reshape(-1)[order])
    block_e = jnp.minimum(jnp.searchsorted(pends, jnp.arange(n_blocks) * EXPERT_BLOCK, side='right'), N_EXPERTS - 1)
    xb = x[slot_tok].reshape(n_blocks, EXPERT_BLOCK, x.shape[1])

    def expert_block(args):
        xe, e = args
        g = jnp.minimum(xe @ wg[e] + bg[e], SWIGLU_LIMIT)
        u = jnp.clip(xe @ wu[e] + bu[e], -SWIGLU_LIMIT, SWIGLU_LIMIT)
        return (g * jax.nn.sigmoid(SWIGLU_ALPHA * g) * (u + 1)) @ wd[e] + bd[e]

    yb = lax.map(expert_block, (xb, block_e)).reshape(n_slots, x.shape[1])
    return jnp.zeros_like(x).at[slot_tok].add(yb * slot_w[:, None])


def setup_inputs(seed: int = 0) -> dict:
    key = jax.random.key(seed)
    ks = iter(jax.random.split(key, 64))
    d = D_MODEL
    n_even = (DEPTH + 1) // 2
    n_odd = DEPTH // 2

    def nrm(shape, scale):
        return jax.random.normal(next(ks), shape, jnp.float32) * scale

    def lam(shape):
        u = jax.random.uniform(next(ks), shape, jnp.float32, minval=0.9, maxval=0.999)
        s = u ** (1.0 / LRU_C)
        return jnp.log(s) - jnp.log1p(-s)

    inp = {}
    inp['x'] = nrm((BATCH, SEQ, d), 1.0)
    inp['c'] = nrm((BATCH, d), 1.0)
    inp['ctx'] = nrm((BATCH, CTX_LEN, d), 1.0)
    inp['c_ctx'] = nrm((d,), 1.0)
    inp['ada_w'] = nrm((DEPTH, d, 6 * d), 0.5 * d ** -0.5)
    inp['ada_b'] = nrm((DEPTH, 6 * d), 0.02)
    inp['norm1_g'] = 1.0 + nrm((DEPTH, d), 0.05)
    inp['norm2_g'] = 1.0 + nrm((DEPTH, d), 0.05)
    inp['ev_w_in'] = nrm((n_even, d, 3 * NA_WIDTH + 3 * SC_WIDTH), d ** -0.5)
    inp['ev_w_out'] = nrm((n_even, NA_WIDTH + SC_WIDTH, d), (NA_WIDTH + SC_WIDTH) ** -0.5)
    inp['ev_q_gain'] = 1.0 + nrm((n_even, NA_HEAD_DIM), 0.05)
    inp['ev_k_gain'] = 1.0 + nrm((n_even, NA_HEAD_DIM), 0.05)
    inp['ev_rpb'] = nrm((n_even, NA_HEADS, 2 * WIN_H - 1, 2 * WIN_W - 1), 0.1)
    inp['ev_conv_w'] = nrm((n_even, SC_CONV, SC_WIDTH), SC_CONV ** -0.5)
    inp['ev_conv_b'] = nrm((n_even, SC_WIDTH), 0.02)
    inp['od_w_in'] = nrm((n_odd, d, 2 * LRU_WIDTH), d ** -0.5)
    inp['od_w_out'] = nrm((n_odd, LRU_WIDTH, d), LRU_WIDTH ** -0.5)
    inp['od_conv_w'] = nrm((n_odd, LRU_CONV, LRU_WIDTH), LRU_CONV ** -0.5)
    inp['od_conv_b'] = nrm((n_odd, LRU_WIDTH), 0.02)
    for dr in ('fwd', 'bwd'):
        inp['od_' + dr + '_wa'] = nrm((n_odd, LRU_BLOCKS, LRU_BLOCK, LRU_BLOCK), LRU_BLOCK ** -0.5)
        inp['od_' + dr + '_ba'] = nrm((n_odd, LRU_WIDTH), 0.02)
        inp['od_' + dr + '_wx'] = nrm((n_odd, LRU_BLOCKS, LRU_BLOCK, LRU_BLOCK), LRU_BLOCK ** -0.5)
        inp['od_' + dr + '_bx'] = nrm((n_odd, LRU_WIDTH), 0.02)
        inp['od_' + dr + '_lam'] = lam((n_odd, LRU_WIDTH))
    inp['router_w'] = nrm((DEPTH, d, N_EXPERTS), d ** -0.5)
    inp['router_b'] = nrm((DEPTH, N_EXPERTS), 0.01)
    inp['exp_w_gate'] = nrm((DEPTH, N_EXPERTS, d, D_EXPERT), d ** -0.5)
    inp['exp_b_gate'] = nrm((DEPTH, N_EXPERTS, D_EXPERT), 0.02)
    inp['exp_w_up'] = nrm((DEPTH, N_EXPERTS, d, D_EXPERT), d ** -0.5)
    inp['exp_b_up'] = nrm((DEPTH, N_EXPERTS, D_EXPERT), 0.02)
    inp['exp_w_down'] = nrm((DEPTH, N_EXPERTS, D_EXPERT, d), D_EXPERT ** -0.5)
    inp['exp_b_down'] = nrm((DEPTH, N_EXPERTS, d), 0.02)
    return inp


def reference(x, c, ctx, c_ctx, ada_w, ada_b, norm1_g, norm2_g,
              ev_w_in, ev_w_out, ev_q_gain, ev_k_gain, ev_rpb, ev_conv_w, ev_conv_b,
              od_w_in, od_w_out, od_conv_w, od_conv_b,
              od_fwd_wa, od_fwd_ba, od_fwd_wx, od_fwd_bx, od_fwd_lam,
              od_bwd_wa, od_bwd_ba, od_bwd_wx, od_bwd_bx, od_bwd_lam,
              router_w, router_b, exp_w_gate, exp_b_gate, exp_w_up, exp_b_up, exp_w_down, exp_b_down):
    b_, t, d = x.shape
    n_ctx = ctx.shape[1]
    s_lat = jax.nn.silu(c)
    s_ctx = jax.nn.silu(c_ctx)
    hctx = ctx
    for l in range(DEPTH):
        last = l == DEPTH - 1
        mod = (s_lat @ ada_w[l] + ada_b[l])[:, None, :]
        modc = s_ctx @ ada_w[l] + ada_b[l]
        sh1, sc1, g1, sh2, sc2, g2 = jnp.split(mod, 6, axis=-1)
        csh1, csc1, cg1, csh2, csc2, cg2 = jnp.split(modc, 6, axis=-1)
        h = modulate(rms_norm(x, norm1_g[l]), sh1, sc1)
        hc = modulate(rms_norm(hctx, norm1_g[l]), csh1, csc1)
        if l % 2 == 0:
            j = l // 2
            y, yc = even_mixer(h, hc, ev_w_in[j], ev_w_out[j], ev_q_gain[j], ev_k_gain[j], ev_rpb[j],
                               ev_conv_w[j], ev_conv_b[j], not last)
        else:
            j = l // 2
            fwd = (od_fwd_wa[j], od_fwd_ba[j], od_fwd_wx[j], od_fwd_bx[j], od_fwd_lam[j])
            bwd = (od_bwd_wa[j], od_bwd_ba[j], od_bwd_wx[j], od_bwd_bx[j], od_bwd_lam[j])
            y, yc = odd_mixer(h, hc, od_w_in[j], od_w_out[j], od_conv_w[j], od_conv_b[j], fwd, bwd, not last)
        x = x + g1 * y
        h2 = modulate(rms_norm(x, norm2_g[l]), sh2, sc2)
        moe_w = (router_w[l], router_b[l], exp_w_gate[l], exp_b_gate[l], exp_w_up[l], exp_b_up[l],
                 exp_w_down[l], exp_b_down[l])
        if last:
            x = x + g2 * moe(h2.reshape(-1, d), *moe_w).reshape(b_, t, d)
        else:
            hctx = hctx + cg1 * yc
            h2c = modulate(rms_norm(hctx, norm2_g[l]), csh2, csc2)
            tokens = jnp.concatenate([h2c, h2], axis=1).reshape(-1, d)
            y2 = moe(tokens, *moe_w).reshape(b_, n_ctx + t, d)
            hctx = hctx + cg2 * y2[:, :n_ctx]
            x = x + g2 * y2[:, n_ctx:]
    return x
```

```cpp
#include <hip/hip_runtime.h>
#include <stdint.h>
#include <stdio.h>

constexpr int D = 1024, NB = 16, SEQ = 2048, NT = NB * SEQ, LC = 256, NC = NB * LC, R = NT + NC;
constexpr int NE = 32, CAP = R;
constexpr int NWAVES = 8;

typedef unsigned short bf16;
typedef short bf16x8 __attribute__((ext_vector_type(8)));
typedef float f32x4 __attribute__((ext_vector_type(4)));
typedef unsigned v4u __attribute__((ext_vector_type(4)));
#define LAS __attribute__((address_space(3)))
#define RLX_AGENT __ATOMIC_RELAXED, __HIP_MEMORY_SCOPE_AGENT

constexpr size_t MiB = 1u << 20;
constexpr size_t WS_CTL = 0, CTL_ZERO_BYTES = 1 * MiB;
constexpr size_t WS_MOD = 1 * MiB;
constexpr size_t WS_WIN0 = 2 * MiB, WS_WOUT0 = 8 * MiB, WS_WIN1 = 10 * MiB, WS_WOUT1 = 14 * MiB, WS_WLRU = 16 * MiB;
constexpr size_t WS_TOKLIST = 18 * MiB;
constexpr size_t WS_SEL = 23 * MiB;
constexpr size_t WS_GATEV = 24 * MiB;
constexpr size_t WS_XC = 25 * MiB;
constexpr size_t WS_WEXP = 41 * MiB;
constexpr size_t WS_H = 233 * MiB;
constexpr size_t WS_P = 305 * MiB;
constexpr size_t WS_A2 = 521 * MiB;
constexpr size_t WS_ACT = 593 * MiB;
constexpr size_t WS_YB = 305 * MiB;
constexpr size_t WS_G = 305 * MiB;
constexpr size_t WS_U = 369 * MiB;
constexpr size_t WS_UC = 441 * MiB;
constexpr size_t WS_AF = 513 * MiB;
constexpr size_t WS_AB = 657 * MiB;
constexpr size_t WS_BF = 801 * MiB;
constexpr size_t WS_BB = 873 * MiB;
constexpr size_t WS_END = 945 * MiB;
constexpr int CW_BAR = 4096;
constexpr int CW_CNT = 16384;

__device__ __forceinline__ float bf2f(bf16 v) { return __uint_as_float(((unsigned)v) << 16); }
__device__ __forceinline__ bf16 f2bf(float f) { unsigned u = __float_as_uint(f); return (bf16)((u + 0x7fffu + ((u >> 16) & 1u)) >> 16); }
__device__ __forceinline__ unsigned pk2(float lo, float hi) { return (unsigned)f2bf(lo) | ((unsigned)f2bf(hi) << 16); }
__device__ __forceinline__ float wave_sum(float v) {
#pragma unroll
    for (int o = 1; o < 64; o <<= 1) v += __shfl_xor(v, o);
    return v;
}
__device__ __forceinline__ float wave_max(float v) {
#pragma unroll
    for (int o = 1; o < 64; o <<= 1) v = fmaxf(v, __shfl_xor(v, o));
    return v;
}
__device__ __forceinline__ float sigmoidf_(float x) { return 1.0f / (1.0f + __expf(-x)); }
__device__ __forceinline__ float gelu_tanh(float x) { return 0.5f * x * (1.0f + tanhf(0.7978845608028654f * (x + 0.044715f * x * x * x))); }

#define XB_TMO      128
#define XB_XCNT(j)  (256  + 64 * (j))
#define XB_XSUB(j)  (1280 + 64 * (j))
#define XB_XGEN(j)  (2304 + 64 * (j))
#define XB_TOP      3328
#define XB_TOPGEN   3392
#define XCD_BAR_WORDS 3456
#define XB_SPIN_CAP (1u << 18)
__device__ __forceinline__ unsigned xb_ld(unsigned* p)              { return __hip_atomic_load(p, __ATOMIC_RELAXED, __HIP_MEMORY_SCOPE_AGENT); }
__device__ __forceinline__ unsigned xb_add(unsigned* p, unsigned v) { return __hip_atomic_fetch_add(p, v, __ATOMIC_RELAXED, __HIP_MEMORY_SCOPE_AGENT); }
__device__ __forceinline__ unsigned xb_xcc_id() { return (unsigned)__builtin_amdgcn_s_getreg((3 << 11) | 20) & 0xFu; }
#define XB_SPIN(cond, bar) do { unsigned _sp = 0; while (cond) { __builtin_amdgcn_s_sleep(1); \
    if ((++_sp & 255u) == 0u) { if (xb_ld(&(bar)[XB_TMO])) break; if (_sp > XB_SPIN_CAP) { atomicAdd(&(bar)[XB_TMO], 1u); break; } } } } while (0)
struct XcdBarrier { unsigned* bar; unsigned x; volatile LAS unsigned* st; };
__device__ __forceinline__ XcdBarrier xcd_barrier_post(unsigned* bar, volatile LAS unsigned* st) {
    XcdBarrier b; b.bar = bar; b.x = xb_xcc_id(); b.st = st;
    if (threadIdx.x == 0) (void)xb_add(&bar[XB_XCNT(b.x)], 1u);
    return b;
}
__device__ __forceinline__ void xcd_barrier_complete(unsigned* bar, unsigned x, unsigned& nloc, unsigned& nx) {
    const unsigned G = gridDim.x * gridDim.y * gridDim.z;
    unsigned sum, cnt, mine, sp = 0u;
    for (;;) {
        sum = 0u; cnt = 0u; mine = 0u;
#pragma unroll
        for (unsigned j = 0; j < 16; ++j) { const unsigned c = xb_ld(&bar[XB_XCNT(j)]); sum += c; cnt += (c > 0u) ? 1u : 0u; mine = (j == x) ? c : mine; }
        if (sum == G) break;
        __builtin_amdgcn_s_sleep(1);
        if ((++sp & 255u) == 0u) { if (xb_ld(&bar[XB_TMO])) break; if (sp > XB_SPIN_CAP) { atomicAdd(&bar[XB_TMO], 1u); break; } }
    }
    nloc = mine > 0u ? mine : 1u; nx = cnt > 0u ? cnt : 1u;
}
__device__ __forceinline__ void xcd_barrier(const XcdBarrier& b) {
    asm volatile("s_waitcnt vmcnt(0)" ::: "memory");
    __syncthreads();
    if (threadIdx.x == 0) {
        unsigned* bar = b.bar;
        __builtin_amdgcn_s_waitcnt(0);
        unsigned nloc = b.st[0], nx = b.st[1];
        if (nloc == 0u) { xcd_barrier_complete(bar, b.x, nloc, nx); b.st[0] = nloc; b.st[1] = nx; }
        const unsigned old = xb_add(&bar[XB_XSUB(b.x)], 1u);
        const unsigned gen = old / nloc;
        if (old + 1u == (gen + 1u) * nloc) {
            __builtin_amdgcn_fence(__ATOMIC_RELEASE, "agent");
            asm volatile("s_waitcnt vmcnt(0)" ::: "memory");
            const unsigned og = xb_add(&bar[XB_TOP], 1u);
            const unsigned tg = og / nx;
            if (og + 1u == (tg + 1u) * nx) xb_add(&bar[XB_TOPGEN], 1u);
            else XB_SPIN(xb_ld(&bar[XB_TOPGEN]) == tg, bar);
            __builtin_amdgcn_fence(__ATOMIC_ACQUIRE, "agent");
            xb_add(&bar[XB_XGEN(b.x)], 1u);
            asm volatile("s_waitcnt vmcnt(0)" ::: "memory");
        } else {
            XB_SPIN(xb_ld(&bar[XB_XGEN(b.x)]) == gen, bar);
            __builtin_amdgcn_fence(__ATOMIC_ACQUIRE, "agent");
            asm volatile("s_waitcnt vmcnt(0)" ::: "memory");
        }
    }
    __syncthreads();
}

struct Args { const float* in[37]; float* out; unsigned char* ws; int ph_lo, ph_hi; };
struct Frame {
    unsigned char* lds;
    int tid, lane, wave, gw, ngw, G, bid;
};

template <int NS, class FA, class FB, class FS>
__device__ __forceinline__ void tile_gemm32(int K, FA arow, FB brow, FS store, int lane) {
    const int lr = lane & 15, lq = lane >> 4;
    const bf16* ap[2]; const bf16* bp[NS][2];
#pragma unroll
    for (int i = 0; i < 2; ++i) ap[i] = arow(16 * i + lr) + 8 * lq;
#pragma unroll
    for (int s = 0; s < NS; ++s)
#pragma unroll
        for (int j = 0; j < 2; ++j) bp[s][j] = brow(s, 16 * j + lr) + 8 * lq;
    f32x4 acc[NS][2][2];
#pragma unroll
    for (int s = 0; s < NS; ++s)
#pragma unroll
        for (int i = 0; i < 2; ++i)
#pragma unroll
            for (int j = 0; j < 2; ++j) acc[s][i][j] = (f32x4){0.f, 0.f, 0.f, 0.f};
    for (int k0 = 0; k0 < K; k0 += 32) {
        bf16x8 a[2], b[NS][2];
#pragma unroll
        for (int i = 0; i < 2; ++i) a[i] = *(const bf16x8*)(ap[i] + k0);
#pragma unroll
        for (int s = 0; s < NS; ++s)
#pragma unroll
            for (int j = 0; j < 2; ++j) b[s][j] = *(const bf16x8*)(bp[s][j] + k0);
#pragma unroll
        for (int s = 0; s < NS; ++s)
#pragma unroll
            for (int i = 0; i < 2; ++i)
#pragma unroll
                for (int j = 0; j < 2; ++j) acc[s][i][j] = __builtin_amdgcn_mfma_f32_16x16x32_bf16(a[i], b[s][j], acc[s][i][j], 0, 0, 0);
    }
#pragma unroll
    for (int i = 0; i < 2; ++i)
#pragma unroll
        for (int j = 0; j < 2; ++j)
#pragma unroll
            for (int q = 0; q < 4; ++q) {
                float v[NS];
#pragma unroll
                for (int s = 0; s < NS; ++s) v[s] = acc[s][i][j][q];
                store(16 * i + 4 * lq + q, 16 * j + lr, v);
            }
}

__device__ __forceinline__ void transpose_item(const float* W, int K, int N, bf16* WT, int row_off, float* scr, int item, int lane) {
    const int nblk = N / 32, kb = item / nblk, nb = item % nblk, k0 = 64 * kb, n0 = 32 * nb;
#pragma unroll 8
    for (int i = 0; i < 32; ++i) { const int kk = 2 * i + (lane >> 5); scr[kk * 33 + (lane & 31)] = W[(size_t)(k0 + kk) * N + n0 + (lane & 31)]; }
    asm volatile("s_waitcnt lgkmcnt(0)" ::: "memory");
    const int c = lane & 7;
#pragma unroll
    for (int j = 0; j < 4; ++j) { const int n = (lane >> 3) + 8 * j; const float* s = scr + (8 * c) * 33 + n;
        v4u o; o.x = pk2(s[0 * 33], s[1 * 33]); o.y = pk2(s[2 * 33], s[3 * 33]); o.z = pk2(s[4 * 33], s[5 * 33]); o.w = pk2(s[6 * 33], s[7 * 33]);
        *(v4u*)(WT + (size_t)(row_off + n0 + n) * K + k0 + 8 * c) = o; }
    asm volatile("s_waitcnt lgkmcnt(0)" ::: "memory");
}
__device__ __forceinline__ void convert_experts(const Args& a, const Frame& F, int layer) {
    float* scr = (float*)(F.lds + F.wave * 8448);
    bf16* WE = (bf16*)(a.ws + WS_WEXP);
    constexpr int IPM = 16 * 32;
    for (int it = F.gw; it < NE * 3 * IPM; it += F.ngw) {
        const int m = it / IPM, r = it % IPM, e = m / 3, which = m % 3;
        const float* W = a.in[31 + 2 * which] + ((size_t)(layer * NE + e) << 20);
        transpose_item(W, D, D, WE + ((size_t)m << 20), 0, scr, r, F.lane);
    }
}
__device__ __forceinline__ void p0_prologue(const Args& a, const Frame& F) {
    float* scr = (float*)(F.lds + F.wave * 8448);
    constexpr int I_IN0 = 16 * 96, I_O = 16 * 32, I_IN1 = 16 * 64, I_LRU1 = 4 * 8;
    constexpr int NSMALL = I_IN0 + I_O + I_IN1 + I_O + 16 * I_LRU1;
    for (int it = F.gw; it < NSMALL; it += F.ngw) {
        int r = it;
        if (r < I_IN0) { transpose_item(a.in[8], D, 3072, (bf16*)(a.ws + WS_WIN0), 0, scr, r, F.lane); continue; } r -= I_IN0;
        if (r < I_O) { transpose_item(a.in[9], D, D, (bf16*)(a.ws + WS_WOUT0), 0, scr, r, F.lane); continue; } r -= I_O;
        if (r < I_IN1) { transpose_item(a.in[15], D, 2048, (bf16*)(a.ws + WS_WIN1), 0, scr, r, F.lane); continue; } r -= I_IN1;
        if (r < I_O) { transpose_item(a.in[16], D, D, (bf16*)(a.ws + WS_WOUT1), 0, scr, r, F.lane); continue; } r -= I_O;
        const int gh = r / I_LRU1, rr = r % I_LRU1, g = gh >> 2, h = gh & 3;
        const float* W = a.in[g == 0 ? 19 : g == 1 ? 21 : g == 2 ? 24 : 26] + (size_t)h * 65536;
        transpose_item(W, 256, 256, (bf16*)(a.ws + WS_WLRU) + (size_t)h * 1024 * 256, g * 256, scr, rr, F.lane);
    }
    convert_experts(a, F, 0);
    __syncthreads();
    float* sc = (float*)F.lds;
    float* red = (float*)(F.lds + 17 * 1024 * 4);
    for (int i = F.tid; i < 17 * 1024; i += NWAVES * 64) { const float v = i < 16 * 1024 ? a.in[1][i] : a.in[3][i - 16 * 1024]; sc[i] = v / (1.0f + __expf(-v)); }
    __syncthreads();
    float* MOD = (float*)(a.ws + WS_MOD);
    for (int u = F.bid; u < 192; u += F.G) {
        const int l = u / 96, n = (u % 96) * 64 + F.lane;
        const float* w = a.in[4] + (size_t)l * D * 6144 + n;
        float acc[17];
#pragma unroll
        for (int b = 0; b < 17; ++b) acc[b] = 0.f;
        for (int k = F.wave * 128; k < F.wave * 128 + 128; ++k) {
            const float wv = w[(size_t)k * 6144];
#pragma unroll
            for (int b = 0; b < 17; ++b) acc[b] += sc[b * 1024 + k] * wv;
        }
#pragma unroll
        for (int b = 0; b < 17; ++b) red[(F.wave * 17 + b) * 64 + F.lane] = acc[b];
        __syncthreads();
        for (int i = F.tid; i < 17 * 64; i += NWAVES * 64) {
            const int b = i / 64, ln = i % 64; float s = 0.f;
#pragma unroll
            for (int w8 = 0; w8 < 8; ++w8) s += red[(w8 * 17 + b) * 64 + ln];
            const int nn = (u % 96) * 64 + ln;
            MOD[((size_t)l * 17 + b) * 6144 + nn] = s + a.in[5][l * 6144 + nn];
        }
        __syncthreads();
    }
}

__device__ __forceinline__ void load_row16(const float* row, int lane, float (&v)[16]) {
#pragma unroll
    for (int j = 0; j < 4; ++j) { const f32x4 t = *(const f32x4*)(row + 256 * j + 4 * lane); v[4 * j] = t.x; v[4 * j + 1] = t.y; v[4 * j + 2] = t.z; v[4 * j + 3] = t.w; }
}
__device__ __forceinline__ void store_row16_f32(float* row, int lane, const float (&v)[16]) {
#pragma unroll
    for (int j = 0; j < 4; ++j) *(f32x4*)(row + 256 * j + 4 * lane) = (f32x4){v[4 * j], v[4 * j + 1], v[4 * j + 2], v[4 * j + 3]};
}
__device__ __forceinline__ void norm_mod(const float (&v)[16], const float* g, const float* sh, const float* sc, bf16* out, int lane, float (&hv)[16]) {
    float s = 0.f;
#pragma unroll
    for (int i = 0; i < 16; ++i) s += v[i] * v[i];
    const float rstd = rsqrtf(wave_sum(s) * (1.0f / D) + 1e-6f);
#pragma unroll
    for (int j = 0; j < 4; ++j) {
        const int e = 256 * j + 4 * lane;
        const f32x4 gg = *(const f32x4*)(g + e), ss = *(const f32x4*)(sh + e), cc = *(const f32x4*)(sc + e);
        hv[4 * j] = v[4 * j] * rstd * gg.x * (1.f + cc.x) + ss.x; hv[4 * j + 1] = v[4 * j + 1] * rstd * gg.y * (1.f + cc.y) + ss.y;
        hv[4 * j + 2] = v[4 * j + 2] * rstd * gg.z * (1.f + cc.z) + ss.z; hv[4 * j + 3] = v[4 * j + 3] * rstd * gg.w * (1.f + cc.w) + ss.w;
        uint2 o; o.x = pk2(hv[4 * j], hv[4 * j + 1]); o.y = pk2(hv[4 * j + 2], hv[4 * j + 3]);
        *(uint2*)(out + e) = o;
    }
}
__device__ __forceinline__ int row_batch(int r) { return r < NT ? (r >> 11) : 16; }
__device__ __forceinline__ const float* mod_ptr(const Args& a, int l, int r, int chunk) { return (const float*)(a.ws + WS_MOD) + ((size_t)l * 17 + row_batch(r)) * 6144 + chunk * D; }

__device__ __forceinline__ void p_norm1_l0(const Args& a, const Frame& F) {
    bf16* H = (bf16*)(a.ws + WS_H);
    for (int r = F.gw; r < R; r += F.ngw) {
        const float* src = r < NT ? a.in[0] + (size_t)r * D : a.in[2] + (size_t)(r - NT) * D;
        float v[16], hv[16]; load_row16(src, F.lane, v);
        norm_mod(v, a.in[6], mod_ptr(a, 0, r, 0), mod_ptr(a, 0, r, 1), H + (size_t)r * D, F.lane, hv);
    }
}

__device__ __forceinline__ void p_inproj0(const Args& a, const Frame& F) {
    const bf16* H = (const bf16*)(a.ws + WS_H); const bf16* W = (const bf16*)(a.ws + WS_WIN0); bf16* P = (bf16*)(a.ws + WS_P);
    constexpr int NTN = 3072 / 32, NTM = R / 32;
    for (int t = F.gw; t < NTM * NTN; t += F.ngw) {
        const int mt = t / NTN, nt = t % NTN, r0 = mt * 32, n0 = nt * 32;
        tile_gemm32<1>(D, [=](int r) { return H + (size_t)(r0 + r) * D; }, [=](int, int n) { return W + (size_t)(n0 + n) * D; },
            [=](int r, int n, float (&v)[1]) { P[(size_t)(r0 + r) * 3072 + n0 + n] = f2bf(v[0]); }, F.lane);
    }
}
__device__ __forceinline__ void p_qknorm(const Args& a, const Frame& F) {
    bf16* P = (bf16*)(a.ws + WS_P);
    for (int u = F.gw; u < R * 16; u += F.ngw) {
        const int r = u >> 4, wh = (u >> 3) & 1, hd = u & 7;
        bf16* p = P + (size_t)r * 3072 + wh * 512 + hd * 64 + F.lane;
        const float x = bf2f(*p);
        const float rstd = rsqrtf(wave_sum(x * x) * (1.0f / 64.0f) + 1e-6f);
        const float g = a.in[wh ? 11 : 10][F.lane];
        float y = x * rstd * g; if (!wh) y *= 0.125f;
        *p = f2bf(y);
    }
}
__device__ __forceinline__ void p_attn(const Args& a, const Frame& F) {
    const bf16* P = (const bf16*)(a.ws + WS_P); bf16* A2 = (bf16*)(a.ws + WS_A2);
    float* qs = (float*)(F.lds + F.wave * 2048);
    float* ps = qs + 64;
    const float* rpb = a.in[12];
    for (int u = F.gw; u < R * 8; u += F.ngw) {
        const int row = u >> 3, hd = u & 7;
        const bool lat = row < NT;
        const int b = lat ? (row >> 11) : ((row - NT) >> 8);
        int r = 0, c = 0, r0 = 0, c0 = 0;
        if (lat) { const int t = row & 2047; r = t >> 6; c = t & 63; r0 = min(max(r - 4, 0), 24); c0 = min(max(c - 8, 0), 48); }
        const int nlat = lat ? 128 : 0, nkeys = nlat + 256;
        qs[F.lane] = bf2f(P[(size_t)row * 3072 + hd * 64 + F.lane]);
        asm volatile("s_waitcnt lgkmcnt(0)" ::: "memory");
        float sc[6]; float mx = -3.0e38f;
#pragma unroll
        for (int m = 0; m < 6; ++m) {
            const int kidx = F.lane + 64 * m; sc[m] = -3.0e38f;
            if (kidx < nkeys) {
                int krow; float bias = 0.f;
                if (kidx < nlat) { const int i = kidx >> 4, cc = kidx & 15, kr = r0 + i, kc = c0 + cc; krow = b * 2048 + kr * 64 + kc; bias = rpb[(hd * 15 + (kr - r + 7)) * 31 + (kc - c + 15)]; }
                else krow = NT + b * 256 + (kidx - nlat);
                const bf16* kp = P + (size_t)krow * 3072 + 512 + hd * 64;
                float s = 0.f;
#pragma unroll
                for (int d8 = 0; d8 < 8; ++d8) { const v4u kv = *(const v4u*)(kp + 8 * d8);
                    const unsigned w[4] = {kv.x, kv.y, kv.z, kv.w};
#pragma unroll
                    for (int j = 0; j < 4; ++j) { s += qs[8 * d8 + 2 * j] * __uint_as_float(w[j] << 16) + qs[8 * d8 + 2 * j + 1] * __uint_as_float(w[j] & 0xffff0000u); } }
                sc[m] = s + bias;
            }
            mx = fmaxf(mx, sc[m]);
        }
        mx = wave_max(mx);
        float sum = 0.f;
#pragma unroll
        for (int m = 0; m < 6; ++m) { const int kidx = F.lane + 64 * m; if (kidx < nkeys) { const float e = __expf(sc[m] - mx); sum += e; ps[kidx] = e; } }
        sum = wave_sum(sum);
        asm volatile("s_waitcnt lgkmcnt(0)" ::: "memory");
        float o = 0.f;
        for (int kidx = 0; kidx < nkeys; ++kidx) {
            int krow;
            if (kidx < nlat) { const int i = kidx >> 4, cc = kidx & 15; krow = b * 2048 + (r0 + i) * 64 + c0 + cc; } else krow = NT + b * 256 + (kidx - nlat);
            o += ps[kidx] * bf2f(P[(size_t)krow * 3072 + 1024 + hd * 64 + F.lane]);
        }
        A2[(size_t)row * D + hd * 64 + F.lane] = f2bf(o / sum);
        asm volatile("s_waitcnt lgkmcnt(0)" ::: "memory");
    }
    const float* cw = a.in[13]; const float* cb = a.in[14];
    for (int u = F.gw; u < R * 8; u += F.ngw) {
        const int row = u >> 3, j = (u & 7) * 64 + F.lane;
        const bool lat = row < NT;
        const int t = lat ? (row & 2047) : ((row - NT) & 255), len = lat ? 2048 : 256;
        const bf16* pr = P + (size_t)row * 3072;
        float acc = cb[j];
#pragma unroll
        for (int dt = -1; dt <= 1; ++dt) {
            if (t + dt >= 0 && t + dt < len) { const bf16* q = pr + (ptrdiff_t)dt * 3072; acc += cw[(dt + 1) * 512 + j] * bf2f(q[2048 + j]) * bf2f(q[2560 + j]); }
        }
        A2[(size_t)row * D + 512 + j] = f2bf(bf2f(pr[1536 + j]) * acc);
    }
}
__device__ __forceinline__ void p_outproj(const Args& a, const Frame& F, int l) {
    const bf16* A = (const bf16*)(a.ws + (l == 0 ? WS_A2 : WS_UC)); const bf16* W = (const bf16*)(a.ws + (l == 0 ? WS_WOUT0 : WS_WOUT1));
    float* XC = (float*)(a.ws + WS_XC); const float* MOD = (const float*)(a.ws + WS_MOD);
    const int rows = l == 0 ? R : NT;
    constexpr int NTN = D / 32; const int NTM = rows / 32;
    const float* xin = a.in[0]; const float* cin = a.in[2]; float* out = a.out;
    for (int t = F.gw; t < NTM * NTN; t += F.ngw) {
        const int mt = t / NTN, nt = t % NTN, r0 = mt * 32, n0 = nt * 32;
        tile_gemm32<1>(D, [=](int r) { return A + (size_t)(r0 + r) * D; }, [=](int, int n) { return W + (size_t)(n0 + n) * D; },
            [=](int r, int n, float (&v)[1]) {
                const int row = r0 + r, col = n0 + n;
                const float g1 = MOD[((size_t)l * 17 + row_batch(row)) * 6144 + 2 * D + col];
                if (row < NT) { const float base = l == 0 ? xin[(size_t)row * D + col] : out[(size_t)row * D + col]; out[(size_t)row * D + col] = base + g1 * v[0]; }
                else XC[(size_t)(row - NT) * D + col] = cin[(size_t)(row - NT) * D + col] + g1 * v[0];
            }, F.lane);
    }
}
#define RS_STEP(half, m) do { const bool up = (F.lane & (m)) != 0; _Pragma("unroll") for (int i = 0; i < (half); ++i) { \
        const float keep = up ? part[i + (half)] : part[i]; const float send = up ? part[i] : part[i + (half)]; part[i] = keep + __shfl_xor(send, (m)); } } while (0)
__device__ __forceinline__ void p_norm2_router(const Args& a, const Frame& F, int l) {
    bf16* H = (bf16*)(a.ws + WS_H); const float* XC = (const float*)(a.ws + WS_XC);
    unsigned* ctl = (unsigned*)(a.ws + WS_CTL);
    int* toklist = (int*)(a.ws + WS_TOKLIST); int* sel = (int*)(a.ws + WS_SEL); float* gatev = (float*)(a.ws + WS_GATEV);
    const float* wr = a.in[29] + (size_t)l * D * NE; const float* br = a.in[30] + l * NE;
    const int rows = l == 0 ? R : NT;
    for (int r = F.gw; r < rows; r += F.ngw) {
        const float* src = r < NT ? a.out + (size_t)r * D : XC + (size_t)(r - NT) * D;
        float v[16], hv[16]; load_row16(src, F.lane, v);
        norm_mod(v, a.in[7] + l * D, mod_ptr(a, l, r, 3), mod_ptr(a, l, r, 4), H + (size_t)r * D, F.lane, hv);
        float part[32];
#pragma unroll
        for (int i = 0; i < 32; ++i) part[i] = 0.f;
#pragma unroll
        for (int j = 0; j < 4; ++j)
#pragma unroll
            for (int c = 0; c < 4; ++c) {
                const float hx = hv[4 * j + c]; const f32x4* w4 = (const f32x4*)(wr + (size_t)(256 * j + 4 * F.lane + c) * NE);
#pragma unroll
                for (int q = 0; q < 8; ++q) { const f32x4 w = w4[q]; part[4 * q] += hx * w.x; part[4 * q + 1] += hx * w.y; part[4 * q + 2] += hx * w.z; part[4 * q + 3] += hx * w.w; }
            }
        RS_STEP(16, 32); RS_STEP(8, 16); RS_STEP(4, 8); RS_STEP(2, 4); RS_STEP(1, 2);
        const int ex = (F.lane >> 1) & 31;
        float logit = part[0] + __shfl_xor(part[0], 1) + br[ex];
        float tv[4]; int ti[4];
#pragma unroll
        for (int k = 0; k < 4; ++k) {
            float bv = logit; int bi = ex;
#pragma unroll
            for (int o = 1; o < 64; o <<= 1) { const float ov = __shfl_xor(bv, o); const int oi = __shfl_xor(bi, o); if (ov > bv || (ov == bv && oi < bi)) { bv = ov; bi = oi; } }
            tv[k] = bv; ti[k] = bi; if (ex == bi) logit = -3.0e38f;
        }
        const float e1 = __expf(tv[1] - tv[0]), e2 = __expf(tv[2] - tv[0]), e3 = __expf(tv[3] - tv[0]);
        const float inv = 1.0f / (1.0f + e1 + e2 + e3);
        if (F.lane < 4) {
            const int k = F.lane; const int e = k == 0 ? ti[0] : k == 1 ? ti[1] : k == 2 ? ti[2] : ti[3];
            const float gk = (k == 0 ? 1.0f : k == 1 ? e1 : k == 2 ? e2 : e3) * inv;
            const unsigned pos = __hip_atomic_fetch_add(ctl + CW_CNT + (l * 32 + e) * 64, 1u, RLX_AGENT);
            toklist[(size_t)e * CAP + pos] = r; sel[r * 4 + k] = (int)((pos << 5) | (unsigned)e); gatev[r * 4 + k] = gk;
        }
    }
}
struct MoeTab { int cnt[NE], base[NE + 1], tpre[NE + 1]; };
__device__ __forceinline__ void moe_tab_build(const Args& a, const Frame& F, int l, MoeTab* tb) {
    unsigned* ctl = (unsigned*)(a.ws + WS_CTL);
    if (F.tid == 0) { int bs = 0, tp = 0; for (int e = 0; e < NE; ++e) { const int c = (int)__hip_atomic_load(ctl + CW_CNT + (l * 32 + e) * 64, RLX_AGENT); tb->cnt[e] = c; tb->base[e] = bs; tb->tpre[e] = tp; bs += c; tp += (c + 31) >> 5; } tb->base[NE] = bs; tb->tpre[NE] = tp; }
    __syncthreads();
}
__device__ __forceinline__ void p_moe_up(const Args& a, const Frame& F, int l) {
    MoeTab* tb = (MoeTab*)(F.lds + 65536); moe_tab_build(a, F, l, tb);
    const bf16* H = (const bf16*)(a.ws + WS_H); const bf16* WE = (const bf16*)(a.ws + WS_WEXP); bf16* ACT = (bf16*)(a.ws + WS_ACT);
    const int* toklist = (const int*)(a.ws + WS_TOKLIST);
    const float* bgate = a.in[32] + (size_t)l * NE * D; const float* bup = a.in[34] + (size_t)l * NE * D;
    constexpr int NTN = D / 32; const int ntm = tb->tpre[NE];
    for (int t = F.gw; t < ntm * NTN; t += F.ngw) {
        const int mt = t / NTN, nt = t % NTN, n0 = nt * 32;
        int e = 0; while (e < NE - 1 && mt >= tb->tpre[e + 1]) ++e;
        const int lr0 = (mt - tb->tpre[e]) * 32, cnt = tb->cnt[e], base = tb->base[e];
        const int* tl = toklist + (size_t)e * CAP; const bf16* Wg = WE + ((size_t)(e * 3 + 0) << 20); const bf16* Wu = WE + ((size_t)(e * 3 + 1) << 20);
        const float* bg = bgate + e * D; const float* bu = bup + e * D;
        tile_gemm32<2>(D, [=](int r) { const int lr = min(lr0 + r, cnt - 1); return H + (size_t)tl[lr] * D; },
            [=](int s, int n) { return (s == 0 ? Wg : Wu) + (size_t)(n0 + n) * D; },
            [=](int r, int n, float (&v)[2]) {
                const int lr = lr0 + r; if (lr >= cnt) return;
                const float g = fminf(v[0] + bg[n0 + n], 7.0f); const float uu = fminf(fmaxf(v[1] + bu[n0 + n], -7.0f), 7.0f);
                ACT[(size_t)(base + lr) * D + n0 + n] = f2bf(g * sigmoidf_(1.702f * g) * (uu + 1.0f));
            }, F.lane);
    }
}
__device__ __forceinline__ void p_moe_down(const Args& a, const Frame& F, int l) {
    MoeTab* tb = (MoeTab*)(F.lds + 65536); moe_tab_build(a, F, l, tb);
    const bf16* WE = (const bf16*)(a.ws + WS_WEXP); const bf16* ACT = (const bf16*)(a.ws + WS_ACT); bf16* YB = (bf16*)(a.ws + WS_YB);
    const float* bdown = a.in[36] + (size_t)l * NE * D;
    constexpr int NTN = D / 32; const int ntm = tb->tpre[NE];
    for (int t = F.gw; t < ntm * NTN; t += F.ngw) {
        const int mt = t / NTN, nt = t % NTN, n0 = nt * 32;
        int e = 0; while (e < NE - 1 && mt >= tb->tpre[e + 1]) ++e;
        const int lr0 = (mt - tb->tpre[e]) * 32, cnt = tb->cnt[e], base = tb->base[e];
        const bf16* Wd = WE + ((size_t)(e * 3 + 2) << 20); const float* bd = bdown + e * D;
        tile_gemm32<1>(D, [=](int r) { const int lr = min(lr0 + r, cnt - 1); return ACT + (size_t)(base + lr) * D; },
            [=](int, int n) { return Wd + (size_t)(n0 + n) * D; },
            [=](int r, int n, float (&v)[1]) { const int lr = lr0 + r; if (lr >= cnt) return; YB[(size_t)(base + lr) * D + n0 + n] = f2bf(v[0] + bd[n0 + n]); }, F.lane);
    }
}
__device__ __forceinline__ void p_combine(const Args& a, const Frame& F, int l) {
    MoeTab* tb = (MoeTab*)(F.lds + 65536); moe_tab_build(a, F, l, tb);
    const bf16* YB = (const bf16*)(a.ws + WS_YB); float* XC = (float*)(a.ws + WS_XC); bf16* H = (bf16*)(a.ws + WS_H);
    const int* sel = (const int*)(a.ws + WS_SEL); const float* gatev = (const float*)(a.ws + WS_GATEV);
    const int rows = l == 0 ? R : NT;
    for (int r = F.gw; r < rows; r += F.ngw) {
        float* dst = r < NT ? a.out + (size_t)r * D : XC + (size_t)(r - NT) * D;
        float v[16]; load_row16(dst, F.lane, v);
        float m[16];
#pragma unroll
        for (int i = 0; i < 16; ++i) m[i] = 0.f;
#pragma unroll
        for (int k = 0; k < 4; ++k) {
            const int sv = sel[r * 4 + k]; const float gk = gatev[r * 4 + k]; const int e = sv & 31, pos = sv >> 5;
            const bf16* y = YB + (size_t)(tb->base[e] + pos) * D;
#pragma unroll
            for (int j = 0; j < 4; ++j) { const uint2 w = *(const uint2*)(y + 256 * j + 4 * F.lane);
                m[4 * j] += gk * __uint_as_float(w.x << 16); m[4 * j + 1] += gk * __uint_as_float(w.x & 0xffff0000u); m[4 * j + 2] += gk * __uint_as_float(w.y << 16); m[4 * j + 3] += gk * __uint_as_float(w.y & 0xffff0000u); }
        }
        const float* g2 = mod_ptr(a, l, r, 5);
#pragma unroll
        for (int j = 0; j < 4; ++j) { const f32x4 gg = *(const f32x4*)(g2 + 256 * j + 4 * F.lane); v[4 * j] += gg.x * m[4 * j]; v[4 * j + 1] += gg.y * m[4 * j + 1]; v[4 * j + 2] += gg.z * m[4 * j + 2]; v[4 * j + 3] += gg.w * m[4 * j + 3]; }
        store_row16_f32(dst, F.lane, v);
        if (l == 0) { float hv[16]; norm_mod(v, a.in[6] + D, mod_ptr(a, 1, r, 0), mod_ptr(a, 1, r, 1), H + (size_t)r * D, F.lane, hv); }
    }
}
__device__ __forceinline__ void p_inproj1(const Args& a, const Frame& F) {
    const bf16* H = (const bf16*)(a.ws + WS_H); const bf16* W = (const bf16*)(a.ws + WS_WIN1); bf16* Gt = (bf16*)(a.ws + WS_G); bf16* U = (bf16*)(a.ws + WS_U);
    constexpr int NTN = 2048 / 32, NTM = R / 32;
    for (int t = F.gw; t < NTM * NTN; t += F.ngw) {
        const int mt = t / NTN, nt = t % NTN, r0 = mt * 32, n0 = nt * 32;
        if (n0 < D && r0 >= NT) continue;
        tile_gemm32<1>(D, [=](int r) { return H + (size_t)(r0 + r) * D; }, [=](int, int n) { return W + (size_t)(n0 + n) * D; },
            [=](int r, int n, float (&v)[1]) { const int col = n0 + n; if (col < D) Gt[(size_t)(r0 + r) * D + col] = f2bf(gelu_tanh(v[0])); else U[(size_t)(r0 + r) * D + col - D] = f2bf(v[0]); }, F.lane);
    }
}
__device__ __forceinline__ void p_conv4(const Args& a, const Frame& F) {
    const bf16* U = (const bf16*)(a.ws + WS_U); bf16* UC = (bf16*)(a.ws + WS_UC); const float* cw = a.in[17]; const float* cb = a.in[18];
    for (int u = F.gw; u < R * 16; u += F.ngw) {
        const int row = u >> 4, j = (u & 15) * 64 + F.lane;
        const bool lat = row < NT; const int t = lat ? (row & 2047) : ((row - NT) & 255), len = lat ? 2048 : 256;
        float acc = cb[j];
#pragma unroll
        for (int dt = -1; dt <= 2; ++dt) if (t + dt >= 0 && t + dt < len) acc += cw[(dt + 1) * D + j] * bf2f(U[(size_t)(row + dt) * D + j]);
        UC[(size_t)row * D + j] = f2bf(acc);
    }
}
__device__ __forceinline__ void p_lru_coef(const Args& a, const Frame& F) {
    const bf16* UC = (const bf16*)(a.ws + WS_UC); const bf16* WL = (const bf16*)(a.ws + WS_WLRU);
    float* AF = (float*)(a.ws + WS_AF); float* AB = (float*)(a.ws + WS_AB); bf16* BF = (bf16*)(a.ws + WS_BF); bf16* BB = (bf16*)(a.ws + WS_BB);
    const float* ba_f = a.in[20]; const float* bx_f = a.in[22]; const float* lam_f = a.in[23]; const float* ba_b = a.in[25]; const float* bx_b = a.in[27]; const float* lam_b = a.in[28];
    constexpr int NTN = D / 32, NTM = R / 32;
    for (int t = F.gw; t < NTM * NTN; t += F.ngw) {
        const int mt = t / NTN, nt = t % NTN, r0 = mt * 32, c0 = nt * 32, h = c0 >> 8, j0 = c0 & 255;
        const bf16* Wh = WL + (size_t)h * 1024 * 256;
        tile_gemm32<4>(256, [=](int r) { return UC + (size_t)(r0 + r) * D + h * 256; }, [=](int s, int n) { return Wh + (size_t)(s * 256 + j0 + n) * 256; },
            [=](int r, int n, float (&v)[4]) {
                const int row = r0 + r, ch = c0 + n; const float u = bf2f(UC[(size_t)row * D + ch]);
                {   const float rr = sigmoidf_(v[0] + ba_f[ch]), ii = sigmoidf_(v[1] + bx_f[ch]); const float lam = lam_f[ch];
                    const float la = 8.0f * rr * (-log1pf(expf(-lam))); AF[(size_t)row * D + ch] = expf(la); BF[(size_t)row * D + ch] = f2bf(sqrtf(-expm1f(2.0f * la)) * ii * u); }
                {   const float rr = sigmoidf_(v[2] + ba_b[ch]), ii = sigmoidf_(v[3] + bx_b[ch]); const float lam = lam_b[ch];
                    const float la = 8.0f * rr * (-log1pf(expf(-lam))); AB[(size_t)row * D + ch] = expf(la); BB[(size_t)row * D + ch] = f2bf(sqrtf(-expm1f(2.0f * la)) * ii * u); }
            }, F.lane);
    }
}
__device__ __forceinline__ void p_scan(const Args& a, const Frame& F) {
    const float* AF = (const float*)(a.ws + WS_AF); const float* AB = (const float*)(a.ws + WS_AB); bf16* BF = (bf16*)(a.ws + WS_BF); bf16* BB = (bf16*)(a.ws + WS_BB);
    for (int u = F.wave * F.G + F.bid; u < 512; u += F.G * NWAVES) {
        const int dir = u & 1, b = (u >> 1) & 15, ch = (u >> 5) * 64 + F.lane;
        const float* A = dir ? AB : AF; bf16* Bv = dir ? BB : BF;
        float h = 0.f;
        if (!dir) {
            for (int s = 0; s < 2304; s += 8) {
                float av[8], bv[8];
#pragma unroll
                for (int q = 0; q < 8; ++q) { const int st = s + q; const size_t row = st < 256 ? (size_t)(NT + b * 256 + st) : (size_t)(b * 2048 + st - 256); av[q] = A[row * D + ch]; bv[q] = bf2f(Bv[row * D + ch]); }
#pragma unroll
                for (int q = 0; q < 8; ++q) { const int st = s + q; h = av[q] * h + bv[q]; if (st >= 256) Bv[(size_t)(b * 2048 + st - 256) * D + ch] = f2bf(h); }
            }
        } else {
            for (int s = 0; s < 2304; s += 8) {
                float av[8], bv[8];
#pragma unroll
                for (int q = 0; q < 8; ++q) { const int st = s + q; const size_t row = st < 256 ? (size_t)(NT + b * 256 + 255 - st) : (size_t)(b * 2048 + 2047 - (st - 256)); av[q] = A[row * D + ch]; bv[q] = bf2f(Bv[row * D + ch]); }
#pragma unroll
                for (int q = 0; q < 8; ++q) { const int st = s + q; h = av[q] * h + bv[q]; if (st >= 256) Bv[(size_t)(b * 2048 + 2047 - (st - 256)) * D + ch] = f2bf(h); }
            }
        }
    }
}
__device__ __forceinline__ void p_a3(const Args& a, const Frame& F) {
    const bf16* BF = (const bf16*)(a.ws + WS_BF); const bf16* BB = (const bf16*)(a.ws + WS_BB); const bf16* Gt = (const bf16*)(a.ws + WS_G); bf16* A3 = (bf16*)(a.ws + WS_UC);
    for (size_t i = (size_t)F.gw * 64 + F.lane; i < (size_t)NT * D; i += (size_t)F.ngw * 64) A3[i] = f2bf((bf2f(BF[i]) + bf2f(BB[i])) * bf2f(Gt[i]));
}

constexpr int LDS_BYTES = 147456;
constexpr int NPHASE = 20;
__global__ void __launch_bounds__(NWAVES * 64, 2) fwd(Args args) {
    extern __shared__ __attribute__((aligned(16))) unsigned char lds[];
    Frame F; F.lds = lds; F.tid = threadIdx.x; F.lane = F.tid & 63; F.wave = __builtin_amdgcn_readfirstlane(F.tid >> 6);
    F.G = gridDim.x; F.bid = blockIdx.x; F.gw = F.bid * NWAVES + F.wave; F.ngw = F.G * NWAVES;
    volatile LAS unsigned* misc = (volatile LAS unsigned*)((LAS unsigned char*)lds + (LDS_BYTES - 64));
    if (F.tid < 16) misc[F.tid] = 0u;
    __syncthreads();
    const int lo = args.ph_lo, hi = args.ph_hi;
    XcdBarrier bar; bar.bar = (unsigned*)(args.ws + WS_CTL) + CW_BAR; bar.x = 0; bar.st = misc;
    if (hi - lo > 1) bar = xcd_barrier_post((unsigned*)(args.ws + WS_CTL) + CW_BAR, misc);
#define PH(k, body) if (lo <= (k) && (k) < hi) { body; if ((k) + 1 < hi) xcd_barrier(bar); else { asm volatile("s_waitcnt vmcnt(0)" ::: "memory"); __syncthreads(); } }
    PH(0, p0_prologue(args, F))
    PH(1, p_norm1_l0(args, F))
    PH(2, p_inproj0(args, F))
    PH(3, p_qknorm(args, F))
    PH(4, p_attn(args, F))
    PH(5, p_outproj(args, F, 0))
    PH(6, p_norm2_router(args, F, 0))
    PH(7, p_moe_up(args, F, 0))
    PH(8, p_moe_down(args, F, 0))
    PH(9, { p_combine(args, F, 0); __syncthreads(); convert_experts(args, F, 1); })
    PH(10, p_inproj1(args, F))
    PH(11, p_conv4(args, F))
    PH(12, p_lru_coef(args, F))
    PH(13, p_scan(args, F))
    PH(14, p_a3(args, F))
    PH(15, p_outproj(args, F, 1))
    PH(16, p_norm2_router(args, F, 1))
    PH(17, p_moe_up(args, F, 1))
    PH(18, p_moe_down(args, F, 1))
    PH(19, p_combine(args, F, 1))
#undef PH
}

#ifndef N_LAUNCH_MODE
#define N_LAUNCH_MODE 0
#endif
extern "C" void kernel_launch(void* const* d_in, const int* in_sizes, int n_in, void* d_out, int out_size, void* d_ws, size_t ws_size, hipStream_t stream) {
    static int grid = 0;
    if (grid == 0) {
        if (n_in != 37 || out_size != NT * D || ws_size < WS_END) { fprintf(stderr, "kernel_launch: unexpected shapes (n_in %d out %d ws %zu)\n", n_in, out_size, ws_size); grid = -1; return; }
        int dev = 0, cus = 0, per_cu = 0;
        if (hipGetDevice(&dev) != hipSuccess || hipDeviceGetAttribute(&cus, hipDeviceAttributeMultiprocessorCount, dev) != hipSuccess) { grid = -1; return; }
        if (hipFuncSetAttribute((const void*)fwd, hipFuncAttributeMaxDynamicSharedMemorySize, LDS_BYTES) != hipSuccess) { fprintf(stderr, "kernel_launch: hipFuncSetAttribute failed\n"); grid = -1; return; }
        if (hipOccupancyMaxActiveBlocksPerMultiprocessor(&per_cu, (const void*)fwd, NWAVES * 64, LDS_BYTES) != hipSuccess || per_cu < 1) fprintf(stderr, "kernel_launch: occupancy query says %d\n", per_cu);
        (void)hipGetLastError();
        grid = cus;
    }
    if (grid < 0) return;
    if (hipMemsetAsync((char*)d_ws + WS_CTL, 0, CTL_ZERO_BYTES, stream) != hipSuccess) return;
    Args a{};
    for (int i = 0; i < 37; ++i) a.in[i] = (const float*)d_in[i];
    a.out = (float*)d_out; a.ws = (unsigned char*)d_ws;
#if N_LAUNCH_MODE == 1
    a.ph_lo = 0; a.ph_hi = NPHASE;
    hipLaunchKernelGGL(fwd, dim3(grid), dim3(NWAVES * 64), LDS_BYTES, stream, a);
#else
    for (int p = 0; p < NPHASE; ++p) { a.ph_lo = p; a.ph_hi = p + 1; hipLaunchKernelGGL(fwd, dim3(grid), dim3(NWAVES * 64), LDS_BYTES, stream, a); }
#endif
}
```

```cpp
#include <hip/hip_runtime.h>
#include <stdint.h>
#include <stdio.h>

constexpr int D = 1024, NB = 16, SEQ = 2048, NT = NB * SEQ, LC = 256, NC = NB * LC, R = NT + NC;
constexpr int NE = 32, CAP = R;
constexpr int NWAVES = 8;

typedef unsigned short bf16;
typedef short bf16x8 __attribute__((ext_vector_type(8)));
typedef float f32x4 __attribute__((ext_vector_type(4)));
typedef unsigned v4u __attribute__((ext_vector_type(4)));
#define LAS __attribute__((address_space(3)))
#define CAS __attribute__((address_space(4)))
#define RLX_AGENT __ATOMIC_RELAXED, __HIP_MEMORY_SCOPE_AGENT

constexpr size_t MiB = 1u << 20;
constexpr size_t WS_CTL = 0, CTL_ZERO_BYTES = 1 * MiB;
constexpr size_t WS_MOD = 1 * MiB;
constexpr size_t WS_WIN0 = 2 * MiB, WS_WOUT0 = 8 * MiB, WS_WIN1 = 10 * MiB, WS_WOUT1 = 14 * MiB, WS_WLRU = 16 * MiB;
constexpr size_t WS_TOKLIST = 18 * MiB;
constexpr size_t WS_SEL = 23 * MiB;
constexpr size_t WS_GATEV = 24 * MiB;
constexpr size_t WS_XC = 25 * MiB;
constexpr size_t WS_WEXP = 41 * MiB;
constexpr size_t WS_H = 233 * MiB;
constexpr size_t WS_P = 305 * MiB;
constexpr int PP = 2560;
constexpr size_t WS_A2 = 521 * MiB;
constexpr size_t WS_ACT = 593 * MiB;
constexpr size_t WS_YB = 305 * MiB;
constexpr size_t WS_G = 305 * MiB;
constexpr size_t WS_U = 369 * MiB;
constexpr size_t WS_UC = 441 * MiB;
constexpr size_t WS_AF = 513 * MiB;
constexpr size_t WS_AB = 657 * MiB;
constexpr size_t WS_HF = WS_AF;
constexpr size_t WS_A3 = WS_AB;
constexpr size_t WS_BF = 801 * MiB;
constexpr size_t WS_BB = 873 * MiB;
constexpr size_t WS_GS2 = 840 * MiB;
constexpr size_t WS_XB = 760 * MiB;
constexpr size_t WS_END = 945 * MiB;
constexpr int CW_BAR = 4096;
constexpr int CW_CNT = 65536;

__device__ __forceinline__ float bf2f(bf16 v) { return __uint_as_float(((unsigned)v) << 16); }
__device__ __forceinline__ bf16 f2bf(float f) { unsigned u = __float_as_uint(f); return (bf16)((u + 0x7fffu + ((u >> 16) & 1u)) >> 16); }
__device__ __forceinline__ unsigned pk2(float lo, float hi) { return (unsigned)f2bf(lo) | ((unsigned)f2bf(hi) << 16); }
__device__ __forceinline__ int lane_id_fresh() { int l; asm volatile("v_mbcnt_lo_u32_b32 %0, -1, 0\n\tv_mbcnt_hi_u32_b32 %0, -1, %0" : "=v"(l)); return l; }
__device__ __forceinline__ unsigned pk4_fp8(float a, float b, float c, float d) {
    a = fminf(fmaxf(a, -448.f), 448.f); b = fminf(fmaxf(b, -448.f), 448.f); c = fminf(fmaxf(c, -448.f), 448.f); d = fminf(fmaxf(d, -448.f), 448.f);
    unsigned w = 0u; w = __builtin_amdgcn_cvt_pk_fp8_f32(a, b, w, false); w = __builtin_amdgcn_cvt_pk_fp8_f32(c, d, w, true); return w;
}
constexpr float W8_SCALE = 32.0f, ACT8_SCALE = 4.0f, YB8_SCALE = 16.0f;
__device__ __forceinline__ float wave_sum(float v) {
#pragma unroll
    for (int o = 1; o < 64; o <<= 1) v += __shfl_xor(v, o);
    return v;
}
__device__ __forceinline__ float wave_max(float v) {
#pragma unroll
    for (int o = 1; o < 64; o <<= 1) v = fmaxf(v, __shfl_xor(v, o));
    return v;
}
__device__ __forceinline__ float sigmoidf_(float x) { return 1.0f / (1.0f + __expf(-x)); }
__device__ __forceinline__ float gelu_tanh(float x) { return 0.5f * x * (1.0f + tanhf(0.7978845608028654f * (x + 0.044715f * x * x * x))); }

#define XB_TMO      128
#define XB_XCNT(j)  (256  + 64 * (j))
#define XB_XSUB(j)  (1280 + 64 * (j))
#define XB_XGEN(j)  (2304 + 64 * (j))
#define XB_TOP      3328
#define XB_TOPGEN   3392
#define XCD_BAR_WORDS 3456
#define XB_SPIN_CAP (1u << 18)
__device__ __forceinline__ unsigned xb_ld(unsigned* p)              { return __hip_atomic_load(p, __ATOMIC_RELAXED, __HIP_MEMORY_SCOPE_AGENT); }
__device__ __forceinline__ unsigned xb_add(unsigned* p, unsigned v) { return __hip_atomic_fetch_add(p, v, __ATOMIC_RELAXED, __HIP_MEMORY_SCOPE_AGENT); }
__device__ __forceinline__ unsigned xb_xcc_id() { return (unsigned)__builtin_amdgcn_s_getreg((3 << 11) | 20) & 0xFu; }
#define XB_SPIN(cond, bar) do { unsigned _sp = 0; while (cond) { __builtin_amdgcn_s_sleep(1); \
    if ((++_sp & 255u) == 0u) { if (xb_ld(&(bar)[XB_TMO])) break; if (_sp > XB_SPIN_CAP) { atomicAdd(&(bar)[XB_TMO], 1u); break; } } } } while (0)
struct XcdBarrier { unsigned* bar; unsigned x; volatile LAS unsigned* st; };
__device__ __forceinline__ XcdBarrier xcd_barrier_post(unsigned* bar, volatile LAS unsigned* st, int tid) {
    XcdBarrier b; b.bar = bar; b.x = xb_xcc_id(); b.st = st;
    if (tid == 0) (void)xb_add(&bar[XB_XCNT(b.x)], 1u);
    return b;
}
__device__ __forceinline__ void xcd_barrier_complete(unsigned* bar, unsigned x, unsigned& nloc, unsigned& nx) {
    const unsigned G = gridDim.x * gridDim.y * gridDim.z;
    unsigned sum, cnt, mine, sp = 0u;
    for (;;) {
        sum = 0u; cnt = 0u; mine = 0u;
#pragma unroll
        for (unsigned j = 0; j < 16; ++j) { const unsigned c = xb_ld(&bar[XB_XCNT(j)]); sum += c; cnt += (c > 0u) ? 1u : 0u; mine = (j == x) ? c : mine; }
        if (sum == G) break;
        __builtin_amdgcn_s_sleep(1);
        if ((++sp & 255u) == 0u) { if (xb_ld(&bar[XB_TMO])) break; if (sp > XB_SPIN_CAP) { atomicAdd(&bar[XB_TMO], 1u); break; } }
    }
    nloc = mine > 0u ? mine : 1u; nx = cnt > 0u ? cnt : 1u;
}
__device__ __forceinline__ void xcd_barrier(const XcdBarrier& b, int tid) {
    asm volatile("s_waitcnt vmcnt(0)" ::: "memory");
    __syncthreads();
    if (tid == 0) {
        unsigned* bar = b.bar;
        __builtin_amdgcn_s_waitcnt(0);
        unsigned nloc = b.st[0], nx = b.st[1];
        if (nloc == 0u) { xcd_barrier_complete(bar, b.x, nloc, nx); b.st[0] = nloc; b.st[1] = nx; }
        const unsigned old = xb_add(&bar[XB_XSUB(b.x)], 1u);
        const unsigned gen = old / nloc;
        if (old + 1u == (gen + 1u) * nloc) {
            __builtin_amdgcn_fence(__ATOMIC_RELEASE, "agent");
            asm volatile("s_waitcnt vmcnt(0)" ::: "memory");
            const unsigned og = xb_add(&bar[XB_TOP], 1u);
            const unsigned tg = og / nx;
            if (og + 1u == (tg + 1u) * nx) xb_add(&bar[XB_TOPGEN], 1u);
            else XB_SPIN(xb_ld(&bar[XB_TOPGEN]) == tg, bar);
            __builtin_amdgcn_fence(__ATOMIC_ACQUIRE, "agent");
            xb_add(&bar[XB_XGEN(b.x)], 1u);
            asm volatile("s_waitcnt vmcnt(0)" ::: "memory");
        } else {
            XB_SPIN(xb_ld(&bar[XB_XGEN(b.x)]) == gen, bar);
            __builtin_amdgcn_fence(__ATOMIC_ACQUIRE, "agent");
            asm volatile("s_waitcnt vmcnt(0)" ::: "memory");
        }
    }
    __syncthreads();
}

struct Args { const float* in[37]; float* out; unsigned char* ws; int ph_lo, ph_hi, li, pad; };
struct Frame {
    unsigned char* lds;
    LAS unsigned char* ldsl;
    int tid, lane, wave, gw, ngw, G, bid;
};

template <int NS, class FA, class FB, class FS>
__device__ __forceinline__ void tile_gemm32(int K, FA arow, FB brow, FS store, int lane) {
    const int lr = lane & 15, lq = lane >> 4;
    const bf16* ap[2]; const bf16* bp[NS][2];
#pragma unroll
    for (int i = 0; i < 2; ++i) ap[i] = arow(16 * i + lr) + 8 * lq;
#pragma unroll
    for (int s = 0; s < NS; ++s)
#pragma unroll
        for (int j = 0; j < 2; ++j) bp[s][j] = brow(s, 16 * j + lr) + 8 * lq;
    f32x4 acc[NS][2][2];
#pragma unroll
    for (int s = 0; s < NS; ++s)
#pragma unroll
        for (int i = 0; i < 2; ++i)
#pragma unroll
            for (int j = 0; j < 2; ++j) acc[s][i][j] = (f32x4){0.f, 0.f, 0.f, 0.f};
#pragma nounroll
    for (int k0 = 0; k0 < K; k0 += 32) {
        bf16x8 a[2], b[NS][2];
#pragma unroll
        for (int i = 0; i < 2; ++i) a[i] = *(const bf16x8*)(ap[i] + k0);
#pragma unroll
        for (int s = 0; s < NS; ++s)
#pragma unroll
            for (int j = 0; j < 2; ++j) b[s][j] = *(const bf16x8*)(bp[s][j] + k0);
#pragma unroll
        for (int s = 0; s < NS; ++s)
#pragma unroll
            for (int i = 0; i < 2; ++i)
#pragma unroll
                for (int j = 0; j < 2; ++j) acc[s][i][j] = __builtin_amdgcn_mfma_f32_16x16x32_bf16(a[i], b[s][j], acc[s][i][j], 0, 0, 0);
    }
#pragma unroll
    for (int i = 0; i < 2; ++i)
#pragma unroll
        for (int j = 0; j < 2; ++j)
#pragma unroll
            for (int q = 0; q < 4; ++q) {
                float v[NS];
#pragma unroll
                for (int s = 0; s < NS; ++s) v[s] = acc[s][i][j][q];
                store(16 * i + 4 * lq + q, 16 * j + lr, v);
            }
}


namespace pg8 {
constexpr int BM = 256, BK = 64, HALF = 128, HTB = HALF * BK * 2, STAGE_BYTES = 8 * HTB;
__device__ __forceinline__ int lds_byte(int r, int c) { const int st = (r >> 4) * 2 + (c >> 5), rr = r & 15, cc = c & 31, ob = rr * 64 + cc * 2; return st * 1024 + (ob ^ (((ob >> 9) & 1) << 5)); }
__device__ __forceinline__ void stage_rc(int b, int& R_, int& C_) { const int st = b / 1024, sb = b % 1024, swz = sb ^ (((sb >> 9) & 1) << 5); R_ = (st >> 1) * 16 + swz / 64; C_ = (st & 1) * 32 + (swz % 64) / 2; }
__device__ __forceinline__ int perm32(int rho) { const int n = rho >> 4, i = rho & 15; return 8 * (i >> 2) + 4 * n + (i & 3); }
struct Unit { int pm, pn, e, rows, base, newe; };
typedef int v8i __attribute__((ext_vector_type(8)));
typedef int v4i __attribute__((ext_vector_type(4)));
__device__ __forceinline__ void mfma8(f32x4& acc, v8i a, v8i b, unsigned sc) {
    asm volatile("v_mfma_scale_f32_16x16x128_f8f6f4 %0, %1, %2, %0, %3, %3 op_sel_hi:[0,0,0]" : "+v"(acc) : "v"(a), "v"(b), "v"(sc));
}
__device__ __forceinline__ v8i cat8(bf16x8 a, bf16x8 b) { return __builtin_shufflevector(__builtin_bit_cast(v4i, a), __builtin_bit_cast(v4i, b), 0, 1, 2, 3, 4, 5, 6, 7); }
__device__ __forceinline__ unsigned cvt_pk_bf16(float lo, float hi) { unsigned r; asm volatile("v_cvt_pk_bf16_f32 %0, %1, %2" : "=v"(r) : "v"(lo), "v"(hi)); return r; }

template <int RB  , bool FP8, class Epi, class Sched>
__device__ __forceinline__ void gemm_phase(LAS unsigned char* lds, const Sched& S, const Epi& E, const int wave_id) {
    const int tid_ = wave_id * 64 + lane_id_fresh();
    const int tid = tid_, wid = wave_id, lane = tid & 63, wr = wid >> 2, wc = wid & 3, fr = lane & 15, fq = lane >> 4;
    constexpr int nt = RB / 128;
    unsigned voffA[2], voffB[2]; int rA[2];
#pragma unroll
    for (int i = 0; i < 2; ++i) { int R_, C_; stage_rc(tid * 16 + i * 8192, R_, C_); const int Rb = Epi::PERM ? ((R_ & ~31) + perm32(R_ & 31)) : R_;
        voffA[i] = Sched::GATHER ? (unsigned)C_ * 2u : (unsigned)(R_ * RB + C_ * 2); rA[i] = R_; voffB[i] = (unsigned)(Rb * RB + C_ * 2); }
    constexpr size_t kstep = (size_t)(BK * 2);
    constexpr size_t hstep = (size_t)HALF * RB;
    const unsigned ldsw = (unsigned)wid * 1024u;
    const int aoff = lds_byte(wr * 64 + fr, fq * 8), boff = lds_byte(wc * 32 + fr, fq * 8);
#define PG8_SA(b, h) (((b) * 2 + (h)) * HTB)
#define PG8_SB(b, h) ((4 + (b) * 2 + (h)) * HTB)
#define PG8_STAGE(bufoff, gbase, voff) do { _Pragma("unroll") for (int _i = 0; _i < 2; ++_i) \
        __builtin_amdgcn_global_load_lds((const unsigned*)((const char*)(gbase) + (voff)[_i]), (LAS unsigned*)(lds + (bufoff) + ldsw + _i * 8192), 16, 0, 0); } while (0)
#define PG8_STAGE_A(bufoff, ubase, uoff, h) do { if constexpr (Sched::GATHER) PG8_STAGE(bufoff, ubase, (uoff)[h]); else PG8_STAGE(bufoff, (ubase) + (h) * hstep, voffA); } while (0)
#define PG8_LDA(dst, b, h) do { _Pragma("unroll") for (int m = 0; m < 4; ++m) _Pragma("unroll") for (int k = 0; k < 2; ++k) dst[m][k] = *(const LAS bf16x8*)(lds + PG8_SA(b, h) + aoff + m * 2048 + k * 1024); } while (0)
#define PG8_LDB(dst, b, h) do { _Pragma("unroll") for (int n = 0; n < 2; ++n) _Pragma("unroll") for (int k = 0; k < 2; ++k) dst[n][k] = *(const LAS bf16x8*)(lds + PG8_SB(b, h) + boff + n * 2048 + k * 1024); } while (0)
#define PG8_MMA(ai, bj, At, Bt) do { __builtin_amdgcn_s_setprio(1); _Pragma("unroll") for (int m = 0; m < 4; ++m) _Pragma("unroll") for (int n = 0; n < 2; ++n) { \
        if constexpr (FP8) mfma8(acc[ai][bj][m][n], cat8(Bt[n][0], Bt[n][1]), cat8(At[m][0], At[m][1]), sc1); \
        else { _Pragma("unroll") for (int k = 0; k < 2; ++k) acc[ai][bj][m][n] = __builtin_amdgcn_mfma_f32_16x16x32_bf16(Bt[n][k], At[m][k], acc[ai][bj][m][n], 0, 0, 0); } } __builtin_amdgcn_s_setprio(0); } while (0)
#define PG8_WAIT_V(n) asm volatile("s_waitcnt vmcnt(" #n ")" ::: "memory")
#define PG8_WAIT_L(n) asm volatile("s_waitcnt lgkmcnt(" #n ")" ::: "memory")
#define PG8_BAR __builtin_amdgcn_s_barrier()
#define PG8_SCHED __builtin_amdgcn_sched_barrier(0)
#define PG8_KBODY(a1, a2, b2, off2) do { const char* _a1 = (a1); const char* _a2 = (a2); const char* _b2 = (b2); const char* _a3 = _a2 + kstep; const char* _b3 = _b2 + kstep; \
            asm volatile("" : "+s"(_a1), "+s"(_a2), "+s"(_b2), "+s"(_a3), "+s"(_b3));   \
            PG8_LDB(B0, 0, 0); PG8_LDB(B1, 0, 1); PG8_SCHED; PG8_LDA(At, 0, 0); PG8_STAGE_A(PG8_SA(1, 1), _a1, coff, 1); \
            PG8_WAIT_V(8); PG8_WAIT_L(0); PG8_BAR; PG8_MMA(0, 0, At, B0); PG8_MMA(0, 1, At, B1); PG8_BAR; PG8_SCHED; \
            PG8_LDA(At, 0, 1); PG8_STAGE(PG8_SB(0, 0), _b2, voffB); PG8_STAGE(PG8_SB(0, 1), _b2 + hstep, voffB); PG8_STAGE_A(PG8_SA(0, 0), _a2, off2, 0); \
            PG8_WAIT_V(8); PG8_WAIT_L(0); PG8_BAR; PG8_MMA(1, 0, At, B0); PG8_MMA(1, 1, At, B1); PG8_BAR; PG8_SCHED; \
            PG8_LDB(B0, 1, 0); PG8_LDB(B1, 1, 1); PG8_SCHED; PG8_LDA(At, 1, 0); PG8_STAGE_A(PG8_SA(0, 1), _a2, off2, 1); \
            PG8_WAIT_V(8); PG8_WAIT_L(0); PG8_BAR; PG8_MMA(0, 0, At, B0); PG8_MMA(0, 1, At, B1); PG8_BAR; PG8_SCHED; \
            PG8_LDA(At, 1, 1); PG8_STAGE(PG8_SB(1, 0), _b3, voffB); PG8_STAGE(PG8_SB(1, 1), _b3 + hstep, voffB); PG8_STAGE_A(PG8_SA(1, 0), _a3, off2, 0); \
            PG8_WAIT_V(8); PG8_WAIT_L(0); PG8_BAR; PG8_MMA(1, 0, At, B0); PG8_MMA(1, 1, At, B1); PG8_BAR; PG8_SCHED; } while (0)
    int ui = 0;
    const char* cA; const char* cB;
    if (!S.bases(0, cA, cB)) return;
    f32x4 acc[2][2][4][2];
#pragma unroll
    for (int a = 0; a < 2; ++a)
#pragma unroll
        for (int b = 0; b < 2; ++b)
#pragma unroll
            for (int m = 0; m < 4; ++m)
#pragma unroll
                for (int n = 0; n < 2; ++n) acc[a][b][m][n] = (f32x4){0.f, 0.f, 0.f, 0.f};
    bf16x8 At[4][2], B0[2][2], B1[2][2];
    unsigned sc1 = 0x7f7f7f7fu; asm volatile("" : "+v"(sc1));
    unsigned coff[2][2], noff[2][2];
    if constexpr (Sched::GATHER) S.aoffs(0, rA, voffA, coff);
    PG8_STAGE(PG8_SB(0, 0), cB, voffB); PG8_STAGE(PG8_SB(0, 1), cB + hstep, voffB); PG8_STAGE_A(PG8_SA(0, 0), cA, coff, 0); PG8_STAGE_A(PG8_SA(0, 1), cA, coff, 1);
    if (wr == 1) PG8_BAR;
    PG8_WAIT_V(2); PG8_BAR;
    PG8_STAGE(PG8_SB(1, 0), cB + kstep, voffB); PG8_STAGE_A(PG8_SA(1, 0), cA + kstep, coff, 0); PG8_STAGE(PG8_SB(1, 1), cB + hstep + kstep, voffB);
    PG8_WAIT_V(6); PG8_BAR;
    for (;;) {
        const char* nA; const char* nB;
        const bool has_next = S.bases(ui + 1, nA, nB);
        if (!has_next) { nA = cA; nB = cB; }
        int ntok[2][2];
        if constexpr (Sched::GATHER) { if (has_next) S.atoks(ui + 1, rA, ntok); }
#pragma nounroll
        for (int t = 0; t < nt - 2; t += 2) PG8_KBODY(cA + (size_t)(t + 1) * kstep, cA + (size_t)(t + 2) * kstep, cB + (size_t)(t + 2) * kstep, coff);
        if constexpr (Sched::GATHER) {
            if (has_next) { asm volatile("" : "+v"(ntok[0][0]), "+v"(ntok[0][1]), "+v"(ntok[1][0]), "+v"(ntok[1][1]));
#pragma unroll
                for (int h = 0; h < 2; ++h)
#pragma unroll
                    for (int i = 0; i < 2; ++i) noff[h][i] = (unsigned)ntok[h][i] * (unsigned)RB + voffA[i]; }
            else {
#pragma unroll
                for (int h = 0; h < 2; ++h)
#pragma unroll
                    for (int i = 0; i < 2; ++i) noff[h][i] = coff[h][i]; }
        }
        PG8_KBODY(cA + (size_t)(nt - 1) * kstep, nA, nB, noff);
        if (wr == 0) PG8_BAR;
        if constexpr (FP8) asm volatile("s_nop 15\n\ts_nop 3" ::: "memory");
        {
            const int t2 = lane_id_fresh();
            const int w2 = wave_id, l2 = t2 & 63;
            Unit cur; S.unit(ui, cur); E(acc, cur, w2 >> 2, w2 & 3, l2 & 15, l2 >> 4); }
        if (!has_next) break;
#pragma unroll
        for (int a = 0; a < 2; ++a)
#pragma unroll
            for (int b = 0; b < 2; ++b)
#pragma unroll
                for (int m = 0; m < 4; ++m)
#pragma unroll
                    for (int n = 0; n < 2; ++n) acc[a][b][m][n] = (f32x4){0.f, 0.f, 0.f, 0.f};
        cA = nA; cB = nB; ++ui;
        if constexpr (Sched::GATHER) {
#pragma unroll
            for (int h = 0; h < 2; ++h)
#pragma unroll
                for (int i = 0; i < 2; ++i) coff[h][i] = noff[h][i]; }
        if (wr == 1) PG8_BAR;
    }
    PG8_WAIT_V(0);
    PG8_BAR;
#undef PG8_SA
#undef PG8_SB
#undef PG8_STAGE
#undef PG8_STAGE_A
#undef PG8_KBODY
#undef PG8_LDA
#undef PG8_LDB
#undef PG8_MMA
#undef PG8_WAIT_V
#undef PG8_WAIT_L
#undef PG8_BAR
#undef PG8_SCHED
}
__device__ __forceinline__ int xcd_remap(long L, int nwg) { const int q = nwg / 8, r = nwg % 8, xcd = (int)(L % 8), off = (int)(L / 8); return (xcd < r ? xcd * (q + 1) : r * (q + 1) + (xcd - r) * q) + off; }
struct RectSched {
    static constexpr bool GATHER = false;
    const char* A; const char* B; int RB, nM, nN, G, c, nM2, nN2, pm2, pn2;
    __device__ __forceinline__ bool unit(int i, Unit& u) const {
        const int n1 = nM * nN, nwg = n1 + nM2 * nN2; const long L = (long)i * G + c; if (L >= nwg) return false;
        int w = xcd_remap(L, nwg); int rm = nM, rn = nN, pm0 = 0, pn0 = 0;
        if (w >= n1) { w -= n1; rm = nM2; rn = nN2; pm0 = pm2; pn0 = pn2; }
        const int nig = 8 * rn, gid = w / nig, fm = gid * 8, gsz = (rm - fm) < 8 ? (rm - fm) : 8;
        u.pm = pm0 + fm + ((w % nig) % gsz); u.pn = pn0 + (w % nig) / gsz; u.e = 0; u.rows = 256; u.base = u.pm * 256; u.newe = 0;
        return true;
    }
    __device__ __forceinline__ bool bases(int i, const char*& a, const char*& b) const {
        Unit u; if (!unit(i, u)) return false;
        a = A + (size_t)u.pm * 256 * RB; b = B + (size_t)u.pn * 256 * RB; return true;
    }
    __device__ __forceinline__ void aoffs(int, const int (&)[2], const unsigned (&)[2], unsigned (&)[2][2]) const {}
    __device__ __forceinline__ void atoks(int, const int (&)[2], int (&)[2][2]) const {}
};
}

template <class MapF>
__device__ __forceinline__ void transpose_item(const float* W, int K, int N, bf16* WT, MapF rowmap, float* scr, int item, int lane) {
    const int nblk = N / 32, kb = item / nblk, nb = item % nblk, k0 = 64 * kb, n0 = 32 * nb;
#pragma unroll 8
    for (int i = 0; i < 32; ++i) { const int kk = 2 * i + (lane >> 5); scr[kk * 33 + (lane & 31)] = W[(size_t)(k0 + kk) * N + n0 + (lane & 31)]; }
    asm volatile("s_waitcnt lgkmcnt(0)" ::: "memory");
    const int c = lane & 7;
#pragma unroll
    for (int j = 0; j < 4; ++j) { const int n = (lane >> 3) + 8 * j; const float* s = scr + (8 * c) * 33 + n;
        v4u o; o.x = pk2(s[0 * 33], s[1 * 33]); o.y = pk2(s[2 * 33], s[3 * 33]); o.z = pk2(s[4 * 33], s[5 * 33]); o.w = pk2(s[6 * 33], s[7 * 33]);
        *(v4u*)(WT + (size_t)rowmap(n0 + n) * K + k0 + 8 * c) = o; }
    asm volatile("s_waitcnt lgkmcnt(0)" ::: "memory");
}
template <class MapF>
__device__ __forceinline__ void transpose_item8(const float* W, int K, int N, unsigned char* WT, MapF rowmap, float* scr, int item, int lane) {
    const int nblk = N / 32, kb = item / nblk, nb = item % nblk, k0 = 128 * kb, n0 = 32 * nb;
    const int r8 = lane >> 3, c8 = lane & 7;
    f32x4 t[16];
#pragma unroll
    for (int i = 0; i < 16; ++i) t[i] = __builtin_nontemporal_load((const f32x4*)(W + (size_t)(k0 + 8 * i + r8) * N + n0 + 4 * c8));
#pragma unroll
    for (int i = 0; i < 16; ++i) *(f32x4*)(scr + (8 * i + r8) * 36 + 4 * c8) = t[i] * W8_SCALE;
    asm volatile("s_waitcnt lgkmcnt(0)" ::: "memory");
#pragma unroll
    for (int j = 0; j < 4; ++j) {
        const int n = r8 + 8 * j; const float* s = scr + (16 * c8) * 36 + n;
        v4u o;
        o.x = pk4_fp8(s[0 * 36], s[1 * 36], s[2 * 36], s[3 * 36]); o.y = pk4_fp8(s[4 * 36], s[5 * 36], s[6 * 36], s[7 * 36]);
        o.z = pk4_fp8(s[8 * 36], s[9 * 36], s[10 * 36], s[11 * 36]); o.w = pk4_fp8(s[12 * 36], s[13 * 36], s[14 * 36], s[15 * 36]);
        *(v4u*)(WT + (size_t)rowmap(n0 + n) * K + k0 + 16 * c8) = o;
    }
    asm volatile("s_waitcnt lgkmcnt(0)" ::: "memory");
}
__device__ __forceinline__ void convert_experts(const CAS Args& a, const Frame& F) {
    float* scr = (float*)(F.lds + F.wave * 18432);
    unsigned char* WE = (unsigned char*)(a.ws + WS_WEXP);
    constexpr int IPM = 8 * 32;
    for (int it = F.gw; it < 2 * NE * 3 * IPM; it += F.ngw) {
        const int m = it / IPM, r = it % IPM, le = m / 3, which = m % 3;
        const float* W = (which == 0 ? a.in[31] : which == 1 ? a.in[33] : a.in[35]) + ((size_t)le << 20);
        unsigned char* dst = WE + (size_t)le * 3072 * 1024;
        if (which == 0) transpose_item8(W, D, D, dst, [](int n) { return ((n >> 7) << 8) + (n & 127); }, scr, r, F.lane);
        else if (which == 1) transpose_item8(W, D, D, dst, [](int n) { return ((n >> 7) << 8) + 128 + (n & 127); }, scr, r, F.lane);
        else transpose_item8(W, D, D, dst + (size_t)2048 * 1024,
            [](int f) { return (f & ~255) | (((f >> 3) & 1) << 7) | (((f >> 6) & 3) << 5) | (((f >> 4) & 3) << 3) | (f & 7); }, scr, r, F.lane);
    }
}
__device__ __forceinline__ void p0_prologue(const CAS Args& a, const Frame& F) {
    float* scr = (float*)(F.lds + F.wave * 8448);
    constexpr int I_IN0 = 16 * 96, I_O = 16 * 32, I_IN1 = 16 * 64, I_LRU1 = 4 * 8;
    constexpr int NSMALL = I_IN0 + I_O + I_IN1 + I_O + 16 * I_LRU1;
    for (int it = F.gw; it < NSMALL; it += F.ngw) {
        int r = it;
        if (r < I_IN0) {
            transpose_item(a.in[8], D, 3072, (bf16*)(a.ws + WS_WIN0), [](int f) {
                if (f < 2048) return (f & ~255) | (((f >> 5) & 1) << 7) | (((f >> 6) & 3) << 5) | (f & 31);
                if (f < 2560) { const int j = f - 2048; return (8 + (j >> 7)) * 256 + (j & 127); }
                const int j = f - 2560; return (8 + (j >> 7)) * 256 + 128 + (j & 127); }, scr, r, F.lane); continue; } r -= I_IN0;
        if (r < I_O) { transpose_item(a.in[9], D, D, (bf16*)(a.ws + WS_WOUT0), [](int n) { return n; }, scr, r, F.lane); continue; } r -= I_O;
        if (r < I_IN1) { transpose_item(a.in[15], D, 2048, (bf16*)(a.ws + WS_WIN1), [](int n) { return n; }, scr, r, F.lane); continue; } r -= I_IN1;
        if (r < I_O) { transpose_item(a.in[16], D, D, (bf16*)(a.ws + WS_WOUT1), [](int n) { return n; }, scr, r, F.lane); continue; } r -= I_O;
        const int gh = r / I_LRU1, rr = r % I_LRU1, g = gh >> 2, h = gh & 3;
        const float* W = (g == 0 ? a.in[19] : g == 1 ? a.in[21] : g == 2 ? a.in[24] : a.in[26]) + (size_t)h * 65536;
        transpose_item(W, 256, 256, (bf16*)(a.ws + WS_WLRU) + (size_t)h * 1024 * 256, [g](int n) { return g * 256 + n; }, scr, rr, F.lane);
    }
    __syncthreads();
    convert_experts(a, F);
    __syncthreads();
    float* sc = (float*)F.lds;
    float* red = (float*)(F.lds + 17 * 1024 * 4);
    {
#pragma unroll
        for (int hbat = 0; hbat < 2; ++hbat) { float tv[17];
#pragma unroll
            for (int j = 0; j < 17; ++j) { const int i = F.tid + 512 * (17 * hbat + j); tv[j] = i < 16 * 1024 ? a.in[1][i] : a.in[3][i - 16 * 1024]; }
#pragma unroll
            for (int j = 0; j < 17; ++j) { const int i = F.tid + 512 * (17 * hbat + j); sc[i] = tv[j] / (1.0f + __expf(-tv[j])); } }
    }
    __syncthreads();
    float* MOD = (float*)(a.ws + WS_MOD);
    for (int u = F.bid; u < 192; u += F.G) {
        const int l = u / 96, n = (u % 96) * 64 + F.lane;
        const float* w = a.in[4] + (size_t)l * D * 6144 + n;
        float acc[17];
#pragma unroll
        for (int b = 0; b < 17; ++b) acc[b] = 0.f;
        for (int k0 = F.wave * 128; k0 < F.wave * 128 + 128; k0 += 16) {
            float wv[16];
#pragma unroll
            for (int q = 0; q < 16; ++q) wv[q] = __builtin_nontemporal_load(w + (size_t)(k0 + q) * 6144);
#pragma unroll
            for (int q = 0; q < 16; ++q)
#pragma unroll
                for (int b = 0; b < 17; ++b) acc[b] += sc[b * 1024 + k0 + q] * wv[q];
        }
#pragma unroll
        for (int b = 0; b < 17; ++b) red[(F.wave * 17 + b) * 64 + F.lane] = acc[b];
        __syncthreads();
        for (int i = F.tid; i < 17 * 64; i += NWAVES * 64) {
            const int b = i / 64, ln = i % 64; float s = 0.f;
#pragma unroll
            for (int w8 = 0; w8 < 8; ++w8) s += red[(w8 * 17 + b) * 64 + ln];
            const int nn = (u % 96) * 64 + ln;
            MOD[((size_t)l * 17 + b) * 6144 + nn] = s + a.in[5][l * 6144 + nn];
        }
        __syncthreads();
    }
}

__device__ __forceinline__ void load_row16(const float* row, int lane, float (&v)[16]) {
#pragma unroll
    for (int j = 0; j < 4; ++j) { const f32x4 t = *(const f32x4*)(row + 256 * j + 4 * lane); v[4 * j] = t.x; v[4 * j + 1] = t.y; v[4 * j + 2] = t.z; v[4 * j + 3] = t.w; }
}
__device__ __forceinline__ void load_row16_bf16(const bf16* row, int lane, float (&v)[16]) {
#pragma unroll
    for (int j = 0; j < 4; ++j) { const uint2 t = *(const uint2*)(row + 256 * j + 4 * lane); v[4 * j] = __uint_as_float(t.x << 16); v[4 * j + 1] = __uint_as_float(t.x & 0xffff0000u); v[4 * j + 2] = __uint_as_float(t.y << 16); v[4 * j + 3] = __uint_as_float(t.y & 0xffff0000u); }
}
__device__ __forceinline__ void store_row16_bf16(bf16* row, int lane, const float (&v)[16]) {
#pragma unroll
    for (int j = 0; j < 4; ++j) { uint2 o; o.x = pk2(v[4 * j], v[4 * j + 1]); o.y = pk2(v[4 * j + 2], v[4 * j + 3]); *(uint2*)(row + 256 * j + 4 * lane) = o; }
}
__device__ __forceinline__ void store_row16_f32(float* row, int lane, const float (&v)[16]) {
#pragma unroll
    for (int j = 0; j < 4; ++j) *(f32x4*)(row + 256 * j + 4 * lane) = (f32x4){v[4 * j], v[4 * j + 1], v[4 * j + 2], v[4 * j + 3]};
}
template <bool FP8OUT = false>
__device__ __forceinline__ void norm_mod(const float (&v)[16], const float* g, const float* sh, const float* sc, bf16* out, int lane, float (&hv)[16]) {
    float s = 0.f;
#pragma unroll
    for (int i = 0; i < 16; ++i) s += v[i] * v[i];
    const float rstd = rsqrtf(wave_sum(s) * (1.0f / D) + 1e-6f);
#pragma unroll
    for (int j = 0; j < 4; ++j) {
        const int e = 256 * j + 4 * lane;
        const f32x4 gg = *(const f32x4*)(g + e), ss = *(const f32x4*)(sh + e), cc = *(const f32x4*)(sc + e);
        hv[4 * j] = v[4 * j] * rstd * gg.x * (1.f + cc.x) + ss.x; hv[4 * j + 1] = v[4 * j + 1] * rstd * gg.y * (1.f + cc.y) + ss.y;
        hv[4 * j + 2] = v[4 * j + 2] * rstd * gg.z * (1.f + cc.z) + ss.z; hv[4 * j + 3] = v[4 * j + 3] * rstd * gg.w * (1.f + cc.w) + ss.w;
        if (FP8OUT) *(unsigned*)((unsigned char*)out + e) = pk4_fp8(hv[4 * j], hv[4 * j + 1], hv[4 * j + 2], hv[4 * j + 3]);
        else { uint2 o; o.x = pk2(hv[4 * j], hv[4 * j + 1]); o.y = pk2(hv[4 * j + 2], hv[4 * j + 3]); *(uint2*)(out + e) = o; }
    }
}
__device__ __forceinline__ int row_batch(int r) { return r < NT ? (r >> 11) : 16; }
__device__ __forceinline__ const float* mod_ptr(const CAS Args& a, int l, int r, int chunk) { return (const float*)(a.ws + WS_MOD) + ((size_t)l * 17 + row_batch(r)) * 6144 + chunk * D; }

__device__ __forceinline__ void p_norm1_l0(const CAS Args& a, const Frame& F) {
    bf16* H = (bf16*)(a.ws + WS_H);
    { float* GS2 = (float*)(a.ws + WS_GS2); const float* MOD = (const float*)(a.ws + WS_MOD);
      for (int i = F.gw * 64 + F.lane; i < 2 * 17 * D; i += F.ngw * 64) { const int l = i / (17 * D), bb = (i / D) % 17, k = i % D; GS2[i] = a.in[7][l * D + k] * (1.0f + MOD[((size_t)l * 17 + bb) * 6144 + 4 * D + k]); } }
    for (int r = F.gw; r < R; r += 3 * F.ngw) {
        float v[3][16], hv[16];
#pragma unroll
        for (int k = 0; k < 3; ++k) { const int rr = r + k * F.ngw; if (rr < R) load_row16(rr < NT ? a.in[0] + (size_t)rr * D : a.in[2] + (size_t)(rr - NT) * D, F.lane, v[k]); }
#pragma unroll
        for (int k = 0; k < 3; ++k) { const int rr = r + k * F.ngw; if (rr < R) norm_mod(v[k], a.in[6], mod_ptr(a, 0, rr, 0), mod_ptr(a, 0, rr, 1), H + (size_t)rr * D, F.lane, hv); }
    }
}

struct EpiInProj0 {
    static constexpr bool PERM = true;
    bf16* P; const float* qg; const float* kg;
    __device__ __forceinline__ void operator()(const f32x4 (&acc)[2][2][4][2], const pg8::Unit& u, int wr, int wc, int fr, int fq) const {
        const int row0 = u.pm * 256 + wr * 64 + fr, pn = u.pn;
        if (pn < 4) {
            const float* g = pn < 2 ? qg : kg; const float sc = pn < 2 ? 0.125f : 1.0f;
            f32x4 gv[2][2];
#pragma unroll
            for (int bj = 0; bj < 2; ++bj)
#pragma unroll
                for (int n = 0; n < 2; ++n) gv[bj][n] = *(const f32x4*)(g + 32 * bj + 8 * fq + 4 * n);
#pragma unroll
            for (int ai = 0; ai < 2; ++ai)
#pragma unroll
                for (int m = 0; m < 4; ++m) {
                    float ss = 0.f;
#pragma unroll
                    for (int bj = 0; bj < 2; ++bj)
#pragma unroll
                        for (int n = 0; n < 2; ++n) { const f32x4 x = acc[ai][bj][m][n]; ss += (x[0] * x[0] + x[1] * x[1]) + (x[2] * x[2] + x[3] * x[3]); }
                    ss += __shfl_xor(ss, 16); ss += __shfl_xor(ss, 32);
                    const float rs = rsqrtf(ss * (1.0f / 64.0f) + 1e-6f) * sc;
                    bf16* rowp = P + (size_t)(row0 + ai * 128 + m * 16) * PP + pn * 256 + wc * 64 + 8 * fq;
#pragma unroll
                    for (int bj = 0; bj < 2; ++bj) { const f32x4 v0 = acc[ai][bj][m][0] * rs * gv[bj][0], v1 = acc[ai][bj][m][1] * rs * gv[bj][1];
                        v4u w; w.x = pg8::cvt_pk_bf16(v0[0], v0[1]); w.y = pg8::cvt_pk_bf16(v0[2], v0[3]); w.z = pg8::cvt_pk_bf16(v1[0], v1[1]); w.w = pg8::cvt_pk_bf16(v1[2], v1[3]);
                        *(v4u*)(rowp + 32 * bj) = w; }
                }
        } else if (pn < 8) {
#pragma unroll
            for (int ai = 0; ai < 2; ++ai)
#pragma unroll
                for (int m = 0; m < 4; ++m) { bf16* rowp = P + (size_t)(row0 + ai * 128 + m * 16) * PP + pn * 256 + wc * 64 + 8 * fq;
#pragma unroll
                    for (int bj = 0; bj < 2; ++bj) { const f32x4 v0 = acc[ai][bj][m][0], v1 = acc[ai][bj][m][1];
                        v4u w; w.x = pg8::cvt_pk_bf16(v0[0], v0[1]); w.y = pg8::cvt_pk_bf16(v0[2], v0[3]); w.z = pg8::cvt_pk_bf16(v1[0], v1[1]); w.w = pg8::cvt_pk_bf16(v1[2], v1[3]);
                        *(v4u*)(rowp + 32 * bj) = w; } }
        } else {
#pragma unroll
            for (int ai = 0; ai < 2; ++ai)
#pragma unroll
                for (int m = 0; m < 4; ++m) { bf16* rowp = P + (size_t)(row0 + ai * 128 + m * 16) * PP + 2048 + (pn - 8) * 128 + wc * 32 + 8 * fq;
                    const f32x4 v0 = acc[ai][0][m][0] * acc[ai][1][m][0], v1 = acc[ai][0][m][1] * acc[ai][1][m][1];
                    v4u w; w.x = pg8::cvt_pk_bf16(v0[0], v0[1]); w.y = pg8::cvt_pk_bf16(v0[2], v0[3]); w.z = pg8::cvt_pk_bf16(v1[0], v1[1]); w.w = pg8::cvt_pk_bf16(v1[2], v1[3]);
                    *(v4u*)rowp = w; }
        }
    }
};
__device__ __forceinline__ void p_inproj0(const CAS Args& a, const Frame& F) {
    pg8::RectSched S{(const char*)(a.ws + WS_H), (const char*)(a.ws + WS_WIN0), 2 * D, R / 256, 3072 / 256, F.G, F.bid, 0, 0, 0, 0};
    EpiInProj0 E{(bf16*)(a.ws + WS_P), a.in[10], a.in[11]};
    pg8::gemm_phase<2 * D, false>(F.ldsl, S, E, F.wave);
}
typedef __bf16 bf16x2_t __attribute__((ext_vector_type(2)));
typedef float f32x2_t __attribute__((ext_vector_type(2)));
typedef short s16x4 __attribute__((ext_vector_type(4)));
__device__ __forceinline__ unsigned pk_bf16(float a, float b) { f32x2_t v = {a, b}; bf16x2_t r = __builtin_convertvector(v, bf16x2_t); return __builtin_bit_cast(unsigned, r); }
constexpr int AT_LAT = 0, AT_CK = 576 * 128, AT_CV = AT_CK + 256 * 128, AT_RPB = AT_CV + 256 * 128;
__device__ __forceinline__ int at_swz(int key) { return (key ^ (key >> 3)) & 7; }
__device__ __forceinline__ unsigned at_addr(int key, int chunk) { return (unsigned)(key * 128 + ((chunk ^ at_swz(key)) << 4)); }
template <class RowF>
__device__ __forceinline__ void at_stage(LAS unsigned char* dst, int npieces, RowF rowf, int colbyte, const bf16* P, int wave, int lane) {
    for (int p = wave; p < npieces; p += NWAVES) {
        const int key = 8 * p + (lane >> 3), c = (lane & 7) ^ at_swz(key);
        const char* src = (const char*)P + (size_t)rowf(key) * (PP * 2) + colbyte + 16 * c;
        __builtin_amdgcn_global_load_lds((const unsigned*)src, (LAS unsigned*)(dst + p * 1024), 16, 0, 0);
    }
}
__device__ __forceinline__ void at_tr8(unsigned a0, unsigned a1, unsigned a2, unsigned a3, unsigned a4, unsigned a5, unsigned a6, unsigned a7, s16x4 (&r)[8]) {
    asm volatile("ds_read_b64_tr_b16 %0, %8\n\tds_read_b64_tr_b16 %1, %9\n\tds_read_b64_tr_b16 %2, %10\n\tds_read_b64_tr_b16 %3, %11\n\t"
                 "ds_read_b64_tr_b16 %4, %12\n\tds_read_b64_tr_b16 %5, %13\n\tds_read_b64_tr_b16 %6, %14\n\tds_read_b64_tr_b16 %7, %15\n\ts_waitcnt lgkmcnt(0)"
                 : "=&v"(r[0]), "=&v"(r[1]), "=&v"(r[2]), "=&v"(r[3]), "=&v"(r[4]), "=&v"(r[5]), "=&v"(r[6]), "=&v"(r[7])
                 : "v"(a0), "v"(a1), "v"(a2), "v"(a3), "v"(a4), "v"(a5), "v"(a6), "v"(a7) : "memory");
}
__device__ __forceinline__ void p_attn(const CAS Args& a, const Frame& F) {
    const bf16* P = (const bf16*)(a.ws + WS_P); bf16* A2 = (bf16*)(a.ws + WS_A2);
    LAS unsigned char* lds = F.ldsl;
    const int lane = F.lane, wave = F.wave, rho = lane & 15, g = lane >> 4;
    for (int wu = F.bid; wu < NB * 8 * 2; wu += F.G) {
        const int half = wu & 1, hd = (wu >> 1) & 7, b = wu >> 4;
        __syncthreads();
        for (int i = F.tid; i < 465; i += NWAVES * 64) ((LAS float*)(lds + AT_RPB))[i] = a.in[12][hd * 465 + i];
        at_stage(lds + AT_CK, 32, [=](int key) { return NT + b * 256 + key; }, (512 + hd * 64) * 2, P, wave, lane);
        at_stage(lds + AT_CV, 32, [=](int key) { return NT + b * 256 + key; }, (1024 + hd * 64) * 2, P, wave, lane);
        for (int un = 0; un < 9; ++un) {
            const bool lat = un < 8;
            int r = 0, n = 0, qrow, krow_lo = 0;
            if (lat) { const int rp = half * 8 + un; r = 2 * rp + (wave >> 2); n = wave & 3; qrow = b * 2048 + r * 64 + 16 * n + rho; krow_lo = min(max(2 * rp - 4, 0), 24); }
            else qrow = NT + b * 256 + half * 128 + 16 * wave + rho;
            const int r0 = min(max(r - 4, 0), 24), ro = r0 - krow_lo, kc0 = min(max(16 * n - 8, 0), 32);
            const int c = 16 * n + rho, c0 = min(max(c - 8, 0), 48);
            if (lat) at_stage(lds + AT_LAT, 72, [=](int key) { return b * 2048 + min(krow_lo + (key >> 6), 31) * 64 + (key & 63); }, (512 + hd * 64) * 2, P, wave, lane);
            const bf16x8 q0 = *(const bf16x8*)(P + (size_t)qrow * PP + hd * 64 + 8 * g), q1 = *(const bf16x8*)(P + (size_t)qrow * PP + hd * 64 + 32 + 8 * g);
            asm volatile("s_waitcnt vmcnt(0)" ::: "memory");
            __syncthreads();
            const int pk = 8 * (rho >> 2) + (rho & 3);
            float mxb[2] = {-1e30f, -1e30f}, smb[2] = {0.f, 0.f}; v4u pf[16];
#pragma unroll
            for (int blk = 0; blk < 2; ++blk) {
                if (blk == 0 && !lat) {
#pragma unroll
                    for (int i = 0; i < 8; ++i) pf[i] = (v4u){0u, 0u, 0u, 0u};
                    continue; }
                f32x4 s[16];
#pragma unroll
                for (int i = 0; i < 8; ++i)
#pragma unroll
                    for (int t = 0; t < 2; ++t) {
                        const int key = (blk == 0 ? (ro + i) * 64 + kc0 : 32 * i) + pk + 4 * t;
                        const unsigned kbase = blk == 0 ? AT_LAT : AT_CK;
                        const bf16x8 k0 = *(const LAS bf16x8*)(lds + kbase + at_addr(key, g)), k1 = *(const LAS bf16x8*)(lds + kbase + at_addr(key, 4 + g));
                        f32x4 acc = __builtin_amdgcn_mfma_f32_16x16x32_bf16(k0, q0, (f32x4){0.f, 0.f, 0.f, 0.f}, 0, 0, 0);
                        acc = __builtin_amdgcn_mfma_f32_16x16x32_bf16(k1, q1, acc, 0, 0, 0);
                        if (blk == 0) {
                            const int dr = r0 + i - r + 7;
#pragma unroll
                            for (int jj = 0; jj < 4; ++jj) { const int kcol = kc0 + 8 * g + 4 * t + jj; const int dc = min(max(kcol - c + 15, 0), 30);
                                const float bias = ((const LAS float*)(lds + AT_RPB))[dr * 31 + dc];
                                acc[jj] = ((unsigned)(kcol - c0) < 16u) ? acc[jj] + bias : -1e30f; }
                        }
                        s[2 * i + t] = acc;
                    }
                float mx = -1e30f;
#pragma unroll
                for (int i = 0; i < 16; ++i) mx = fmaxf(fmaxf(mx, fmaxf(s[i][0], s[i][1])), fmaxf(s[i][2], s[i][3]));
                mx = fmaxf(mx, __shfl_xor(mx, 16)); mx = fmaxf(mx, __shfl_xor(mx, 32));
                float sum = 0.f;
#pragma unroll
                for (int i = 0; i < 8; ++i) {
                    float e[8];
#pragma unroll
                    for (int t = 0; t < 2; ++t)
#pragma unroll
                        for (int jj = 0; jj < 4; ++jj) { e[4 * t + jj] = __expf(s[2 * i + t][jj] - mx); sum += e[4 * t + jj]; }
                    pf[8 * blk + i].x = pk_bf16(e[0], e[1]); pf[8 * blk + i].y = pk_bf16(e[2], e[3]); pf[8 * blk + i].z = pk_bf16(e[4], e[5]); pf[8 * blk + i].w = pk_bf16(e[6], e[7]);
                }
                sum += __shfl_xor(sum, 16); sum += __shfl_xor(sum, 32);
                mxb[blk] = mx; smb[blk] = sum;
            }
            __syncthreads();
            if (lat) at_stage(lds + AT_LAT, 72, [=](int key) { return b * 2048 + min(krow_lo + (key >> 6), 31) * 64 + (key & 63); }, (1024 + hd * 64) * 2, P, wave, lane);
            asm volatile("s_waitcnt vmcnt(0)" ::: "memory");
            __syncthreads();
            f32x4 o[2][4];
#pragma unroll
            for (int blk = 0; blk < 2; ++blk)
#pragma unroll
                for (int db = 0; db < 4; ++db) o[blk][db] = (f32x4){0.f, 0.f, 0.f, 0.f};
            const int tq = rho >> 2, tp = rho & 3;
#pragma unroll
            for (int ch = 0; ch < 16; ++ch) {
                if (ch < 8 && !lat) continue;
                int zo = 0; asm volatile("" : "+v"(zo));
                const int kb = (ch < 8 ? (ro + ch) * 64 + kc0 + 8 * g + tq : 32 * (ch - 8) + 8 * g + tq) + zo;
                const unsigned base = (unsigned)(size_t)(lds + (ch < 8 ? AT_LAT : AT_CV));
                unsigned ad[8];
#pragma unroll
                for (int db = 0; db < 4; ++db) { ad[2 * db] = base + at_addr(kb, 2 * db + (tp >> 1)) + 8 * (tp & 1); ad[2 * db + 1] = base + at_addr(kb + 4, 2 * db + (tp >> 1)) + 8 * (tp & 1); }
                s16x4 vr[8]; at_tr8(ad[0], ad[1], ad[2], ad[3], ad[4], ad[5], ad[6], ad[7], vr);
#pragma unroll
                for (int db = 0; db < 4; ++db) { const bf16x8 vf = __builtin_shufflevector(vr[2 * db], vr[2 * db + 1], 0, 1, 2, 3, 4, 5, 6, 7);
                    o[ch >> 3][db] = __builtin_amdgcn_mfma_f32_16x16x32_bf16(vf, __builtin_bit_cast(bf16x8, pf[ch]), o[ch >> 3][db], 0, 0, 0); }
            }
            const float mxa = fmaxf(mxb[0], mxb[1]), f0 = __expf(mxb[0] - mxa), f1 = __expf(mxb[1] - mxa);
            const float inv = 1.0f / (f0 * smb[0] + f1 * smb[1]), g0 = f0 * inv, g1 = f1 * inv;
#pragma unroll
            for (int db = 0; db < 4; ++db) { uint2 w; w.x = pk_bf16(o[0][db][0] * g0 + o[1][db][0] * g1, o[0][db][1] * g0 + o[1][db][1] * g1); w.y = pk_bf16(o[0][db][2] * g0 + o[1][db][2] * g1, o[0][db][3] * g0 + o[1][db][3] * g1);
                *(uint2*)(A2 + (size_t)qrow * D + hd * 64 + 16 * db + 4 * g) = w; }
            __syncthreads();
        }
    }
    const float* cw = a.in[13]; const float* cb = a.in[14];
    const int j0 = 8 * lane;
    float w0[8], w1[8], w2[8], bb[8];
#pragma unroll
    for (int q = 0; q < 8; ++q) { w0[q] = cw[j0 + q]; w1[q] = cw[512 + j0 + q]; w2[q] = cw[1024 + j0 + q]; bb[q] = cb[j0 + q]; }
    for (int blk = F.gw; blk < R / 6; blk += F.ngw) {
        const int row0 = 6 * blk;
        v4u pw[8], bgw[6];
#pragma unroll
        for (int k = 0; k < 8; ++k) { const int rr = row0 + k - 1; pw[k] = (rr >= 0 && rr < R) ? *(const v4u*)(P + (size_t)rr * PP + 2048 + j0) : (v4u){0u, 0u, 0u, 0u}; }
#pragma unroll
        for (int k = 0; k < 6; ++k) bgw[k] = *(const v4u*)(P + (size_t)(row0 + k) * PP + 1536 + j0);
#pragma unroll
        for (int k = 0; k < 6; ++k) {
            const int row = row0 + k; const bool latr = row < NT; const int t = latr ? (row & 2047) : ((row - NT) & 255), len = latr ? 2048 : 256;
            const v4u pm = t > 0 ? pw[k] : (v4u){0u, 0u, 0u, 0u}, pc = pw[k + 1], pn = (t + 1 < len) ? pw[k + 2] : (v4u){0u, 0u, 0u, 0u}, bgv = bgw[k];
            const unsigned am[4] = {pm.x, pm.y, pm.z, pm.w}, ac[4] = {pc.x, pc.y, pc.z, pc.w}, an[4] = {pn.x, pn.y, pn.z, pn.w}, ab[4] = {bgv.x, bgv.y, bgv.z, bgv.w};
            unsigned ow[4];
#pragma unroll
            for (int q = 0; q < 4; ++q) {
                const float lo = __uint_as_float(ab[q] << 16) * (bb[2 * q] + w0[2 * q] * __uint_as_float(am[q] << 16) + w1[2 * q] * __uint_as_float(ac[q] << 16) + w2[2 * q] * __uint_as_float(an[q] << 16));
                const float hi = __uint_as_float(ab[q] & 0xffff0000u) * (bb[2 * q + 1] + w0[2 * q + 1] * __uint_as_float(am[q] & 0xffff0000u) + w1[2 * q + 1] * __uint_as_float(ac[q] & 0xffff0000u) + w2[2 * q + 1] * __uint_as_float(an[q] & 0xffff0000u));
                ow[q] = pk_bf16(lo, hi);
            }
            *(v4u*)(A2 + (size_t)row * D + 512 + j0) = (v4u){ow[0], ow[1], ow[2], ow[3]};
        }
    }
}
template <int L>
struct EpiOutProj {
    static constexpr bool PERM = true;
    const float* baseL; const float* baseC; bf16* XB; const float* MODl;
    __device__ __forceinline__ void operator()(const f32x4 (&acc)[2][2][4][2], const pg8::Unit& u, int wr, int wc, int fr, int fq) const {
        const bool lat = u.pm < NT / 256;
        const int mb = lat ? (u.pm >> 3) : 16;
        const int row0 = u.pm * 256 + wr * 64 + fr, col0 = u.pn * 256 + wc * 32 + 8 * fq;
        const float* g1 = MODl + (size_t)mb * 6144 + 2 * D + col0;
        f32x4 gv[2][2];
#pragma unroll
        for (int bj = 0; bj < 2; ++bj)
#pragma unroll
            for (int n = 0; n < 2; ++n) gv[bj][n] = *(const f32x4*)(g1 + bj * 128 + 4 * n);
#pragma unroll
        for (int ai = 0; ai < 2; ++ai)
#pragma unroll
            for (int m = 0; m < 4; ++m) { const int row = row0 + ai * 128 + m * 16;
#pragma unroll
                for (int bj = 0; bj < 2; ++bj) {
                    f32x4 b0, b1;
                    if (L == 0) { const float* bp = (lat ? baseL + (size_t)row * D : baseC + (size_t)(row - NT) * D) + col0 + bj * 128; b0 = *(const f32x4*)bp; b1 = *(const f32x4*)(bp + 4); }
                    else { const v4u w = *(const v4u*)(XB + (size_t)row * D + col0 + bj * 128);
                        b0 = (f32x4){__uint_as_float(w.x << 16), __uint_as_float(w.x & 0xffff0000u), __uint_as_float(w.y << 16), __uint_as_float(w.y & 0xffff0000u)};
                        b1 = (f32x4){__uint_as_float(w.z << 16), __uint_as_float(w.z & 0xffff0000u), __uint_as_float(w.w << 16), __uint_as_float(w.w & 0xffff0000u)}; }
                    const f32x4 v0 = b0 + gv[bj][0] * acc[ai][bj][m][0], v1 = b1 + gv[bj][1] * acc[ai][bj][m][1];
                    v4u o; o.x = pg8::cvt_pk_bf16(v0[0], v0[1]); o.y = pg8::cvt_pk_bf16(v0[2], v0[3]); o.z = pg8::cvt_pk_bf16(v1[0], v1[1]); o.w = pg8::cvt_pk_bf16(v1[2], v1[3]);
                    *(v4u*)(XB + (size_t)row * D + col0 + bj * 128) = o; }
                asm volatile("" ::: "memory"); }
    }
};
template <int L>
__device__ __forceinline__ void p_outproj(const CAS Args& a, const Frame& F) {
    pg8::RectSched S{(const char*)(a.ws + (L == 0 ? WS_A2 : WS_A3)), (const char*)(a.ws + (L == 0 ? WS_WOUT0 : WS_WOUT1)), 2 * D, (L == 0 ? R : NT) / 256, D / 256, F.G, F.bid, 0, 0, 0, 0};
    EpiOutProj<L> E{a.in[0], a.in[2], (bf16*)(a.ws + WS_XB), (const float*)(a.ws + WS_MOD) + (size_t)L * 17 * 6144};
    pg8::gemm_phase<2 * D, false>(F.ldsl, S, E, F.wave);
}
#define RS_STEP(half, m) do { const bool up = (F.lane & (m)) != 0; _Pragma("unroll") for (int i = 0; i < (half); ++i) { \
        const float keep = up ? part[i + (half)] : part[i]; const float send = up ? part[i] : part[i + (half)]; part[i] = keep + __shfl_xor(send, (m)); } } while (0)
constexpr int RT_WH = 0, RT_WL = 65536, RT_GS = 131072, RT_LG = 139264, RT_CNT = 155648;
__device__ __forceinline__ void p_norm2_router(const CAS Args& a, const Frame& F, int l) {
    unsigned char* H8 = (unsigned char*)(a.ws + WS_H); const bf16* XB = (const bf16*)(a.ws + WS_XB);
    unsigned* ctl = (unsigned*)(a.ws + WS_CTL);
    int* toklist = (int*)(a.ws + WS_TOKLIST); int* sel = (int*)(a.ws + WS_SEL); float* gatev = (float*)(a.ws + WS_GATEV);
    const float* wr = a.in[29] + (size_t)l * D * NE; const float* br = a.in[30] + l * NE;
    const float* GS2 = (const float*)(a.ws + WS_GS2) + (size_t)l * 17 * D; const float* MODl = (const float*)(a.ws + WS_MOD) + (size_t)l * 17 * 6144;
    const int rows = l == 0 ? R : NT, rpw = rows / F.G, row_lo = F.bid * rpw, nblk = rpw / 16;
    LAS unsigned char* lds = F.ldsl;
    const int lane = F.lane, wave = F.wave, rho = lane & 15, g = lane >> 4;
    const int b_first = row_batch(row_lo);
    __syncthreads();
    {
        f32x4 wv[16];
#pragma unroll
        for (int j = 0; j < 16; ++j) wv[j] = *(const f32x4*)(wr + 4 * (F.tid + 512 * j));
#pragma unroll
        for (int j = 0; j < 16; ++j) { const int i0 = 4 * (F.tid + 512 * j), k = i0 >> 5;
#pragma unroll
            for (int q = 0; q < 4; ++q) { const int e = (i0 & 31) + q; const float w = wv[j][q]; const bf16 hi = f2bf(w), lo = f2bf(w - bf2f(hi));
                const int off = e * 2048 + 16 * ((k >> 3) ^ (e & 15)) + 2 * (k & 7);
                *(LAS bf16*)(lds + RT_WH + off) = hi; *(LAS bf16*)(lds + RT_WL + off) = lo; } }
    }
    for (int i = F.tid; i < 2 * D; i += NWAVES * 64) { const int s = i >> 10, k = i & 1023; const int bb = s == 0 ? b_first : row_batch(row_lo + rpw - 1); ((LAS float*)(lds + RT_GS))[i] = GS2[bb * D + k]; }
    LAS unsigned* wcnt = (LAS unsigned*)(lds + RT_CNT); LAS unsigned* wbase = wcnt + 32; LAS unsigned* stmp = wcnt + 64;
    if (F.tid < NE) wcnt[F.tid] = 0u;
    __syncthreads();
    for (int blk = wave; blk < nblk; blk += NWAVES) {
        const int r0 = row_lo + 16 * blk, row = r0 + rho, bb = row_batch(r0);
        const bf16* xr = XB + (size_t)row * D + 8 * g;
        float ss = 0.f;
#pragma unroll
        for (int kh = 0; kh < 2; ++kh) {
            v4u xw[16];
#pragma unroll
            for (int ks = 0; ks < 16; ++ks) xw[ks] = *(const v4u*)(xr + 32 * (16 * kh + ks));
#pragma unroll
            for (int ks = 0; ks < 16; ++ks) { const unsigned u4[4] = {xw[ks].x, xw[ks].y, xw[ks].z, xw[ks].w};
#pragma unroll
                for (int q = 0; q < 4; ++q) { const float x0 = __uint_as_float(u4[q] << 16), x1 = __uint_as_float(u4[q] & 0xffff0000u); ss += x0 * x0 + x1 * x1; } }
            asm volatile("" ::: "memory");
        }
        ss += __shfl_xor(ss, 16); ss += __shfl_xor(ss, 32);
        const float rstd = rsqrtf(ss * (1.0f / D) + 1e-6f);
        const LAS float* gs = (const LAS float*)(lds + RT_GS) + (bb == b_first ? 0 : D) + 8 * g;
        const float* sh = MODl + (size_t)bb * 6144 + 3 * D + 8 * g;
        f32x4 acc[2] = {(f32x4){0.f, 0.f, 0.f, 0.f}, (f32x4){0.f, 0.f, 0.f, 0.f}};
        int offb[4];
#pragma unroll
        for (int b4 = 0; b4 < 4; ++b4) offb[b4] = rho * 2048 + (((4 * (b4 ^ ((rho >> 2) & 3))) + (g ^ (rho & 3))) << 4);
        for (int k4 = 0; k4 < 8; ++k4) {
            v4u xw[4]; f32x4 sv[4][2];
#pragma unroll
            for (int b4 = 0; b4 < 4; ++b4) { const int ks = 4 * k4 + b4; xw[b4] = *(const v4u*)(xr + 32 * ks); sv[b4][0] = *(const f32x4*)(sh + 32 * ks); sv[b4][1] = *(const f32x4*)(sh + 32 * ks + 4); }
#pragma unroll
            for (int b4 = 0; b4 < 4; ++b4) {
                const int ks = 4 * k4 + b4;
                const unsigned u4[4] = {xw[b4].x, xw[b4].y, xw[b4].z, xw[b4].w};
                const f32x4 g0 = *(const LAS f32x4*)(gs + 32 * ks), g1 = *(const LAS f32x4*)(gs + 32 * ks + 4);
                const f32x4 s0 = sv[b4][0], s1 = sv[b4][1];
                float hv[8];
#pragma unroll
                for (int q = 0; q < 4; ++q) { const float x0 = __uint_as_float(u4[q] << 16) * rstd, x1 = __uint_as_float(u4[q] & 0xffff0000u) * rstd;
                    const float gg0 = q < 2 ? g0[2 * q] : g1[2 * q - 4], gg1 = q < 2 ? g0[2 * q + 1] : g1[2 * q - 3], t0 = q < 2 ? s0[2 * q] : s1[2 * q - 4], t1 = q < 2 ? s0[2 * q + 1] : s1[2 * q - 3];
                    hv[2 * q] = x0 * gg0 + t0; hv[2 * q + 1] = x1 * gg1 + t1; }
                v4u hi, lo;
#pragma unroll
                for (int q = 0; q < 4; ++q) { const unsigned p = pk_bf16(hv[2 * q], hv[2 * q + 1]); ((unsigned*)&hi)[q] = p;
                    ((unsigned*)&lo)[q] = pk_bf16(hv[2 * q] - __uint_as_float(p << 16), hv[2 * q + 1] - __uint_as_float(p & 0xffff0000u)); }
                { uint2 f8; unsigned t0 = 0u, t1 = 0u; t0 = __builtin_amdgcn_cvt_pk_fp8_f32(hv[0], hv[1], t0, false); t0 = __builtin_amdgcn_cvt_pk_fp8_f32(hv[2], hv[3], t0, true);
                  t1 = __builtin_amdgcn_cvt_pk_fp8_f32(hv[4], hv[5], t1, false); t1 = __builtin_amdgcn_cvt_pk_fp8_f32(hv[6], hv[7], t1, true); f8.x = t0; f8.y = t1;
                  *(uint2*)(H8 + (size_t)row * D + 32 * ks + 8 * g) = f8; }
#pragma unroll
                for (int nt = 0; nt < 2; ++nt) { const int off = nt * 32768 + k4 * 256 + offb[b4];
                    const bf16x8 bh = *(const LAS bf16x8*)(lds + RT_WH + off), bl = *(const LAS bf16x8*)(lds + RT_WL + off);
                    acc[nt] = __builtin_amdgcn_mfma_f32_16x16x32_bf16(__builtin_bit_cast(bf16x8, hi), bh, acc[nt], 0, 0, 0);
                    acc[nt] = __builtin_amdgcn_mfma_f32_16x16x32_bf16(__builtin_bit_cast(bf16x8, lo), bh, acc[nt], 0, 0, 0);
                    acc[nt] = __builtin_amdgcn_mfma_f32_16x16x32_bf16(__builtin_bit_cast(bf16x8, hi), bl, acc[nt], 0, 0, 0); }
            }
        }
        LAS float* lg = (LAS float*)(lds + RT_LG + wave * 2048);
#pragma unroll
        for (int nt = 0; nt < 2; ++nt)
#pragma unroll
            for (int jj = 0; jj < 4; ++jj) lg[(4 * g + jj) * 32 + 16 * nt + rho] = acc[nt][jj] + br[16 * nt + rho];
        {
            float mine[8], allv[32];
#pragma unroll
            for (int q = 0; q < 8; ++q) { const f32x4 t = *(const LAS f32x4*)(lg + rho * 32 + 4 * q); allv[4 * q] = t[0]; allv[4 * q + 1] = t[1]; allv[4 * q + 2] = t[2]; allv[4 * q + 3] = t[3]; }
#pragma unroll
            for (int q = 0; q < 8; ++q) mine[q] = g == 0 ? allv[q] : g == 1 ? allv[8 + q] : g == 2 ? allv[16 + q] : allv[24 + q];
            LAS float* rs = lg;
#pragma unroll
            for (int q = 0; q < 8; ++q) { const int e = 8 * g + q; int rank = 0;
#pragma unroll
                for (int jx = 0; jx < 32; ++jx) rank += (allv[jx] > mine[q] || (allv[jx] == mine[q] && jx < e)) ? 1 : 0;
                if (rank < 4) { rs[(rho * 4 + rank) * 2] = mine[q]; ((LAS int*)rs)[(rho * 4 + rank) * 2 + 1] = e; } }
            if (lane < 16) {
                const f32x4 q0 = *(const LAS f32x4*)(rs + lane * 8), q1 = *(const LAS f32x4*)(rs + lane * 8 + 4);
                const float tv0 = q0[0], tv1 = q0[2], tv2 = q1[0], tv3 = q1[2]; const int ti[4] = {__float_as_int(q0[1]), __float_as_int(q0[3]), __float_as_int(q1[1]), __float_as_int(q1[3])};
                const float e1 = __expf(tv1 - tv0), e2 = __expf(tv2 - tv0), e3 = __expf(tv3 - tv0), inv = 1.0f / (1.0f + e1 + e2 + e3);
                const float gk[4] = {inv, e1 * inv, e2 * inv, e3 * inv};
                const int rl = 16 * blk + lane;
#pragma unroll
                for (int k = 0; k < 4; ++k) { const unsigned p = __hip_atomic_fetch_add(wcnt + ti[k], 1u, __ATOMIC_RELAXED, __HIP_MEMORY_SCOPE_WORKGROUP);
                    stmp[(rl * 4 + k) * 2] = (p << 5) | (unsigned)ti[k]; stmp[(rl * 4 + k) * 2 + 1] = __float_as_uint(gk[k]); }
            }
        }
    }
    __syncthreads();
    if (F.tid < NE) { const unsigned c = wcnt[F.tid]; wbase[F.tid] = c ? __hip_atomic_fetch_add(ctl + CW_CNT + (l * 32 + F.tid) * 64, c, RLX_AGENT) : 0u; }
    __syncthreads();
    for (int i = F.tid; i < rpw * 4; i += NWAVES * 64) { const int rl = i >> 2, k = i & 3, r = row_lo + rl; const unsigned pe = stmp[i * 2], e = pe & 31u, pos = wbase[e] + (pe >> 5);
        toklist[(size_t)e * CAP + pos] = r; sel[r * 4 + k] = (int)((pos << 5) | e); gatev[r * 4 + k] = __uint_as_float(stmp[i * 2 + 1]); }
}
struct MoeTab { int cnt[NE], base[NE + 1], tpre[NE + 1]; };
__device__ __forceinline__ void moe_tab_build(const CAS Args& a, const Frame& F, int l, LAS MoeTab* tb) {
    unsigned* ctl = (unsigned*)(a.ws + WS_CTL);
    __syncthreads();
    if (F.tid < NE) tb->cnt[F.tid] = (int)__hip_atomic_load(ctl + CW_CNT + (l * 32 + F.tid) * 64, RLX_AGENT);
    __syncthreads();
    if (F.tid == 0) { int bs = 0, tp = 0; for (int e = 0; e < NE; ++e) { const int c = tb->cnt[e]; tb->base[e] = bs; tb->tpre[e] = tp; bs += c; tp += (c + 255) >> 8; } tb->base[NE] = bs; tb->tpre[NE] = tp; }
    __syncthreads();
}
constexpr int MOE_UT_MAX = 64;
template <bool UP>
struct MoeSched {
    static constexpr bool GATHER = UP;
    const LAS MoeTab* tb; const LAS int* ut; const char* A; const char* WE; const int* toklist; int G, c;
    static constexpr int NN = UP ? 8 : 4;
    static __device__ __forceinline__ int rfl(int v) { return __builtin_amdgcn_readfirstlane(v); }
    static __device__ __forceinline__ const char* ufy(const char* p) { const unsigned long long v = (unsigned long long)p; const unsigned lo = __builtin_amdgcn_readfirstlane((unsigned)v), hi = __builtin_amdgcn_readfirstlane((unsigned)(v >> 32)); return (const char*)(((unsigned long long)hi << 32) | lo); }
    __device__ __forceinline__ bool unit_search(int i, int& pm, int& pn, int& e_, int& rows, int& base) const {
        const int nwg = tb->tpre[NE] * NN; const long L = (long)i * G + c; if (L >= nwg) return false;
        const int w = pg8::xcd_remap(L, nwg);
        int e = 0; while (e < NE - 1 && w >= tb->tpre[e + 1] * NN) ++e;
        const int tp0 = tb->tpre[e], tp1 = tb->tpre[e + 1];
        const int q = w - tp0 * NN, nte = tp1 - tp0;
        const int nig = 8 * NN, gid = q / nig, fm = gid * 8, gsz = (nte - fm) < 8 ? (nte - fm) : 8;
        pm = fm + ((q % nig) % gsz); pn = (q % nig) / gsz; e_ = e; rows = min(256, tb->cnt[e] - pm * 256); base = tb->base[e] + pm * 256;
        return true;
    }
    __device__ __forceinline__ void build(LAS int* utw, int tid) const {
        if (tid < MOE_UT_MAX) { int pm = -1, pn = 0, e = 0, rows = 0, base = 0; unit_search(tid, pm, pn, e, rows, base);
            utw[tid * 8 + 0] = pm; utw[tid * 8 + 1] = pn; utw[tid * 8 + 2] = e; utw[tid * 8 + 3] = rows; utw[tid * 8 + 4] = base; }
    }
    __device__ __forceinline__ bool unit(int i, pg8::Unit& u) const {
        if (i >= MOE_UT_MAX) return false;
        const LAS int* p = ut + i * 8; const int pm = rfl(p[0]); if (pm < 0) return false;
        u.pm = pm; u.pn = rfl(p[1]); u.e = rfl(p[2]); u.rows = rfl(p[3]); u.base = rfl(p[4]); u.newe = (i == 0) || (rfl(p[2 - 8]) != u.e);
        return true;
    }
    __device__ __forceinline__ bool bases(int i, const char*& a, const char*& b) const {
        pg8::Unit u; if (!unit(i, u)) return false;
        a = UP ? A : A + (size_t)u.base * D;
        b = WE + (size_t)u.e * 3072 * 1024 + (UP ? 0 : (size_t)2048 * 1024) + (size_t)u.pn * 256 * 1024;
        a = ufy(a); b = ufy(b);
        return true;
    }
    __device__ __forceinline__ void atoks(int i, const int (&rA)[2], int (&tok)[2][2]) const {
        pg8::Unit u; unit(i, u);
        const int* tl = toklist + (size_t)u.e * CAP + u.pm * 256;
#pragma unroll
        for (int h = 0; h < 2; ++h)
#pragma unroll
            for (int i2 = 0; i2 < 2; ++i2) { const int rr = h * 128 + rA[i2]; tok[h][i2] = tl[rr < u.rows ? rr : 0]; }
    }
    __device__ __forceinline__ void aoffs(int i, const int (&rA)[2], const unsigned (&voffA)[2], unsigned (&off)[2][2]) const {
        pg8::Unit u; unit(i, u);
        const int* tl = toklist + (size_t)u.e * CAP + u.pm * 256;
#pragma unroll
        for (int h = 0; h < 2; ++h)
#pragma unroll
            for (int i2 = 0; i2 < 2; ++i2) { const int rr = h * 128 + rA[i2]; const int tok = tl[rr < u.rows ? rr : 0]; off[h][i2] = (unsigned)tok * (unsigned)D + voffA[i2]; }
    }
};
struct EpiMoeUp {
    static constexpr bool PERM = true;
    bf16* ACT; const float* bgate; const float* bup; LAS float* btab;
    __device__ __forceinline__ void operator()(const f32x4 (&acc)[2][2][4][2], const pg8::Unit& u, int wr, int wc, int fr, int fq) const {
        const int col0 = u.pn * 128 + wc * 32 + 8 * fq, rl0 = wr * 64 + fr;
        if (u.newe) { const int tid = (wr * 4 + wc) * 64 + fr + 16 * fq;
            const f32x4 t = *(const f32x4*)((tid < 256 ? bgate : bup) + u.e * D + 4 * (tid & 255));
            *(LAS f32x4*)(btab + 4 * tid) = t;
            asm volatile("s_waitcnt lgkmcnt(0)" ::: "memory"); __builtin_amdgcn_s_barrier(); asm volatile("" ::: "memory"); }
        f32x2_t bg[2][2], bu[2][2];
#pragma unroll
        for (int n = 0; n < 2; ++n) { const f32x4 g4 = *(const LAS f32x4*)(btab + col0 + 4 * n), u4 = *(const LAS f32x4*)(btab + 1024 + col0 + 4 * n);
            bg[n][0] = (f32x2_t){g4[0], g4[1]}; bg[n][1] = (f32x2_t){g4[2], g4[3]};
            bu[n][0] = (f32x2_t){u4[0], u4[1]} * ACT8_SCALE + ACT8_SCALE; bu[n][1] = (f32x2_t){u4[2], u4[3]} * ACT8_SCALE + ACT8_SCALE; }
#pragma unroll
        for (int ai = 0; ai < 2; ++ai)
#pragma unroll
            for (int m = 0; m < 4; ++m) { const int rl = rl0 + ai * 128 + m * 16;
                f32x2_t o[2][2];
#pragma unroll
                for (int n = 0; n < 2; ++n)
#pragma unroll
                    for (int p = 0; p < 2; ++p) {
                        f32x2_t gg = (f32x2_t){acc[ai][0][m][n][2 * p], acc[ai][0][m][n][2 * p + 1]} * (1.0f / W8_SCALE) + bg[n][p];
                        gg.x = fminf(gg.x, 7.0f); gg.y = fminf(gg.y, 7.0f);
                        const f32x2_t tt = gg * (-1.702f * 1.44269504f);
                        f32x2_t dd; dd.x = __builtin_amdgcn_exp2f(tt.x); dd.y = __builtin_amdgcn_exp2f(tt.y); dd = dd + 1.0f;
                        f32x2_t rr; rr.x = __builtin_amdgcn_rcpf(dd.x); rr.y = __builtin_amdgcn_rcpf(dd.y);
                        f32x2_t uu = (f32x2_t){acc[ai][1][m][n][2 * p], acc[ai][1][m][n][2 * p + 1]} * (ACT8_SCALE / W8_SCALE) + bu[n][p];
                        uu.x = __builtin_amdgcn_fmed3f(uu.x, -6.0f * ACT8_SCALE, 8.0f * ACT8_SCALE); uu.y = __builtin_amdgcn_fmed3f(uu.y, -6.0f * ACT8_SCALE, 8.0f * ACT8_SCALE);
                        o[n][p] = (gg * rr) * uu;
                    }
                if (rl < u.rows) { uint2 w; unsigned w0 = 0u, w1 = 0u;
                    w0 = __builtin_amdgcn_cvt_pk_fp8_f32(o[0][0].x, o[0][0].y, w0, false); w0 = __builtin_amdgcn_cvt_pk_fp8_f32(o[0][1].x, o[0][1].y, w0, true);
                    w1 = __builtin_amdgcn_cvt_pk_fp8_f32(o[1][0].x, o[1][0].y, w1, false); w1 = __builtin_amdgcn_cvt_pk_fp8_f32(o[1][1].x, o[1][1].y, w1, true);
                    w.x = w0; w.y = w1;
                    *(uint2*)((unsigned char*)ACT + (size_t)(u.base + rl) * D + col0) = w; } }
    }
};
struct EpiMoeDown {
    static constexpr bool PERM = true;
    unsigned char* YB; const float* bdown; LAS float* btab;
    __device__ __forceinline__ void operator()(const f32x4 (&acc)[2][2][4][2], const pg8::Unit& u, int wr, int wc, int fr, int fq) const {
        const int col0 = u.pn * 256 + wc * 64 + 16 * fq, rl0 = wr * 64 + fr;
        if (u.newe) { const int tid = (wr * 4 + wc) * 64 + fr + 16 * fq;
            if (tid < 256) { const f32x4 t = *(const f32x4*)(bdown + u.e * D + 4 * tid); *(LAS f32x4*)(btab + 4 * tid) = t; }
            asm volatile("s_waitcnt lgkmcnt(0)" ::: "memory"); __builtin_amdgcn_s_barrier(); asm volatile("" ::: "memory"); }
        f32x4 bv[2][2];
#pragma unroll
        for (int bj = 0; bj < 2; ++bj)
#pragma unroll
            for (int n = 0; n < 2; ++n) bv[bj][n] = *(const LAS f32x4*)(btab + col0 + 8 * bj + 4 * n) * YB8_SCALE;
#pragma unroll
        for (int ai = 0; ai < 2; ++ai)
#pragma unroll
            for (int m = 0; m < 4; ++m) { const int rl = rl0 + ai * 128 + m * 16;
                if (rl < u.rows) { v4u w;
                    { const f32x4 v = acc[ai][0][m][0] * (YB8_SCALE / (W8_SCALE * ACT8_SCALE)) + bv[0][0]; w.x = pk4_fp8(v[0], v[1], v[2], v[3]); }
                    { const f32x4 v = acc[ai][0][m][1] * (YB8_SCALE / (W8_SCALE * ACT8_SCALE)) + bv[0][1]; w.y = pk4_fp8(v[0], v[1], v[2], v[3]); }
                    { const f32x4 v = acc[ai][1][m][0] * (YB8_SCALE / (W8_SCALE * ACT8_SCALE)) + bv[1][0]; w.z = pk4_fp8(v[0], v[1], v[2], v[3]); }
                    { const f32x4 v = acc[ai][1][m][1] * (YB8_SCALE / (W8_SCALE * ACT8_SCALE)) + bv[1][1]; w.w = pk4_fp8(v[0], v[1], v[2], v[3]); }
                    *(v4u*)(YB + (size_t)(u.base + rl) * D + col0) = w; } }
    }
};
constexpr int LDS_TAB = 131072;
__device__ __forceinline__ void p_moe_up(const CAS Args& a, const Frame& F, int l) {
    LAS MoeTab* tb = (LAS MoeTab*)(F.ldsl + LDS_TAB); moe_tab_build(a, F, l, tb);
    LAS int* utw = (LAS int*)(F.ldsl + LDS_TAB + 1024);
    MoeSched<true> S{tb, utw, (const char*)(a.ws + WS_H), (const char*)(a.ws + WS_WEXP) + (size_t)l * NE * 3072 * 1024, (const int*)(a.ws + WS_TOKLIST), F.G, F.bid};
    S.build(utw, F.tid); __syncthreads();
    EpiMoeUp E{(bf16*)(a.ws + WS_ACT), a.in[32] + (size_t)l * NE * D, a.in[34] + (size_t)l * NE * D, (LAS float*)(F.ldsl + LDS_TAB + 4096)};
    pg8::gemm_phase<D, true>(F.ldsl, S, E, F.wave);
}
__device__ __forceinline__ void p_moe_down(const CAS Args& a, const Frame& F, int l) {
    LAS MoeTab* tb = (LAS MoeTab*)(F.ldsl + LDS_TAB); moe_tab_build(a, F, l, tb);
    LAS int* utw = (LAS int*)(F.ldsl + LDS_TAB + 1024);
    MoeSched<false> S{tb, utw, (const char*)(a.ws + WS_ACT), (const char*)(a.ws + WS_WEXP) + (size_t)l * NE * 3072 * 1024, nullptr, F.G, F.bid};
    S.build(utw, F.tid); __syncthreads();
    EpiMoeDown E{(unsigned char*)(a.ws + WS_YB), a.in[36] + (size_t)l * NE * D, (LAS float*)(F.ldsl + LDS_TAB + 4096)};
    pg8::gemm_phase<D, true>(F.ldsl, S, E, F.wave);
}
__device__ __forceinline__ void p_combine(const CAS Args& a, const Frame& F, int l) {
    LAS MoeTab* tb = (LAS MoeTab*)(F.ldsl + LDS_TAB); moe_tab_build(a, F, l, tb);
    const unsigned char* YB = (const unsigned char*)(a.ws + WS_YB); bf16* XB = (bf16*)(a.ws + WS_XB); bf16* H = (bf16*)(a.ws + WS_H);
    const int* sel = (const int*)(a.ws + WS_SEL); const float* gatev = (const float*)(a.ws + WS_GATEV);
    const int rows = l == 0 ? R : NT;
    for (int r = F.gw; r < rows; r += 2 * F.ngw) {
        float v[2][16]; unsigned yw[2][4][4]; float gk[2][4];
#pragma unroll
        for (int t = 0; t < 2; ++t) { const int rr = r + t * F.ngw; if (rr < rows) {
            load_row16_bf16(XB + (size_t)rr * D, F.lane, v[t]);
#pragma unroll
            for (int k = 0; k < 4; ++k) { const int sv = sel[rr * 4 + k]; gk[t][k] = gatev[rr * 4 + k]; const int e = sv & 31, pos = sv >> 5;
                const unsigned char* y = YB + (size_t)(tb->base[e] + pos) * D;
#pragma unroll
                for (int j = 0; j < 4; ++j) yw[t][k][j] = *(const unsigned*)(y + 256 * j + 4 * F.lane); } } }
#pragma unroll
        for (int t = 0; t < 2; ++t) { const int rr = r + t * F.ngw; if (rr < rows) {
            float m[16];
#pragma unroll
            for (int i = 0; i < 16; ++i) m[i] = 0.f;
#pragma unroll
            for (int k = 0; k < 4; ++k)
#pragma unroll
                for (int j = 0; j < 4; ++j) { const unsigned w = yw[t][k][j]; const float gg = gk[t][k] * (1.0f / YB8_SCALE);
                    const f32x2_t lo = __builtin_amdgcn_cvt_pk_f32_fp8((int)w, false), hi = __builtin_amdgcn_cvt_pk_f32_fp8((int)w, true);
                    m[4 * j] += gg * lo.x; m[4 * j + 1] += gg * lo.y; m[4 * j + 2] += gg * hi.x; m[4 * j + 3] += gg * hi.y; }
            const float* g2 = mod_ptr(a, l, rr, 5);
#pragma unroll
            for (int j = 0; j < 4; ++j) { const f32x4 gg = *(const f32x4*)(g2 + 256 * j + 4 * F.lane); v[t][4 * j] += gg.x * m[4 * j]; v[t][4 * j + 1] += gg.y * m[4 * j + 1]; v[t][4 * j + 2] += gg.z * m[4 * j + 2]; v[t][4 * j + 3] += gg.w * m[4 * j + 3]; }
            if (l == 0) store_row16_bf16(XB + (size_t)rr * D, F.lane, v[t]); else store_row16_f32(a.out + (size_t)rr * D, F.lane, v[t]);
            if (l == 0) { float hv[16]; norm_mod(v[t], a.in[6] + D, mod_ptr(a, 1, rr, 0), mod_ptr(a, 1, rr, 1), H + (size_t)rr * D, F.lane, hv); } } }
    }
}
struct EpiInProj1 {
    static constexpr bool PERM = true;
    bf16* Gt; bf16* U;
    __device__ __forceinline__ void operator()(const f32x4 (&acc)[2][2][4][2], const pg8::Unit& u, int wr, int wc, int fr, int fq) const {
        const int row0 = u.pm * 256 + wr * 64 + fr; const bool gate = u.pn < 4;
        bf16* dst = gate ? Gt : U; const int col0 = (u.pn & 3) * 256 + wc * 32 + 8 * fq;
#pragma unroll
        for (int ai = 0; ai < 2; ++ai)
#pragma unroll
            for (int m = 0; m < 4; ++m) { bf16* rowp = dst + (size_t)(row0 + ai * 128 + m * 16) * D + col0;
#pragma unroll
                for (int bj = 0; bj < 2; ++bj) { f32x4 v0 = acc[ai][bj][m][0], v1 = acc[ai][bj][m][1];
                    if (gate) {
#pragma unroll
                        for (int j = 0; j < 4; ++j) { const float x = v0[j]; v0[j] = x * __builtin_amdgcn_rcpf(1.0f + __expf(-1.5957691216f * (x + 0.044715f * x * x * x)));
                                                      const float y = v1[j]; v1[j] = y * __builtin_amdgcn_rcpf(1.0f + __expf(-1.5957691216f * (y + 0.044715f * y * y * y))); } }
                    v4u w; w.x = pg8::cvt_pk_bf16(v0[0], v0[1]); w.y = pg8::cvt_pk_bf16(v0[2], v0[3]); w.z = pg8::cvt_pk_bf16(v1[0], v1[1]); w.w = pg8::cvt_pk_bf16(v1[2], v1[3]);
                    *(v4u*)(rowp + bj * 128) = w; } }
    }
};
__device__ __forceinline__ void p_inproj1(const CAS Args& a, const Frame& F) {
    pg8::RectSched S{(const char*)(a.ws + WS_H), (const char*)(a.ws + WS_WIN1), 2 * D, NT / 256, 8, F.G, F.bid, NC / 256, 4, NT / 256, 4};
    EpiInProj1 E{(bf16*)(a.ws + WS_G), (bf16*)(a.ws + WS_U)};
    pg8::gemm_phase<2 * D, false>(F.ldsl, S, E, F.wave);
}
__device__ __forceinline__ void p_conv4(const CAS Args& a, const Frame& F) {
    const bf16* U = (const bf16*)(a.ws + WS_U); bf16* UC = (bf16*)(a.ws + WS_UC);
    for (int u = F.gw; u < (R / 8) * 2; u += F.ngw) {
        const int rb = u >> 1, ch0 = (u & 1) * 512 + 8 * F.lane, row0 = rb * 8;
        const bool lat = row0 < NT; const int t0 = lat ? (row0 & 2047) : ((row0 - NT) & 255), len = lat ? 2048 : 256;
        float cw[4][8], cbv[8];
#pragma unroll
        for (int q = 0; q < 8; ++q) { cbv[q] = a.in[18][ch0 + q];
#pragma unroll
            for (int k = 0; k < 4; ++k) cw[k][q] = a.in[17][k * D + ch0 + q]; }
        v4u uv[11];
#pragma unroll
        for (int k = 0; k < 11; ++k) { const int tt = t0 + k - 1; uv[k] = (tt >= 0 && tt < len) ? *(const v4u*)(U + (size_t)(row0 + k - 1) * D + ch0) : (v4u){0u, 0u, 0u, 0u}; }
#pragma unroll
        for (int i = 0; i < 8; ++i) {
            float acc[8];
#pragma unroll
            for (int q = 0; q < 8; ++q) acc[q] = cbv[q];
#pragma unroll
            for (int k = 0; k < 4; ++k) { const unsigned w[4] = {uv[i + k].x, uv[i + k].y, uv[i + k].z, uv[i + k].w};
#pragma unroll
                for (int q = 0; q < 4; ++q) { acc[2 * q] += cw[k][2 * q] * __uint_as_float(w[q] << 16); acc[2 * q + 1] += cw[k][2 * q + 1] * __uint_as_float(w[q] & 0xffff0000u); } }
            *(v4u*)(UC + (size_t)(row0 + i) * D + ch0) = (v4u){pk_bf16(acc[0], acc[1]), pk_bf16(acc[2], acc[3]), pk_bf16(acc[4], acc[5]), pk_bf16(acc[6], acc[7])};
        }
    }
}
constexpr int LR_A = 0, LR_SC = 65536, LR_AG = 131072, LR_CY = LR_AG + 8192;
__device__ __forceinline__ void p_lru(const CAS Args& a, const Frame& F) {
    const bf16* UC = (const bf16*)(a.ws + WS_UC); const bf16* WL = (const bf16*)(a.ws + WS_WLRU); const bf16* Gt = (const bf16*)(a.ws + WS_G);
    bf16* HF = (bf16*)(a.ws + WS_HF); bf16* A3 = (bf16*)(a.ws + WS_A3);
    LAS unsigned char* lds = F.ldsl;
    const int lane_ = F.lane, wave = F.wave, sub = wave & 3, th = wave >> 2;
    for (int wu = F.bid; wu < 256; wu += F.G) {
        const int b = wu >> 4, h = (wu >> 2) & 3, cg = wu & 3;
        for (int dir = 0; dir < 2; ++dir) {
            const int lane = lane_, rho = lane & 15, g = lane >> 4;
            bf16x8 bw[2][8];
#pragma unroll
            for (int n = 0; n < 2; ++n)
#pragma unroll
                for (int ks = 0; ks < 8; ++ks) bw[n][ks] = *(const bf16x8*)(WL + ((size_t)h * 1024 + (2 * dir + n) * 256 + cg * 64 + 16 * sub + rho) * 256 + 32 * ks + 8 * g);
            const int chc = h * 256 + cg * 64 + 16 * sub + rho;
            const float bav = (dir ? a.in[25] : a.in[20])[chc] * -1.44269504f, bxv = (dir ? a.in[27] : a.in[22])[chc] * -1.44269504f;
            const float lamv = (dir ? a.in[28] : a.in[23])[chc];
            const float L8 = -8.0f * log1pf(expf(-lamv)) * 1.44269504f;
            __syncthreads();
            if (wave == 0) ((LAS float*)(lds + LR_CY))[lane] = 0.f;
#define LR_GROW0(ck_) ((ck_) < 2 ? (size_t)(NT + b * 256 + 128 * (dir ? 1 - (ck_) : (ck_))) : (size_t)(b * 2048 + 128 * (dir ? 15 - ((ck_) - 2) : (ck_) - 2)))
#define LR_STAGE(ck_) do { const size_t g0_ = LR_GROW0(ck_); _Pragma("unroll") for (int p_ = 0; p_ < 8; ++p_) { const int pc_ = wave * 8 + p_, row_ = 2 * pc_ + (lane >> 5), c_ = (lane & 31) ^ (row_ & 15); \
                __builtin_amdgcn_global_load_lds((const unsigned*)((const char*)UC + (g0_ + row_) * (D * 2) + h * 512 + 16 * c_), (LAS unsigned*)(lds + LR_A + pc_ * 1024), 16, 0, 0); } } while (0)
            LR_STAGE(0);
            for (int ck = 0; ck < 18; ++ck) {
                const bool isctx = ck < 2;
                const size_t grow0 = LR_GROW0(ck);
                int lane = lane_; asm volatile("" : "+v"(lane)); const int rho = lane & 15, g = lane >> 4, chs = h * 256 + cg * 64 + lane, ucol = cg * 64 + 16 * sub + rho;
                asm volatile("s_waitcnt vmcnt(0)" ::: "memory");
                __syncthreads();
                const int row0 = dir ? 112 - 16 * wave : 16 * wave;
                v4u hfr[2], gtr[2];
                if (dir && !isctx) {
#pragma unroll
                    for (int t = 0; t < 2; ++t) { const int tk = lane + 64 * t; const size_t gi = (grow0 + row0 + (tk >> 3)) * D + h * 256 + cg * 64 + 8 * (tk & 7);
                        hfr[t] = *(const v4u*)(HF + gi); gtr[t] = *(const v4u*)(Gt + gi); } }
                {
                    f32x4 acc[4][2];
#pragma unroll
                    for (int m = 0; m < 4; ++m)
#pragma unroll
                        for (int n = 0; n < 2; ++n) acc[m][n] = (f32x4){0.f, 0.f, 0.f, 0.f};
#pragma unroll
                    for (int ks = 0; ks < 8; ++ks)
#pragma unroll
                        for (int m = 0; m < 4; ++m) { const int rw = 64 * th + 16 * m + rho; const bf16x8 af = *(const LAS bf16x8*)(lds + LR_A + rw * 512 + (((4 * ks + g) ^ (rw & 15)) << 4));
#pragma unroll
                            for (int n = 0; n < 2; ++n) acc[m][n] = __builtin_amdgcn_mfma_f32_16x16x32_bf16(af, bw[n][ks], acc[m][n], 0, 0, 0);
                            if (m == 3 && (ks & 1)) asm volatile("" ::: "memory"); }
#pragma unroll
                    for (int m = 0; m < 4; ++m)
#pragma unroll
                        for (int p = 0; p < 2; ++p) {
                            const int row = 64 * th + 16 * m + 4 * g + 2 * p;
                            f32x2_t uc;
                            uc.x = bf2f(*(const LAS bf16*)(lds + LR_A + row * 512 + (((ucol >> 3) ^ (row & 15)) << 4) + 2 * (ucol & 7)));
                            uc.y = bf2f(*(const LAS bf16*)(lds + LR_A + (row + 1) * 512 + (((ucol >> 3) ^ ((row + 1) & 15)) << 4) + 2 * (ucol & 7)));
                            const f32x2_t xa = (f32x2_t){acc[m][0][2 * p], acc[m][0][2 * p + 1]} * -1.44269504f + bav, xx = (f32x2_t){acc[m][1][2 * p], acc[m][1][2 * p + 1]} * -1.44269504f + bxv;
                            f32x2_t da, dx; da.x = __builtin_amdgcn_exp2f(xa.x); da.y = __builtin_amdgcn_exp2f(xa.y); dx.x = __builtin_amdgcn_exp2f(xx.x); dx.y = __builtin_amdgcn_exp2f(xx.y);
                            da = da + 1.0f; dx = dx + 1.0f;
                            f32x2_t rr, ii; rr.x = __builtin_amdgcn_rcpf(da.x); rr.y = __builtin_amdgcn_rcpf(da.y); ii.x = __builtin_amdgcn_rcpf(dx.x); ii.y = __builtin_amdgcn_rcpf(dx.y);
                            const f32x2_t la = rr * L8;
                            f32x2_t av; av.x = __builtin_amdgcn_exp2f(la.x); av.y = __builtin_amdgcn_exp2f(la.y);
                            f32x2_t tt = 1.0f - av * av; tt.x = fmaxf(tt.x, 0.f); tt.y = fmaxf(tt.y, 0.f);
                            f32x2_t sq; sq.x = __builtin_amdgcn_sqrtf(tt.x); sq.y = __builtin_amdgcn_sqrtf(tt.y);
                            const f32x2_t bv = sq * ii * uc;
                            *(LAS f32x2_t*)(lds + LR_SC + (row * 64 + 16 * sub + rho) * 8) = (f32x2_t){av.x, bv.x};
                            *(LAS f32x2_t*)(lds + LR_SC + ((row + 1) * 64 + 16 * sub + rho) * 8) = (f32x2_t){av.y, bv.y};
                        }
                }
                __syncthreads();
                if (ck + 1 < 18) LR_STAGE(ck + 1);
                f32x2_t ab[16];
                {
#pragma unroll
                    for (int q = 0; q < 16; ++q) { const int s = 16 * wave + q, row = dir ? 127 - s : s; ab[q] = *(const LAS f32x2_t*)(lds + LR_SC + (row * 64 + lane) * 8); }
                    float hl = 0.f, pr = 1.f;
#pragma unroll
                    for (int q = 0; q < 16; ++q) { hl = ab[q].x * hl + ab[q].y; pr *= ab[q].x; ab[q] = (f32x2_t){pr, hl}; }
                    *(LAS f32x2_t*)(lds + LR_AG + ((ck & 1) * 512 + wave * 64 + lane) * 8) = (f32x2_t){pr, hl};
                }
                __syncthreads();
                {
                    float c = ((const LAS float*)(lds + LR_CY))[(ck & 1) * 64 + lane], cin = 0.f;
#pragma unroll
                    for (int w2 = 0; w2 < 8; ++w2) { if (w2 == wave) cin = c; const f32x2_t ag = *(const LAS f32x2_t*)(lds + LR_AG + ((ck & 1) * 512 + w2 * 64 + lane) * 8); c = ag.x * c + ag.y; }
                    if (wave == 0) ((LAS float*)(lds + LR_CY))[((ck + 1) & 1) * 64 + lane] = c;
                    if (!isctx) {
                        LAS unsigned char* scr = lds + LR_SC + row0 * 512;
                        if (dir) {
#pragma unroll
                            for (int t = 0; t < 2; ++t) { const int tk = lane + 64 * t; *(LAS v4u*)(scr + tk * 16) = hfr[t]; *(LAS v4u*)(scr + 2048 + tk * 16) = gtr[t]; }
                        }
#pragma unroll
                        for (int q = 0; q < 16; ++q) { const int tr = dir ? 15 - q : q;
                            float hv = ab[q].y + ab[q].x * cin;
                            if (dir) hv = (bf2f(*(const LAS bf16*)(scr + (tr * 64 + lane) * 2)) + hv) * bf2f(*(const LAS bf16*)(scr + 2048 + (tr * 64 + lane) * 2));
                            *(LAS bf16*)(scr + 4096 + (tr * 64 + lane) * 2) = f2bf(hv); }
                        bf16* dstp = dir ? A3 : HF;
#pragma unroll
                        for (int t = 0; t < 2; ++t) { const int tk = lane + 64 * t; const size_t gi = (grow0 + row0 + (tk >> 3)) * D + h * 256 + cg * 64 + 8 * (tk & 7);
                            *(v4u*)(dstp + gi) = *(const LAS v4u*)(scr + 4096 + tk * 16); }
                    }
                }
            }
#undef LR_STAGE
#undef LR_GROW0
        }
    }
}

constexpr int LDS_BYTES = 163840;
constexpr int NPHASE = 17;
template <unsigned KMASK>
__global__ void __launch_bounds__(NWAVES * 64, 2) fwd(Args kargs) {
    extern __shared__ __attribute__((aligned(16))) unsigned char lds[];
    const int wave_s = __builtin_amdgcn_readfirstlane((int)threadIdx.x >> 6);
    const int tid0 = wave_s * 64 + lane_id_fresh();
    volatile LAS unsigned* misc = (volatile LAS unsigned*)((LAS unsigned char*)lds + (LDS_BYTES - 64));
    if (tid0 < 16) misc[tid0] = 0u;
    __syncthreads();
    const int lo = kargs.ph_lo, hi = kargs.ph_hi;
    XcdBarrier bar; bar.bar = (unsigned*)(kargs.ws + WS_CTL) + CW_BAR + kargs.li * XCD_BAR_WORDS; bar.x = 0; bar.st = misc;
    if (hi - lo > 1) bar = xcd_barrier_post((unsigned*)(kargs.ws + WS_CTL) + CW_BAR + kargs.li * XCD_BAR_WORDS, misc, tid0);
#ifndef ONLY_PHASE
#define ONLY_PHASE -1
#endif
#ifndef PHASE_MASK
#define PHASE_MASK 0xFFFFFFFFu
#endif
#ifndef REPMASK
#define REPMASK 0u
#endif
#define PH(k, body) if constexpr (((KMASK >> (k)) & 1u) != 0u) if ((ONLY_PHASE < 0 || ONLY_PHASE == (k)) && ((PHASE_MASK >> (k)) & 1u) && lo <= (k) && (k) < hi) { \
        const CAS Args* ap_ = (const CAS Args*)__builtin_amdgcn_kernarg_segment_ptr(); asm volatile("" : "+s"(ap_)); const CAS Args& args = *ap_; \
        Frame F; F.lds = lds; F.ldsl = (LAS unsigned char*)lds; F.wave = wave_s; F.lane = lane_id_fresh(); \
        F.tid = F.wave * 64 + F.lane; F.G = gridDim.x; F.bid = blockIdx.x; F.gw = F.bid * NWAVES + F.wave; F.ngw = F.G * NWAVES; \
        if (((REPMASK >> (k)) & 1u) == 0u) { body; } else { int nrep_ = 2; asm volatile("" : "+s"(nrep_)); for (int rep_ = 0; rep_ < nrep_; ++rep_) { body; asm volatile("s_waitcnt vmcnt(0)" ::: "memory"); __syncthreads(); } } if ((k) + 1 < hi) xcd_barrier(bar, F.tid); else { asm volatile("s_waitcnt vmcnt(0)" ::: "memory"); __syncthreads(); } }
    PH(0, p0_prologue(args, F))
    PH(1, p_norm1_l0(args, F))
    PH(2, p_inproj0(args, F))
    PH(3, p_attn(args, F))
    PH(4, p_outproj<0>(args, F))
    PH(5, p_norm2_router(args, F, 0))
    PH(6, p_moe_up(args, F, 0))
    PH(7, p_moe_down(args, F, 0))
    PH(8, p_combine(args, F, 0))
    PH(9, p_inproj1(args, F))
    PH(10, p_conv4(args, F))
    PH(11, p_lru(args, F))
    PH(12, p_outproj<1>(args, F))
    PH(13, p_norm2_router(args, F, 1))
    PH(14, p_moe_up(args, F, 1))
    PH(15, p_moe_down(args, F, 1))
    PH(16, p_combine(args, F, 1))
#undef PH
}

constexpr unsigned MASK_A = (1u<<2)|(1u<<4)|(1u<<6)|(1u<<7)|(1u<<9)|(1u<<11)|(1u<<13)|(1u<<14), MASK_C = 1u << 3, MASK_D = 1u << 10, MASK_ALL = 0x1FFFFu, MASK_B = MASK_ALL & ~(MASK_A | MASK_C | MASK_D);
__host__ inline int kid_of(int p) { return ((MASK_A >> p) & 1u) ? 0 : ((MASK_C >> p) & 1u) ? 2 : ((MASK_D >> p) & 1u) ? 3 : 1; }
extern "C" void kernel_launch(void* const* d_in, const int* in_sizes, int n_in, void* d_out, int out_size, void* d_ws, size_t ws_size, hipStream_t stream) {
    static int grid = 0;
    if (grid == 0) {
        if (n_in != 37 || out_size != NT * D || ws_size < WS_END) { fprintf(stderr, "kernel_launch: unexpected shapes (n_in %d out %d ws %zu)\n", n_in, out_size, ws_size); grid = -1; return; }
        int dev = 0, cus = 0;
        if (hipGetDevice(&dev) != hipSuccess || hipDeviceGetAttribute(&cus, hipDeviceAttributeMultiprocessorCount, dev) != hipSuccess) { grid = -1; return; }
#ifndef MULTI_LAUNCH
        if (hipFuncSetAttribute((const void*)fwd<MASK_ALL>, hipFuncAttributeMaxDynamicSharedMemorySize, LDS_BYTES) != hipSuccess) { fprintf(stderr, "kernel_launch: hipFuncSetAttribute failed\n"); grid = -1; return; }
#else
        if (hipFuncSetAttribute((const void*)fwd<MASK_A>, hipFuncAttributeMaxDynamicSharedMemorySize, LDS_BYTES) != hipSuccess) { fprintf(stderr, "kernel_launch: hipFuncSetAttribute failed\n"); grid = -1; return; }
        if (hipFuncSetAttribute((const void*)fwd<MASK_B>, hipFuncAttributeMaxDynamicSharedMemorySize, LDS_BYTES) != hipSuccess) { fprintf(stderr, "kernel_launch: hipFuncSetAttribute failed\n"); grid = -1; return; }
        if (hipFuncSetAttribute((const void*)fwd<MASK_C>, hipFuncAttributeMaxDynamicSharedMemorySize, LDS_BYTES) != hipSuccess) { fprintf(stderr, "kernel_launch: hipFuncSetAttribute failed\n"); grid = -1; return; }
        if (hipFuncSetAttribute((const void*)fwd<MASK_D>, hipFuncAttributeMaxDynamicSharedMemorySize, LDS_BYTES) != hipSuccess) { fprintf(stderr, "kernel_launch: hipFuncSetAttribute failed\n"); grid = -1; return; }
#endif
        (void)hipGetLastError();
        grid = cus;
    }
    if (grid < 0) return;
    if (hipMemsetAsync((char*)d_ws + WS_CTL, 0, CTL_ZERO_BYTES, stream) != hipSuccess) return;
    Args a{};
    for (int i = 0; i < 37; ++i) a.in[i] = (const float*)d_in[i];
    a.out = (float*)d_out; a.ws = (unsigned char*)d_ws;
#ifdef MULTI_LAUNCH
    int p = 0, li = 0;
    while (p < NPHASE) {
        const int kid = kid_of(p); int q = p + 1;
        while (q < NPHASE && kid_of(q) == kid) ++q;
        a.ph_lo = p; a.ph_hi = q; a.li = li++;
        if (kid == 0) hipLaunchKernelGGL(fwd<MASK_A>, dim3(grid), dim3(NWAVES * 64), LDS_BYTES, stream, a);
        else if (kid == 1) hipLaunchKernelGGL(fwd<MASK_B>, dim3(grid), dim3(NWAVES * 64), LDS_BYTES, stream, a);
        else if (kid == 2) hipLaunchKernelGGL(fwd<MASK_C>, dim3(grid), dim3(NWAVES * 64), LDS_BYTES, stream, a);
        else hipLaunchKernelGGL(fwd<MASK_D>, dim3(grid), dim3(NWAVES * 64), LDS_BYTES, stream, a);
        p = q;
    }
#else
    a.ph_lo = 0; a.ph_hi = NPHASE; a.li = 0;
    hipLaunchKernelGGL(fwd<MASK_ALL>, dim3(grid), dim3(NWAVES * 64), LDS_BYTES, stream, a);
#endif
}
```

```cpp
#include <hip/hip_runtime.h>
#include <stdint.h>
#include <stdio.h>

constexpr int D = 1024, NB = 16, SEQ = 2048, NT = NB * SEQ, LC = 256, NC = NB * LC, R = NT + NC;
constexpr int NE = 32, CAP = R;
constexpr int NWAVES = 8;

typedef unsigned short bf16;
typedef short bf16x8 __attribute__((ext_vector_type(8)));
typedef float f32x4 __attribute__((ext_vector_type(4)));
typedef unsigned v4u __attribute__((ext_vector_type(4)));
#define LAS __attribute__((address_space(3)))
#define CAS __attribute__((address_space(4)))
#define RLX_AGENT __ATOMIC_RELAXED, __HIP_MEMORY_SCOPE_AGENT

constexpr size_t MiB = 1u << 20;
constexpr size_t WS_CTL = 0, CTL_ZERO_BYTES = 1 * MiB;
constexpr size_t WS_MOD = 1 * MiB;
constexpr size_t WS_WIN0 = 2 * MiB, WS_WOUT0 = 8 * MiB, WS_WIN1 = 10 * MiB, WS_WOUT1 = 14 * MiB, WS_WLRU = 16 * MiB;
constexpr size_t WS_TOKLIST = 18 * MiB;
constexpr size_t WS_SEL = 23 * MiB;
constexpr size_t WS_GATEV = 24 * MiB;
constexpr size_t WS_XC = 25 * MiB;
constexpr size_t WS_WEXP = 41 * MiB;
constexpr size_t WS_H = 233 * MiB;
constexpr size_t WS_P = 305 * MiB;
constexpr int PP = 2560;
constexpr size_t WS_A2 = 521 * MiB;
constexpr size_t WS_ACT = 593 * MiB;
constexpr size_t WS_YB = 305 * MiB;
constexpr size_t WS_G = 305 * MiB;
constexpr size_t WS_U = 369 * MiB;
constexpr size_t WS_UC = 441 * MiB;
constexpr size_t WS_AF = 513 * MiB;
constexpr size_t WS_AB = 657 * MiB;
constexpr size_t WS_HF = WS_AF;
constexpr size_t WS_A3 = WS_AB;
constexpr size_t WS_BF = 801 * MiB;
constexpr size_t WS_BB = 873 * MiB;
constexpr size_t WS_GS2 = 840 * MiB;
constexpr size_t WS_XB = 760 * MiB;
constexpr size_t WS_END = 945 * MiB;
constexpr int CW_BAR = 4096;
constexpr int CW_CNT = 65536;

__device__ __forceinline__ float bf2f(bf16 v) { return __uint_as_float(((unsigned)v) << 16); }
__device__ __forceinline__ bf16 f2bf(float f) { unsigned u = __float_as_uint(f); return (bf16)((u + 0x7fffu + ((u >> 16) & 1u)) >> 16); }
__device__ __forceinline__ unsigned pk2(float lo, float hi) { return (unsigned)f2bf(lo) | ((unsigned)f2bf(hi) << 16); }
__device__ __forceinline__ int lane_id_fresh() { int l; asm volatile("v_mbcnt_lo_u32_b32 %0, -1, 0\n\tv_mbcnt_hi_u32_b32 %0, -1, %0" : "=v"(l)); return l; }
__device__ __forceinline__ unsigned pk4_fp8(float a, float b, float c, float d) {
    a = fminf(fmaxf(a, -448.f), 448.f); b = fminf(fmaxf(b, -448.f), 448.f); c = fminf(fmaxf(c, -448.f), 448.f); d = fminf(fmaxf(d, -448.f), 448.f);
    unsigned w = 0u; w = __builtin_amdgcn_cvt_pk_fp8_f32(a, b, w, false); w = __builtin_amdgcn_cvt_pk_fp8_f32(c, d, w, true); return w;
}
constexpr float W8_SCALE = 32.0f, ACT8_SCALE = 4.0f, YB8_SCALE = 16.0f;
__device__ __forceinline__ float wave_sum(float v) {
#pragma unroll
    for (int o = 1; o < 64; o <<= 1) v += __shfl_xor(v, o);
    return v;
}
__device__ __forceinline__ float wave_max(float v) {
#pragma unroll
    for (int o = 1; o < 64; o <<= 1) v = fmaxf(v, __shfl_xor(v, o));
    return v;
}
__device__ __forceinline__ float sigmoidf_(float x) { return 1.0f / (1.0f + __expf(-x)); }
__device__ __forceinline__ float gelu_tanh(float x) { return 0.5f * x * (1.0f + tanhf(0.7978845608028654f * (x + 0.044715f * x * x * x))); }

#define XB_TMO      128
#define XB_XCNT(j)  (256  + 64 * (j))
#define XB_XSUB(j)  (1280 + 64 * (j))
#define XB_XGEN(j)  (2304 + 64 * (j))
#define XB_TOP      3328
#define XB_TOPGEN   3392
#define XCD_BAR_WORDS 3456
#define XB_SPIN_CAP (1u << 18)
__device__ __forceinline__ unsigned xb_ld(unsigned* p)              { return __hip_atomic_load(p, __ATOMIC_RELAXED, __HIP_MEMORY_SCOPE_AGENT); }
__device__ __forceinline__ unsigned xb_add(unsigned* p, unsigned v) { return __hip_atomic_fetch_add(p, v, __ATOMIC_RELAXED, __HIP_MEMORY_SCOPE_AGENT); }
__device__ __forceinline__ unsigned xb_xcc_id() { return (unsigned)__builtin_amdgcn_s_getreg((3 << 11) | 20) & 0xFu; }
#define XB_SPIN(cond, bar) do { unsigned _sp = 0; while (cond) { __builtin_amdgcn_s_sleep(1); \
    if ((++_sp & 255u) == 0u) { if (xb_ld(&(bar)[XB_TMO])) break; if (_sp > XB_SPIN_CAP) { atomicAdd(&(bar)[XB_TMO], 1u); break; } } } } while (0)
struct XcdBarrier { unsigned* bar; unsigned x; volatile LAS unsigned* st; };
__device__ __forceinline__ XcdBarrier xcd_barrier_post(unsigned* bar, volatile LAS unsigned* st, int tid) {
    XcdBarrier b; b.bar = bar; b.x = xb_xcc_id(); b.st = st;
    if (tid == 0) (void)xb_add(&bar[XB_XCNT(b.x)], 1u);
    return b;
}
__device__ __forceinline__ void xcd_barrier_complete(unsigned* bar, unsigned x, unsigned& nloc, unsigned& nx) {
    const unsigned G = gridDim.x * gridDim.y * gridDim.z;
    unsigned sum, cnt, mine, sp = 0u;
    for (;;) {
        sum = 0u; cnt = 0u; mine = 0u;
#pragma unroll
        for (unsigned j = 0; j < 16; ++j) { const unsigned c = xb_ld(&bar[XB_XCNT(j)]); sum += c; cnt += (c > 0u) ? 1u : 0u; mine = (j == x) ? c : mine; }
        if (sum == G) break;
        __builtin_amdgcn_s_sleep(1);
        if ((++sp & 255u) == 0u) { if (xb_ld(&bar[XB_TMO])) break; if (sp > XB_SPIN_CAP) { atomicAdd(&bar[XB_TMO], 1u); break; } }
    }
    nloc = mine > 0u ? mine : 1u; nx = cnt > 0u ? cnt : 1u;
}
__device__ __forceinline__ void xcd_barrier(const XcdBarrier& b, int tid) {
    asm volatile("s_waitcnt vmcnt(0)" ::: "memory");
    __syncthreads();
    if (tid == 0) {
        unsigned* bar = b.bar;
        __builtin_amdgcn_s_waitcnt(0);
        unsigned nloc = b.st[0], nx = b.st[1];
        if (nloc == 0u) { xcd_barrier_complete(bar, b.x, nloc, nx); b.st[0] = nloc; b.st[1] = nx; }
        const unsigned old = xb_add(&bar[XB_XSUB(b.x)], 1u);
        const unsigned gen = old / nloc;
        if (old + 1u == (gen + 1u) * nloc) {
            __builtin_amdgcn_fence(__ATOMIC_RELEASE, "agent");
            asm volatile("s_waitcnt vmcnt(0)" ::: "memory");
            const unsigned og = xb_add(&bar[XB_TOP], 1u);
            const unsigned tg = og / nx;
            if (og + 1u == (tg + 1u) * nx) xb_add(&bar[XB_TOPGEN], 1u);
            else XB_SPIN(xb_ld(&bar[XB_TOPGEN]) == tg, bar);
            __builtin_amdgcn_fence(__ATOMIC_ACQUIRE, "agent");
            xb_add(&bar[XB_XGEN(b.x)], 1u);
            asm volatile("s_waitcnt vmcnt(0)" ::: "memory");
        } else {
            XB_SPIN(xb_ld(&bar[XB_XGEN(b.x)]) == gen, bar);
            __builtin_amdgcn_fence(__ATOMIC_ACQUIRE, "agent");
            asm volatile("s_waitcnt vmcnt(0)" ::: "memory");
        }
    }
    __syncthreads();
}

struct Args { const float* in[37]; float* out; unsigned char* ws; int ph_lo, ph_hi, li, pad; };
struct Frame {
    unsigned char* lds;
    LAS unsigned char* ldsl;
    int tid, lane, wave, gw, ngw, G, bid;
};

template <int NS, class FA, class FB, class FS>
__device__ __forceinline__ void tile_gemm32(int K, FA arow, FB brow, FS store, int lane) {
    const int lr = lane & 15, lq = lane >> 4;
    const bf16* ap[2]; const bf16* bp[NS][2];
#pragma unroll
    for (int i = 0; i < 2; ++i) ap[i] = arow(16 * i + lr) + 8 * lq;
#pragma unroll
    for (int s = 0; s < NS; ++s)
#pragma unroll
        for (int j = 0; j < 2; ++j) bp[s][j] = brow(s, 16 * j + lr) + 8 * lq;
    f32x4 acc[NS][2][2];
#pragma unroll
    for (int s = 0; s < NS; ++s)
#pragma unroll
        for (int i = 0; i < 2; ++i)
#pragma unroll
            for (int j = 0; j < 2; ++j) acc[s][i][j] = (f32x4){0.f, 0.f, 0.f, 0.f};
#pragma nounroll
    for (int k0 = 0; k0 < K; k0 += 32) {
        bf16x8 a[2], b[NS][2];
#pragma unroll
        for (int i = 0; i < 2; ++i) a[i] = *(const bf16x8*)(ap[i] + k0);
#pragma unroll
        for (int s = 0; s < NS; ++s)
#pragma unroll
            for (int j = 0; j < 2; ++j) b[s][j] = *(const bf16x8*)(bp[s][j] + k0);
#pragma unroll
        for (int s = 0; s < NS; ++s)
#pragma unroll
            for (int i = 0; i < 2; ++i)
#pragma unroll
                for (int j = 0; j < 2; ++j) acc[s][i][j] = __builtin_amdgcn_mfma_f32_16x16x32_bf16(a[i], b[s][j], acc[s][i][j], 0, 0, 0);
    }
#pragma unroll
    for (int i = 0; i < 2; ++i)
#pragma unroll
        for (int j = 0; j < 2; ++j)
#pragma unroll
            for (int q = 0; q < 4; ++q) {
                float v[NS];
#pragma unroll
                for (int s = 0; s < NS; ++s) v[s] = acc[s][i][j][q];
                store(16 * i + 4 * lq + q, 16 * j + lr, v);
            }
}


namespace pg8 {
constexpr int BM = 256, BK = 64, HALF = 128, HTB = HALF * BK * 2, STAGE_BYTES = 8 * HTB;
__device__ __forceinline__ int lds_byte(int r, int c) { const int st = (r >> 4) * 2 + (c >> 5), rr = r & 15, cc = c & 31, ob = rr * 64 + cc * 2; return st * 1024 + (ob ^ (((ob >> 9) & 1) << 5)); }
__device__ __forceinline__ void stage_rc(int b, int& R_, int& C_) { const int st = b / 1024, sb = b % 1024, swz = sb ^ (((sb >> 9) & 1) << 5); R_ = (st >> 1) * 16 + swz / 64; C_ = (st & 1) * 32 + (swz % 64) / 2; }
__device__ __forceinline__ int perm32(int rho) { const int n = rho >> 4, i = rho & 15; return 8 * (i >> 2) + 4 * n + (i & 3); }
struct Unit { int pm, pn, e, rows, base, newe; };
typedef int v8i __attribute__((ext_vector_type(8)));
typedef int v4i __attribute__((ext_vector_type(4)));
__device__ __forceinline__ void mfma8(f32x4& acc, v8i a, v8i b, unsigned sc) {
    asm volatile("v_mfma_scale_f32_16x16x128_f8f6f4 %0, %1, %2, %0, %3, %3 op_sel_hi:[0,0,0]" : "+v"(acc) : "v"(a), "v"(b), "v"(sc));
}
__device__ __forceinline__ v8i cat8(bf16x8 a, bf16x8 b) { return __builtin_shufflevector(__builtin_bit_cast(v4i, a), __builtin_bit_cast(v4i, b), 0, 1, 2, 3, 4, 5, 6, 7); }
__device__ __forceinline__ unsigned cvt_pk_bf16(float lo, float hi) { unsigned r; asm volatile("v_cvt_pk_bf16_f32 %0, %1, %2" : "=v"(r) : "v"(lo), "v"(hi)); return r; }

template <int RB  , bool FP8, class Epi, class Sched>
__device__ __forceinline__ void gemm_phase(LAS unsigned char* lds, const Sched& S, const Epi& E, const int wave_id) {
    const int tid_ = wave_id * 64 + lane_id_fresh();
    const int tid = tid_, wid = wave_id, lane = tid & 63, wr = wid >> 2, wc = wid & 3, fr = lane & 15, fq = lane >> 4;
    constexpr int nt = RB / 128;
    unsigned voffA[2], voffB[2]; int rA[2];
#pragma unroll
    for (int i = 0; i < 2; ++i) { int R_, C_; stage_rc(tid * 16 + i * 8192, R_, C_); const int Rb = Epi::PERM ? ((R_ & ~31) + perm32(R_ & 31)) : R_;
        voffA[i] = Sched::GATHER ? (unsigned)C_ * 2u : (unsigned)(R_ * RB + C_ * 2); rA[i] = R_; voffB[i] = (unsigned)(Rb * RB + C_ * 2); }
    constexpr size_t kstep = (size_t)(BK * 2);
    constexpr size_t hstep = (size_t)HALF * RB;
    const unsigned ldsw = (unsigned)wid * 1024u;
    const int aoff = lds_byte(wr * 64 + fr, fq * 8), boff = lds_byte(wc * 32 + fr, fq * 8);
#define PG8_SA(b, h) (((b) * 2 + (h)) * HTB)
#define PG8_SB(b, h) ((4 + (b) * 2 + (h)) * HTB)
#define PG8_STAGE(bufoff, gbase, voff) do { _Pragma("unroll") for (int _i = 0; _i < 2; ++_i) \
        __builtin_amdgcn_global_load_lds((const unsigned*)((const char*)(gbase) + (voff)[_i]), (LAS unsigned*)(lds + (bufoff) + ldsw + _i * 8192), 16, 0, 0); } while (0)
#define PG8_STAGE_A(bufoff, ubase, uoff, h) do { if constexpr (Sched::GATHER) PG8_STAGE(bufoff, ubase, (uoff)[h]); else PG8_STAGE(bufoff, (ubase) + (h) * hstep, voffA); } while (0)
#define PG8_LDA(dst, b, h) do { _Pragma("unroll") for (int m = 0; m < 4; ++m) _Pragma("unroll") for (int k = 0; k < 2; ++k) dst[m][k] = *(const LAS bf16x8*)(lds + PG8_SA(b, h) + aoff + m * 2048 + k * 1024); } while (0)
#define PG8_LDB(dst, b, h) do { _Pragma("unroll") for (int n = 0; n < 2; ++n) _Pragma("unroll") for (int k = 0; k < 2; ++k) dst[n][k] = *(const LAS bf16x8*)(lds + PG8_SB(b, h) + boff + n * 2048 + k * 1024); } while (0)
#define PG8_MMA(ai, bj, At, Bt) do { __builtin_amdgcn_s_setprio(1); _Pragma("unroll") for (int m = 0; m < 4; ++m) _Pragma("unroll") for (int n = 0; n < 2; ++n) { \
        if constexpr (FP8) mfma8(acc[ai][bj][m][n], cat8(Bt[n][0], Bt[n][1]), cat8(At[m][0], At[m][1]), sc1); \
        else { _Pragma("unroll") for (int k = 0; k < 2; ++k) acc[ai][bj][m][n] = __builtin_amdgcn_mfma_f32_16x16x32_bf16(Bt[n][k], At[m][k], acc[ai][bj][m][n], 0, 0, 0); } } __builtin_amdgcn_s_setprio(0); } while (0)
#define PG8_WAIT_V(n) asm volatile("s_waitcnt vmcnt(" #n ")" ::: "memory")
#define PG8_WAIT_L(n) asm volatile("s_waitcnt lgkmcnt(" #n ")" ::: "memory")
#define PG8_BAR __builtin_amdgcn_s_barrier()
#define PG8_SCHED __builtin_amdgcn_sched_barrier(0)
#define PG8_KBODY(a1, a2, b2, off2) do { const char* _a1 = (a1); const char* _a2 = (a2); const char* _b2 = (b2); const char* _a3 = _a2 + kstep; const char* _b3 = _b2 + kstep; \
            asm volatile("" : "+s"(_a1), "+s"(_a2), "+s"(_b2), "+s"(_a3), "+s"(_b3));   \
            PG8_LDB(B0, 0, 0); PG8_LDB(B1, 0, 1); PG8_SCHED; PG8_LDA(At, 0, 0); PG8_STAGE_A(PG8_SA(1, 1), _a1, coff, 1); \
            PG8_WAIT_V(8); PG8_WAIT_L(0); PG8_BAR; PG8_MMA(0, 0, At, B0); PG8_MMA(0, 1, At, B1); PG8_BAR; PG8_SCHED; \
            PG8_LDA(At, 0, 1); PG8_STAGE(PG8_SB(0, 0), _b2, voffB); PG8_STAGE(PG8_SB(0, 1), _b2 + hstep, voffB); PG8_STAGE_A(PG8_SA(0, 0), _a2, off2, 0); \
            PG8_WAIT_V(8); PG8_WAIT_L(0); PG8_BAR; PG8_MMA(1, 0, At, B0); PG8_MMA(1, 1, At, B1); PG8_BAR; PG8_SCHED; \
            PG8_LDB(B0, 1, 0); PG8_LDB(B1, 1, 1); PG8_SCHED; PG8_LDA(At, 1, 0); PG8_STAGE_A(PG8_SA(0, 1), _a2, off2, 1); \
            PG8_WAIT_V(8); PG8_WAIT_L(0); PG8_BAR; PG8_MMA(0, 0, At, B0); PG8_MMA(0, 1, At, B1); PG8_BAR; PG8_SCHED; \
            PG8_LDA(At, 1, 1); PG8_STAGE(PG8_SB(1, 0), _b3, voffB); PG8_STAGE(PG8_SB(1, 1), _b3 + hstep, voffB); PG8_STAGE_A(PG8_SA(1, 0), _a3, off2, 0); \
            PG8_WAIT_V(8); PG8_WAIT_L(0); PG8_BAR; PG8_MMA(1, 0, At, B0); PG8_MMA(1, 1, At, B1); PG8_BAR; PG8_SCHED; } while (0)
    int ui = 0;
    const char* cA; const char* cB;
    if (!S.bases(0, cA, cB)) return;
    f32x4 acc[2][2][4][2];
#pragma unroll
    for (int a = 0; a < 2; ++a)
#pragma unroll
        for (int b = 0; b < 2; ++b)
#pragma unroll
            for (int m = 0; m < 4; ++m)
#pragma unroll
                for (int n = 0; n < 2; ++n) acc[a][b][m][n] = (f32x4){0.f, 0.f, 0.f, 0.f};
    bf16x8 At[4][2], B0[2][2], B1[2][2];
    unsigned sc1 = 0x7f7f7f7fu; asm volatile("" : "+v"(sc1));
    unsigned coff[2][2], noff[2][2];
    if constexpr (Sched::GATHER) S.aoffs(0, rA, voffA, coff);
    PG8_STAGE(PG8_SB(0, 0), cB, voffB); PG8_STAGE(PG8_SB(0, 1), cB + hstep, voffB); PG8_STAGE_A(PG8_SA(0, 0), cA, coff, 0); PG8_STAGE_A(PG8_SA(0, 1), cA, coff, 1);
    if (wr == 1) PG8_BAR;
    PG8_WAIT_V(2); PG8_BAR;
    PG8_STAGE(PG8_SB(1, 0), cB + kstep, voffB); PG8_STAGE_A(PG8_SA(1, 0), cA + kstep, coff, 0); PG8_STAGE(PG8_SB(1, 1), cB + hstep + kstep, voffB);
    PG8_WAIT_V(6); PG8_BAR;
    for (;;) {
        const char* nA; const char* nB;
        const bool has_next = S.bases(ui + 1, nA, nB);
        if (!has_next) { nA = cA; nB = cB; }
        int ntok[2][2];
        if constexpr (Sched::GATHER) { if (has_next) S.atoks(ui + 1, rA, ntok); }
#pragma nounroll
        for (int t = 0; t < nt - 2; t += 2) PG8_KBODY(cA + (size_t)(t + 1) * kstep, cA + (size_t)(t + 2) * kstep, cB + (size_t)(t + 2) * kstep, coff);
        if constexpr (Sched::GATHER) {
            if (has_next) { asm volatile("" : "+v"(ntok[0][0]), "+v"(ntok[0][1]), "+v"(ntok[1][0]), "+v"(ntok[1][1]));
#pragma unroll
                for (int h = 0; h < 2; ++h)
#pragma unroll
                    for (int i = 0; i < 2; ++i) noff[h][i] = (unsigned)ntok[h][i] * (unsigned)RB + voffA[i]; }
            else {
#pragma unroll
                for (int h = 0; h < 2; ++h)
#pragma unroll
                    for (int i = 0; i < 2; ++i) noff[h][i] = coff[h][i]; }
        }
        PG8_KBODY(cA + (size_t)(nt - 1) * kstep, nA, nB, noff);
        if (wr == 0) PG8_BAR;
        if constexpr (FP8) asm volatile("s_nop 15\n\ts_nop 3" ::: "memory");
        {
            const int t2 = lane_id_fresh();
            const int w2 = wave_id, l2 = t2 & 63;
            Unit cur; S.unit(ui, cur); E(acc, cur, w2 >> 2, w2 & 3, l2 & 15, l2 >> 4); }
        if (!has_next) break;
#pragma unroll
        for (int a = 0; a < 2; ++a)
#pragma unroll
            for (int b = 0; b < 2; ++b)
#pragma unroll
                for (int m = 0; m < 4; ++m)
#pragma unroll
                    for (int n = 0; n < 2; ++n) acc[a][b][m][n] = (f32x4){0.f, 0.f, 0.f, 0.f};
        cA = nA; cB = nB; ++ui;
        if constexpr (Sched::GATHER) {
#pragma unroll
            for (int h = 0; h < 2; ++h)
#pragma unroll
                for (int i = 0; i < 2; ++i) coff[h][i] = noff[h][i]; }
        if (wr == 1) PG8_BAR;
    }
    PG8_WAIT_V(0);
    PG8_BAR;
#undef PG8_SA
#undef PG8_SB
#undef PG8_STAGE
#undef PG8_STAGE_A
#undef PG8_KBODY
#undef PG8_LDA
#undef PG8_LDB
#undef PG8_MMA
#undef PG8_WAIT_V
#undef PG8_WAIT_L
#undef PG8_BAR
#undef PG8_SCHED
}
__device__ __forceinline__ int xcd_remap(long L, int nwg) { const int q = nwg / 8, r = nwg % 8, xcd = (int)(L % 8), off = (int)(L / 8); return (xcd < r ? xcd * (q + 1) : r * (q + 1) + (xcd - r) * q) + off; }
struct RectSched {
    static constexpr bool GATHER = false;
    const char* A; const char* B; int RB, nM, nN, G, c, nM2, nN2, pm2, pn2;
    __device__ __forceinline__ bool unit(int i, Unit& u) const {
        const int n1 = nM * nN, nwg = n1 + nM2 * nN2; const long L = (long)i * G + c; if (L >= nwg) return false;
        int w = xcd_remap(L, nwg); int rm = nM, rn = nN, pm0 = 0, pn0 = 0;
        if (w >= n1) { w -= n1; rm = nM2; rn = nN2; pm0 = pm2; pn0 = pn2; }
        const int nig = 8 * rn, gid = w / nig, fm = gid * 8, gsz = (rm - fm) < 8 ? (rm - fm) : 8;
        u.pm = pm0 + fm + ((w % nig) % gsz); u.pn = pn0 + (w % nig) / gsz; u.e = 0; u.rows = 256; u.base = u.pm * 256; u.newe = 0;
        return true;
    }
    __device__ __forceinline__ bool bases(int i, const char*& a, const char*& b) const {
        Unit u; if (!unit(i, u)) return false;
        a = A + (size_t)u.pm * 256 * RB; b = B + (size_t)u.pn * 256 * RB; return true;
    }
    __device__ __forceinline__ void aoffs(int, const int (&)[2], const unsigned (&)[2], unsigned (&)[2][2]) const {}
    __device__ __forceinline__ void atoks(int, const int (&)[2], int (&)[2][2]) const {}
};
}

template <class MapF>
__device__ __forceinline__ void transpose_item(const float* W, int K, int N, bf16* WT, MapF rowmap, float* scr, int item, int lane) {
    const int nblk = N / 32, kb = item / nblk, nb = item % nblk, k0 = 64 * kb, n0 = 32 * nb;
#pragma unroll 8
    for (int i = 0; i < 32; ++i) { const int kk = 2 * i + (lane >> 5); scr[kk * 33 + (lane & 31)] = W[(size_t)(k0 + kk) * N + n0 + (lane & 31)]; }
    asm volatile("s_waitcnt lgkmcnt(0)" ::: "memory");
    const int c = lane & 7;
#pragma unroll
    for (int j = 0; j < 4; ++j) { const int n = (lane >> 3) + 8 * j; const float* s = scr + (8 * c) * 33 + n;
        v4u o; o.x = pk2(s[0 * 33], s[1 * 33]); o.y = pk2(s[2 * 33], s[3 * 33]); o.z = pk2(s[4 * 33], s[5 * 33]); o.w = pk2(s[6 * 33], s[7 * 33]);
        *(v4u*)(WT + (size_t)rowmap(n0 + n) * K + k0 + 8 * c) = o; }
    asm volatile("s_waitcnt lgkmcnt(0)" ::: "memory");
}
template <class MapF>
__device__ __forceinline__ void transpose_item8(const float* W, int K, int N, unsigned char* WT, MapF rowmap, float* scr, int item, int lane) {
    const int nblk = N / 32, kb = item / nblk, nb = item % nblk, k0 = 128 * kb, n0 = 32 * nb;
    const int r8 = lane >> 3, c8 = lane & 7;
    f32x4 t[16];
#pragma unroll
    for (int i = 0; i < 16; ++i) t[i] = __builtin_nontemporal_load((const f32x4*)(W + (size_t)(k0 + 8 * i + r8) * N + n0 + 4 * c8));
#pragma unroll
    for (int i = 0; i < 16; ++i) *(f32x4*)(scr + (8 * i + r8) * 36 + 4 * c8) = t[i] * W8_SCALE;
    asm volatile("s_waitcnt lgkmcnt(0)" ::: "memory");
#pragma unroll
    for (int j = 0; j < 4; ++j) {
        const int n = r8 + 8 * j; const float* s = scr + (16 * c8) * 36 + n;
        v4u o;
        o.x = pk4_fp8(s[0 * 36], s[1 * 36], s[2 * 36], s[3 * 36]); o.y = pk4_fp8(s[4 * 36], s[5 * 36], s[6 * 36], s[7 * 36]);
        o.z = pk4_fp8(s[8 * 36], s[9 * 36], s[10 * 36], s[11 * 36]); o.w = pk4_fp8(s[12 * 36], s[13 * 36], s[14 * 36], s[15 * 36]);
        *(v4u*)(WT + (size_t)rowmap(n0 + n) * K + k0 + 16 * c8) = o;
    }
    asm volatile("s_waitcnt lgkmcnt(0)" ::: "memory");
}
__device__ __forceinline__ void convert_experts(const CAS Args& a, const Frame& F) {
    float* scr = (float*)(F.lds + F.wave * 18432);
    unsigned char* WE = (unsigned char*)(a.ws + WS_WEXP);
    constexpr int IPM = 8 * 32;
    for (int it = F.gw; it < 2 * NE * 3 * IPM; it += F.ngw) {
        const int m = it / IPM, r = it % IPM, le = m / 3, which = m % 3;
        const float* W = (which == 0 ? a.in[31] : which == 1 ? a.in[33] : a.in[35]) + ((size_t)le << 20);
        unsigned char* dst = WE + (size_t)le * 3072 * 1024;
        if (which == 0) transpose_item8(W, D, D, dst, [](int n) { return ((n >> 7) << 8) + (n & 127); }, scr, r, F.lane);
        else if (which == 1) transpose_item8(W, D, D, dst, [](int n) { return ((n >> 7) << 8) + 128 + (n & 127); }, scr, r, F.lane);
        else transpose_item8(W, D, D, dst + (size_t)2048 * 1024,
            [](int f) { return (f & ~255) | (((f >> 3) & 1) << 7) | (((f >> 6) & 3) << 5) | (((f >> 4) & 3) << 3) | (f & 7); }, scr, r, F.lane);
    }
}
__device__ __forceinline__ void p0_prologue(const CAS Args& a, const Frame& F) {
    float* scr = (float*)(F.lds + F.wave * 8448);
    constexpr int I_IN0 = 16 * 96, I_O = 16 * 32, I_IN1 = 16 * 64, I_LRU1 = 4 * 8;
    constexpr int NSMALL = I_IN0 + I_O + I_IN1 + I_O + 16 * I_LRU1;
    for (int it = F.gw; it < NSMALL; it += F.ngw) {
        int r = it;
        if (r < I_IN0) {
            transpose_item(a.in[8], D, 3072, (bf16*)(a.ws + WS_WIN0), [](int f) {
                if (f < 2048) return (f & ~255) | (((f >> 5) & 1) << 7) | (((f >> 6) & 3) << 5) | (f & 31);
                if (f < 2560) { const int j = f - 2048; return (8 + (j >> 7)) * 256 + (j & 127); }
                const int j = f - 2560; return (8 + (j >> 7)) * 256 + 128 + (j & 127); }, scr, r, F.lane); continue; } r -= I_IN0;
        if (r < I_O) { transpose_item(a.in[9], D, D, (bf16*)(a.ws + WS_WOUT0), [](int n) { return n; }, scr, r, F.lane); continue; } r -= I_O;
        if (r < I_IN1) { transpose_item(a.in[15], D, 2048, (bf16*)(a.ws + WS_WIN1), [](int n) { return n; }, scr, r, F.lane); continue; } r -= I_IN1;
        if (r < I_O) { transpose_item(a.in[16], D, D, (bf16*)(a.ws + WS_WOUT1), [](int n) { return n; }, scr, r, F.lane); continue; } r -= I_O;
        const int gh = r / I_LRU1, rr = r % I_LRU1, g = gh >> 2, h = gh & 3;
        const float* W = (g == 0 ? a.in[19] : g == 1 ? a.in[21] : g == 2 ? a.in[24] : a.in[26]) + (size_t)h * 65536;
        transpose_item(W, 256, 256, (bf16*)(a.ws + WS_WLRU) + (size_t)h * 1024 * 256, [g](int n) { return g * 256 + n; }, scr, rr, F.lane);
    }
    __syncthreads();
    convert_experts(a, F);
    __syncthreads();
    float* sc = (float*)F.lds;
    float* red = (float*)(F.lds + 17 * 1024 * 4);
    {
#pragma unroll
        for (int hbat = 0; hbat < 2; ++hbat) { float tv[17];
#pragma unroll
            for (int j = 0; j < 17; ++j) { const int i = F.tid + 512 * (17 * hbat + j); tv[j] = i < 16 * 1024 ? a.in[1][i] : a.in[3][i - 16 * 1024]; }
#pragma unroll
            for (int j = 0; j < 17; ++j) { const int i = F.tid + 512 * (17 * hbat + j); sc[i] = tv[j] / (1.0f + __expf(-tv[j])); } }
    }
    __syncthreads();
    float* MOD = (float*)(a.ws + WS_MOD);
    for (int u = F.bid; u < 192; u += F.G) {
        const int l = u / 96, n = (u % 96) * 64 + F.lane;
        const float* w = a.in[4] + (size_t)l * D * 6144 + n;
        float acc[17];
#pragma unroll
        for (int b = 0; b < 17; ++b) acc[b] = 0.f;
        for (int k0 = F.wave * 128; k0 < F.wave * 128 + 128; k0 += 16) {
            float wv[16];
#pragma unroll
            for (int q = 0; q < 16; ++q) wv[q] = __builtin_nontemporal_load(w + (size_t)(k0 + q) * 6144);
#pragma unroll
            for (int q = 0; q < 16; ++q)
#pragma unroll
                for (int b = 0; b < 17; ++b) acc[b] += sc[b * 1024 + k0 + q] * wv[q];
        }
#pragma unroll
        for (int b = 0; b < 17; ++b) red[(F.wave * 17 + b) * 64 + F.lane] = acc[b];
        __syncthreads();
        for (int i = F.tid; i < 17 * 64; i += NWAVES * 64) {
            const int b = i / 64, ln = i % 64; float s = 0.f;
#pragma unroll
            for (int w8 = 0; w8 < 8; ++w8) s += red[(w8 * 17 + b) * 64 + ln];
            const int nn = (u % 96) * 64 + ln;
            MOD[((size_t)l * 17 + b) * 6144 + nn] = s + a.in[5][l * 6144 + nn];
        }
        __syncthreads();
    }
}

__device__ __forceinline__ void load_row16(const float* row, int lane, float (&v)[16]) {
#pragma unroll
    for (int j = 0; j < 4; ++j) { const f32x4 t = *(const f32x4*)(row + 256 * j + 4 * lane); v[4 * j] = t.x; v[4 * j + 1] = t.y; v[4 * j + 2] = t.z; v[4 * j + 3] = t.w; }
}
__device__ __forceinline__ void load_row16_bf16(const bf16* row, int lane, float (&v)[16]) {
#pragma unroll
    for (int j = 0; j < 4; ++j) { const uint2 t = *(const uint2*)(row + 256 * j + 4 * lane); v[4 * j] = __uint_as_float(t.x << 16); v[4 * j + 1] = __uint_as_float(t.x & 0xffff0000u); v[4 * j + 2] = __uint_as_float(t.y << 16); v[4 * j + 3] = __uint_as_float(t.y & 0xffff0000u); }
}
__device__ __forceinline__ void store_row16_bf16(bf16* row, int lane, const float (&v)[16]) {
#pragma unroll
    for (int j = 0; j < 4; ++j) { uint2 o; o.x = pk2(v[4 * j], v[4 * j + 1]); o.y = pk2(v[4 * j + 2], v[4 * j + 3]); *(uint2*)(row + 256 * j + 4 * lane) = o; }
}
__device__ __forceinline__ void store_row16_f32(float* row, int lane, const float (&v)[16]) {
#pragma unroll
    for (int j = 0; j < 4; ++j) *(f32x4*)(row + 256 * j + 4 * lane) = (f32x4){v[4 * j], v[4 * j + 1], v[4 * j + 2], v[4 * j + 3]};
}
template <bool FP8OUT = false>
__device__ __forceinline__ void norm_mod(const float (&v)[16], const float* g, const float* sh, const float* sc, bf16* out, int lane, float (&hv)[16]) {
    float s = 0.f;
#pragma unroll
    for (int i = 0; i < 16; ++i) s += v[i] * v[i];
    const float rstd = rsqrtf(wave_sum(s) * (1.0f / D) + 1e-6f);
#pragma unroll
    for (int j = 0; j < 4; ++j) {
        const int e = 256 * j + 4 * lane;
        const f32x4 gg = *(const f32x4*)(g + e), ss = *(const f32x4*)(sh + e), cc = *(const f32x4*)(sc + e);
        hv[4 * j] = v[4 * j] * rstd * gg.x * (1.f + cc.x) + ss.x; hv[4 * j + 1] = v[4 * j + 1] * rstd * gg.y * (1.f + cc.y) + ss.y;
        hv[4 * j + 2] = v[4 * j + 2] * rstd * gg.z * (1.f + cc.z) + ss.z; hv[4 * j + 3] = v[4 * j + 3] * rstd * gg.w * (1.f + cc.w) + ss.w;
        if (FP8OUT) *(unsigned*)((unsigned char*)out + e) = pk4_fp8(hv[4 * j], hv[4 * j + 1], hv[4 * j + 2], hv[4 * j + 3]);
        else { uint2 o; o.x = pk2(hv[4 * j], hv[4 * j + 1]); o.y = pk2(hv[4 * j + 2], hv[4 * j + 3]); *(uint2*)(out + e) = o; }
    }
}
__device__ __forceinline__ int row_batch(int r) { return r < NT ? (r >> 11) : 16; }
__device__ __forceinline__ const float* mod_ptr(const CAS Args& a, int l, int r, int chunk) { return (const float*)(a.ws + WS_MOD) + ((size_t)l * 17 + row_batch(r)) * 6144 + chunk * D; }

__device__ __forceinline__ void p_norm1_l0(const CAS Args& a, const Frame& F) {
    bf16* H = (bf16*)(a.ws + WS_H);
    { float* GS2 = (float*)(a.ws + WS_GS2); const float* MOD = (const float*)(a.ws + WS_MOD);
      for (int i = F.gw * 64 + F.lane; i < 2 * 17 * D; i += F.ngw * 64) { const int l = i / (17 * D), bb = (i / D) % 17, k = i % D; GS2[i] = a.in[7][l * D + k] * (1.0f + MOD[((size_t)l * 17 + bb) * 6144 + 4 * D + k]); } }
    for (int r = F.gw; r < R; r += 3 * F.ngw) {
        float v[3][16], hv[16];
#pragma unroll
        for (int k = 0; k < 3; ++k) { const int rr = r + k * F.ngw; if (rr < R) load_row16(rr < NT ? a.in[0] + (size_t)rr * D : a.in[2] + (size_t)(rr - NT) * D, F.lane, v[k]); }
#pragma unroll
        for (int k = 0; k < 3; ++k) { const int rr = r + k * F.ngw; if (rr < R) norm_mod(v[k], a.in[6], mod_ptr(a, 0, rr, 0), mod_ptr(a, 0, rr, 1), H + (size_t)rr * D, F.lane, hv); }
    }
}

struct EpiInProj0 {
    static constexpr bool PERM = true;
    bf16* P; const float* qg; const float* kg;
    __device__ __forceinline__ void operator()(const f32x4 (&acc)[2][2][4][2], const pg8::Unit& u, int wr, int wc, int fr, int fq) const {
        const int row0 = u.pm * 256 + wr * 64 + fr, pn = u.pn;
        if (pn < 4) {
            const float* g = pn < 2 ? qg : kg; const float sc = pn < 2 ? 0.125f : 1.0f;
            f32x4 gv[2][2];
#pragma unroll
            for (int bj = 0; bj < 2; ++bj)
#pragma unroll
                for (int n = 0; n < 2; ++n) gv[bj][n] = *(const f32x4*)(g + 32 * bj + 8 * fq + 4 * n);
#pragma unroll
            for (int ai = 0; ai < 2; ++ai)
#pragma unroll
                for (int m = 0; m < 4; ++m) {
                    float ss = 0.f;
#pragma unroll
                    for (int bj = 0; bj < 2; ++bj)
#pragma unroll
                        for (int n = 0; n < 2; ++n) { const f32x4 x = acc[ai][bj][m][n]; ss += (x[0] * x[0] + x[1] * x[1]) + (x[2] * x[2] + x[3] * x[3]); }
                    ss += __shfl_xor(ss, 16); ss += __shfl_xor(ss, 32);
                    const float rs = rsqrtf(ss * (1.0f / 64.0f) + 1e-6f) * sc;
                    bf16* rowp = P + (size_t)(row0 + ai * 128 + m * 16) * PP + pn * 256 + wc * 64 + 8 * fq;
#pragma unroll
                    for (int bj = 0; bj < 2; ++bj) { const f32x4 v0 = acc[ai][bj][m][0] * rs * gv[bj][0], v1 = acc[ai][bj][m][1] * rs * gv[bj][1];
                        v4u w; w.x = pg8::cvt_pk_bf16(v0[0], v0[1]); w.y = pg8::cvt_pk_bf16(v0[2], v0[3]); w.z = pg8::cvt_pk_bf16(v1[0], v1[1]); w.w = pg8::cvt_pk_bf16(v1[2], v1[3]);
                        *(v4u*)(rowp + 32 * bj) = w; }
                }
        } else if (pn < 8) {
#pragma unroll
            for (int ai = 0; ai < 2; ++ai)
#pragma unroll
                for (int m = 0; m < 4; ++m) { bf16* rowp = P + (size_t)(row0 + ai * 128 + m * 16) * PP + pn * 256 + wc * 64 + 8 * fq;
#pragma unroll
                    for (int bj = 0; bj < 2; ++bj) { const f32x4 v0 = acc[ai][bj][m][0], v1 = acc[ai][bj][m][1];
                        v4u w; w.x = pg8::cvt_pk_bf16(v0[0], v0[1]); w.y = pg8::cvt_pk_bf16(v0[2], v0[3]); w.z = pg8::cvt_pk_bf16(v1[0], v1[1]); w.w = pg8::cvt_pk_bf16(v1[2], v1[3]);
                        *(v4u*)(rowp + 32 * bj) = w; } }
        } else {
#pragma unroll
            for (int ai = 0; ai < 2; ++ai)
#pragma unroll
                for (int m = 0; m < 4; ++m) { bf16* rowp = P + (size_t)(row0 + ai * 128 + m * 16) * PP + 2048 + (pn - 8) * 128 + wc * 32 + 8 * fq;
                    const f32x4 v0 = acc[ai][0][m][0] * acc[ai][1][m][0], v1 = acc[ai][0][m][1] * acc[ai][1][m][1];
                    v4u w; w.x = pg8::cvt_pk_bf16(v0[0], v0[1]); w.y = pg8::cvt_pk_bf16(v0[2], v0[3]); w.z = pg8::cvt_pk_bf16(v1[0], v1[1]); w.w = pg8::cvt_pk_bf16(v1[2], v1[3]);
                    *(v4u*)rowp = w; }
        }
    }
};
__device__ __forceinline__ void p_inproj0(const CAS Args& a, const Frame& F) {
    pg8::RectSched S{(const char*)(a.ws + WS_H), (const char*)(a.ws + WS_WIN0), 2 * D, R / 256, 3072 / 256, F.G, F.bid, 0, 0, 0, 0};
    EpiInProj0 E{(bf16*)(a.ws + WS_P), a.in[10], a.in[11]};
    pg8::gemm_phase<2 * D, false>(F.ldsl, S, E, F.wave);
}
typedef __bf16 bf16x2_t __attribute__((ext_vector_type(2)));
typedef float f32x2_t __attribute__((ext_vector_type(2)));
typedef short s16x4 __attribute__((ext_vector_type(4)));
__device__ __forceinline__ unsigned pk_bf16(float a, float b) { f32x2_t v = {a, b}; bf16x2_t r = __builtin_convertvector(v, bf16x2_t); return __builtin_bit_cast(unsigned, r); }
constexpr int AT_LAT = 0, AT_CK = 576 * 128, AT_CV = AT_CK + 256 * 128, AT_RPB = AT_CV + 256 * 128;
__device__ __forceinline__ int at_swz(int key) { return (key ^ (key >> 3)) & 7; }
__device__ __forceinline__ unsigned at_addr(int key, int chunk) { return (unsigned)(key * 128 + ((chunk ^ at_swz(key)) << 4)); }
template <class RowF>
__device__ __forceinline__ void at_stage(LAS unsigned char* dst, int npieces, RowF rowf, int colbyte, const bf16* P, int wave, int lane) {
    for (int p = wave; p < npieces; p += NWAVES) {
        const int key = 8 * p + (lane >> 3), c = (lane & 7) ^ at_swz(key);
        const char* src = (const char*)P + (size_t)rowf(key) * (PP * 2) + colbyte + 16 * c;
        __builtin_amdgcn_global_load_lds((const unsigned*)src, (LAS unsigned*)(dst + p * 1024), 16, 0, 0);
    }
}
__device__ __forceinline__ void at_tr8(unsigned a0, unsigned a1, unsigned a2, unsigned a3, unsigned a4, unsigned a5, unsigned a6, unsigned a7, s16x4 (&r)[8]) {
    asm volatile("ds_read_b64_tr_b16 %0, %8\n\tds_read_b64_tr_b16 %1, %9\n\tds_read_b64_tr_b16 %2, %10\n\tds_read_b64_tr_b16 %3, %11\n\t"
                 "ds_read_b64_tr_b16 %4, %12\n\tds_read_b64_tr_b16 %5, %13\n\tds_read_b64_tr_b16 %6, %14\n\tds_read_b64_tr_b16 %7, %15\n\ts_waitcnt lgkmcnt(0)"
                 : "=&v"(r[0]), "=&v"(r[1]), "=&v"(r[2]), "=&v"(r[3]), "=&v"(r[4]), "=&v"(r[5]), "=&v"(r[6]), "=&v"(r[7])
                 : "v"(a0), "v"(a1), "v"(a2), "v"(a3), "v"(a4), "v"(a5), "v"(a6), "v"(a7) : "memory");
}
__device__ __forceinline__ void p_attn(const CAS Args& a, const Frame& F) {
    const bf16* P = (const bf16*)(a.ws + WS_P); bf16* A2 = (bf16*)(a.ws + WS_A2);
    LAS unsigned char* lds = F.ldsl;
    const int lane = F.lane, wave = F.wave, rho = lane & 15, g = lane >> 4;
    for (int wu = F.bid; wu < NB * 8 * 2; wu += F.G) {
        const int half = wu & 1, hd = (wu >> 1) & 7, b = wu >> 4;
        __syncthreads();
        for (int i = F.tid; i < 465; i += NWAVES * 64) ((LAS float*)(lds + AT_RPB))[i] = a.in[12][hd * 465 + i];
        at_stage(lds + AT_CK, 32, [=](int key) { return NT + b * 256 + key; }, (512 + hd * 64) * 2, P, wave, lane);
        at_stage(lds + AT_CV, 32, [=](int key) { return NT + b * 256 + key; }, (1024 + hd * 64) * 2, P, wave, lane);
        for (int un = 0; un < 9; ++un) {
            const bool lat = un < 8;
            int r = 0, n = 0, qrow, krow_lo = 0;
            if (lat) { const int rp = half * 8 + un; r = 2 * rp + (wave >> 2); n = wave & 3; qrow = b * 2048 + r * 64 + 16 * n + rho; krow_lo = min(max(2 * rp - 4, 0), 24); }
            else qrow = NT + b * 256 + half * 128 + 16 * wave + rho;
            const int r0 = min(max(r - 4, 0), 24), ro = r0 - krow_lo, kc0 = min(max(16 * n - 8, 0), 32);
            const int c = 16 * n + rho, c0 = min(max(c - 8, 0), 48);
            if (lat) at_stage(lds + AT_LAT, 72, [=](int key) { return b * 2048 + min(krow_lo + (key >> 6), 31) * 64 + (key & 63); }, (512 + hd * 64) * 2, P, wave, lane);
            const bf16x8 q0 = *(const bf16x8*)(P + (size_t)qrow * PP + hd * 64 + 8 * g), q1 = *(const bf16x8*)(P + (size_t)qrow * PP + hd * 64 + 32 + 8 * g);
            asm volatile("s_waitcnt vmcnt(0)" ::: "memory");
            __syncthreads();
            const int pk = 8 * (rho >> 2) + (rho & 3);
            float mxb[2] = {-1e30f, -1e30f}, smb[2] = {0.f, 0.f}; v4u pf[16];
#pragma unroll
            for (int blk = 0; blk < 2; ++blk) {
                if (blk == 0 && !lat) {
#pragma unroll
                    for (int i = 0; i < 8; ++i) pf[i] = (v4u){0u, 0u, 0u, 0u};
                    continue; }
                f32x4 s[16];
#pragma unroll
                for (int i = 0; i < 8; ++i)
#pragma unroll
                    for (int t = 0; t < 2; ++t) {
                        const int key = (blk == 0 ? (ro + i) * 64 + kc0 : 32 * i) + pk + 4 * t;
                        const unsigned kbase = blk == 0 ? AT_LAT : AT_CK;
                        const bf16x8 k0 = *(const LAS bf16x8*)(lds + kbase + at_addr(key, g)), k1 = *(const LAS bf16x8*)(lds + kbase + at_addr(key, 4 + g));
                        f32x4 acc = __builtin_amdgcn_mfma_f32_16x16x32_bf16(k0, q0, (f32x4){0.f, 0.f, 0.f, 0.f}, 0, 0, 0);
                        acc = __builtin_amdgcn_mfma_f32_16x16x32_bf16(k1, q1, acc, 0, 0, 0);
                        if (blk == 0) {
                            const int dr = r0 + i - r + 7;
#pragma unroll
                            for (int jj = 0; jj < 4; ++jj) { const int kcol = kc0 + 8 * g + 4 * t + jj; const int dc = min(max(kcol - c + 15, 0), 30);
                                const float bias = ((const LAS float*)(lds + AT_RPB))[dr * 31 + dc];
                                acc[jj] = ((unsigned)(kcol - c0) < 16u) ? acc[jj] + bias : -1e30f; }
                        }
                        s[2 * i + t] = acc;
                    }
                float mx = -1e30f;
#pragma unroll
                for (int i = 0; i < 16; ++i) mx = fmaxf(fmaxf(mx, fmaxf(s[i][0], s[i][1])), fmaxf(s[i][2], s[i][3]));
                mx = fmaxf(mx, __shfl_xor(mx, 16)); mx = fmaxf(mx, __shfl_xor(mx, 32));
                float sum = 0.f;
#pragma unroll
                for (int i = 0; i < 8; ++i) {
                    float e[8];
#pragma unroll
                    for (int t = 0; t < 2; ++t)
#pragma unroll
                        for (int jj = 0; jj < 4; ++jj) { e[4 * t + jj] = __expf(s[2 * i + t][jj] - mx); sum += e[4 * t + jj]; }
                    pf[8 * blk + i].x = pk_bf16(e[0], e[1]); pf[8 * blk + i].y = pk_bf16(e[2], e[3]); pf[8 * blk + i].z = pk_bf16(e[4], e[5]); pf[8 * blk + i].w = pk_bf16(e[6], e[7]);
                }
                sum += __shfl_xor(sum, 16); sum += __shfl_xor(sum, 32);
                mxb[blk] = mx; smb[blk] = sum;
            }
            __syncthreads();
            if (lat) at_stage(lds + AT_LAT, 72, [=](int key) { return b * 2048 + min(krow_lo + (key >> 6), 31) * 64 + (key & 63); }, (1024 + hd * 64) * 2, P, wave, lane);
            asm volatile("s_waitcnt vmcnt(0)" ::: "memory");
            __syncthreads();
            f32x4 o[2][4];
#pragma unroll
            for (int blk = 0; blk < 2; ++blk)
#pragma unroll
                for (int db = 0; db < 4; ++db) o[blk][db] = (f32x4){0.f, 0.f, 0.f, 0.f};
            const int tq = rho >> 2, tp = rho & 3;
#pragma unroll
            for (int ch = 0; ch < 16; ++ch) {
                if (ch < 8 && !lat) continue;
                int zo = 0; asm volatile("" : "+v"(zo));
                const int kb = (ch < 8 ? (ro + ch) * 64 + kc0 + 8 * g + tq : 32 * (ch - 8) + 8 * g + tq) + zo;
                const unsigned base = (unsigned)(size_t)(lds + (ch < 8 ? AT_LAT : AT_CV));
                unsigned ad[8];
#pragma unroll
                for (int db = 0; db < 4; ++db) { ad[2 * db] = base + at_addr(kb, 2 * db + (tp >> 1)) + 8 * (tp & 1); ad[2 * db + 1] = base + at_addr(kb + 4, 2 * db + (tp >> 1)) + 8 * (tp & 1); }
                s16x4 vr[8]; at_tr8(ad[0], ad[1], ad[2], ad[3], ad[4], ad[5], ad[6], ad[7], vr);
#pragma unroll
                for (int db = 0; db < 4; ++db) { const bf16x8 vf = __builtin_shufflevector(vr[2 * db], vr[2 * db + 1], 0, 1, 2, 3, 4, 5, 6, 7);
                    o[ch >> 3][db] = __builtin_amdgcn_mfma_f32_16x16x32_bf16(vf, __builtin_bit_cast(bf16x8, pf[ch]), o[ch >> 3][db], 0, 0, 0); }
            }
            const float mxa = fmaxf(mxb[0], mxb[1]), f0 = __expf(mxb[0] - mxa), f1 = __expf(mxb[1] - mxa);
            const float inv = 1.0f / (f0 * smb[0] + f1 * smb[1]), g0 = f0 * inv, g1 = f1 * inv;
#pragma unroll
            for (int db = 0; db < 4; ++db) { uint2 w; w.x = pk_bf16(o[0][db][0] * g0 + o[1][db][0] * g1, o[0][db][1] * g0 + o[1][db][1] * g1); w.y = pk_bf16(o[0][db][2] * g0 + o[1][db][2] * g1, o[0][db][3] * g0 + o[1][db][3] * g1);
                *(uint2*)(A2 + (size_t)qrow * D + hd * 64 + 16 * db + 4 * g) = w; }
            __syncthreads();
        }
    }
    const float* cw = a.in[13]; const float* cb = a.in[14];
    const int j0 = 8 * lane;
    float w0[8], w1[8], w2[8], bb[8];
#pragma unroll
    for (int q = 0; q < 8; ++q) { w0[q] = cw[j0 + q]; w1[q] = cw[512 + j0 + q]; w2[q] = cw[1024 + j0 + q]; bb[q] = cb[j0 + q]; }
    for (int blk = F.gw; blk < R / 6; blk += F.ngw) {
        const int row0 = 6 * blk;
        v4u pw[8], bgw[6];
#pragma unroll
        for (int k = 0; k < 8; ++k) { const int rr = row0 + k - 1; pw[k] = (rr >= 0 && rr < R) ? *(const v4u*)(P + (size_t)rr * PP + 2048 + j0) : (v4u){0u, 0u, 0u, 0u}; }
#pragma unroll
        for (int k = 0; k < 6; ++k) bgw[k] = *(const v4u*)(P + (size_t)(row0 + k) * PP + 1536 + j0);
#pragma unroll
        for (int k = 0; k < 6; ++k) {
            const int row = row0 + k; const bool latr = row < NT; const int t = latr ? (row & 2047) : ((row - NT) & 255), len = latr ? 2048 : 256;
            const v4u pm = t > 0 ? pw[k] : (v4u){0u, 0u, 0u, 0u}, pc = pw[k + 1], pn = (t + 1 < len) ? pw[k + 2] : (v4u){0u, 0u, 0u, 0u}, bgv = bgw[k];
            const unsigned am[4] = {pm.x, pm.y, pm.z, pm.w}, ac[4] = {pc.x, pc.y, pc.z, pc.w}, an[4] = {pn.x, pn.y, pn.z, pn.w}, ab[4] = {bgv.x, bgv.y, bgv.z, bgv.w};
            unsigned ow[4];
#pragma unroll
            for (int q = 0; q < 4; ++q) {
                const float lo = __uint_as_float(ab[q] << 16) * (bb[2 * q] + w0[2 * q] * __uint_as_float(am[q] << 16) + w1[2 * q] * __uint_as_float(ac[q] << 16) + w2[2 * q] * __uint_as_float(an[q] << 16));
                const float hi = __uint_as_float(ab[q] & 0xffff0000u) * (bb[2 * q + 1] + w0[2 * q + 1] * __uint_as_float(am[q] & 0xffff0000u) + w1[2 * q + 1] * __uint_as_float(ac[q] & 0xffff0000u) + w2[2 * q + 1] * __uint_as_float(an[q] & 0xffff0000u));
                ow[q] = pk_bf16(lo, hi);
            }
            *(v4u*)(A2 + (size_t)row * D + 512 + j0) = (v4u){ow[0], ow[1], ow[2], ow[3]};
        }
    }
}
template <int L>
struct EpiOutProj {
    static constexpr bool PERM = true;
    const float* baseL; const float* baseC; bf16* XB; const float* MODl;
    __device__ __forceinline__ void operator()(const f32x4 (&acc)[2][2][4][2], const pg8::Unit& u, int wr, int wc, int fr, int fq) const {
        const bool lat = u.pm < NT / 256;
        const int mb = lat ? (u.pm >> 3) : 16;
        const int row0 = u.pm * 256 + wr * 64 + fr, col0 = u.pn * 256 + wc * 32 + 8 * fq;
        const float* g1 = MODl + (size_t)mb * 6144 + 2 * D + col0;
        f32x4 gv[2][2];
#pragma unroll
        for (int bj = 0; bj < 2; ++bj)
#pragma unroll
            for (int n = 0; n < 2; ++n) gv[bj][n] = *(const f32x4*)(g1 + bj * 128 + 4 * n);
#pragma unroll
        for (int ai = 0; ai < 2; ++ai)
#pragma unroll
            for (int m = 0; m < 4; ++m) { const int row = row0 + ai * 128 + m * 16;
#pragma unroll
                for (int bj = 0; bj < 2; ++bj) {
                    f32x4 b0, b1;
                    if (L == 0) { const float* bp = (lat ? baseL + (size_t)row * D : baseC + (size_t)(row - NT) * D) + col0 + bj * 128; b0 = *(const f32x4*)bp; b1 = *(const f32x4*)(bp + 4); }
                    else { const v4u w = *(const v4u*)(XB + (size_t)row * D + col0 + bj * 128);
                        b0 = (f32x4){__uint_as_float(w.x << 16), __uint_as_float(w.x & 0xffff0000u), __uint_as_float(w.y << 16), __uint_as_float(w.y & 0xffff0000u)};
                        b1 = (f32x4){__uint_as_float(w.z << 16), __uint_as_float(w.z & 0xffff0000u), __uint_as_float(w.w << 16), __uint_as_float(w.w & 0xffff0000u)}; }
                    const f32x4 v0 = b0 + gv[bj][0] * acc[ai][bj][m][0], v1 = b1 + gv[bj][1] * acc[ai][bj][m][1];
                    v4u o; o.x = pg8::cvt_pk_bf16(v0[0], v0[1]); o.y = pg8::cvt_pk_bf16(v0[2], v0[3]); o.z = pg8::cvt_pk_bf16(v1[0], v1[1]); o.w = pg8::cvt_pk_bf16(v1[2], v1[3]);
                    *(v4u*)(XB + (size_t)row * D + col0 + bj * 128) = o; }
                asm volatile("" ::: "memory"); }
    }
};
template <int L>
__device__ __forceinline__ void p_outproj(const CAS Args& a, const Frame& F) {
    pg8::RectSched S{(const char*)(a.ws + (L == 0 ? WS_A2 : WS_A3)), (const char*)(a.ws + (L == 0 ? WS_WOUT0 : WS_WOUT1)), 2 * D, (L == 0 ? R : NT) / 256, D / 256, F.G, F.bid, 0, 0, 0, 0};
    EpiOutProj<L> E{a.in[0], a.in[2], (bf16*)(a.ws + WS_XB), (const float*)(a.ws + WS_MOD) + (size_t)L * 17 * 6144};
    pg8::gemm_phase<2 * D, false>(F.ldsl, S, E, F.wave);
}
#define RS_STEP(half, m) do { const bool up = (F.lane & (m)) != 0; _Pragma("unroll") for (int i = 0; i < (half); ++i) { \
        const float keep = up ? part[i + (half)] : part[i]; const float send = up ? part[i] : part[i + (half)]; part[i] = keep + __shfl_xor(send, (m)); } } while (0)
constexpr int RT_WH = 0, RT_WL = 65536, RT_GS = 131072, RT_LG = 139264, RT_CNT = 155648;
__device__ __forceinline__ void p_norm2_router(const CAS Args& a, const Frame& F, int l) {
    unsigned char* H8 = (unsigned char*)(a.ws + WS_H); const bf16* XB = (const bf16*)(a.ws + WS_XB);
    unsigned* ctl = (unsigned*)(a.ws + WS_CTL);
    int* toklist = (int*)(a.ws + WS_TOKLIST); int* sel = (int*)(a.ws + WS_SEL); float* gatev = (float*)(a.ws + WS_GATEV);
    const float* wr = a.in[29] + (size_t)l * D * NE; const float* br = a.in[30] + l * NE;
    const float* GS2 = (const float*)(a.ws + WS_GS2) + (size_t)l * 17 * D; const float* MODl = (const float*)(a.ws + WS_MOD) + (size_t)l * 17 * 6144;
    const int rows = l == 0 ? R : NT, rpw = rows / F.G, row_lo = F.bid * rpw, nblk = rpw / 16;
    LAS unsigned char* lds = F.ldsl;
    const int lane = F.lane, wave = F.wave, rho = lane & 15, g = lane >> 4;
    const int b_first = row_batch(row_lo);
    __syncthreads();
    {
        f32x4 wv[16];
#pragma unroll
        for (int j = 0; j < 16; ++j) wv[j] = *(const f32x4*)(wr + 4 * (F.tid + 512 * j));
#pragma unroll
        for (int j = 0; j < 16; ++j) { const int i0 = 4 * (F.tid + 512 * j), k = i0 >> 5;
#pragma unroll
            for (int q = 0; q < 4; ++q) { const int e = (i0 & 31) + q; const float w = wv[j][q]; const bf16 hi = f2bf(w), lo = f2bf(w - bf2f(hi));
                const int off = e * 2048 + 16 * ((k >> 3) ^ (e & 15)) + 2 * (k & 7);
                *(LAS bf16*)(lds + RT_WH + off) = hi; *(LAS bf16*)(lds + RT_WL + off) = lo; } }
    }
    for (int i = F.tid; i < 2 * D; i += NWAVES * 64) { const int s = i >> 10, k = i & 1023; const int bb = s == 0 ? b_first : row_batch(row_lo + rpw - 1); ((LAS float*)(lds + RT_GS))[i] = GS2[bb * D + k]; }
    LAS unsigned* wcnt = (LAS unsigned*)(lds + RT_CNT); LAS unsigned* wbase = wcnt + 32; LAS unsigned* stmp = wcnt + 64;
    if (F.tid < NE) wcnt[F.tid] = 0u;
    __syncthreads();
    for (int blk = wave; blk < nblk; blk += NWAVES) {
        const int r0 = row_lo + 16 * blk, row = r0 + rho, bb = row_batch(r0);
        const bf16* xr = XB + (size_t)row * D + 8 * g;
        float ss = 0.f;
#pragma unroll
        for (int kh = 0; kh < 2; ++kh) {
            v4u xw[16];
#pragma unroll
            for (int ks = 0; ks < 16; ++ks) xw[ks] = *(const v4u*)(xr + 32 * (16 * kh + ks));
#pragma unroll
            for (int ks = 0; ks < 16; ++ks) { const unsigned u4[4] = {xw[ks].x, xw[ks].y, xw[ks].z, xw[ks].w};
#pragma unroll
                for (int q = 0; q < 4; ++q) { const float x0 = __uint_as_float(u4[q] << 16), x1 = __uint_as_float(u4[q] & 0xffff0000u); ss += x0 * x0 + x1 * x1; } }
            asm volatile("" ::: "memory");
        }
        ss += __shfl_xor(ss, 16); ss += __shfl_xor(ss, 32);
        const float rstd = rsqrtf(ss * (1.0f / D) + 1e-6f);
        const LAS float* gs = (const LAS float*)(lds + RT_GS) + (bb == b_first ? 0 : D) + 8 * g;
        const float* sh = MODl + (size_t)bb * 6144 + 3 * D + 8 * g;
        f32x4 acc[2] = {(f32x4){0.f, 0.f, 0.f, 0.f}, (f32x4){0.f, 0.f, 0.f, 0.f}};
        int offb[4];
#pragma unroll
        for (int b4 = 0; b4 < 4; ++b4) offb[b4] = rho * 2048 + (((4 * (b4 ^ ((rho >> 2) & 3))) + (g ^ (rho & 3))) << 4);
        for (int k4 = 0; k4 < 8; ++k4) {
            v4u xw[4]; f32x4 sv[4][2];
#pragma unroll
            for (int b4 = 0; b4 < 4; ++b4) { const int ks = 4 * k4 + b4; xw[b4] = *(const v4u*)(xr + 32 * ks); sv[b4][0] = *(const f32x4*)(sh + 32 * ks); sv[b4][1] = *(const f32x4*)(sh + 32 * ks + 4); }
#pragma unroll
            for (int b4 = 0; b4 < 4; ++b4) {
                const int ks = 4 * k4 + b4;
                const unsigned u4[4] = {xw[b4].x, xw[b4].y, xw[b4].z, xw[b4].w};
                const f32x4 g0 = *(const LAS f32x4*)(gs + 32 * ks), g1 = *(const LAS f32x4*)(gs + 32 * ks + 4);
                const f32x4 s0 = sv[b4][0], s1 = sv[b4][1];
                float hv[8];
#pragma unroll
                for (int q = 0; q < 4; ++q) { const float x0 = __uint_as_float(u4[q] << 16) * rstd, x1 = __uint_as_float(u4[q] & 0xffff0000u) * rstd;
                    const float gg0 = q < 2 ? g0[2 * q] : g1[2 * q - 4], gg1 = q < 2 ? g0[2 * q + 1] : g1[2 * q - 3], t0 = q < 2 ? s0[2 * q] : s1[2 * q - 4], t1 = q < 2 ? s0[2 * q + 1] : s1[2 * q - 3];
                    hv[2 * q] = x0 * gg0 + t0; hv[2 * q + 1] = x1 * gg1 + t1; }
                v4u hi, lo;
#pragma unroll
                for (int q = 0; q < 4; ++q) { const unsigned p = pk_bf16(hv[2 * q], hv[2 * q + 1]); ((unsigned*)&hi)[q] = p;
                    ((unsigned*)&lo)[q] = pk_bf16(hv[2 * q] - __uint_as_float(p << 16), hv[2 * q + 1] - __uint_as_float(p & 0xffff0000u)); }
                { uint2 f8; unsigned t0 = 0u, t1 = 0u; t0 = __builtin_amdgcn_cvt_pk_fp8_f32(hv[0], hv[1], t0, false); t0 = __builtin_amdgcn_cvt_pk_fp8_f32(hv[2], hv[3], t0, true);
                  t1 = __builtin_amdgcn_cvt_pk_fp8_f32(hv[4], hv[5], t1, false); t1 = __builtin_amdgcn_cvt_pk_fp8_f32(hv[6], hv[7], t1, true); f8.x = t0; f8.y = t1;
                  *(uint2*)(H8 + (size_t)row * D + 32 * ks + 8 * g) = f8; }
#pragma unroll
                for (int nt = 0; nt < 2; ++nt) { const int off = nt * 32768 + k4 * 256 + offb[b4];
                    const bf16x8 bh = *(const LAS bf16x8*)(lds + RT_WH + off), bl = *(const LAS bf16x8*)(lds + RT_WL + off);
                    acc[nt] = __builtin_amdgcn_mfma_f32_16x16x32_bf16(__builtin_bit_cast(bf16x8, hi), bh, acc[nt], 0, 0, 0);
                    acc[nt] = __builtin_amdgcn_mfma_f32_16x16x32_bf16(__builtin_bit_cast(bf16x8, lo), bh, acc[nt], 0, 0, 0);
                    acc[nt] = __builtin_amdgcn_mfma_f32_16x16x32_bf16(__builtin_bit_cast(bf16x8, hi), bl, acc[nt], 0, 0, 0); }
            }
        }
        LAS float* lg = (LAS float*)(lds + RT_LG + wave * 2048);
#pragma unroll
        for (int nt = 0; nt < 2; ++nt)
#pragma unroll
            for (int jj = 0; jj < 4; ++jj) lg[(4 * g + jj) * 32 + 16 * nt + rho] = acc[nt][jj] + br[16 * nt + rho];
        {
            float mine[8], allv[32];
#pragma unroll
            for (int q = 0; q < 8; ++q) { const f32x4 t = *(const LAS f32x4*)(lg + rho * 32 + 4 * q); allv[4 * q] = t[0]; allv[4 * q + 1] = t[1]; allv[4 * q + 2] = t[2]; allv[4 * q + 3] = t[3]; }
#pragma unroll
            for (int q = 0; q < 8; ++q) mine[q] = g == 0 ? allv[q] : g == 1 ? allv[8 + q] : g == 2 ? allv[16 + q] : allv[24 + q];
            LAS float* rs = lg;
#pragma unroll
            for (int q = 0; q < 8; ++q) { const int e = 8 * g + q; int rank = 0;
#pragma unroll
                for (int jx = 0; jx < 32; ++jx) rank += (allv[jx] > mine[q] || (allv[jx] == mine[q] && jx < e)) ? 1 : 0;
                if (rank < 4) { rs[(rho * 4 + rank) * 2] = mine[q]; ((LAS int*)rs)[(rho * 4 + rank) * 2 + 1] = e; } }
            if (lane < 16) {
                const f32x4 q0 = *(const LAS f32x4*)(rs + lane * 8), q1 = *(const LAS f32x4*)(rs + lane * 8 + 4);
                const float tv0 = q0[0], tv1 = q0[2], tv2 = q1[0], tv3 = q1[2]; const int ti[4] = {__float_as_int(q0[1]), __float_as_int(q0[3]), __float_as_int(q1[1]), __float_as_int(q1[3])};
                const float e1 = __expf(tv1 - tv0), e2 = __expf(tv2 - tv0), e3 = __expf(tv3 - tv0), inv = 1.0f / (1.0f + e1 + e2 + e3);
                const float gk[4] = {inv, e1 * inv, e2 * inv, e3 * inv};
                const int rl = 16 * blk + lane;
#pragma unroll
                for (int k = 0; k < 4; ++k) { const unsigned p = __hip_atomic_fetch_add(wcnt + ti[k], 1u, __ATOMIC_RELAXED, __HIP_MEMORY_SCOPE_WORKGROUP);
                    stmp[(rl * 4 + k) * 2] = (p << 5) | (unsigned)ti[k]; stmp[(rl * 4 + k) * 2 + 1] = __float_as_uint(gk[k]); }
            }
        }
    }
    __syncthreads();
    if (F.tid < NE) { const unsigned c = wcnt[F.tid]; wbase[F.tid] = c ? __hip_atomic_fetch_add(ctl + CW_CNT + (l * 32 + F.tid) * 64, c, RLX_AGENT) : 0u; }
    __syncthreads();
    for (int i = F.tid; i < rpw * 4; i += NWAVES * 64) { const int rl = i >> 2, k = i & 3, r = row_lo + rl; const unsigned pe = stmp[i * 2], e = pe & 31u, pos = wbase[e] + (pe >> 5);
        toklist[(size_t)e * CAP + pos] = r; sel[r * 4 + k] = (int)((pos << 5) | e); gatev[r * 4 + k] = __uint_as_float(stmp[i * 2 + 1]); }
}
struct MoeTab { int cnt[NE], base[NE + 1], tpre[NE + 1]; };
__device__ __forceinline__ void moe_tab_build(const CAS Args& a, const Frame& F, int l, LAS MoeTab* tb) {
    unsigned* ctl = (unsigned*)(a.ws + WS_CTL);
    __syncthreads();
    if (F.tid < NE) tb->cnt[F.tid] = (int)__hip_atomic_load(ctl + CW_CNT + (l * 32 + F.tid) * 64, RLX_AGENT);
    __syncthreads();
    if (F.tid == 0) { int bs = 0, tp = 0; for (int e = 0; e < NE; ++e) { const int c = tb->cnt[e]; tb->base[e] = bs; tb->tpre[e] = tp; bs += c; tp += (c + 255) >> 8; } tb->base[NE] = bs; tb->tpre[NE] = tp; }
    __syncthreads();
}
constexpr int MOE_UT_MAX = 64;
template <bool UP>
struct MoeSched {
    static constexpr bool GATHER = UP;
    const LAS MoeTab* tb; const LAS int* ut; const char* A; const char* WE; const int* toklist; int G, c;
    static constexpr int NN = UP ? 8 : 4;
    static __device__ __forceinline__ int rfl(int v) { return __builtin_amdgcn_readfirstlane(v); }
    static __device__ __forceinline__ const char* ufy(const char* p) { const unsigned long long v = (unsigned long long)p; const unsigned lo = __builtin_amdgcn_readfirstlane((unsigned)v), hi = __builtin_amdgcn_readfirstlane((unsigned)(v >> 32)); return (const char*)(((unsigned long long)hi << 32) | lo); }
    __device__ __forceinline__ bool unit_search(int i, int& pm, int& pn, int& e_, int& rows, int& base) const {
        const int nwg = tb->tpre[NE] * NN; const long L = (long)i * G + c; if (L >= nwg) return false;
        const int w = pg8::xcd_remap(L, nwg);
        int e = 0; while (e < NE - 1 && w >= tb->tpre[e + 1] * NN) ++e;
        const int tp0 = tb->tpre[e], tp1 = tb->tpre[e + 1];
        const int q = w - tp0 * NN, nte = tp1 - tp0;
        const int nig = 8 * NN, gid = q / nig, fm = gid * 8, gsz = (nte - fm) < 8 ? (nte - fm) : 8;
        pm = fm + ((q % nig) % gsz); pn = (q % nig) / gsz; e_ = e; rows = min(256, tb->cnt[e] - pm * 256); base = tb->base[e] + pm * 256;
        return true;
    }
    __device__ __forceinline__ void build(LAS int* utw, int tid) const {
        if (tid < MOE_UT_MAX) { int pm = -1, pn = 0, e = 0, rows = 0, base = 0; unit_search(tid, pm, pn, e, rows, base);
            utw[tid * 8 + 0] = pm; utw[tid * 8 + 1] = pn; utw[tid * 8 + 2] = e; utw[tid * 8 + 3] = rows; utw[tid * 8 + 4] = base; }
    }
    __device__ __forceinline__ bool unit(int i, pg8::Unit& u) const {
        if (i >= MOE_UT_MAX) return false;
        const LAS int* p = ut + i * 8; const int pm = rfl(p[0]); if (pm < 0) return false;
        u.pm = pm; u.pn = rfl(p[1]); u.e = rfl(p[2]); u.rows = rfl(p[3]); u.base = rfl(p[4]); u.newe = (i == 0) || (rfl(p[2 - 8]) != u.e);
        return true;
    }
    __device__ __forceinline__ bool bases(int i, const char*& a, const char*& b) const {
        pg8::Unit u; if (!unit(i, u)) return false;
        a = UP ? A : A + (size_t)u.base * D;
        b = WE + (size_t)u.e * 3072 * 1024 + (UP ? 0 : (size_t)2048 * 1024) + (size_t)u.pn * 256 * 1024;
        a = ufy(a); b = ufy(b);
        return true;
    }
    __device__ __forceinline__ void atoks(int i, const int (&rA)[2], int (&tok)[2][2]) const {
        pg8::Unit u; unit(i, u);
        const int* tl = toklist + (size_t)u.e * CAP + u.pm * 256;
#pragma unroll
        for (int h = 0; h < 2; ++h)
#pragma unroll
            for (int i2 = 0; i2 < 2; ++i2) { const int rr = h * 128 + rA[i2]; tok[h][i2] = tl[rr < u.rows ? rr : 0]; }
    }
    __device__ __forceinline__ void aoffs(int i, const int (&rA)[2], const unsigned (&voffA)[2], unsigned (&off)[2][2]) const {
        pg8::Unit u; unit(i, u);
        const int* tl = toklist + (size_t)u.e * CAP + u.pm * 256;
#pragma unroll
        for (int h = 0; h < 2; ++h)
#pragma unroll
            for (int i2 = 0; i2 < 2; ++i2) { const int rr = h * 128 + rA[i2]; const int tok = tl[rr < u.rows ? rr : 0]; off[h][i2] = (unsigned)tok * (unsigned)D + voffA[i2]; }
    }
};
struct EpiMoeUp {
    static constexpr bool PERM = true;
    bf16* ACT; const float* bgate; const float* bup; LAS float* btab;
    __device__ __forceinline__ void operator()(const f32x4 (&acc)[2][2][4][2], const pg8::Unit& u, int wr, int wc, int fr, int fq) const {
        const int col0 = u.pn * 128 + wc * 32 + 8 * fq, rl0 = wr * 64 + fr;
        if (u.newe) { const int tid = (wr * 4 + wc) * 64 + fr + 16 * fq;
            const f32x4 t = *(const f32x4*)((tid < 256 ? bgate : bup) + u.e * D + 4 * (tid & 255));
            *(LAS f32x4*)(btab + 4 * tid) = t;
            asm volatile("s_waitcnt lgkmcnt(0)" ::: "memory"); __builtin_amdgcn_s_barrier(); asm volatile("" ::: "memory"); }
        f32x2_t bg[2][2], bu[2][2];
#pragma unroll
        for (int n = 0; n < 2; ++n) { const f32x4 g4 = *(const LAS f32x4*)(btab + col0 + 4 * n), u4 = *(const LAS f32x4*)(btab + 1024 + col0 + 4 * n);
            bg[n][0] = (f32x2_t){g4[0], g4[1]}; bg[n][1] = (f32x2_t){g4[2], g4[3]};
            bu[n][0] = (f32x2_t){u4[0], u4[1]} * ACT8_SCALE + ACT8_SCALE; bu[n][1] = (f32x2_t){u4[2], u4[3]} * ACT8_SCALE + ACT8_SCALE; }
#pragma unroll
        for (int ai = 0; ai < 2; ++ai)
#pragma unroll
            for (int m = 0; m < 4; ++m) { const int rl = rl0 + ai * 128 + m * 16;
                f32x2_t o[2][2];
#pragma unroll
                for (int n = 0; n < 2; ++n)
#pragma unroll
                    for (int p = 0; p < 2; ++p) {
                        f32x2_t gg = (f32x2_t){acc[ai][0][m][n][2 * p], acc[ai][0][m][n][2 * p + 1]} * (1.0f / W8_SCALE) + bg[n][p];
                        gg.x = fminf(gg.x, 7.0f); gg.y = fminf(gg.y, 7.0f);
                        const f32x2_t tt = gg * (-1.702f * 1.44269504f);
                        f32x2_t dd; dd.x = __builtin_amdgcn_exp2f(tt.x); dd.y = __builtin_amdgcn_exp2f(tt.y); dd = dd + 1.0f;
                        f32x2_t rr; rr.x = __builtin_amdgcn_rcpf(dd.x); rr.y = __builtin_amdgcn_rcpf(dd.y);
                        f32x2_t uu = (f32x2_t){acc[ai][1][m][n][2 * p], acc[ai][1][m][n][2 * p + 1]} * (ACT8_SCALE / W8_SCALE) + bu[n][p];
                        uu.x = __builtin_amdgcn_fmed3f(uu.x, -6.0f * ACT8_SCALE, 8.0f * ACT8_SCALE); uu.y = __builtin_amdgcn_fmed3f(uu.y, -6.0f * ACT8_SCALE, 8.0f * ACT8_SCALE);
                        o[n][p] = (gg * rr) * uu;
                    }
                if (rl < u.rows) { uint2 w; unsigned w0 = 0u, w1 = 0u;
                    w0 = __builtin_amdgcn_cvt_pk_fp8_f32(o[0][0].x, o[0][0].y, w0, false); w0 = __builtin_amdgcn_cvt_pk_fp8_f32(o[0][1].x, o[0][1].y, w0, true);
                    w1 = __builtin_amdgcn_cvt_pk_fp8_f32(o[1][0].x, o[1][0].y, w1, false); w1 = __builtin_amdgcn_cvt_pk_fp8_f32(o[1][1].x, o[1][1].y, w1, true);
                    w.x = w0; w.y = w1;
                    *(uint2*)((unsigned char*)ACT + (size_t)(u.base + rl) * D + col0) = w; } }
    }
};
struct EpiMoeDown {
    static constexpr bool PERM = true;
    unsigned char* YB; const float* bdown; LAS float* btab;
    __device__ __forceinline__ void operator()(const f32x4 (&acc)[2][2][4][2], const pg8::Unit& u, int wr, int wc, int fr, int fq) const {
        const int col0 = u.pn * 256 + wc * 64 + 16 * fq, rl0 = wr * 64 + fr;
        if (u.newe) { const int tid = (wr * 4 + wc) * 64 + fr + 16 * fq;
            if (tid < 256) { const f32x4 t = *(const f32x4*)(bdown + u.e * D + 4 * tid); *(LAS f32x4*)(btab + 4 * tid) = t; }
            asm volatile("s_waitcnt lgkmcnt(0)" ::: "memory"); __builtin_amdgcn_s_barrier(); asm volatile("" ::: "memory"); }
        f32x4 bv[2][2];
#pragma unroll
        for (int bj = 0; bj < 2; ++bj)
#pragma unroll
            for (int n = 0; n < 2; ++n) bv[bj][n] = *(const LAS f32x4*)(btab + col0 + 8 * bj + 4 * n) * YB8_SCALE;
#pragma unroll
        for (int ai = 0; ai < 2; ++ai)
#pragma unroll
            for (int m = 0; m < 4; ++m) { const int rl = rl0 + ai * 128 + m * 16;
                if (rl < u.rows) { v4u w;
                    { const f32x4 v = acc[ai][0][m][0] * (YB8_SCALE / (W8_SCALE * ACT8_SCALE)) + bv[0][0]; w.x = pk4_fp8(v[0], v[1], v[2], v[3]); }
                    { const f32x4 v = acc[ai][0][m][1] * (YB8_SCALE / (W8_SCALE * ACT8_SCALE)) + bv[0][1]; w.y = pk4_fp8(v[0], v[1], v[2], v[3]); }
                    { const f32x4 v = acc[ai][1][m][0] * (YB8_SCALE / (W8_SCALE * ACT8_SCALE)) + bv[1][0]; w.z = pk4_fp8(v[0], v[1], v[2], v[3]); }
                    { const f32x4 v = acc[ai][1][m][1] * (YB8_SCALE / (W8_SCALE * ACT8_SCALE)) + bv[1][1]; w.w = pk4_fp8(v[0], v[1], v[2], v[3]); }
                    *(v4u*)(YB + (size_t)(u.base + rl) * D + col0) = w; } }
    }
};
constexpr int LDS_TAB = 131072;
__device__ __forceinline__ void p_moe_up(const CAS Args& a, const Frame& F, int l) {
    LAS MoeTab* tb = (LAS MoeTab*)(F.ldsl + LDS_TAB); moe_tab_build(a, F, l, tb);
    LAS int* utw = (LAS int*)(F.ldsl + LDS_TAB + 1024);
    MoeSched<true> S{tb, utw, (const char*)(a.ws + WS_H), (const char*)(a.ws + WS_WEXP) + (size_t)l * NE * 3072 * 1024, (const int*)(a.ws + WS_TOKLIST), F.G, F.bid};
    S.build(utw, F.tid); __syncthreads();
    EpiMoeUp E{(bf16*)(a.ws + WS_ACT), a.in[32] + (size_t)l * NE * D, a.in[34] + (size_t)l * NE * D, (LAS float*)(F.ldsl + LDS_TAB + 4096)};
    pg8::gemm_phase<D, true>(F.ldsl, S, E, F.wave);
}
__device__ __forceinline__ void p_moe_down(const CAS Args& a, const Frame& F, int l) {
    LAS MoeTab* tb = (LAS MoeTab*)(F.ldsl + LDS_TAB); moe_tab_build(a, F, l, tb);
    LAS int* utw = (LAS int*)(F.ldsl + LDS_TAB + 1024);
    MoeSched<false> S{tb, utw, (const char*)(a.ws + WS_ACT), (const char*)(a.ws + WS_WEXP) + (size_t)l * NE * 3072 * 1024, nullptr, F.G, F.bid};
    S.build(utw, F.tid); __syncthreads();
    EpiMoeDown E{(unsigned char*)(a.ws + WS_YB), a.in[36] + (size_t)l * NE * D, (LAS float*)(F.ldsl + LDS_TAB + 4096)};
    pg8::gemm_phase<D, true>(F.ldsl, S, E, F.wave);
}
__device__ __forceinline__ void p_combine(const CAS Args& a, const Frame& F, int l) {
    const unsigned char* YB = (const unsigned char*)(a.ws + WS_YB); bf16* XB = (bf16*)(a.ws + WS_XB); bf16* H = (bf16*)(a.ws + WS_H);
    const int* sel = (const int*)(a.ws + WS_SEL); const float* gatev = (const float*)(a.ws + WS_GATEV);
    LAS MoeTab* tb = (LAS MoeTab*)(F.ldsl + LDS_TAB); moe_tab_build(a, F, l, tb);
    const int rows = l == 0 ? R : NT, lane = F.lane;
    for (int r = F.gw; r < rows; r += 2 * F.ngw) {
        v4u xw[2][2]; uint2 yw[2][4][2]; float gk[2][4];
#pragma unroll
        for (int t = 0; t < 2; ++t) { const int rr = r + t * F.ngw; if (rr < rows) {
#pragma unroll
            for (int jh = 0; jh < 2; ++jh) xw[t][jh] = *(const v4u*)(XB + (size_t)rr * D + 512 * jh + 8 * lane);
#pragma unroll
            for (int k = 0; k < 4; ++k) { const int sv = sel[rr * 4 + k]; gk[t][k] = gatev[rr * 4 + k]; const int e = sv & 31, pos = sv >> 5;
                const unsigned char* y = YB + (size_t)(tb->base[e] + pos) * D;
#pragma unroll
                for (int jh = 0; jh < 2; ++jh) yw[t][k][jh] = *(const uint2*)(y + 512 * jh + 8 * lane); } } }
#pragma unroll
        for (int t = 0; t < 2; ++t) { const int rr = r + t * F.ngw; if (rr < rows) {
            float m[16], v[16];
#pragma unroll
            for (int i = 0; i < 16; ++i) m[i] = 0.f;
#pragma unroll
            for (int k = 0; k < 4; ++k) { const float gg = gk[t][k] * (1.0f / YB8_SCALE);
#pragma unroll
                for (int jh = 0; jh < 2; ++jh) { const unsigned w2[2] = {yw[t][k][jh].x, yw[t][k][jh].y};
#pragma unroll
                    for (int q = 0; q < 2; ++q) { const f32x2_t lo = __builtin_amdgcn_cvt_pk_f32_fp8((int)w2[q], false), hi = __builtin_amdgcn_cvt_pk_f32_fp8((int)w2[q], true);
                        m[8 * jh + 4 * q] += gg * lo.x; m[8 * jh + 4 * q + 1] += gg * lo.y; m[8 * jh + 4 * q + 2] += gg * hi.x; m[8 * jh + 4 * q + 3] += gg * hi.y; } } }
#pragma unroll
            for (int jh = 0; jh < 2; ++jh) { const unsigned x4[4] = {xw[t][jh].x, xw[t][jh].y, xw[t][jh].z, xw[t][jh].w};
#pragma unroll
                for (int q = 0; q < 4; ++q) { v[8 * jh + 2 * q] = __uint_as_float(x4[q] << 16); v[8 * jh + 2 * q + 1] = __uint_as_float(x4[q] & 0xffff0000u); } }
            const float* g2 = mod_ptr(a, l, rr, 5);
#pragma unroll
            for (int jh = 0; jh < 2; ++jh)
#pragma unroll
                for (int q = 0; q < 2; ++q) { const f32x4 gg = *(const f32x4*)(g2 + 512 * jh + 8 * lane + 4 * q);
#pragma unroll
                    for (int c = 0; c < 4; ++c) v[8 * jh + 4 * q + c] += gg[c] * m[8 * jh + 4 * q + c]; }
            if (l == 0) {
#pragma unroll
                for (int jh = 0; jh < 2; ++jh) *(v4u*)(XB + (size_t)rr * D + 512 * jh + 8 * lane) = (v4u){pk_bf16(v[8 * jh], v[8 * jh + 1]), pk_bf16(v[8 * jh + 2], v[8 * jh + 3]), pk_bf16(v[8 * jh + 4], v[8 * jh + 5]), pk_bf16(v[8 * jh + 6], v[8 * jh + 7])};
                float s = 0.f;
#pragma unroll
                for (int i2 = 0; i2 < 16; ++i2) s += v[i2] * v[i2];
                const float rstd = rsqrtf(wave_sum(s) * (1.0f / D) + 1e-6f);
                const float* gp = a.in[6] + D; const float* shp = mod_ptr(a, 1, rr, 0); const float* scp = mod_ptr(a, 1, rr, 1);
#pragma unroll
                for (int jh = 0; jh < 2; ++jh) { float hv[8];
#pragma unroll
                    for (int q = 0; q < 2; ++q) { const int e0 = 512 * jh + 8 * lane + 4 * q; const f32x4 gg = *(const f32x4*)(gp + e0), ss = *(const f32x4*)(shp + e0), cc = *(const f32x4*)(scp + e0);
#pragma unroll
                        for (int c = 0; c < 4; ++c) hv[4 * q + c] = v[8 * jh + 4 * q + c] * rstd * gg[c] * (1.f + cc[c]) + ss[c]; }
                    *(v4u*)(H + (size_t)rr * D + 512 * jh + 8 * lane) = (v4u){pk_bf16(hv[0], hv[1]), pk_bf16(hv[2], hv[3]), pk_bf16(hv[4], hv[5]), pk_bf16(hv[6], hv[7])}; }
            } else {
#pragma unroll
                for (int jh = 0; jh < 2; ++jh)
#pragma unroll
                    for (int q = 0; q < 2; ++q) *(f32x4*)(a.out + (size_t)rr * D + 512 * jh + 8 * lane + 4 * q) = (f32x4){v[8 * jh + 4 * q], v[8 * jh + 4 * q + 1], v[8 * jh + 4 * q + 2], v[8 * jh + 4 * q + 3]};
            } } }
    }
}
struct EpiInProj1 {
    static constexpr bool PERM = true;
    bf16* Gt; bf16* U;
    __device__ __forceinline__ void operator()(const f32x4 (&acc)[2][2][4][2], const pg8::Unit& u, int wr, int wc, int fr, int fq) const {
        const int row0 = u.pm * 256 + wr * 64 + fr; const bool gate = u.pn < 4;
        bf16* dst = gate ? Gt : U; const int col0 = (u.pn & 3) * 256 + wc * 32 + 8 * fq;
#pragma unroll
        for (int ai = 0; ai < 2; ++ai)
#pragma unroll
            for (int m = 0; m < 4; ++m) { bf16* rowp = dst + (size_t)(row0 + ai * 128 + m * 16) * D + col0;
#pragma unroll
                for (int bj = 0; bj < 2; ++bj) { f32x4 v0 = acc[ai][bj][m][0], v1 = acc[ai][bj][m][1];
                    if (gate) {
#pragma unroll
                        for (int j = 0; j < 4; ++j) { const float x = v0[j]; v0[j] = x * __builtin_amdgcn_rcpf(1.0f + __expf(-1.5957691216f * (x + 0.044715f * x * x * x)));
                                                      const float y = v1[j]; v1[j] = y * __builtin_amdgcn_rcpf(1.0f + __expf(-1.5957691216f * (y + 0.044715f * y * y * y))); } }
                    v4u w; w.x = pg8::cvt_pk_bf16(v0[0], v0[1]); w.y = pg8::cvt_pk_bf16(v0[2], v0[3]); w.z = pg8::cvt_pk_bf16(v1[0], v1[1]); w.w = pg8::cvt_pk_bf16(v1[2], v1[3]);
                    *(v4u*)(rowp + bj * 128) = w; } }
    }
};
__device__ __forceinline__ void p_inproj1(const CAS Args& a, const Frame& F) {
    pg8::RectSched S{(const char*)(a.ws + WS_H), (const char*)(a.ws + WS_WIN1), 2 * D, NT / 256, 8, F.G, F.bid, NC / 256, 4, NT / 256, 4};
    EpiInProj1 E{(bf16*)(a.ws + WS_G), (bf16*)(a.ws + WS_U)};
    pg8::gemm_phase<2 * D, false>(F.ldsl, S, E, F.wave);
}
__device__ __forceinline__ void p_conv4(const CAS Args& a, const Frame& F) {
    const bf16* U = (const bf16*)(a.ws + WS_U); bf16* UC = (bf16*)(a.ws + WS_UC);
    for (int u = F.gw; u < (R / 8) * 2; u += F.ngw) {
        const int rb = u >> 1, ch0 = (u & 1) * 512 + 8 * F.lane, row0 = rb * 8;
        const bool lat = row0 < NT; const int t0 = lat ? (row0 & 2047) : ((row0 - NT) & 255), len = lat ? 2048 : 256;
        float cw[4][8], cbv[8];
#pragma unroll
        for (int q = 0; q < 8; ++q) { cbv[q] = a.in[18][ch0 + q];
#pragma unroll
            for (int k = 0; k < 4; ++k) cw[k][q] = a.in[17][k * D + ch0 + q]; }
        v4u uv[11];
#pragma unroll
        for (int k = 0; k < 11; ++k) { const int tt = t0 + k - 1; uv[k] = (tt >= 0 && tt < len) ? *(const v4u*)(U + (size_t)(row0 + k - 1) * D + ch0) : (v4u){0u, 0u, 0u, 0u}; }
#pragma unroll
        for (int i = 0; i < 8; ++i) {
            float acc[8];
#pragma unroll
            for (int q = 0; q < 8; ++q) acc[q] = cbv[q];
#pragma unroll
            for (int k = 0; k < 4; ++k) { const unsigned w[4] = {uv[i + k].x, uv[i + k].y, uv[i + k].z, uv[i + k].w};
#pragma unroll
                for (int q = 0; q < 4; ++q) { acc[2 * q] += cw[k][2 * q] * __uint_as_float(w[q] << 16); acc[2 * q + 1] += cw[k][2 * q + 1] * __uint_as_float(w[q] & 0xffff0000u); } }
            *(v4u*)(UC + (size_t)(row0 + i) * D + ch0) = (v4u){pk_bf16(acc[0], acc[1]), pk_bf16(acc[2], acc[3]), pk_bf16(acc[4], acc[5]), pk_bf16(acc[6], acc[7])};
        }
    }
}
constexpr int LR_A = 0, LR_SC = 65536, LR_AG = 131072, LR_CY = LR_AG + 8192;
__device__ __forceinline__ void p_lru(const CAS Args& a, const Frame& F) {
    const bf16* UC = (const bf16*)(a.ws + WS_UC); const bf16* WL = (const bf16*)(a.ws + WS_WLRU); const bf16* Gt = (const bf16*)(a.ws + WS_G);
    bf16* HF = (bf16*)(a.ws + WS_HF); bf16* A3 = (bf16*)(a.ws + WS_A3);
    LAS unsigned char* lds = F.ldsl;
    const int lane_ = F.lane, wave = F.wave, sub = wave & 3, th = wave >> 2;
    for (int wu = F.bid; wu < 256; wu += F.G) {
        const int b = wu >> 4, h = (wu >> 2) & 3, cg = wu & 3;
        for (int dir = 0; dir < 2; ++dir) {
            const int lane = lane_, rho = lane & 15, g = lane >> 4;
            bf16x8 bw[2][8];
#pragma unroll
            for (int n = 0; n < 2; ++n)
#pragma unroll
                for (int ks = 0; ks < 8; ++ks) bw[n][ks] = *(const bf16x8*)(WL + ((size_t)h * 1024 + (2 * dir + n) * 256 + cg * 64 + 16 * sub + rho) * 256 + 32 * ks + 8 * g);
            const int chc = h * 256 + cg * 64 + 16 * sub + rho;
            const float bav = (dir ? a.in[25] : a.in[20])[chc] * -1.44269504f, bxv = (dir ? a.in[27] : a.in[22])[chc] * -1.44269504f;
            const float lamv = (dir ? a.in[28] : a.in[23])[chc];
            const float L8 = -8.0f * log1pf(expf(-lamv)) * 1.44269504f;
            __syncthreads();
            if (wave == 0) ((LAS float*)(lds + LR_CY))[lane] = 0.f;
#define LR_GROW0(ck_) ((ck_) < 2 ? (size_t)(NT + b * 256 + 128 * (dir ? 1 - (ck_) : (ck_))) : (size_t)(b * 2048 + 128 * (dir ? 15 - ((ck_) - 2) : (ck_) - 2)))
#define LR_STAGE(ck_) do { const size_t g0_ = LR_GROW0(ck_); _Pragma("unroll") for (int p_ = 0; p_ < 8; ++p_) { const int pc_ = wave * 8 + p_, row_ = 2 * pc_ + (lane >> 5), c_ = (lane & 31) ^ (row_ & 15); \
                __builtin_amdgcn_global_load_lds((const unsigned*)((const char*)UC + (g0_ + row_) * (D * 2) + h * 512 + 16 * c_), (LAS unsigned*)(lds + LR_A + pc_ * 1024), 16, 0, 0); } } while (0)
            LR_STAGE(0);
            for (int ck = 0; ck < 18; ++ck) {
                const bool isctx = ck < 2;
                const size_t grow0 = LR_GROW0(ck);
                int lane = lane_; asm volatile("" : "+v"(lane)); const int rho = lane & 15, g = lane >> 4, chs = h * 256 + cg * 64 + lane, ucol = cg * 64 + 16 * sub + rho;
                asm volatile("s_waitcnt vmcnt(0)" ::: "memory");
                __syncthreads();
                const int row0 = dir ? 112 - 16 * wave : 16 * wave;
                v4u hfr[2], gtr[2];
                if (dir && !isctx) {
#pragma unroll
                    for (int t = 0; t < 2; ++t) { const int tk = lane + 64 * t; const size_t gi = (grow0 + row0 + (tk >> 3)) * D + h * 256 + cg * 64 + 8 * (tk & 7);
                        hfr[t] = *(const v4u*)(HF + gi); gtr[t] = *(const v4u*)(Gt + gi); } }
                {
                    f32x4 acc[4][2];
#pragma unroll
                    for (int m = 0; m < 4; ++m)
#pragma unroll
                        for (int n = 0; n < 2; ++n) acc[m][n] = (f32x4){0.f, 0.f, 0.f, 0.f};
#pragma unroll
                    for (int ks = 0; ks < 8; ++ks)
#pragma unroll
                        for (int m = 0; m < 4; ++m) { const int rw = 64 * th + 16 * m + rho; const bf16x8 af = *(const LAS bf16x8*)(lds + LR_A + rw * 512 + (((4 * ks + g) ^ (rw & 15)) << 4));
#pragma unroll
                            for (int n = 0; n < 2; ++n) acc[m][n] = __builtin_amdgcn_mfma_f32_16x16x32_bf16(af, bw[n][ks], acc[m][n], 0, 0, 0);
                            if (m == 3 && (ks & 1)) asm volatile("" ::: "memory"); }
#pragma unroll
                    for (int m = 0; m < 4; ++m)
#pragma unroll
                        for (int p = 0; p < 2; ++p) {
                            const int row = 64 * th + 16 * m + 4 * g + 2 * p;
                            f32x2_t uc;
                            uc.x = bf2f(*(const LAS bf16*)(lds + LR_A + row * 512 + (((ucol >> 3) ^ (row & 15)) << 4) + 2 * (ucol & 7)));
                            uc.y = bf2f(*(const LAS bf16*)(lds + LR_A + (row + 1) * 512 + (((ucol >> 3) ^ ((row + 1) & 15)) << 4) + 2 * (ucol & 7)));
                            const f32x2_t xa = (f32x2_t){acc[m][0][2 * p], acc[m][0][2 * p + 1]} * -1.44269504f + bav, xx = (f32x2_t){acc[m][1][2 * p], acc[m][1][2 * p + 1]} * -1.44269504f + bxv;
                            f32x2_t da, dx; da.x = __builtin_amdgcn_exp2f(xa.x); da.y = __builtin_amdgcn_exp2f(xa.y); dx.x = __builtin_amdgcn_exp2f(xx.x); dx.y = __builtin_amdgcn_exp2f(xx.y);
                            da = da + 1.0f; dx = dx + 1.0f;
                            f32x2_t rr, ii; rr.x = __builtin_amdgcn_rcpf(da.x); rr.y = __builtin_amdgcn_rcpf(da.y); ii.x = __builtin_amdgcn_rcpf(dx.x); ii.y = __builtin_amdgcn_rcpf(dx.y);
                            const f32x2_t la = rr * L8;
                            f32x2_t av; av.x = __builtin_amdgcn_exp2f(la.x); av.y = __builtin_amdgcn_exp2f(la.y);
                            f32x2_t tt = 1.0f - av * av; tt.x = fmaxf(tt.x, 0.f); tt.y = fmaxf(tt.y, 0.f);
                            f32x2_t sq; sq.x = __builtin_amdgcn_sqrtf(tt.x); sq.y = __builtin_amdgcn_sqrtf(tt.y);
                            const f32x2_t bv = sq * ii * uc;
                            *(LAS f32x2_t*)(lds + LR_SC + (row * 64 + 16 * sub + rho) * 8) = (f32x2_t){av.x, bv.x};
                            *(LAS f32x2_t*)(lds + LR_SC + ((row + 1) * 64 + 16 * sub + rho) * 8) = (f32x2_t){av.y, bv.y};
                        }
                }
                __syncthreads();
                if (ck + 1 < 18) LR_STAGE(ck + 1);
                f32x2_t ab[16];
                {
#pragma unroll
                    for (int q = 0; q < 16; ++q) { const int s = 16 * wave + q, row = dir ? 127 - s : s; ab[q] = *(const LAS f32x2_t*)(lds + LR_SC + (row * 64 + lane) * 8); }
                    float hl = 0.f, pr = 1.f;
#pragma unroll
                    for (int q = 0; q < 16; ++q) { hl = ab[q].x * hl + ab[q].y; pr *= ab[q].x; ab[q] = (f32x2_t){pr, hl}; }
                    *(LAS f32x2_t*)(lds + LR_AG + ((ck & 1) * 512 + wave * 64 + lane) * 8) = (f32x2_t){pr, hl};
                }
                __syncthreads();
                {
                    float c = ((const LAS float*)(lds + LR_CY))[(ck & 1) * 64 + lane], cin = 0.f;
#pragma unroll
                    for (int w2 = 0; w2 < 8; ++w2) { if (w2 == wave) cin = c; const f32x2_t ag = *(const LAS f32x2_t*)(lds + LR_AG + ((ck & 1) * 512 + w2 * 64 + lane) * 8); c = ag.x * c + ag.y; }
                    if (wave == 0) ((LAS float*)(lds + LR_CY))[((ck + 1) & 1) * 64 + lane] = c;
                    if (!isctx) {
                        LAS unsigned char* scr = lds + LR_SC + row0 * 512;
                        if (dir) {
#pragma unroll
                            for (int t = 0; t < 2; ++t) { const int tk = lane + 64 * t; *(LAS v4u*)(scr + tk * 16) = hfr[t]; *(LAS v4u*)(scr + 2048 + tk * 16) = gtr[t]; }
                        }
#pragma unroll
                        for (int q = 0; q < 16; ++q) { const int tr = dir ? 15 - q : q;
                            float hv = ab[q].y + ab[q].x * cin;
                            if (dir) hv = (bf2f(*(const LAS bf16*)(scr + (tr * 64 + lane) * 2)) + hv) * bf2f(*(const LAS bf16*)(scr + 2048 + (tr * 64 + lane) * 2));
                            *(LAS bf16*)(scr + 4096 + (tr * 64 + lane) * 2) = f2bf(hv); }
                        bf16* dstp = dir ? A3 : HF;
#pragma unroll
                        for (int t = 0; t < 2; ++t) { const int tk = lane + 64 * t; const size_t gi = (grow0 + row0 + (tk >> 3)) * D + h * 256 + cg * 64 + 8 * (tk & 7);
                            *(v4u*)(dstp + gi) = *(const LAS v4u*)(scr + 4096 + tk * 16); }
                    }
                }
            }
#undef LR_STAGE
#undef LR_GROW0
        }
    }
}

constexpr int LDS_BYTES = 163840;
constexpr int NPHASE = 17;
template <unsigned KMASK>
__global__ void __launch_bounds__(NWAVES * 64, 2) fwd(Args kargs) {
    extern __shared__ __attribute__((aligned(16))) unsigned char lds[];
    const int wave_s = __builtin_amdgcn_readfirstlane((int)threadIdx.x >> 6);
    const int tid0 = wave_s * 64 + lane_id_fresh();
    volatile LAS unsigned* misc = (volatile LAS unsigned*)((LAS unsigned char*)lds + (LDS_BYTES - 64));
    if (tid0 < 16) misc[tid0] = 0u;
    __syncthreads();
    const int lo = kargs.ph_lo, hi = kargs.ph_hi;
    XcdBarrier bar; bar.bar = (unsigned*)(kargs.ws + WS_CTL) + CW_BAR + kargs.li * XCD_BAR_WORDS; bar.x = 0; bar.st = misc;
    if (hi - lo > 1) bar = xcd_barrier_post((unsigned*)(kargs.ws + WS_CTL) + CW_BAR + kargs.li * XCD_BAR_WORDS, misc, tid0);
#ifndef ONLY_PHASE
#define ONLY_PHASE -1
#endif
#ifndef PHASE_MASK
#define PHASE_MASK 0xFFFFFFFFu
#endif
#ifndef REPMASK
#define REPMASK 0u
#endif
#define PH(k, body) if constexpr (((KMASK >> (k)) & 1u) != 0u) if ((ONLY_PHASE < 0 || ONLY_PHASE == (k)) && ((PHASE_MASK >> (k)) & 1u) && lo <= (k) && (k) < hi) { \
        const CAS Args* ap_ = (const CAS Args*)__builtin_amdgcn_kernarg_segment_ptr(); asm volatile("" : "+s"(ap_)); const CAS Args& args = *ap_; \
        Frame F; F.lds = lds; F.ldsl = (LAS unsigned char*)lds; F.wave = wave_s; F.lane = lane_id_fresh(); \
        F.tid = F.wave * 64 + F.lane; F.G = gridDim.x; F.bid = blockIdx.x; F.gw = F.bid * NWAVES + F.wave; F.ngw = F.G * NWAVES; \
        if (((REPMASK >> (k)) & 1u) == 0u) { body; } else { int nrep_ = 2; asm volatile("" : "+s"(nrep_)); for (int rep_ = 0; rep_ < nrep_; ++rep_) { body; asm volatile("s_waitcnt vmcnt(0)" ::: "memory"); __syncthreads(); } } if ((k) + 1 < hi) xcd_barrier(bar, F.tid); else { asm volatile("s_waitcnt vmcnt(0)" ::: "memory"); __syncthreads(); } }
    PH(0, p0_prologue(args, F))
    PH(1, p_norm1_l0(args, F))
    PH(2, p_inproj0(args, F))
    PH(3, p_attn(args, F))
    PH(4, p_outproj<0>(args, F))
    PH(5, p_norm2_router(args, F, 0))
    PH(6, p_moe_up(args, F, 0))
    PH(7, p_moe_down(args, F, 0))
    PH(8, p_combine(args, F, 0))
    PH(9, p_inproj1(args, F))
    PH(10, p_conv4(args, F))
    PH(11, p_lru(args, F))
    PH(12, p_outproj<1>(args, F))
    PH(13, p_norm2_router(args, F, 1))
    PH(14, p_moe_up(args, F, 1))
    PH(15, p_moe_down(args, F, 1))
    PH(16, p_combine(args, F, 1))
#undef PH
}

constexpr unsigned MASK_A = (1u<<2)|(1u<<4)|(1u<<6)|(1u<<7)|(1u<<9)|(1u<<11)|(1u<<13)|(1u<<14), MASK_C = 1u << 3, MASK_D = 1u << 10, MASK_ALL = 0x1FFFFu, MASK_B = MASK_ALL & ~(MASK_A | MASK_C | MASK_D);
__host__ inline int kid_of(int p) { return ((MASK_A >> p) & 1u) ? 0 : ((MASK_C >> p) & 1u) ? 2 : ((MASK_D >> p) & 1u) ? 3 : 1; }
extern "C" void kernel_launch(void* const* d_in, const int* in_sizes, int n_in, void* d_out, int out_size, void* d_ws, size_t ws_size, hipStream_t stream) {
    static int grid = 0;
    if (grid == 0) {
        if (n_in != 37 || out_size != NT * D || ws_size < WS_END) { fprintf(stderr, "kernel_launch: unexpected shapes (n_in %d out %d ws %zu)\n", n_in, out_size, ws_size); grid = -1; return; }
        int dev = 0, cus = 0;
        if (hipGetDevice(&dev) != hipSuccess || hipDeviceGetAttribute(&cus, hipDeviceAttributeMultiprocessorCount, dev) != hipSuccess) { grid = -1; return; }
#ifndef MULTI_LAUNCH
        if (hipFuncSetAttribute((const void*)fwd<MASK_ALL>, hipFuncAttributeMaxDynamicSharedMemorySize, LDS_BYTES) != hipSuccess) { fprintf(stderr, "kernel_launch: hipFuncSetAttribute failed\n"); grid = -1; return; }
#else
        if (hipFuncSetAttribute((const void*)fwd<MASK_A>, hipFuncAttributeMaxDynamicSharedMemorySize, LDS_BYTES) != hipSuccess) { fprintf(stderr, "kernel_launch: hipFuncSetAttribute failed\n"); grid = -1; return; }
        if (hipFuncSetAttribute((const void*)fwd<MASK_B>, hipFuncAttributeMaxDynamicSharedMemorySize, LDS_BYTES) != hipSuccess) { fprintf(stderr, "kernel_launch: hipFuncSetAttribute failed\n"); grid = -1; return; }
        if (hipFuncSetAttribute((const void*)fwd<MASK_C>, hipFuncAttributeMaxDynamicSharedMemorySize, LDS_BYTES) != hipSuccess) { fprintf(stderr, "kernel_launch: hipFuncSetAttribute failed\n"); grid = -1; return; }
        if (hipFuncSetAttribute((const void*)fwd<MASK_D>, hipFuncAttributeMaxDynamicSharedMemorySize, LDS_BYTES) != hipSuccess) { fprintf(stderr, "kernel_launch: hipFuncSetAttribute failed\n"); grid = -1; return; }
#endif
        (void)hipGetLastError();
        grid = cus;
    }
    if (grid < 0) return;
    if (hipMemsetAsync((char*)d_ws + WS_CTL, 0, CTL_ZERO_BYTES, stream) != hipSuccess) return;
    Args a{};
    for (int i = 0; i < 37; ++i) a.in[i] = (const float*)d_in[i];
    a.out = (float*)d_out; a.ws = (unsigned char*)d_ws;
#ifdef MULTI_LAUNCH
    int p = 0, li = 0;
    while (p < NPHASE) {
        const int kid = kid_of(p); int q = p + 1;
        while (q < NPHASE && kid_of(q) == kid) ++q;
        a.ph_lo = p; a.ph_hi = q; a.li = li++;
        if (kid == 0) hipLaunchKernelGGL(fwd<MASK_A>, dim3(grid), dim3(NWAVES * 64), LDS_BYTES, stream, a);
        else if (kid == 1) hipLaunchKernelGGL(fwd<MASK_B>, dim3(grid), dim3(NWAVES * 64), LDS_BYTES, stream, a);
        else if (kid == 2) hipLaunchKernelGGL(fwd<MASK_C>, dim3(grid), dim3(NWAVES * 64), LDS_BYTES, stream, a);
        else hipLaunchKernelGGL(fwd<MASK_D>, dim3(grid), dim3(NWAVES * 64), LDS_BYTES, stream, a);
        p = q;
    }
#else
    a.ph_lo = 0; a.ph_hi = NPHASE; a.li = 0;
    hipLaunchKernelGGL(fwd<MASK_ALL>, dim3(grid), dim3(NWAVES * 64), LDS_BYTES, stream, a);
#endif
}
```

```cpp
#include <hip/hip_runtime.h>
#include <stdint.h>
#include <stdio.h>

constexpr int D = 1024, NB = 16, SEQ = 2048, NT = NB * SEQ, LC = 256, NC = NB * LC, R = NT + NC;
constexpr int NE = 32, CAP = R;
constexpr int NWAVES = 8;

typedef unsigned short bf16;
typedef short bf16x8 __attribute__((ext_vector_type(8)));
typedef float f32x4 __attribute__((ext_vector_type(4)));
typedef unsigned v4u __attribute__((ext_vector_type(4)));
#define LAS __attribute__((address_space(3)))
#define CAS __attribute__((address_space(4)))
#define RLX_AGENT __ATOMIC_RELAXED, __HIP_MEMORY_SCOPE_AGENT

constexpr size_t MiB = 1u << 20;
constexpr size_t WS_CTL = 0, CTL_ZERO_BYTES = 1 * MiB;
constexpr size_t WS_MOD = 1 * MiB;
constexpr size_t WS_WIN0 = 2 * MiB, WS_WOUT0 = 8 * MiB, WS_WIN1 = 10 * MiB, WS_WOUT1 = 14 * MiB, WS_WLRU = 16 * MiB;
constexpr size_t WS_TOKLIST = 18 * MiB;
constexpr size_t WS_SEL = 23 * MiB;
constexpr size_t WS_GATEV = 24 * MiB;
constexpr size_t WS_XC = 25 * MiB;
constexpr size_t WS_WEXP = 41 * MiB;
constexpr size_t WS_H = 233 * MiB;
constexpr size_t WS_P = 305 * MiB;
constexpr int PP = 2560;
constexpr size_t WS_A2 = 521 * MiB;
constexpr size_t WS_ACT = 593 * MiB;
constexpr size_t WS_YB = 305 * MiB;
constexpr size_t WS_G = 305 * MiB;
constexpr size_t WS_U = 369 * MiB;
constexpr size_t WS_UC = 441 * MiB;
constexpr size_t WS_AF = 513 * MiB;
constexpr size_t WS_AB = 657 * MiB;
constexpr size_t WS_HF = WS_AF;
constexpr size_t WS_A3 = WS_AB;
constexpr size_t WS_BF = 801 * MiB;
constexpr size_t WS_BB = 873 * MiB;
constexpr size_t WS_GS2 = 840 * MiB;
constexpr size_t WS_XB = 760 * MiB;
constexpr size_t WS_END = 945 * MiB;
constexpr int CW_BAR = 4096;
constexpr int CW_CNT = 65536;

__device__ __forceinline__ float bf2f(bf16 v) { return __uint_as_float(((unsigned)v) << 16); }
__device__ __forceinline__ bf16 f2bf(float f) { unsigned u = __float_as_uint(f); return (bf16)((u + 0x7fffu + ((u >> 16) & 1u)) >> 16); }
__device__ __forceinline__ unsigned pk2(float lo, float hi) { return (unsigned)f2bf(lo) | ((unsigned)f2bf(hi) << 16); }
__device__ __forceinline__ int lane_id_fresh() { int l; asm volatile("v_mbcnt_lo_u32_b32 %0, -1, 0\n\tv_mbcnt_hi_u32_b32 %0, -1, %0" : "=v"(l)); return l; }
__device__ __forceinline__ unsigned pk4_fp8(float a, float b, float c, float d) {
    a = fminf(fmaxf(a, -448.f), 448.f); b = fminf(fmaxf(b, -448.f), 448.f); c = fminf(fmaxf(c, -448.f), 448.f); d = fminf(fmaxf(d, -448.f), 448.f);
    unsigned w = 0u; w = __builtin_amdgcn_cvt_pk_fp8_f32(a, b, w, false); w = __builtin_amdgcn_cvt_pk_fp8_f32(c, d, w, true); return w;
}
constexpr float W8_SCALE = 32.0f, ACT8_SCALE = 4.0f, YB8_SCALE = 16.0f;
__device__ __forceinline__ float wave_sum(float v) {
#pragma unroll
    for (int o = 1; o < 64; o <<= 1) v += __shfl_xor(v, o);
    return v;
}
__device__ __forceinline__ float wave_max(float v) {
#pragma unroll
    for (int o = 1; o < 64; o <<= 1) v = fmaxf(v, __shfl_xor(v, o));
    return v;
}
__device__ __forceinline__ float sigmoidf_(float x) { return 1.0f / (1.0f + __expf(-x)); }
__device__ __forceinline__ float gelu_tanh(float x) { return 0.5f * x * (1.0f + tanhf(0.7978845608028654f * (x + 0.044715f * x * x * x))); }

#define XB_TMO      128
#define XB_XCNT(j)  (256  + 64 * (j))
#define XB_XSUB(j)  (1280 + 64 * (j))
#define XB_XGEN(j)  (2304 + 64 * (j))
#define XB_TOP      3328
#define XB_TOPGEN   3392
#define XCD_BAR_WORDS 3456
#define XB_SPIN_CAP (1u << 18)
__device__ __forceinline__ unsigned xb_ld(unsigned* p)              { return __hip_atomic_load(p, __ATOMIC_RELAXED, __HIP_MEMORY_SCOPE_AGENT); }
__device__ __forceinline__ unsigned xb_add(unsigned* p, unsigned v) { return __hip_atomic_fetch_add(p, v, __ATOMIC_RELAXED, __HIP_MEMORY_SCOPE_AGENT); }
__device__ __forceinline__ unsigned xb_xcc_id() { return (unsigned)__builtin_amdgcn_s_getreg((3 << 11) | 20) & 0xFu; }
#define XB_SPIN(cond, bar) do { unsigned _sp = 0; while (cond) { __builtin_amdgcn_s_sleep(1); \
    if ((++_sp & 255u) == 0u) { if (xb_ld(&(bar)[XB_TMO])) break; if (_sp > XB_SPIN_CAP) { atomicAdd(&(bar)[XB_TMO], 1u); break; } } } } while (0)
struct XcdBarrier { unsigned* bar; unsigned x; volatile LAS unsigned* st; };
__device__ __forceinline__ XcdBarrier xcd_barrier_post(unsigned* bar, volatile LAS unsigned* st, int tid) {
    XcdBarrier b; b.bar = bar; b.x = xb_xcc_id(); b.st = st;
    if (tid == 0) (void)xb_add(&bar[XB_XCNT(b.x)], 1u);
    return b;
}
__device__ __forceinline__ void xcd_barrier_complete(unsigned* bar, unsigned x, unsigned& nloc, unsigned& nx) {
    const unsigned G = gridDim.x * gridDim.y * gridDim.z;
    unsigned sum, cnt, mine, sp = 0u;
    for (;;) {
        sum = 0u; cnt = 0u; mine = 0u;
#pragma unroll
        for (unsigned j = 0; j < 16; ++j) { const unsigned c = xb_ld(&bar[XB_XCNT(j)]); sum += c; cnt += (c > 0u) ? 1u : 0u; mine = (j == x) ? c : mine; }
        if (sum == G) break;
        __builtin_amdgcn_s_sleep(1);
        if ((++sp & 255u) == 0u) { if (xb_ld(&bar[XB_TMO])) break; if (sp > XB_SPIN_CAP) { atomicAdd(&bar[XB_TMO], 1u); break; } }
    }
    nloc = mine > 0u ? mine : 1u; nx = cnt > 0u ? cnt : 1u;
}
__device__ __forceinline__ void xcd_barrier(const XcdBarrier& b, int tid) {
    asm volatile("s_waitcnt vmcnt(0)" ::: "memory");
    __syncthreads();
    if (tid == 0) {
        unsigned* bar = b.bar;
        __builtin_amdgcn_s_waitcnt(0);
        unsigned nloc = b.st[0], nx = b.st[1];
        if (nloc == 0u) { xcd_barrier_complete(bar, b.x, nloc, nx); b.st[0] = nloc; b.st[1] = nx; }
        const unsigned old = xb_add(&bar[XB_XSUB(b.x)], 1u);
        const unsigned gen = old / nloc;
        if (old + 1u == (gen + 1u) * nloc) {
            __builtin_amdgcn_fence(__ATOMIC_RELEASE, "agent");
            asm volatile("s_waitcnt vmcnt(0)" ::: "memory");
            const unsigned og = xb_add(&bar[XB_TOP], 1u);
            const unsigned tg = og / nx;
            if (og + 1u == (tg + 1u) * nx) xb_add(&bar[XB_TOPGEN], 1u);
            else XB_SPIN(xb_ld(&bar[XB_TOPGEN]) == tg, bar);
            __builtin_amdgcn_fence(__ATOMIC_ACQUIRE, "agent");
            xb_add(&bar[XB_XGEN(b.x)], 1u);
            asm volatile("s_waitcnt vmcnt(0)" ::: "memory");
        } else {
            XB_SPIN(xb_ld(&bar[XB_XGEN(b.x)]) == gen, bar);
            __builtin_amdgcn_fence(__ATOMIC_ACQUIRE, "agent");
            asm volatile("s_waitcnt vmcnt(0)" ::: "memory");
        }
    }
    __syncthreads();
}

struct Args { const float* in[37]; float* out; unsigned char* ws; int ph_lo, ph_hi, li, pad; };
struct Frame {
    unsigned char* lds;
    LAS unsigned char* ldsl;
    int tid, lane, wave, gw, ngw, G, bid;
};

template <int NS, class FA, class FB, class FS>
__device__ __forceinline__ void tile_gemm32(int K, FA arow, FB brow, FS store, int lane) {
    const int lr = lane & 15, lq = lane >> 4;
    const bf16* ap[2]; const bf16* bp[NS][2];
#pragma unroll
    for (int i = 0; i < 2; ++i) ap[i] = arow(16 * i + lr) + 8 * lq;
#pragma unroll
    for (int s = 0; s < NS; ++s)
#pragma unroll
        for (int j = 0; j < 2; ++j) bp[s][j] = brow(s, 16 * j + lr) + 8 * lq;
    f32x4 acc[NS][2][2];
#pragma unroll
    for (int s = 0; s < NS; ++s)
#pragma unroll
        for (int i = 0; i < 2; ++i)
#pragma unroll
            for (int j = 0; j < 2; ++j) acc[s][i][j] = (f32x4){0.f, 0.f, 0.f, 0.f};
#pragma nounroll
    for (int k0 = 0; k0 < K; k0 += 32) {
        bf16x8 a[2], b[NS][2];
#pragma unroll
        for (int i = 0; i < 2; ++i) a[i] = *(const bf16x8*)(ap[i] + k0);
#pragma unroll
        for (int s = 0; s < NS; ++s)
#pragma unroll
            for (int j = 0; j < 2; ++j) b[s][j] = *(const bf16x8*)(bp[s][j] + k0);
#pragma unroll
        for (int s = 0; s < NS; ++s)
#pragma unroll
            for (int i = 0; i < 2; ++i)
#pragma unroll
                for (int j = 0; j < 2; ++j) acc[s][i][j] = __builtin_amdgcn_mfma_f32_16x16x32_bf16(a[i], b[s][j], acc[s][i][j], 0, 0, 0);
    }
#pragma unroll
    for (int i = 0; i < 2; ++i)
#pragma unroll
        for (int j = 0; j < 2; ++j)
#pragma unroll
            for (int q = 0; q < 4; ++q) {
                float v[NS];
#pragma unroll
                for (int s = 0; s < NS; ++s) v[s] = acc[s][i][j][q];
                store(16 * i + 4 * lq + q, 16 * j + lr, v);
            }
}


namespace pg8 {
constexpr int BM = 256, BK = 64, HALF = 128, HTB = HALF * BK * 2, STAGE_BYTES = 8 * HTB;
__device__ __forceinline__ int lds_byte(int r, int c) { const int st = (r >> 4) * 2 + (c >> 5), rr = r & 15, cc = c & 31, ob = rr * 64 + cc * 2; return st * 1024 + (ob ^ (((ob >> 9) & 1) << 5)); }
__device__ __forceinline__ void stage_rc(int b, int& R_, int& C_) { const int st = b / 1024, sb = b % 1024, swz = sb ^ (((sb >> 9) & 1) << 5); R_ = (st >> 1) * 16 + swz / 64; C_ = (st & 1) * 32 + (swz % 64) / 2; }
__device__ __forceinline__ int perm32(int rho) { const int n = rho >> 4, i = rho & 15; return 8 * (i >> 2) + 4 * n + (i & 3); }
struct Unit { int pm, pn, e, rows, base, newe; };
typedef int v8i __attribute__((ext_vector_type(8)));
typedef int v4i __attribute__((ext_vector_type(4)));
__device__ __forceinline__ void mfma8(f32x4& acc, v8i a, v8i b, unsigned sc) {
    asm volatile("v_mfma_scale_f32_16x16x128_f8f6f4 %0, %1, %2, %0, %3, %3 op_sel_hi:[0,0,0]" : "+v"(acc) : "v"(a), "v"(b), "v"(sc));
}
__device__ __forceinline__ v8i cat8(bf16x8 a, bf16x8 b) { return __builtin_shufflevector(__builtin_bit_cast(v4i, a), __builtin_bit_cast(v4i, b), 0, 1, 2, 3, 4, 5, 6, 7); }
__device__ __forceinline__ unsigned cvt_pk_bf16(float lo, float hi) { unsigned r; asm volatile("v_cvt_pk_bf16_f32 %0, %1, %2" : "=v"(r) : "v"(lo), "v"(hi)); return r; }

template <int RB  , bool FP8, class Epi, class Sched>
__device__ __forceinline__ void gemm_phase(LAS unsigned char* lds, const Sched& S, const Epi& E, const int wave_id) {
    const int tid_ = wave_id * 64 + lane_id_fresh();
    const int tid = tid_, wid = wave_id, lane = tid & 63, wr = wid >> 2, wc = wid & 3, fr = lane & 15, fq = lane >> 4;
    constexpr int nt = RB / 128;
    unsigned voffA[2], voffB[2]; int rA[2];
#pragma unroll
    for (int i = 0; i < 2; ++i) { int R_, C_; stage_rc(tid * 16 + i * 8192, R_, C_); const int Rb = Epi::PERM ? ((R_ & ~31) + perm32(R_ & 31)) : R_;
        voffA[i] = Sched::GATHER ? (unsigned)C_ * 2u : (unsigned)(R_ * RB + C_ * 2); rA[i] = R_; voffB[i] = (unsigned)(Rb * RB + C_ * 2); }
    constexpr size_t kstep = (size_t)(BK * 2);
    constexpr size_t hstep = (size_t)HALF * RB;
    const unsigned ldsw = (unsigned)wid * 1024u;
    const int aoff = lds_byte(wr * 64 + fr, fq * 8), boff = lds_byte(wc * 32 + fr, fq * 8);
#define PG8_SA(b, h) (((b) * 2 + (h)) * HTB)
#define PG8_SB(b, h) ((4 + (b) * 2 + (h)) * HTB)
#define PG8_STAGE(bufoff, gbase, voff) do { _Pragma("unroll") for (int _i = 0; _i < 2; ++_i) \
        __builtin_amdgcn_global_load_lds((const unsigned*)((const char*)(gbase) + (voff)[_i]), (LAS unsigned*)(lds + (bufoff) + ldsw + _i * 8192), 16, 0, 0); } while (0)
#define PG8_STAGE_A(bufoff, ubase, uoff, h) do { if constexpr (Sched::GATHER) PG8_STAGE(bufoff, ubase, (uoff)[h]); else PG8_STAGE(bufoff, (ubase) + (h) * hstep, voffA); } while (0)
#define PG8_LDA(dst, b, h) do { _Pragma("unroll") for (int m = 0; m < 4; ++m) _Pragma("unroll") for (int k = 0; k < 2; ++k) dst[m][k] = *(const LAS bf16x8*)(lds + PG8_SA(b, h) + aoff + m * 2048 + k * 1024); } while (0)
#define PG8_LDB(dst, b, h) do { _Pragma("unroll") for (int n = 0; n < 2; ++n) _Pragma("unroll") for (int k = 0; k < 2; ++k) dst[n][k] = *(const LAS bf16x8*)(lds + PG8_SB(b, h) + boff + n * 2048 + k * 1024); } while (0)
#define PG8_MMA(ai, bj, At, Bt) do { __builtin_amdgcn_s_setprio(1); _Pragma("unroll") for (int m = 0; m < 4; ++m) _Pragma("unroll") for (int n = 0; n < 2; ++n) { \
        if constexpr (FP8) mfma8(acc[ai][bj][m][n], cat8(Bt[n][0], Bt[n][1]), cat8(At[m][0], At[m][1]), sc1); \
        else { _Pragma("unroll") for (int k = 0; k < 2; ++k) acc[ai][bj][m][n] = __builtin_amdgcn_mfma_f32_16x16x32_bf16(Bt[n][k], At[m][k], acc[ai][bj][m][n], 0, 0, 0); } } __builtin_amdgcn_s_setprio(0); } while (0)
#define PG8_WAIT_V(n) asm volatile("s_waitcnt vmcnt(" #n ")" ::: "memory")
#define PG8_WAIT_L(n) asm volatile("s_waitcnt lgkmcnt(" #n ")" ::: "memory")
#define PG8_BAR __builtin_amdgcn_s_barrier()
#define PG8_SCHED __builtin_amdgcn_sched_barrier(0)
#define PG8_KBODY(a1, a2, b2, off2) do { const char* _a1 = (a1); const char* _a2 = (a2); const char* _b2 = (b2); const char* _a3 = _a2 + kstep; const char* _b3 = _b2 + kstep; \
            asm volatile("" : "+s"(_a1), "+s"(_a2), "+s"(_b2), "+s"(_a3), "+s"(_b3));   \
            PG8_LDB(B0, 0, 0); PG8_LDB(B1, 0, 1); PG8_SCHED; PG8_LDA(At, 0, 0); PG8_STAGE_A(PG8_SA(1, 1), _a1, coff, 1); \
            PG8_WAIT_V(8); PG8_WAIT_L(0); PG8_BAR; PG8_MMA(0, 0, At, B0); PG8_MMA(0, 1, At, B1); PG8_BAR; PG8_SCHED; \
            PG8_LDA(At, 0, 1); PG8_STAGE(PG8_SB(0, 0), _b2, voffB); PG8_STAGE(PG8_SB(0, 1), _b2 + hstep, voffB); PG8_STAGE_A(PG8_SA(0, 0), _a2, off2, 0); \
            PG8_WAIT_V(8); PG8_WAIT_L(0); PG8_BAR; PG8_MMA(1, 0, At, B0); PG8_MMA(1, 1, At, B1); PG8_BAR; PG8_SCHED; \
            PG8_LDB(B0, 1, 0); PG8_LDB(B1, 1, 1); PG8_SCHED; PG8_LDA(At, 1, 0); PG8_STAGE_A(PG8_SA(0, 1), _a2, off2, 1); \
            PG8_WAIT_V(8); PG8_WAIT_L(0); PG8_BAR; PG8_MMA(0, 0, At, B0); PG8_MMA(0, 1, At, B1); PG8_BAR; PG8_SCHED; \
            PG8_LDA(At, 1, 1); PG8_STAGE(PG8_SB(1, 0), _b3, voffB); PG8_STAGE(PG8_SB(1, 1), _b3 + hstep, voffB); PG8_STAGE_A(PG8_SA(1, 0), _a3, off2, 0); \
            PG8_WAIT_V(8); PG8_WAIT_L(0); PG8_BAR; PG8_MMA(1, 0, At, B0); PG8_MMA(1, 1, At, B1); PG8_BAR; PG8_SCHED; } while (0)
    int ui = 0;
    const char* cA; const char* cB;
    if (!S.bases(0, cA, cB)) return;
    f32x4 acc[2][2][4][2];
#pragma unroll
    for (int a = 0; a < 2; ++a)
#pragma unroll
        for (int b = 0; b < 2; ++b)
#pragma unroll
            for (int m = 0; m < 4; ++m)
#pragma unroll
                for (int n = 0; n < 2; ++n) acc[a][b][m][n] = (f32x4){0.f, 0.f, 0.f, 0.f};
    bf16x8 At[4][2], B0[2][2], B1[2][2];
    unsigned sc1 = 0x7f7f7f7fu; asm volatile("" : "+v"(sc1));
    unsigned coff[2][2], noff[2][2];
    if constexpr (Sched::GATHER) S.aoffs(0, rA, voffA, coff);
    PG8_STAGE(PG8_SB(0, 0), cB, voffB); PG8_STAGE(PG8_SB(0, 1), cB + hstep, voffB); PG8_STAGE_A(PG8_SA(0, 0), cA, coff, 0); PG8_STAGE_A(PG8_SA(0, 1), cA, coff, 1);
    if (wr == 1) PG8_BAR;
    PG8_WAIT_V(2); PG8_BAR;
    PG8_STAGE(PG8_SB(1, 0), cB + kstep, voffB); PG8_STAGE_A(PG8_SA(1, 0), cA + kstep, coff, 0); PG8_STAGE(PG8_SB(1, 1), cB + hstep + kstep, voffB);
    PG8_WAIT_V(6); PG8_BAR;
    for (;;) {
        const char* nA; const char* nB;
        const bool has_next = S.bases(ui + 1, nA, nB);
        if (!has_next) { nA = cA; nB = cB; }
        int ntok[2][2];
        if constexpr (Sched::GATHER) { if (has_next) S.atoks(ui + 1, rA, ntok); }
#pragma nounroll
        for (int t = 0; t < nt - 2; t += 2) PG8_KBODY(cA + (size_t)(t + 1) * kstep, cA + (size_t)(t + 2) * kstep, cB + (size_t)(t + 2) * kstep, coff);
        if constexpr (Sched::GATHER) {
            if (has_next) { asm volatile("" : "+v"(ntok[0][0]), "+v"(ntok[0][1]), "+v"(ntok[1][0]), "+v"(ntok[1][1]));
#pragma unroll
                for (int h = 0; h < 2; ++h)
#pragma unroll
                    for (int i = 0; i < 2; ++i) noff[h][i] = (unsigned)ntok[h][i] * (unsigned)RB + voffA[i]; }
            else {
#pragma unroll
                for (int h = 0; h < 2; ++h)
#pragma unroll
                    for (int i = 0; i < 2; ++i) noff[h][i] = coff[h][i]; }
        }
        PG8_KBODY(cA + (size_t)(nt - 1) * kstep, nA, nB, noff);
        if (wr == 0) PG8_BAR;
        if constexpr (FP8) asm volatile("s_nop 15\n\ts_nop 3" ::: "memory");
        {
            const int t2 = lane_id_fresh();
            const int w2 = wave_id, l2 = t2 & 63;
            Unit cur; S.unit(ui, cur); E(acc, cur, w2 >> 2, w2 & 3, l2 & 15, l2 >> 4); }
        if (!has_next) break;
#pragma unroll
        for (int a = 0; a < 2; ++a)
#pragma unroll
            for (int b = 0; b < 2; ++b)
#pragma unroll
                for (int m = 0; m < 4; ++m)
#pragma unroll
                    for (int n = 0; n < 2; ++n) acc[a][b][m][n] = (f32x4){0.f, 0.f, 0.f, 0.f};
        cA = nA; cB = nB; ++ui;
        if constexpr (Sched::GATHER) {
#pragma unroll
            for (int h = 0; h < 2; ++h)
#pragma unroll
                for (int i = 0; i < 2; ++i) coff[h][i] = noff[h][i]; }
        if (wr == 1) PG8_BAR;
    }
    PG8_WAIT_V(0);
    PG8_BAR;
#undef PG8_SA
#undef PG8_SB
#undef PG8_STAGE
#undef PG8_STAGE_A
#undef PG8_KBODY
#undef PG8_LDA
#undef PG8_LDB
#undef PG8_MMA
#undef PG8_WAIT_V
#undef PG8_WAIT_L
#undef PG8_BAR
#undef PG8_SCHED
}
__device__ __forceinline__ int xcd_remap(long L, int nwg) { const int q = nwg / 8, r = nwg % 8, xcd = (int)(L % 8), off = (int)(L / 8); return (xcd < r ? xcd * (q + 1) : r * (q + 1) + (xcd - r) * q) + off; }
struct RectSched {
    static constexpr bool GATHER = false;
    const char* A; const char* B; int RB, nM, nN, G, c, nM2, nN2, pm2, pn2;
    __device__ __forceinline__ bool unit(int i, Unit& u) const {
        const int n1 = nM * nN, nwg = n1 + nM2 * nN2; const long L = (long)i * G + c; if (L >= nwg) return false;
        int w = xcd_remap(L, nwg); int rm = nM, rn = nN, pm0 = 0, pn0 = 0;
        if (w >= n1) { w -= n1; rm = nM2; rn = nN2; pm0 = pm2; pn0 = pn2; }
        const int nig = 8 * rn, gid = w / nig, fm = gid * 8, gsz = (rm - fm) < 8 ? (rm - fm) : 8;
        u.pm = pm0 + fm + ((w % nig) % gsz); u.pn = pn0 + (w % nig) / gsz; u.e = 0; u.rows = 256; u.base = u.pm * 256; u.newe = 0;
        return true;
    }
    __device__ __forceinline__ bool bases(int i, const char*& a, const char*& b) const {
        Unit u; if (!unit(i, u)) return false;
        a = A + (size_t)u.pm * 256 * RB; b = B + (size_t)u.pn * 256 * RB; return true;
    }
    __device__ __forceinline__ void aoffs(int, const int (&)[2], const unsigned (&)[2], unsigned (&)[2][2]) const {}
    __device__ __forceinline__ void atoks(int, const int (&)[2], int (&)[2][2]) const {}
};
}

template <class MapF>
__device__ __forceinline__ void transpose_item(const float* W, int K, int N, bf16* WT, MapF rowmap, float* scr, int item, int lane) {
    const int nblk = N / 32, kb = item / nblk, nb = item % nblk, k0 = 64 * kb, n0 = 32 * nb;
#pragma unroll 8
    for (int i = 0; i < 32; ++i) { const int kk = 2 * i + (lane >> 5); scr[kk * 33 + (lane & 31)] = W[(size_t)(k0 + kk) * N + n0 + (lane & 31)]; }
    asm volatile("s_waitcnt lgkmcnt(0)" ::: "memory");
    const int c = lane & 7;
#pragma unroll
    for (int j = 0; j < 4; ++j) { const int n = (lane >> 3) + 8 * j; const float* s = scr + (8 * c) * 33 + n;
        v4u o; o.x = pk2(s[0 * 33], s[1 * 33]); o.y = pk2(s[2 * 33], s[3 * 33]); o.z = pk2(s[4 * 33], s[5 * 33]); o.w = pk2(s[6 * 33], s[7 * 33]);
        *(v4u*)(WT + (size_t)rowmap(n0 + n) * K + k0 + 8 * c) = o; }
    asm volatile("s_waitcnt lgkmcnt(0)" ::: "memory");
}
__device__ __forceinline__ void item8_load(const float* W, int N, int item, int lane, f32x4 (&t)[16]) {
    const int nblk = N / 32, kb = item / nblk, nb = item % nblk, k0 = 128 * kb, n0 = 32 * nb;
    const int r8 = lane >> 3, c8 = lane & 7;
#pragma unroll
    for (int i = 0; i < 16; ++i) t[i] = __builtin_nontemporal_load((const f32x4*)(W + (size_t)(k0 + 8 * i + r8) * N + n0 + 4 * c8));
}
__device__ __forceinline__ void item8_to_lds(const f32x4 (&t)[16], float* scr, int lane) {
    const int r8 = lane >> 3, c8 = lane & 7;
#pragma unroll
    for (int i = 0; i < 16; ++i) *(f32x4*)(scr + (8 * i + r8) * 36 + 4 * c8) = t[i] * W8_SCALE;
}
template <class MapF>
__device__ __forceinline__ void item8_store(int K, int N, unsigned char* WT, MapF rowmap, const float* scr, int item, int lane) {
    const int nblk = N / 32, kb = item / nblk, nb = item % nblk, k0 = 128 * kb, n0 = 32 * nb;
    const int r8 = lane >> 3, c8 = lane & 7;
#pragma unroll
    for (int j = 0; j < 4; ++j) {
        const int n = r8 + 8 * j; const float* s = scr + (16 * c8) * 36 + n;
        v4u o;
        o.x = pk4_fp8(s[0 * 36], s[1 * 36], s[2 * 36], s[3 * 36]); o.y = pk4_fp8(s[4 * 36], s[5 * 36], s[6 * 36], s[7 * 36]);
        o.z = pk4_fp8(s[8 * 36], s[9 * 36], s[10 * 36], s[11 * 36]); o.w = pk4_fp8(s[12 * 36], s[13 * 36], s[14 * 36], s[15 * 36]);
        *(v4u*)(WT + (size_t)rowmap(n0 + n) * K + k0 + 16 * c8) = o;
    }
}
__device__ __forceinline__ void convert_experts(const CAS Args& a, const Frame& F, int layer, int wlo, int whi, int gw, int ngw) {
    float* scr = (float*)(F.lds + F.wave * 18432);
    unsigned char* WE = (unsigned char*)(a.ws + WS_WEXP);
    constexpr int IPM = 8 * 32;
    const int nw = whi - wlo, total = NE * nw * IPM;
    int it = gw; if (it >= total) return;
    f32x4 t[16];
    {   const int m = it / IPM, le = layer * NE + m / nw, which = wlo + m % nw;
        item8_load((which == 0 ? a.in[31] : which == 1 ? a.in[33] : a.in[35]) + ((size_t)le << 20), D, it % IPM, F.lane, t); }
    for (;;) {
        item8_to_lds(t, scr, F.lane);
        const int m = it / IPM, r = it % IPM, le = layer * NE + m / nw, which = wlo + m % nw;
        const int nit = it + ngw; const bool more = nit < total;
        if (more) { const int m2 = nit / IPM, le2 = layer * NE + m2 / nw, which2 = wlo + m2 % nw;
            item8_load((which2 == 0 ? a.in[31] : which2 == 1 ? a.in[33] : a.in[35]) + ((size_t)le2 << 20), D, nit % IPM, F.lane, t); }
        asm volatile("s_waitcnt lgkmcnt(0)" ::: "memory");
        unsigned char* dst = WE + (size_t)le * 3072 * 1024;
        if (which == 0) item8_store(D, D, dst, [](int n) { return ((n >> 7) << 8) + (n & 127); }, scr, r, F.lane);
        else if (which == 1) item8_store(D, D, dst, [](int n) { return ((n >> 7) << 8) + 128 + (n & 127); }, scr, r, F.lane);
        else item8_store(D, D, dst + (size_t)2048 * 1024,
            [](int f) { return (f & ~255) | (((f >> 3) & 1) << 7) | (((f >> 6) & 3) << 5) | (((f >> 4) & 3) << 3) | (f & 7); }, scr, r, F.lane);
        asm volatile("s_waitcnt lgkmcnt(0)" ::: "memory");
        if (!more) break;
        it = nit;
    }
}
__device__ __forceinline__ void p0_prologue(const CAS Args& a, const Frame& F) {
    float* scr = (float*)(F.lds + F.wave * 8448);
    constexpr int I_IN0 = 16 * 96, I_O = 16 * 32, I_IN1 = 16 * 64, I_LRU1 = 4 * 8;
    constexpr int NSMALL = I_IN0 + I_O + I_IN1 + I_O + 16 * I_LRU1;
    for (int it = F.gw; it < NSMALL; it += F.ngw) {
        int r = it;
        if (r < I_IN0) {
            transpose_item(a.in[8], D, 3072, (bf16*)(a.ws + WS_WIN0), [](int f) {
                if (f < 2048) return (f & ~255) | (((f >> 5) & 1) << 7) | (((f >> 6) & 3) << 5) | (f & 31);
                if (f < 2560) { const int j = f - 2048; return (8 + (j >> 7)) * 256 + (j & 127); }
                const int j = f - 2560; return (8 + (j >> 7)) * 256 + 128 + (j & 127); }, scr, r, F.lane); continue; } r -= I_IN0;
        if (r < I_O) { transpose_item(a.in[9], D, D, (bf16*)(a.ws + WS_WOUT0), [](int n) { return n; }, scr, r, F.lane); continue; } r -= I_O;
        if (r < I_IN1) { transpose_item(a.in[15], D, 2048, (bf16*)(a.ws + WS_WIN1), [](int n) { return n; }, scr, r, F.lane); continue; } r -= I_IN1;
        if (r < I_O) { transpose_item(a.in[16], D, D, (bf16*)(a.ws + WS_WOUT1), [](int n) { return n; }, scr, r, F.lane); continue; } r -= I_O;
        const int gh = r / I_LRU1, rr = r % I_LRU1, g = gh >> 2, h = gh & 3;
        const float* W = (g == 0 ? a.in[19] : g == 1 ? a.in[21] : g == 2 ? a.in[24] : a.in[26]) + (size_t)h * 65536;
        transpose_item(W, 256, 256, (bf16*)(a.ws + WS_WLRU) + (size_t)h * 1024 * 256, [g](int n) { return g * 256 + n; }, scr, rr, F.lane);
    }
    __syncthreads();
    convert_experts(a, F, 0, 0, 3, F.gw, F.ngw);
    __syncthreads();
    float* sc = (float*)F.lds;
    float* red = (float*)(F.lds + 17 * 1024 * 4);
    {
#pragma unroll
        for (int hbat = 0; hbat < 2; ++hbat) { float tv[17];
#pragma unroll
            for (int j = 0; j < 17; ++j) { const int i = F.tid + 512 * (17 * hbat + j); tv[j] = i < 16 * 1024 ? a.in[1][i] : a.in[3][i - 16 * 1024]; }
#pragma unroll
            for (int j = 0; j < 17; ++j) { const int i = F.tid + 512 * (17 * hbat + j); sc[i] = tv[j] / (1.0f + __expf(-tv[j])); } }
    }
    __syncthreads();
    float* MOD = (float*)(a.ws + WS_MOD);
    for (int u = F.bid; u < 192; u += F.G) {
        const int l = u / 96, n = (u % 96) * 64 + F.lane;
        const float* w = a.in[4] + (size_t)l * D * 6144 + n;
        float acc[17];
#pragma unroll
        for (int b = 0; b < 17; ++b) acc[b] = 0.f;
        for (int k0 = F.wave * 128; k0 < F.wave * 128 + 128; k0 += 16) {
            float wv[16];
#pragma unroll
            for (int q = 0; q < 16; ++q) wv[q] = __builtin_nontemporal_load(w + (size_t)(k0 + q) * 6144);
#pragma unroll
            for (int q = 0; q < 16; ++q)
#pragma unroll
                for (int b = 0; b < 17; ++b) acc[b] += sc[b * 1024 + k0 + q] * wv[q];
        }
#pragma unroll
        for (int b = 0; b < 17; ++b) red[(F.wave * 17 + b) * 64 + F.lane] = acc[b];
        __syncthreads();
        for (int i = F.tid; i < 17 * 64; i += NWAVES * 64) {
            const int b = i / 64, ln = i % 64; float s = 0.f;
#pragma unroll
            for (int w8 = 0; w8 < 8; ++w8) s += red[(w8 * 17 + b) * 64 + ln];
            const int nn = (u % 96) * 64 + ln;
            MOD[((size_t)l * 17 + b) * 6144 + nn] = s + a.in[5][l * 6144 + nn];
        }
        __syncthreads();
    }
}

__device__ __forceinline__ void load_row16(const float* row, int lane, float (&v)[16]) {
#pragma unroll
    for (int j = 0; j < 4; ++j) { const f32x4 t = *(const f32x4*)(row + 256 * j + 4 * lane); v[4 * j] = t.x; v[4 * j + 1] = t.y; v[4 * j + 2] = t.z; v[4 * j + 3] = t.w; }
}
__device__ __forceinline__ void load_row16_bf16(const bf16* row, int lane, float (&v)[16]) {
#pragma unroll
    for (int j = 0; j < 4; ++j) { const uint2 t = *(const uint2*)(row + 256 * j + 4 * lane); v[4 * j] = __uint_as_float(t.x << 16); v[4 * j + 1] = __uint_as_float(t.x & 0xffff0000u); v[4 * j + 2] = __uint_as_float(t.y << 16); v[4 * j + 3] = __uint_as_float(t.y & 0xffff0000u); }
}
__device__ __forceinline__ void store_row16_bf16(bf16* row, int lane, const float (&v)[16]) {
#pragma unroll
    for (int j = 0; j < 4; ++j) { uint2 o; o.x = pk2(v[4 * j], v[4 * j + 1]); o.y = pk2(v[4 * j + 2], v[4 * j + 3]); *(uint2*)(row + 256 * j + 4 * lane) = o; }
}
__device__ __forceinline__ void store_row16_f32(float* row, int lane, const float (&v)[16]) {
#pragma unroll
    for (int j = 0; j < 4; ++j) *(f32x4*)(row + 256 * j + 4 * lane) = (f32x4){v[4 * j], v[4 * j + 1], v[4 * j + 2], v[4 * j + 3]};
}
template <bool FP8OUT = false>
__device__ __forceinline__ void norm_mod(const float (&v)[16], const float* g, const float* sh, const float* sc, bf16* out, int lane, float (&hv)[16]) {
    float s = 0.f;
#pragma unroll
    for (int i = 0; i < 16; ++i) s += v[i] * v[i];
    const float rstd = rsqrtf(wave_sum(s) * (1.0f / D) + 1e-6f);
#pragma unroll
    for (int j = 0; j < 4; ++j) {
        const int e = 256 * j + 4 * lane;
        const f32x4 gg = *(const f32x4*)(g + e), ss = *(const f32x4*)(sh + e), cc = *(const f32x4*)(sc + e);
        hv[4 * j] = v[4 * j] * rstd * gg.x * (1.f + cc.x) + ss.x; hv[4 * j + 1] = v[4 * j + 1] * rstd * gg.y * (1.f + cc.y) + ss.y;
        hv[4 * j + 2] = v[4 * j + 2] * rstd * gg.z * (1.f + cc.z) + ss.z; hv[4 * j + 3] = v[4 * j + 3] * rstd * gg.w * (1.f + cc.w) + ss.w;
        if (FP8OUT) *(unsigned*)((unsigned char*)out + e) = pk4_fp8(hv[4 * j], hv[4 * j + 1], hv[4 * j + 2], hv[4 * j + 3]);
        else { uint2 o; o.x = pk2(hv[4 * j], hv[4 * j + 1]); o.y = pk2(hv[4 * j + 2], hv[4 * j + 3]); *(uint2*)(out + e) = o; }
    }
}
__device__ __forceinline__ int row_batch(int r) { return r < NT ? (r >> 11) : 16; }
__device__ __forceinline__ const float* mod_ptr(const CAS Args& a, int l, int r, int chunk) { return (const float*)(a.ws + WS_MOD) + ((size_t)l * 17 + row_batch(r)) * 6144 + chunk * D; }

__device__ __forceinline__ void p_norm1_l0(const CAS Args& a, const Frame& F) {
    bf16* H = (bf16*)(a.ws + WS_H);
    { float* GS2 = (float*)(a.ws + WS_GS2); const float* MOD = (const float*)(a.ws + WS_MOD);
      for (int i = F.gw * 64 + F.lane; i < 2 * 17 * D; i += F.ngw * 64) { const int l = i / (17 * D), bb = (i / D) % 17, k = i % D; GS2[i] = a.in[7][l * D + k] * (1.0f + MOD[((size_t)l * 17 + bb) * 6144 + 4 * D + k]); } }
    for (int r = F.gw; r < R; r += 3 * F.ngw) {
        float v[3][16], hv[16];
#pragma unroll
        for (int k = 0; k < 3; ++k) { const int rr = r + k * F.ngw; if (rr < R) load_row16(rr < NT ? a.in[0] + (size_t)rr * D : a.in[2] + (size_t)(rr - NT) * D, F.lane, v[k]); }
#pragma unroll
        for (int k = 0; k < 3; ++k) { const int rr = r + k * F.ngw; if (rr < R) norm_mod(v[k], a.in[6], mod_ptr(a, 0, rr, 0), mod_ptr(a, 0, rr, 1), H + (size_t)rr * D, F.lane, hv); }
    }
}

struct EpiInProj0 {
    static constexpr bool PERM = true;
    bf16* P; const float* qg; const float* kg;
    __device__ __forceinline__ void operator()(const f32x4 (&acc)[2][2][4][2], const pg8::Unit& u, int wr, int wc, int fr, int fq) const {
        const int row0 = u.pm * 256 + wr * 64 + fr, pn = u.pn;
        if (pn < 4) {
            const float* g = pn < 2 ? qg : kg; const float sc = pn < 2 ? 0.125f : 1.0f;
            f32x4 gv[2][2];
#pragma unroll
            for (int bj = 0; bj < 2; ++bj)
#pragma unroll
                for (int n = 0; n < 2; ++n) gv[bj][n] = *(const f32x4*)(g + 32 * bj + 8 * fq + 4 * n);
#pragma unroll
            for (int ai = 0; ai < 2; ++ai)
#pragma unroll
                for (int m = 0; m < 4; ++m) {
                    float ss = 0.f;
#pragma unroll
                    for (int bj = 0; bj < 2; ++bj)
#pragma unroll
                        for (int n = 0; n < 2; ++n) { const f32x4 x = acc[ai][bj][m][n]; ss += (x[0] * x[0] + x[1] * x[1]) + (x[2] * x[2] + x[3] * x[3]); }
                    ss += __shfl_xor(ss, 16); ss += __shfl_xor(ss, 32);
                    const float rs = rsqrtf(ss * (1.0f / 64.0f) + 1e-6f) * sc;
                    bf16* rowp = P + (size_t)(row0 + ai * 128 + m * 16) * PP + pn * 256 + wc * 64 + 8 * fq;
#pragma unroll
                    for (int bj = 0; bj < 2; ++bj) { const f32x4 v0 = acc[ai][bj][m][0] * rs * gv[bj][0], v1 = acc[ai][bj][m][1] * rs * gv[bj][1];
                        v4u w; w.x = pg8::cvt_pk_bf16(v0[0], v0[1]); w.y = pg8::cvt_pk_bf16(v0[2], v0[3]); w.z = pg8::cvt_pk_bf16(v1[0], v1[1]); w.w = pg8::cvt_pk_bf16(v1[2], v1[3]);
                        *(v4u*)(rowp + 32 * bj) = w; }
                }
        } else if (pn < 8) {
#pragma unroll
            for (int ai = 0; ai < 2; ++ai)
#pragma unroll
                for (int m = 0; m < 4; ++m) { bf16* rowp = P + (size_t)(row0 + ai * 128 + m * 16) * PP + pn * 256 + wc * 64 + 8 * fq;
#pragma unroll
                    for (int bj = 0; bj < 2; ++bj) { const f32x4 v0 = acc[ai][bj][m][0], v1 = acc[ai][bj][m][1];
                        v4u w; w.x = pg8::cvt_pk_bf16(v0[0], v0[1]); w.y = pg8::cvt_pk_bf16(v0[2], v0[3]); w.z = pg8::cvt_pk_bf16(v1[0], v1[1]); w.w = pg8::cvt_pk_bf16(v1[2], v1[3]);
                        *(v4u*)(rowp + 32 * bj) = w; } }
        } else {
#pragma unroll
            for (int ai = 0; ai < 2; ++ai)
#pragma unroll
                for (int m = 0; m < 4; ++m) { bf16* rowp = P + (size_t)(row0 + ai * 128 + m * 16) * PP + 2048 + (pn - 8) * 128 + wc * 32 + 8 * fq;
                    const f32x4 v0 = acc[ai][0][m][0] * acc[ai][1][m][0], v1 = acc[ai][0][m][1] * acc[ai][1][m][1];
                    v4u w; w.x = pg8::cvt_pk_bf16(v0[0], v0[1]); w.y = pg8::cvt_pk_bf16(v0[2], v0[3]); w.z = pg8::cvt_pk_bf16(v1[0], v1[1]); w.w = pg8::cvt_pk_bf16(v1[2], v1[3]);
                    *(v4u*)rowp = w; }
        }
    }
};
__device__ __forceinline__ void p_inproj0(const CAS Args& a, const Frame& F) {
    pg8::RectSched S{(const char*)(a.ws + WS_H), (const char*)(a.ws + WS_WIN0), 2 * D, R / 256, 3072 / 256, F.G, F.bid, 0, 0, 0, 0};
    EpiInProj0 E{(bf16*)(a.ws + WS_P), a.in[10], a.in[11]};
    pg8::gemm_phase<2 * D, false>(F.ldsl, S, E, F.wave);
}
typedef __bf16 bf16x2_t __attribute__((ext_vector_type(2)));
typedef float f32x2_t __attribute__((ext_vector_type(2)));
typedef short s16x4 __attribute__((ext_vector_type(4)));
__device__ __forceinline__ unsigned pk_bf16(float a, float b) { f32x2_t v = {a, b}; bf16x2_t r = __builtin_convertvector(v, bf16x2_t); return __builtin_bit_cast(unsigned, r); }
constexpr int AT_LAT = 0, AT_CK = 576 * 128, AT_CV = AT_CK + 256 * 128, AT_RPB = AT_CV + 256 * 128;
__device__ __forceinline__ int at_swz(int key) { return (key ^ (key >> 3)) & 7; }
__device__ __forceinline__ unsigned at_addr(int key, int chunk) { return (unsigned)(key * 128 + ((chunk ^ at_swz(key)) << 4)); }
template <class RowF>
__device__ __forceinline__ void at_stage(LAS unsigned char* dst, int npieces, RowF rowf, int colbyte, const bf16* P, int wave, int lane) {
    for (int p = wave; p < npieces; p += NWAVES) {
        const int key = 8 * p + (lane >> 3), c = (lane & 7) ^ at_swz(key);
        const char* src = (const char*)P + (size_t)rowf(key) * (PP * 2) + colbyte + 16 * c;
        __builtin_amdgcn_global_load_lds((const unsigned*)src, (LAS unsigned*)(dst + p * 1024), 16, 0, 0);
    }
}
__device__ __forceinline__ void at_tr8(unsigned a0, unsigned a1, unsigned a2, unsigned a3, unsigned a4, unsigned a5, unsigned a6, unsigned a7, s16x4 (&r)[8]) {
    asm volatile("ds_read_b64_tr_b16 %0, %8\n\tds_read_b64_tr_b16 %1, %9\n\tds_read_b64_tr_b16 %2, %10\n\tds_read_b64_tr_b16 %3, %11\n\t"
                 "ds_read_b64_tr_b16 %4, %12\n\tds_read_b64_tr_b16 %5, %13\n\tds_read_b64_tr_b16 %6, %14\n\tds_read_b64_tr_b16 %7, %15\n\ts_waitcnt lgkmcnt(0)"
                 : "=&v"(r[0]), "=&v"(r[1]), "=&v"(r[2]), "=&v"(r[3]), "=&v"(r[4]), "=&v"(r[5]), "=&v"(r[6]), "=&v"(r[7])
                 : "v"(a0), "v"(a1), "v"(a2), "v"(a3), "v"(a4), "v"(a5), "v"(a6), "v"(a7) : "memory");
}
__device__ __forceinline__ void p_attn(const CAS Args& a, const Frame& F) {
    const bf16* P = (const bf16*)(a.ws + WS_P); bf16* A2 = (bf16*)(a.ws + WS_A2);
    LAS unsigned char* lds = F.ldsl;
    const int lane = F.lane, wave = F.wave, rho = lane & 15, g = lane >> 4;
    for (int wu = F.bid; wu < NB * 8 * 2; wu += F.G) {
        const int half = wu & 1, hd = (wu >> 1) & 7, b = wu >> 4;
        __syncthreads();
        for (int i = F.tid; i < 465; i += NWAVES * 64) ((LAS float*)(lds + AT_RPB))[i] = a.in[12][hd * 465 + i];
        at_stage(lds + AT_CK, 32, [=](int key) { return NT + b * 256 + key; }, (512 + hd * 64) * 2, P, wave, lane);
        at_stage(lds + AT_CV, 32, [=](int key) { return NT + b * 256 + key; }, (1024 + hd * 64) * 2, P, wave, lane);
        for (int un = 0; un < 9; ++un) {
            const bool lat = un < 8;
            int r = 0, n = 0, qrow, krow_lo = 0;
            if (lat) { const int rp = half * 8 + un; r = 2 * rp + (wave >> 2); n = wave & 3; qrow = b * 2048 + r * 64 + 16 * n + rho; krow_lo = min(max(2 * rp - 4, 0), 24); }
            else qrow = NT + b * 256 + half * 128 + 16 * wave + rho;
            const int r0 = min(max(r - 4, 0), 24), ro = r0 - krow_lo, kc0 = min(max(16 * n - 8, 0), 32);
            const int c = 16 * n + rho, c0 = min(max(c - 8, 0), 48);
            if (lat) at_stage(lds + AT_LAT, 72, [=](int key) { return b * 2048 + min(krow_lo + (key >> 6), 31) * 64 + (key & 63); }, (512 + hd * 64) * 2, P, wave, lane);
            const bf16x8 q0 = *(const bf16x8*)(P + (size_t)qrow * PP + hd * 64 + 8 * g), q1 = *(const bf16x8*)(P + (size_t)qrow * PP + hd * 64 + 32 + 8 * g);
            asm volatile("s_waitcnt vmcnt(0)" ::: "memory");
            __syncthreads();
            const int pk = 8 * (rho >> 2) + (rho & 3);
            float mxb[2] = {-1e30f, -1e30f}, smb[2] = {0.f, 0.f}; v4u pf[16];
#pragma unroll
            for (int blk = 0; blk < 2; ++blk) {
                if (blk == 0 && !lat) {
#pragma unroll
                    for (int i = 0; i < 8; ++i) pf[i] = (v4u){0u, 0u, 0u, 0u};
                    continue; }
                f32x4 s[16];
#pragma unroll
                for (int i = 0; i < 8; ++i)
#pragma unroll
                    for (int t = 0; t < 2; ++t) {
                        const int key = (blk == 0 ? (ro + i) * 64 + kc0 : 32 * i) + pk + 4 * t;
                        const unsigned kbase = blk == 0 ? AT_LAT : AT_CK;
                        const bf16x8 k0 = *(const LAS bf16x8*)(lds + kbase + at_addr(key, g)), k1 = *(const LAS bf16x8*)(lds + kbase + at_addr(key, 4 + g));
                        f32x4 acc = __builtin_amdgcn_mfma_f32_16x16x32_bf16(k0, q0, (f32x4){0.f, 0.f, 0.f, 0.f}, 0, 0, 0);
                        acc = __builtin_amdgcn_mfma_f32_16x16x32_bf16(k1, q1, acc, 0, 0, 0);
                        if (blk == 0) {
                            const int dr = r0 + i - r + 7;
#pragma unroll
                            for (int jj = 0; jj < 4; ++jj) { const int kcol = kc0 + 8 * g + 4 * t + jj; const int dc = min(max(kcol - c + 15, 0), 30);
                                const float bias = ((const LAS float*)(lds + AT_RPB))[dr * 31 + dc];
                                acc[jj] = ((unsigned)(kcol - c0) < 16u) ? acc[jj] + bias : -1e30f; }
                        }
                        s[2 * i + t] = acc;
                    }
                float mx = -1e30f;
#pragma unroll
                for (int i = 0; i < 16; ++i) mx = fmaxf(fmaxf(mx, fmaxf(s[i][0], s[i][1])), fmaxf(s[i][2], s[i][3]));
                mx = fmaxf(mx, __shfl_xor(mx, 16)); mx = fmaxf(mx, __shfl_xor(mx, 32));
                float sum = 0.f;
#pragma unroll
                for (int i = 0; i < 8; ++i) {
                    float e[8];
#pragma unroll
                    for (int t = 0; t < 2; ++t)
#pragma unroll
                        for (int jj = 0; jj < 4; ++jj) { e[4 * t + jj] = __expf(s[2 * i + t][jj] - mx); sum += e[4 * t + jj]; }
                    pf[8 * blk + i].x = pk_bf16(e[0], e[1]); pf[8 * blk + i].y = pk_bf16(e[2], e[3]); pf[8 * blk + i].z = pk_bf16(e[4], e[5]); pf[8 * blk + i].w = pk_bf16(e[6], e[7]);
                }
                sum += __shfl_xor(sum, 16); sum += __shfl_xor(sum, 32);
                mxb[blk] = mx; smb[blk] = sum;
            }
            __syncthreads();
            if (lat) at_stage(lds + AT_LAT, 72, [=](int key) { return b * 2048 + min(krow_lo + (key >> 6), 31) * 64 + (key & 63); }, (1024 + hd * 64) * 2, P, wave, lane);
            asm volatile("s_waitcnt vmcnt(0)" ::: "memory");
            __syncthreads();
            f32x4 o[2][4];
#pragma unroll
            for (int blk = 0; blk < 2; ++blk)
#pragma unroll
                for (int db = 0; db < 4; ++db) o[blk][db] = (f32x4){0.f, 0.f, 0.f, 0.f};
            const int tq = rho >> 2, tp = rho & 3;
#pragma unroll
            for (int ch = 0; ch < 16; ++ch) {
                if (ch < 8 && !lat) continue;
                int zo = 0; asm volatile("" : "+v"(zo));
                const int kb = (ch < 8 ? (ro + ch) * 64 + kc0 + 8 * g + tq : 32 * (ch - 8) + 8 * g + tq) + zo;
                const unsigned base = (unsigned)(size_t)(lds + (ch < 8 ? AT_LAT : AT_CV));
                unsigned ad[8];
#pragma unroll
                for (int db = 0; db < 4; ++db) { ad[2 * db] = base + at_addr(kb, 2 * db + (tp >> 1)) + 8 * (tp & 1); ad[2 * db + 1] = base + at_addr(kb + 4, 2 * db + (tp >> 1)) + 8 * (tp & 1); }
                s16x4 vr[8]; at_tr8(ad[0], ad[1], ad[2], ad[3], ad[4], ad[5], ad[6], ad[7], vr);
#pragma unroll
                for (int db = 0; db < 4; ++db) { const bf16x8 vf = __builtin_shufflevector(vr[2 * db], vr[2 * db + 1], 0, 1, 2, 3, 4, 5, 6, 7);
                    o[ch >> 3][db] = __builtin_amdgcn_mfma_f32_16x16x32_bf16(vf, __builtin_bit_cast(bf16x8, pf[ch]), o[ch >> 3][db], 0, 0, 0); }
            }
            const float mxa = fmaxf(mxb[0], mxb[1]), f0 = __expf(mxb[0] - mxa), f1 = __expf(mxb[1] - mxa);
            const float inv = 1.0f / (f0 * smb[0] + f1 * smb[1]), g0 = f0 * inv, g1 = f1 * inv;
#pragma unroll
            for (int db = 0; db < 4; ++db) { uint2 w; w.x = pk_bf16(o[0][db][0] * g0 + o[1][db][0] * g1, o[0][db][1] * g0 + o[1][db][1] * g1); w.y = pk_bf16(o[0][db][2] * g0 + o[1][db][2] * g1, o[0][db][3] * g0 + o[1][db][3] * g1);
                *(uint2*)(A2 + (size_t)qrow * D + hd * 64 + 16 * db + 4 * g) = w; }
            __syncthreads();
        }
    }
    const float* cw = a.in[13]; const float* cb = a.in[14];
    const int j0 = 8 * lane;
    float w0[8], w1[8], w2[8], bb[8];
#pragma unroll
    for (int q = 0; q < 8; ++q) { w0[q] = cw[j0 + q]; w1[q] = cw[512 + j0 + q]; w2[q] = cw[1024 + j0 + q]; bb[q] = cb[j0 + q]; }
    for (int blk = F.gw; blk < R / 6; blk += F.ngw) {
        const int row0 = 6 * blk;
        v4u pw[8], bgw[6];
#pragma unroll
        for (int k = 0; k < 8; ++k) { const int rr = row0 + k - 1; pw[k] = (rr >= 0 && rr < R) ? *(const v4u*)(P + (size_t)rr * PP + 2048 + j0) : (v4u){0u, 0u, 0u, 0u}; }
#pragma unroll
        for (int k = 0; k < 6; ++k) bgw[k] = *(const v4u*)(P + (size_t)(row0 + k) * PP + 1536 + j0);
#pragma unroll
        for (int k = 0; k < 6; ++k) {
            const int row = row0 + k; const bool latr = row < NT; const int t = latr ? (row & 2047) : ((row - NT) & 255), len = latr ? 2048 : 256;
            const v4u pm = t > 0 ? pw[k] : (v4u){0u, 0u, 0u, 0u}, pc = pw[k + 1], pn = (t + 1 < len) ? pw[k + 2] : (v4u){0u, 0u, 0u, 0u}, bgv = bgw[k];
            const unsigned am[4] = {pm.x, pm.y, pm.z, pm.w}, ac[4] = {pc.x, pc.y, pc.z, pc.w}, an[4] = {pn.x, pn.y, pn.z, pn.w}, ab[4] = {bgv.x, bgv.y, bgv.z, bgv.w};
            unsigned ow[4];
#pragma unroll
            for (int q = 0; q < 4; ++q) {
                const float lo = __uint_as_float(ab[q] << 16) * (bb[2 * q] + w0[2 * q] * __uint_as_float(am[q] << 16) + w1[2 * q] * __uint_as_float(ac[q] << 16) + w2[2 * q] * __uint_as_float(an[q] << 16));
                const float hi = __uint_as_float(ab[q] & 0xffff0000u) * (bb[2 * q + 1] + w0[2 * q + 1] * __uint_as_float(am[q] & 0xffff0000u) + w1[2 * q + 1] * __uint_as_float(ac[q] & 0xffff0000u) + w2[2 * q + 1] * __uint_as_float(an[q] & 0xffff0000u));
                ow[q] = pk_bf16(lo, hi);
            }
            *(v4u*)(A2 + (size_t)row * D + 512 + j0) = (v4u){ow[0], ow[1], ow[2], ow[3]};
        }
    }
}
template <int L>
struct EpiOutProj {
    static constexpr bool PERM = true;
    const float* baseL; const float* baseC; bf16* XB; const float* MODl;
    __device__ __forceinline__ void operator()(const f32x4 (&acc)[2][2][4][2], const pg8::Unit& u, int wr, int wc, int fr, int fq) const {
        const bool lat = u.pm < NT / 256;
        const int mb = lat ? (u.pm >> 3) : 16;
        const int row0 = u.pm * 256 + wr * 64 + fr, col0 = u.pn * 256 + wc * 32 + 8 * fq;
        const float* g1 = MODl + (size_t)mb * 6144 + 2 * D + col0;
        f32x4 gv[2][2];
#pragma unroll
        for (int bj = 0; bj < 2; ++bj)
#pragma unroll
            for (int n = 0; n < 2; ++n) gv[bj][n] = *(const f32x4*)(g1 + bj * 128 + 4 * n);
#pragma unroll
        for (int ai = 0; ai < 2; ++ai)
#pragma unroll
            for (int m = 0; m < 4; ++m) { const int row = row0 + ai * 128 + m * 16;
#pragma unroll
                for (int bj = 0; bj < 2; ++bj) {
                    f32x4 b0, b1;
                    if (L == 0) { const float* bp = (lat ? baseL + (size_t)row * D : baseC + (size_t)(row - NT) * D) + col0 + bj * 128; b0 = *(const f32x4*)bp; b1 = *(const f32x4*)(bp + 4); }
                    else { const v4u w = *(const v4u*)(XB + (size_t)row * D + col0 + bj * 128);
                        b0 = (f32x4){__uint_as_float(w.x << 16), __uint_as_float(w.x & 0xffff0000u), __uint_as_float(w.y << 16), __uint_as_float(w.y & 0xffff0000u)};
                        b1 = (f32x4){__uint_as_float(w.z << 16), __uint_as_float(w.z & 0xffff0000u), __uint_as_float(w.w << 16), __uint_as_float(w.w & 0xffff0000u)}; }
                    const f32x4 v0 = b0 + gv[bj][0] * acc[ai][bj][m][0], v1 = b1 + gv[bj][1] * acc[ai][bj][m][1];
                    v4u o; o.x = pg8::cvt_pk_bf16(v0[0], v0[1]); o.y = pg8::cvt_pk_bf16(v0[2], v0[3]); o.z = pg8::cvt_pk_bf16(v1[0], v1[1]); o.w = pg8::cvt_pk_bf16(v1[2], v1[3]);
                    *(v4u*)(XB + (size_t)row * D + col0 + bj * 128) = o; }
                asm volatile("" ::: "memory"); }
    }
};
template <int L>
__device__ __forceinline__ void p_outproj(const CAS Args& a, const Frame& F) {
    pg8::RectSched S{(const char*)(a.ws + (L == 0 ? WS_A2 : WS_A3)), (const char*)(a.ws + (L == 0 ? WS_WOUT0 : WS_WOUT1)), 2 * D, (L == 0 ? R : NT) / 256, D / 256, F.G, F.bid, 0, 0, 0, 0};
    EpiOutProj<L> E{a.in[0], a.in[2], (bf16*)(a.ws + WS_XB), (const float*)(a.ws + WS_MOD) + (size_t)L * 17 * 6144};
    pg8::gemm_phase<2 * D, false>(F.ldsl, S, E, F.wave);
}
#define RS_STEP(half, m) do { const bool up = (F.lane & (m)) != 0; _Pragma("unroll") for (int i = 0; i < (half); ++i) { \
        const float keep = up ? part[i + (half)] : part[i]; const float send = up ? part[i] : part[i + (half)]; part[i] = keep + __shfl_xor(send, (m)); } } while (0)
constexpr int RT_WH = 0, RT_WL = 65536, RT_GS = 131072, RT_LG = 139264, RT_CNT = 155648;
__device__ __forceinline__ void p_norm2_router(const CAS Args& a, const Frame& F, int l) {
    unsigned char* H8 = (unsigned char*)(a.ws + WS_H); const bf16* XB = (const bf16*)(a.ws + WS_XB);
    unsigned* ctl = (unsigned*)(a.ws + WS_CTL);
    int* toklist = (int*)(a.ws + WS_TOKLIST); int* sel = (int*)(a.ws + WS_SEL); float* gatev = (float*)(a.ws + WS_GATEV);
    const float* wr = a.in[29] + (size_t)l * D * NE; const float* br = a.in[30] + l * NE;
    const float* GS2 = (const float*)(a.ws + WS_GS2) + (size_t)l * 17 * D; const float* MODl = (const float*)(a.ws + WS_MOD) + (size_t)l * 17 * 6144;
    const int rows = l == 0 ? R : NT, rpw = rows / F.G, row_lo = F.bid * rpw, nblk = rpw / 16;
    LAS unsigned char* lds = F.ldsl;
    const int lane = F.lane, wave = F.wave, rho = lane & 15, g = lane >> 4;
    const int b_first = row_batch(row_lo);
    __syncthreads();
    {
        f32x4 wv[16];
#pragma unroll
        for (int j = 0; j < 16; ++j) wv[j] = *(const f32x4*)(wr + 4 * (F.tid + 512 * j));
#pragma unroll
        for (int j = 0; j < 16; ++j) { const int i0 = 4 * (F.tid + 512 * j), k = i0 >> 5;
#pragma unroll
            for (int q = 0; q < 4; ++q) { const int e = (i0 & 31) + q; const float w = wv[j][q]; const bf16 hi = f2bf(w), lo = f2bf(w - bf2f(hi));
                const int off = e * 2048 + 16 * ((k >> 3) ^ (e & 15)) + 2 * (k & 7);
                *(LAS bf16*)(lds + RT_WH + off) = hi; *(LAS bf16*)(lds + RT_WL + off) = lo; } }
    }
    for (int i = F.tid; i < 2 * D; i += NWAVES * 64) { const int s = i >> 10, k = i & 1023; const int bb = s == 0 ? b_first : row_batch(row_lo + rpw - 1); ((LAS float*)(lds + RT_GS))[i] = GS2[bb * D + k]; }
    LAS unsigned* wcnt = (LAS unsigned*)(lds + RT_CNT); LAS unsigned* wbase = wcnt + 32; LAS unsigned* stmp = wcnt + 64;
    if (F.tid < NE) wcnt[F.tid] = 0u;
    __syncthreads();
    for (int blk = wave; blk < nblk; blk += NWAVES) {
        const int r0 = row_lo + 16 * blk, row = r0 + rho, bb = row_batch(r0);
        const bf16* xr = XB + (size_t)row * D + 8 * g;
        float ss = 0.f;
#pragma unroll
        for (int kh = 0; kh < 2; ++kh) {
            v4u xw[16];
#pragma unroll
            for (int ks = 0; ks < 16; ++ks) xw[ks] = *(const v4u*)(xr + 32 * (16 * kh + ks));
#pragma unroll
            for (int ks = 0; ks < 16; ++ks) { const unsigned u4[4] = {xw[ks].x, xw[ks].y, xw[ks].z, xw[ks].w};
#pragma unroll
                for (int q = 0; q < 4; ++q) { const float x0 = __uint_as_float(u4[q] << 16), x1 = __uint_as_float(u4[q] & 0xffff0000u); ss += x0 * x0 + x1 * x1; } }
            asm volatile("" ::: "memory");
        }
        ss += __shfl_xor(ss, 16); ss += __shfl_xor(ss, 32);
        const float rstd = rsqrtf(ss * (1.0f / D) + 1e-6f);
        const LAS float* gs = (const LAS float*)(lds + RT_GS) + (bb == b_first ? 0 : D) + 8 * g;
        const float* sh = MODl + (size_t)bb * 6144 + 3 * D + 8 * g;
        f32x4 acc[2] = {(f32x4){0.f, 0.f, 0.f, 0.f}, (f32x4){0.f, 0.f, 0.f, 0.f}};
        int offb[4];
#pragma unroll
        for (int b4 = 0; b4 < 4; ++b4) offb[b4] = rho * 2048 + (((4 * (b4 ^ ((rho >> 2) & 3))) + (g ^ (rho & 3))) << 4);
        for (int k4 = 0; k4 < 8; ++k4) {
            v4u xw[4]; f32x4 sv[4][2];
#pragma unroll
            for (int b4 = 0; b4 < 4; ++b4) { const int ks = 4 * k4 + b4; xw[b4] = *(const v4u*)(xr + 32 * ks); sv[b4][0] = *(const f32x4*)(sh + 32 * ks); sv[b4][1] = *(const f32x4*)(sh + 32 * ks + 4); }
#pragma unroll
            for (int b4 = 0; b4 < 4; ++b4) {
                const int ks = 4 * k4 + b4;
                const unsigned u4[4] = {xw[b4].x, xw[b4].y, xw[b4].z, xw[b4].w};
                const f32x4 g0 = *(const LAS f32x4*)(gs + 32 * ks), g1 = *(const LAS f32x4*)(gs + 32 * ks + 4);
                const f32x4 s0 = sv[b4][0], s1 = sv[b4][1];
                float hv[8];
#pragma unroll
                for (int q = 0; q < 4; ++q) { const float x0 = __uint_as_float(u4[q] << 16) * rstd, x1 = __uint_as_float(u4[q] & 0xffff0000u) * rstd;
                    const float gg0 = q < 2 ? g0[2 * q] : g1[2 * q - 4], gg1 = q < 2 ? g0[2 * q + 1] : g1[2 * q - 3], t0 = q < 2 ? s0[2 * q] : s1[2 * q - 4], t1 = q < 2 ? s0[2 * q + 1] : s1[2 * q - 3];
                    hv[2 * q] = x0 * gg0 + t0; hv[2 * q + 1] = x1 * gg1 + t1; }
                v4u hi, lo;
#pragma unroll
                for (int q = 0; q < 4; ++q) { const unsigned p = pk_bf16(hv[2 * q], hv[2 * q + 1]); ((unsigned*)&hi)[q] = p;
                    ((unsigned*)&lo)[q] = pk_bf16(hv[2 * q] - __uint_as_float(p << 16), hv[2 * q + 1] - __uint_as_float(p & 0xffff0000u)); }
                { uint2 f8; unsigned t0 = 0u, t1 = 0u; t0 = __builtin_amdgcn_cvt_pk_fp8_f32(hv[0], hv[1], t0, false); t0 = __builtin_amdgcn_cvt_pk_fp8_f32(hv[2], hv[3], t0, true);
                  t1 = __builtin_amdgcn_cvt_pk_fp8_f32(hv[4], hv[5], t1, false); t1 = __builtin_amdgcn_cvt_pk_fp8_f32(hv[6], hv[7], t1, true); f8.x = t0; f8.y = t1;
                  *(uint2*)(H8 + (size_t)row * D + 32 * ks + 8 * g) = f8; }
#pragma unroll
                for (int nt = 0; nt < 2; ++nt) { const int off = nt * 32768 + k4 * 256 + offb[b4];
                    const bf16x8 bh = *(const LAS bf16x8*)(lds + RT_WH + off), bl = *(const LAS bf16x8*)(lds + RT_WL + off);
                    acc[nt] = __builtin_amdgcn_mfma_f32_16x16x32_bf16(__builtin_bit_cast(bf16x8, hi), bh, acc[nt], 0, 0, 0);
                    acc[nt] = __builtin_amdgcn_mfma_f32_16x16x32_bf16(__builtin_bit_cast(bf16x8, lo), bh, acc[nt], 0, 0, 0);
                    acc[nt] = __builtin_amdgcn_mfma_f32_16x16x32_bf16(__builtin_bit_cast(bf16x8, hi), bl, acc[nt], 0, 0, 0); }
            }
        }
        LAS float* lg = (LAS float*)(lds + RT_LG + wave * 2048);
#pragma unroll
        for (int nt = 0; nt < 2; ++nt)
#pragma unroll
            for (int jj = 0; jj < 4; ++jj) lg[(4 * g + jj) * 32 + 16 * nt + rho] = acc[nt][jj] + br[16 * nt + rho];
        {
            float mine[8], allv[32];
#pragma unroll
            for (int q = 0; q < 8; ++q) { const f32x4 t = *(const LAS f32x4*)(lg + rho * 32 + 4 * q); allv[4 * q] = t[0]; allv[4 * q + 1] = t[1]; allv[4 * q + 2] = t[2]; allv[4 * q + 3] = t[3]; }
#pragma unroll
            for (int q = 0; q < 8; ++q) mine[q] = g == 0 ? allv[q] : g == 1 ? allv[8 + q] : g == 2 ? allv[16 + q] : allv[24 + q];
            LAS float* rs = lg;
#pragma unroll
            for (int q = 0; q < 8; ++q) { const int e = 8 * g + q; int rank = 0;
#pragma unroll
                for (int jx = 0; jx < 32; ++jx) rank += (allv[jx] > mine[q] || (allv[jx] == mine[q] && jx < e)) ? 1 : 0;
                if (rank < 4) { rs[(rho * 4 + rank) * 2] = mine[q]; ((LAS int*)rs)[(rho * 4 + rank) * 2 + 1] = e; } }
            if (lane < 16) {
                const f32x4 q0 = *(const LAS f32x4*)(rs + lane * 8), q1 = *(const LAS f32x4*)(rs + lane * 8 + 4);
                const float tv0 = q0[0], tv1 = q0[2], tv2 = q1[0], tv3 = q1[2]; const int ti[4] = {__float_as_int(q0[1]), __float_as_int(q0[3]), __float_as_int(q1[1]), __float_as_int(q1[3])};
                const float e1 = __expf(tv1 - tv0), e2 = __expf(tv2 - tv0), e3 = __expf(tv3 - tv0), inv = 1.0f / (1.0f + e1 + e2 + e3);
                const float gk[4] = {inv, e1 * inv, e2 * inv, e3 * inv};
                const int rl = 16 * blk + lane;
#pragma unroll
                for (int k = 0; k < 4; ++k) { const unsigned p = __hip_atomic_fetch_add(wcnt + ti[k], 1u, __ATOMIC_RELAXED, __HIP_MEMORY_SCOPE_WORKGROUP);
                    stmp[(rl * 4 + k) * 2] = (p << 5) | (unsigned)ti[k]; stmp[(rl * 4 + k) * 2 + 1] = __float_as_uint(gk[k]); }
            }
        }
    }
    __syncthreads();
    if (F.tid < NE) { const unsigned c = wcnt[F.tid]; wbase[F.tid] = c ? __hip_atomic_fetch_add(ctl + CW_CNT + (l * 32 + F.tid) * 64, c, RLX_AGENT) : 0u; }
    __syncthreads();
    for (int i = F.tid; i < rpw * 4; i += NWAVES * 64) { const int rl = i >> 2, k = i & 3, r = row_lo + rl; const unsigned pe = stmp[i * 2], e = pe & 31u, pos = wbase[e] + (pe >> 5);
        toklist[(size_t)e * CAP + pos] = r; sel[r * 4 + k] = (int)((pos << 5) | e); gatev[r * 4 + k] = __uint_as_float(stmp[i * 2 + 1]); }
}
struct MoeTab { int cnt[NE], base[NE + 1], tpre[NE + 1]; };
__device__ __forceinline__ void moe_tab_build(const CAS Args& a, const Frame& F, int l, LAS MoeTab* tb) {
    unsigned* ctl = (unsigned*)(a.ws + WS_CTL);
    __syncthreads();
    if (F.tid < NE) tb->cnt[F.tid] = (int)__hip_atomic_load(ctl + CW_CNT + (l * 32 + F.tid) * 64, RLX_AGENT);
    __syncthreads();
    if (F.tid == 0) { int bs = 0, tp = 0; for (int e = 0; e < NE; ++e) { const int c = tb->cnt[e]; tb->base[e] = bs; tb->tpre[e] = tp; bs += c; tp += (c + 255) >> 8; } tb->base[NE] = bs; tb->tpre[NE] = tp; }
    __syncthreads();
}
constexpr int MOE_UT_MAX = 64;
template <bool UP>
struct MoeSched {
    static constexpr bool GATHER = UP;
    const LAS MoeTab* tb; const LAS int* ut; const char* A; const char* WE; const int* toklist; int G, c;
    static constexpr int NN = UP ? 8 : 4;
    static __device__ __forceinline__ int rfl(int v) { return __builtin_amdgcn_readfirstlane(v); }
    static __device__ __forceinline__ const char* ufy(const char* p) { const unsigned long long v = (unsigned long long)p; const unsigned lo = __builtin_amdgcn_readfirstlane((unsigned)v), hi = __builtin_amdgcn_readfirstlane((unsigned)(v >> 32)); return (const char*)(((unsigned long long)hi << 32) | lo); }
    __device__ __forceinline__ bool unit_search(int i, int& pm, int& pn, int& e_, int& rows, int& base) const {
        const int nwg = tb->tpre[NE] * NN; const long L = (long)i * G + c; if (L >= nwg) return false;
        const int w = pg8::xcd_remap(L, nwg);
        int e = 0; while (e < NE - 1 && w >= tb->tpre[e + 1] * NN) ++e;
        const int tp0 = tb->tpre[e], tp1 = tb->tpre[e + 1];
        const int q = w - tp0 * NN, nte = tp1 - tp0;
        const int nig = 8 * NN, gid = q / nig, fm = gid * 8, gsz = (nte - fm) < 8 ? (nte - fm) : 8;
        pm = fm + ((q % nig) % gsz); pn = (q % nig) / gsz; e_ = e; rows = min(256, tb->cnt[e] - pm * 256); base = tb->base[e] + pm * 256;
        return true;
    }
    __device__ __forceinline__ void build(LAS int* utw, int tid) const {
        if (tid < MOE_UT_MAX) { int pm = -1, pn = 0, e = 0, rows = 0, base = 0; unit_search(tid, pm, pn, e, rows, base);
            utw[tid * 8 + 0] = pm; utw[tid * 8 + 1] = pn; utw[tid * 8 + 2] = e; utw[tid * 8 + 3] = rows; utw[tid * 8 + 4] = base; }
    }
    __device__ __forceinline__ bool unit(int i, pg8::Unit& u) const {
        if (i >= MOE_UT_MAX) return false;
        const LAS int* p = ut + i * 8; const int pm = rfl(p[0]); if (pm < 0) return false;
        u.pm = pm; u.pn = rfl(p[1]); u.e = rfl(p[2]); u.rows = rfl(p[3]); u.base = rfl(p[4]); u.newe = (i == 0) || (rfl(p[2 - 8]) != u.e);
        return true;
    }
    __device__ __forceinline__ bool bases(int i, const char*& a, const char*& b) const {
        pg8::Unit u; if (!unit(i, u)) return false;
        a = UP ? A : A + (size_t)u.base * D;
        b = WE + (size_t)u.e * 3072 * 1024 + (UP ? 0 : (size_t)2048 * 1024) + (size_t)u.pn * 256 * 1024;
        a = ufy(a); b = ufy(b);
        return true;
    }
    __device__ __forceinline__ void atoks(int i, const int (&rA)[2], int (&tok)[2][2]) const {
        pg8::Unit u; unit(i, u);
        const int* tl = toklist + (size_t)u.e * CAP + u.pm * 256;
#pragma unroll
        for (int h = 0; h < 2; ++h)
#pragma unroll
            for (int i2 = 0; i2 < 2; ++i2) { const int rr = h * 128 + rA[i2]; tok[h][i2] = tl[rr < u.rows ? rr : 0]; }
    }
    __device__ __forceinline__ void aoffs(int i, const int (&rA)[2], const unsigned (&voffA)[2], unsigned (&off)[2][2]) const {
        pg8::Unit u; unit(i, u);
        const int* tl = toklist + (size_t)u.e * CAP + u.pm * 256;
#pragma unroll
        for (int h = 0; h < 2; ++h)
#pragma unroll
            for (int i2 = 0; i2 < 2; ++i2) { const int rr = h * 128 + rA[i2]; const int tok = tl[rr < u.rows ? rr : 0]; off[h][i2] = (unsigned)tok * (unsigned)D + voffA[i2]; }
    }
};
struct EpiMoeUp {
    static constexpr bool PERM = true;
    bf16* ACT; const float* bgate; const float* bup; LAS float* btab;
    __device__ __forceinline__ void operator()(const f32x4 (&acc)[2][2][4][2], const pg8::Unit& u, int wr, int wc, int fr, int fq) const {
        const int col0 = u.pn * 128 + wc * 32 + 8 * fq, rl0 = wr * 64 + fr;
        if (u.newe) { const int tid = (wr * 4 + wc) * 64 + fr + 16 * fq;
            const f32x4 t = *(const f32x4*)((tid < 256 ? bgate : bup) + u.e * D + 4 * (tid & 255));
            *(LAS f32x4*)(btab + 4 * tid) = t;
            asm volatile("s_waitcnt lgkmcnt(0)" ::: "memory"); __builtin_amdgcn_s_barrier(); asm volatile("" ::: "memory"); }
        f32x2_t bg[2][2], bu[2][2];
#pragma unroll
        for (int n = 0; n < 2; ++n) { const f32x4 g4 = *(const LAS f32x4*)(btab + col0 + 4 * n), u4 = *(const LAS f32x4*)(btab + 1024 + col0 + 4 * n);
            bg[n][0] = (f32x2_t){g4[0], g4[1]}; bg[n][1] = (f32x2_t){g4[2], g4[3]};
            bu[n][0] = (f32x2_t){u4[0], u4[1]} * ACT8_SCALE + ACT8_SCALE; bu[n][1] = (f32x2_t){u4[2], u4[3]} * ACT8_SCALE + ACT8_SCALE; }
#pragma unroll
        for (int ai = 0; ai < 2; ++ai)
#pragma unroll
            for (int m = 0; m < 4; ++m) { const int rl = rl0 + ai * 128 + m * 16;
                f32x2_t o[2][2];
#pragma unroll
                for (int n = 0; n < 2; ++n)
#pragma unroll
                    for (int p = 0; p < 2; ++p) {
                        f32x2_t gg = (f32x2_t){acc[ai][0][m][n][2 * p], acc[ai][0][m][n][2 * p + 1]} * (1.0f / W8_SCALE) + bg[n][p];
                        gg.x = fminf(gg.x, 7.0f); gg.y = fminf(gg.y, 7.0f);
                        const f32x2_t tt = gg * (-1.702f * 1.44269504f);
                        f32x2_t dd; dd.x = __builtin_amdgcn_exp2f(tt.x); dd.y = __builtin_amdgcn_exp2f(tt.y); dd = dd + 1.0f;
                        f32x2_t rr; rr.x = __builtin_amdgcn_rcpf(dd.x); rr.y = __builtin_amdgcn_rcpf(dd.y);
                        f32x2_t uu = (f32x2_t){acc[ai][1][m][n][2 * p], acc[ai][1][m][n][2 * p + 1]} * (ACT8_SCALE / W8_SCALE) + bu[n][p];
                        uu.x = __builtin_amdgcn_fmed3f(uu.x, -6.0f * ACT8_SCALE, 8.0f * ACT8_SCALE); uu.y = __builtin_amdgcn_fmed3f(uu.y, -6.0f * ACT8_SCALE, 8.0f * ACT8_SCALE);
                        o[n][p] = (gg * rr) * uu;
                    }
                if (rl < u.rows) { uint2 w; unsigned w0 = 0u, w1 = 0u;
                    w0 = __builtin_amdgcn_cvt_pk_fp8_f32(o[0][0].x, o[0][0].y, w0, false); w0 = __builtin_amdgcn_cvt_pk_fp8_f32(o[0][1].x, o[0][1].y, w0, true);
                    w1 = __builtin_amdgcn_cvt_pk_fp8_f32(o[1][0].x, o[1][0].y, w1, false); w1 = __builtin_amdgcn_cvt_pk_fp8_f32(o[1][1].x, o[1][1].y, w1, true);
                    w.x = w0; w.y = w1;
                    *(uint2*)((unsigned char*)ACT + (size_t)(u.base + rl) * D + col0) = w; } }
    }
};
struct EpiMoeDown {
    static constexpr bool PERM = true;
    unsigned char* YB; const float* bdown; LAS float* btab;
    __device__ __forceinline__ void operator()(const f32x4 (&acc)[2][2][4][2], const pg8::Unit& u, int wr, int wc, int fr, int fq) const {
        const int col0 = u.pn * 256 + wc * 64 + 16 * fq, rl0 = wr * 64 + fr;
        if (u.newe) { const int tid = (wr * 4 + wc) * 64 + fr + 16 * fq;
            if (tid < 256) { const f32x4 t = *(const f32x4*)(bdown + u.e * D + 4 * tid); *(LAS f32x4*)(btab + 4 * tid) = t; }
            asm volatile("s_waitcnt lgkmcnt(0)" ::: "memory"); __builtin_amdgcn_s_barrier(); asm volatile("" ::: "memory"); }
        f32x4 bv[2][2];
#pragma unroll
        for (int bj = 0; bj < 2; ++bj)
#pragma unroll
            for (int n = 0; n < 2; ++n) bv[bj][n] = *(const LAS f32x4*)(btab + col0 + 8 * bj + 4 * n) * YB8_SCALE;
#pragma unroll
        for (int ai = 0; ai < 2; ++ai)
#pragma unroll
            for (int m = 0; m < 4; ++m) { const int rl = rl0 + ai * 128 + m * 16;
                if (rl < u.rows) { v4u w;
                    { const f32x4 v = acc[ai][0][m][0] * (YB8_SCALE / (W8_SCALE * ACT8_SCALE)) + bv[0][0]; w.x = pk4_fp8(v[0], v[1], v[2], v[3]); }
                    { const f32x4 v = acc[ai][0][m][1] * (YB8_SCALE / (W8_SCALE * ACT8_SCALE)) + bv[0][1]; w.y = pk4_fp8(v[0], v[1], v[2], v[3]); }
                    { const f32x4 v = acc[ai][1][m][0] * (YB8_SCALE / (W8_SCALE * ACT8_SCALE)) + bv[1][0]; w.z = pk4_fp8(v[0], v[1], v[2], v[3]); }
                    { const f32x4 v = acc[ai][1][m][1] * (YB8_SCALE / (W8_SCALE * ACT8_SCALE)) + bv[1][1]; w.w = pk4_fp8(v[0], v[1], v[2], v[3]); }
                    *(v4u*)(YB + (size_t)(u.base + rl) * D + col0) = w; } }
    }
};
constexpr int LDS_TAB = 131072;
constexpr int MOE_NC = 32;
__device__ __forceinline__ void p_moe_up(const CAS Args& a, const Frame& F, int l) {
    const int nc = l == 0 ? MOE_NC : 0;
    if (F.bid >= F.G - nc) { convert_experts(a, F, 1, 0, 2, (F.bid - (F.G - nc)) * NWAVES + F.wave, nc * NWAVES); return; }
    LAS MoeTab* tb = (LAS MoeTab*)(F.ldsl + LDS_TAB); moe_tab_build(a, F, l, tb);
    LAS int* utw = (LAS int*)(F.ldsl + LDS_TAB + 1024);
    MoeSched<true> S{tb, utw, (const char*)(a.ws + WS_H), (const char*)(a.ws + WS_WEXP) + (size_t)l * NE * 3072 * 1024, (const int*)(a.ws + WS_TOKLIST), F.G - nc, F.bid};
    S.build(utw, F.tid); __syncthreads();
    EpiMoeUp E{(bf16*)(a.ws + WS_ACT), a.in[32] + (size_t)l * NE * D, a.in[34] + (size_t)l * NE * D, (LAS float*)(F.ldsl + LDS_TAB + 4096)};
    pg8::gemm_phase<D, true>(F.ldsl, S, E, F.wave);
}
__device__ __forceinline__ void p_moe_down(const CAS Args& a, const Frame& F, int l) {
    const int nc = l == 0 ? MOE_NC : 0;
    if (F.bid >= F.G - nc) { convert_experts(a, F, 1, 2, 3, (F.bid - (F.G - nc)) * NWAVES + F.wave, nc * NWAVES); return; }
    LAS MoeTab* tb = (LAS MoeTab*)(F.ldsl + LDS_TAB); moe_tab_build(a, F, l, tb);
    LAS int* utw = (LAS int*)(F.ldsl + LDS_TAB + 1024);
    MoeSched<false> S{tb, utw, (const char*)(a.ws + WS_ACT), (const char*)(a.ws + WS_WEXP) + (size_t)l * NE * 3072 * 1024, nullptr, F.G - nc, F.bid};
    S.build(utw, F.tid); __syncthreads();
    EpiMoeDown E{(unsigned char*)(a.ws + WS_YB), a.in[36] + (size_t)l * NE * D, (LAS float*)(F.ldsl + LDS_TAB + 4096)};
    pg8::gemm_phase<D, true>(F.ldsl, S, E, F.wave);
}
__device__ __forceinline__ void p_combine(const CAS Args& a, const Frame& F, int l) {
    const unsigned char* YB = (const unsigned char*)(a.ws + WS_YB); bf16* XB = (bf16*)(a.ws + WS_XB); bf16* H = (bf16*)(a.ws + WS_H);
    const int* sel = (const int*)(a.ws + WS_SEL); const float* gatev = (const float*)(a.ws + WS_GATEV);
    LAS MoeTab* tb = (LAS MoeTab*)(F.ldsl + LDS_TAB); moe_tab_build(a, F, l, tb);
    const int rows = l == 0 ? R : NT, lane = F.lane;
    for (int r = F.gw; r < rows; r += 2 * F.ngw) {
        v4u xw[2][2]; uint2 yw[2][4][2]; float gk[2][4];
#pragma unroll
        for (int t = 0; t < 2; ++t) { const int rr = r + t * F.ngw; if (rr < rows) {
#pragma unroll
            for (int jh = 0; jh < 2; ++jh) xw[t][jh] = *(const v4u*)(XB + (size_t)rr * D + 512 * jh + 8 * lane);
#pragma unroll
            for (int k = 0; k < 4; ++k) { const int sv = sel[rr * 4 + k]; gk[t][k] = gatev[rr * 4 + k]; const int e = sv & 31, pos = sv >> 5;
                const unsigned char* y = YB + (size_t)(tb->base[e] + pos) * D;
#pragma unroll
                for (int jh = 0; jh < 2; ++jh) yw[t][k][jh] = *(const uint2*)(y + 512 * jh + 8 * lane); } } }
#pragma unroll
        for (int t = 0; t < 2; ++t) { const int rr = r + t * F.ngw; if (rr < rows) {
            float m[16], v[16];
#pragma unroll
            for (int i = 0; i < 16; ++i) m[i] = 0.f;
#pragma unroll
            for (int k = 0; k < 4; ++k) { const float gg = gk[t][k] * (1.0f / YB8_SCALE);
#pragma unroll
                for (int jh = 0; jh < 2; ++jh) { const unsigned w2[2] = {yw[t][k][jh].x, yw[t][k][jh].y};
#pragma unroll
                    for (int q = 0; q < 2; ++q) { const f32x2_t lo = __builtin_amdgcn_cvt_pk_f32_fp8((int)w2[q], false), hi = __builtin_amdgcn_cvt_pk_f32_fp8((int)w2[q], true);
                        m[8 * jh + 4 * q] += gg * lo.x; m[8 * jh + 4 * q + 1] += gg * lo.y; m[8 * jh + 4 * q + 2] += gg * hi.x; m[8 * jh + 4 * q + 3] += gg * hi.y; } } }
#pragma unroll
            for (int jh = 0; jh < 2; ++jh) { const unsigned x4[4] = {xw[t][jh].x, xw[t][jh].y, xw[t][jh].z, xw[t][jh].w};
#pragma unroll
                for (int q = 0; q < 4; ++q) { v[8 * jh + 2 * q] = __uint_as_float(x4[q] << 16); v[8 * jh + 2 * q + 1] = __uint_as_float(x4[q] & 0xffff0000u); } }
            const float* g2 = mod_ptr(a, l, rr, 5);
#pragma unroll
            for (int jh = 0; jh < 2; ++jh)
#pragma unroll
                for (int q = 0; q < 2; ++q) { const f32x4 gg = *(const f32x4*)(g2 + 512 * jh + 8 * lane + 4 * q);
#pragma unroll
                    for (int c = 0; c < 4; ++c) v[8 * jh + 4 * q + c] += gg[c] * m[8 * jh + 4 * q + c]; }
            if (l == 0) {
#pragma unroll
                for (int jh = 0; jh < 2; ++jh) *(v4u*)(XB + (size_t)rr * D + 512 * jh + 8 * lane) = (v4u){pk_bf16(v[8 * jh], v[8 * jh + 1]), pk_bf16(v[8 * jh + 2], v[8 * jh + 3]), pk_bf16(v[8 * jh + 4], v[8 * jh + 5]), pk_bf16(v[8 * jh + 6], v[8 * jh + 7])};
                float s = 0.f;
#pragma unroll
                for (int i2 = 0; i2 < 16; ++i2) s += v[i2] * v[i2];
                const float rstd = rsqrtf(wave_sum(s) * (1.0f / D) + 1e-6f);
                const float* gp = a.in[6] + D; const float* shp = mod_ptr(a, 1, rr, 0); const float* scp = mod_ptr(a, 1, rr, 1);
#pragma unroll
                for (int jh = 0; jh < 2; ++jh) { float hv[8];
#pragma unroll
                    for (int q = 0; q < 2; ++q) { const int e0 = 512 * jh + 8 * lane + 4 * q; const f32x4 gg = *(const f32x4*)(gp + e0), ss = *(const f32x4*)(shp + e0), cc = *(const f32x4*)(scp + e0);
#pragma unroll
                        for (int c = 0; c < 4; ++c) hv[4 * q + c] = v[8 * jh + 4 * q + c] * rstd * gg[c] * (1.f + cc[c]) + ss[c]; }
                    *(v4u*)(H + (size_t)rr * D + 512 * jh + 8 * lane) = (v4u){pk_bf16(hv[0], hv[1]), pk_bf16(hv[2], hv[3]), pk_bf16(hv[4], hv[5]), pk_bf16(hv[6], hv[7])}; }
            } else {
#pragma unroll
                for (int jh = 0; jh < 2; ++jh)
#pragma unroll
                    for (int q = 0; q < 2; ++q) *(f32x4*)(a.out + (size_t)rr * D + 512 * jh + 8 * lane + 4 * q) = (f32x4){v[8 * jh + 4 * q], v[8 * jh + 4 * q + 1], v[8 * jh + 4 * q + 2], v[8 * jh + 4 * q + 3]};
            } } }
    }
}
struct EpiInProj1 {
    static constexpr bool PERM = true;
    bf16* Gt; bf16* U;
    __device__ __forceinline__ void operator()(const f32x4 (&acc)[2][2][4][2], const pg8::Unit& u, int wr, int wc, int fr, int fq) const {
        const int row0 = u.pm * 256 + wr * 64 + fr; const bool gate = u.pn < 4;
        bf16* dst = gate ? Gt : U; const int col0 = (u.pn & 3) * 256 + wc * 32 + 8 * fq;
#pragma unroll
        for (int ai = 0; ai < 2; ++ai)
#pragma unroll
            for (int m = 0; m < 4; ++m) { bf16* rowp = dst + (size_t)(row0 + ai * 128 + m * 16) * D + col0;
#pragma unroll
                for (int bj = 0; bj < 2; ++bj) { f32x4 v0 = acc[ai][bj][m][0], v1 = acc[ai][bj][m][1];
                    if (gate) {
#pragma unroll
                        for (int j = 0; j < 4; ++j) { const float x = v0[j]; v0[j] = x * __builtin_amdgcn_rcpf(1.0f + __expf(-1.5957691216f * (x + 0.044715f * x * x * x)));
                                                      const float y = v1[j]; v1[j] = y * __builtin_amdgcn_rcpf(1.0f + __expf(-1.5957691216f * (y + 0.044715f * y * y * y))); } }
                    v4u w; w.x = pg8::cvt_pk_bf16(v0[0], v0[1]); w.y = pg8::cvt_pk_bf16(v0[2], v0[3]); w.z = pg8::cvt_pk_bf16(v1[0], v1[1]); w.w = pg8::cvt_pk_bf16(v1[2], v1[3]);
                    *(v4u*)(rowp + bj * 128) = w; } }
    }
};
__device__ __forceinline__ void p_inproj1(const CAS Args& a, const Frame& F) {
    pg8::RectSched S{(const char*)(a.ws + WS_H), (const char*)(a.ws + WS_WIN1), 2 * D, NT / 256, 8, F.G, F.bid, NC / 256, 4, NT / 256, 4};
    EpiInProj1 E{(bf16*)(a.ws + WS_G), (bf16*)(a.ws + WS_U)};
    pg8::gemm_phase<2 * D, false>(F.ldsl, S, E, F.wave);
}
__device__ __forceinline__ void p_conv4(const CAS Args& a, const Frame& F) {
    const bf16* U = (const bf16*)(a.ws + WS_U); bf16* UC = (bf16*)(a.ws + WS_UC);
    for (int u = F.gw; u < (R / 8) * 2; u += F.ngw) {
        const int rb = u >> 1, ch0 = (u & 1) * 512 + 8 * F.lane, row0 = rb * 8;
        const bool lat = row0 < NT; const int t0 = lat ? (row0 & 2047) : ((row0 - NT) & 255), len = lat ? 2048 : 256;
        float cw[4][8], cbv[8];
#pragma unroll
        for (int q = 0; q < 8; ++q) { cbv[q] = a.in[18][ch0 + q];
#pragma unroll
            for (int k = 0; k < 4; ++k) cw[k][q] = a.in[17][k * D + ch0 + q]; }
        v4u uv[11];
#pragma unroll
        for (int k = 0; k < 11; ++k) { const int tt = t0 + k - 1; uv[k] = (tt >= 0 && tt < len) ? *(const v4u*)(U + (size_t)(row0 + k - 1) * D + ch0) : (v4u){0u, 0u, 0u, 0u}; }
#pragma unroll
        for (int i = 0; i < 8; ++i) {
            float acc[8];
#pragma unroll
            for (int q = 0; q < 8; ++q) acc[q] = cbv[q];
#pragma unroll
            for (int k = 0; k < 4; ++k) { const unsigned w[4] = {uv[i + k].x, uv[i + k].y, uv[i + k].z, uv[i + k].w};
#pragma unroll
                for (int q = 0; q < 4; ++q) { acc[2 * q] += cw[k][2 * q] * __uint_as_float(w[q] << 16); acc[2 * q + 1] += cw[k][2 * q + 1] * __uint_as_float(w[q] & 0xffff0000u); } }
            *(v4u*)(UC + (size_t)(row0 + i) * D + ch0) = (v4u){pk_bf16(acc[0], acc[1]), pk_bf16(acc[2], acc[3]), pk_bf16(acc[4], acc[5]), pk_bf16(acc[6], acc[7])};
        }
    }
}
constexpr int LR_A = 0, LR_SC = 65536, LR_AG = 131072, LR_CY = LR_AG + 8192;
__device__ __forceinline__ void p_lru(const CAS Args& a, const Frame& F) {
    const bf16* UC = (const bf16*)(a.ws + WS_UC); const bf16* WL = (const bf16*)(a.ws + WS_WLRU); const bf16* Gt = (const bf16*)(a.ws + WS_G);
    bf16* HF = (bf16*)(a.ws + WS_HF); bf16* A3 = (bf16*)(a.ws + WS_A3);
    LAS unsigned char* lds = F.ldsl;
    const int lane_ = F.lane, wave = F.wave, sub = wave & 3, th = wave >> 2;
    for (int wu = F.bid; wu < 256; wu += F.G) {
        const int b = wu >> 4, h = (wu >> 2) & 3, cg = wu & 3;
        for (int dir = 0; dir < 2; ++dir) {
            const int lane = lane_, rho = lane & 15, g = lane >> 4;
            bf16x8 bw[2][8];
#pragma unroll
            for (int n = 0; n < 2; ++n)
#pragma unroll
                for (int ks = 0; ks < 8; ++ks) bw[n][ks] = *(const bf16x8*)(WL + ((size_t)h * 1024 + (2 * dir + n) * 256 + cg * 64 + 16 * sub + rho) * 256 + 32 * ks + 8 * g);
            const int chc = h * 256 + cg * 64 + 16 * sub + rho;
            const float bav = (dir ? a.in[25] : a.in[20])[chc] * -1.44269504f, bxv = (dir ? a.in[27] : a.in[22])[chc] * -1.44269504f;
            const float lamv = (dir ? a.in[28] : a.in[23])[chc];
            const float L8 = -8.0f * log1pf(expf(-lamv)) * 1.44269504f;
            __syncthreads();
            if (wave == 0) ((LAS float*)(lds + LR_CY))[lane] = 0.f;
#define LR_GROW0(ck_) ((ck_) < 2 ? (size_t)(NT + b * 256 + 128 * (dir ? 1 - (ck_) : (ck_))) : (size_t)(b * 2048 + 128 * (dir ? 15 - ((ck_) - 2) : (ck_) - 2)))
#define LR_STAGE(ck_) do { const size_t g0_ = LR_GROW0(ck_); _Pragma("unroll") for (int p_ = 0; p_ < 8; ++p_) { const int pc_ = wave * 8 + p_, row_ = 2 * pc_ + (lane >> 5), c_ = (lane & 31) ^ (row_ & 15); \
                __builtin_amdgcn_global_load_lds((const unsigned*)((const char*)UC + (g0_ + row_) * (D * 2) + h * 512 + 16 * c_), (LAS unsigned*)(lds + LR_A + pc_ * 1024), 16, 0, 0); } } while (0)
            LR_STAGE(0);
            for (int ck = 0; ck < 18; ++ck) {
                const bool isctx = ck < 2;
                const size_t grow0 = LR_GROW0(ck);
                int lane = lane_; asm volatile("" : "+v"(lane)); const int rho = lane & 15, g = lane >> 4, chs = h * 256 + cg * 64 + lane, ucol = cg * 64 + 16 * sub + rho;
                asm volatile("s_waitcnt vmcnt(0)" ::: "memory");
                __syncthreads();
                const int row0 = dir ? 112 - 16 * wave : 16 * wave;
                v4u hfr[2], gtr[2];
                if (dir && !isctx) {
#pragma unroll
                    for (int t = 0; t < 2; ++t) { const int tk = lane + 64 * t; const size_t gi = (grow0 + row0 + (tk >> 3)) * D + h * 256 + cg * 64 + 8 * (tk & 7);
                        hfr[t] = *(const v4u*)(HF + gi); gtr[t] = *(const v4u*)(Gt + gi); } }
                {
                    f32x4 acc[4][2];
#pragma unroll
                    for (int m = 0; m < 4; ++m)
#pragma unroll
                        for (int n = 0; n < 2; ++n) acc[m][n] = (f32x4){0.f, 0.f, 0.f, 0.f};
#pragma unroll
                    for (int ks = 0; ks < 8; ++ks)
#pragma unroll
                        for (int m = 0; m < 4; ++m) { const int rw = 64 * th + 16 * m + rho; const bf16x8 af = *(const LAS bf16x8*)(lds + LR_A + rw * 512 + (((4 * ks + g) ^ (rw & 15)) << 4));
#pragma unroll
                            for (int n = 0; n < 2; ++n) acc[m][n] = __builtin_amdgcn_mfma_f32_16x16x32_bf16(af, bw[n][ks], acc[m][n], 0, 0, 0);
                            if (m == 3 && (ks & 1)) asm volatile("" ::: "memory"); }
#pragma unroll
                    for (int m = 0; m < 4; ++m)
#pragma unroll
                        for (int p = 0; p < 2; ++p) {
                            const int row = 64 * th + 16 * m + 4 * g + 2 * p;
                            f32x2_t uc;
                            uc.x = bf2f(*(const LAS bf16*)(lds + LR_A + row * 512 + (((ucol >> 3) ^ (row & 15)) << 4) + 2 * (ucol & 7)));
                            uc.y = bf2f(*(const LAS bf16*)(lds + LR_A + (row + 1) * 512 + (((ucol >> 3) ^ ((row + 1) & 15)) << 4) + 2 * (ucol & 7)));
                            const f32x2_t xa = (f32x2_t){acc[m][0][2 * p], acc[m][0][2 * p + 1]} * -1.44269504f + bav, xx = (f32x2_t){acc[m][1][2 * p], acc[m][1][2 * p + 1]} * -1.44269504f + bxv;
                            f32x2_t da, dx; da.x = __builtin_amdgcn_exp2f(xa.x); da.y = __builtin_amdgcn_exp2f(xa.y); dx.x = __builtin_amdgcn_exp2f(xx.x); dx.y = __builtin_amdgcn_exp2f(xx.y);
                            da = da + 1.0f; dx = dx + 1.0f;
                            f32x2_t rr, ii; rr.x = __builtin_amdgcn_rcpf(da.x); rr.y = __builtin_amdgcn_rcpf(da.y); ii.x = __builtin_amdgcn_rcpf(dx.x); ii.y = __builtin_amdgcn_rcpf(dx.y);
                            const f32x2_t la = rr * L8;
                            f32x2_t av; av.x = __builtin_amdgcn_exp2f(la.x); av.y = __builtin_amdgcn_exp2f(la.y);
                            f32x2_t tt = 1.0f - av * av; tt.x = fmaxf(tt.x, 0.f); tt.y = fmaxf(tt.y, 0.f);
                            f32x2_t sq; sq.x = __builtin_amdgcn_sqrtf(tt.x); sq.y = __builtin_amdgcn_sqrtf(tt.y);
                            const f32x2_t bv = sq * ii * uc;
                            *(LAS f32x2_t*)(lds + LR_SC + (row * 64 + 16 * sub + rho) * 8) = (f32x2_t){av.x, bv.x};
                            *(LAS f32x2_t*)(lds + LR_SC + ((row + 1) * 64 + 16 * sub + rho) * 8) = (f32x2_t){av.y, bv.y};
                        }
                }
                __syncthreads();
                if (ck + 1 < 18) LR_STAGE(ck + 1);
                f32x2_t ab[16];
                {
#pragma unroll
                    for (int q = 0; q < 16; ++q) { const int s = 16 * wave + q, row = dir ? 127 - s : s; ab[q] = *(const LAS f32x2_t*)(lds + LR_SC + (row * 64 + lane) * 8); }
                    float hl = 0.f, pr = 1.f;
#pragma unroll
                    for (int q = 0; q < 16; ++q) { hl = ab[q].x * hl + ab[q].y; pr *= ab[q].x; ab[q] = (f32x2_t){pr, hl}; }
                    *(LAS f32x2_t*)(lds + LR_AG + ((ck & 1) * 512 + wave * 64 + lane) * 8) = (f32x2_t){pr, hl};
                }
                __syncthreads();
                {
                    float c = ((const LAS float*)(lds + LR_CY))[(ck & 1) * 64 + lane], cin = 0.f;
#pragma unroll
                    for (int w2 = 0; w2 < 8; ++w2) { if (w2 == wave) cin = c; const f32x2_t ag = *(const LAS f32x2_t*)(lds + LR_AG + ((ck & 1) * 512 + w2 * 64 + lane) * 8); c = ag.x * c + ag.y; }
                    if (wave == 0) ((LAS float*)(lds + LR_CY))[((ck + 1) & 1) * 64 + lane] = c;
                    if (!isctx) {
                        LAS unsigned char* scr = lds + LR_SC + row0 * 512;
                        if (dir) {
#pragma unroll
                            for (int t = 0; t < 2; ++t) { const int tk = lane + 64 * t; *(LAS v4u*)(scr + tk * 16) = hfr[t]; *(LAS v4u*)(scr + 2048 + tk * 16) = gtr[t]; }
                        }
#pragma unroll
                        for (int q = 0; q < 16; ++q) { const int tr = dir ? 15 - q : q;
                            float hv = ab[q].y + ab[q].x * cin;
                            if (dir) hv = (bf2f(*(const LAS bf16*)(scr + (tr * 64 + lane) * 2)) + hv) * bf2f(*(const LAS bf16*)(scr + 2048 + (tr * 64 + lane) * 2));
                            *(LAS bf16*)(scr + 4096 + (tr * 64 + lane) * 2) = f2bf(hv); }
                        bf16* dstp = dir ? A3 : HF;
#pragma unroll
                        for (int t = 0; t < 2; ++t) { const int tk = lane + 64 * t; const size_t gi = (grow0 + row0 + (tk >> 3)) * D + h * 256 + cg * 64 + 8 * (tk & 7);
                            *(v4u*)(dstp + gi) = *(const LAS v4u*)(scr + 4096 + tk * 16); }
                    }
                }
            }
#undef LR_STAGE
#undef LR_GROW0
        }
    }
}

constexpr int LDS_BYTES = 163840;
constexpr int NPHASE = 17;
template <unsigned KMASK>
__global__ void __launch_bounds__(NWAVES * 64, 2) fwd(Args kargs) {
    extern __shared__ __attribute__((aligned(16))) unsigned char lds[];
    const int wave_s = __builtin_amdgcn_readfirstlane((int)threadIdx.x >> 6);
    const int tid0 = wave_s * 64 + lane_id_fresh();
    volatile LAS unsigned* misc = (volatile LAS unsigned*)((LAS unsigned char*)lds + (LDS_BYTES - 64));
    if (tid0 < 16) misc[tid0] = 0u;
    __syncthreads();
    const int lo = kargs.ph_lo, hi = kargs.ph_hi;
    XcdBarrier bar; bar.bar = (unsigned*)(kargs.ws + WS_CTL) + CW_BAR + kargs.li * XCD_BAR_WORDS; bar.x = 0; bar.st = misc;
    if (hi - lo > 1) bar = xcd_barrier_post((unsigned*)(kargs.ws + WS_CTL) + CW_BAR + kargs.li * XCD_BAR_WORDS, misc, tid0);
#ifndef ONLY_PHASE
#define ONLY_PHASE -1
#endif
#ifndef PHASE_MASK
#define PHASE_MASK 0xFFFFFFFFu
#endif
#ifndef REPMASK
#define REPMASK 0u
#endif
#define PH(k, body) if constexpr (((KMASK >> (k)) & 1u) != 0u) if ((ONLY_PHASE < 0 || ONLY_PHASE == (k)) && ((PHASE_MASK >> (k)) & 1u) && lo <= (k) && (k) < hi) { \
        const CAS Args* ap_ = (const CAS Args*)__builtin_amdgcn_kernarg_segment_ptr(); asm volatile("" : "+s"(ap_)); const CAS Args& args = *ap_; \
        Frame F; F.lds = lds; F.ldsl = (LAS unsigned char*)lds; F.wave = wave_s; F.lane = lane_id_fresh(); \
        F.tid = F.wave * 64 + F.lane; F.G = gridDim.x; F.bid = blockIdx.x; F.gw = F.bid * NWAVES + F.wave; F.ngw = F.G * NWAVES; \
        if (((REPMASK >> (k)) & 1u) == 0u) { body; } else { int nrep_ = 2; asm volatile("" : "+s"(nrep_)); for (int rep_ = 0; rep_ < nrep_; ++rep_) { body; asm volatile("s_waitcnt vmcnt(0)" ::: "memory"); __syncthreads(); } } if ((k) + 1 < hi) xcd_barrier(bar, F.tid); else { asm volatile("s_waitcnt vmcnt(0)" ::: "memory"); __syncthreads(); } }
    PH(0, p0_prologue(args, F))
    PH(1, p_norm1_l0(args, F))
    PH(2, p_inproj0(args, F))
    PH(3, p_attn(args, F))
    PH(4, p_outproj<0>(args, F))
    PH(5, p_norm2_router(args, F, 0))
    PH(6, p_moe_up(args, F, 0))
    PH(7, p_moe_down(args, F, 0))
    PH(8, p_combine(args, F, 0))
    PH(9, p_inproj1(args, F))
    PH(10, p_conv4(args, F))
    PH(11, p_lru(args, F))
    PH(12, p_outproj<1>(args, F))
    PH(13, p_norm2_router(args, F, 1))
    PH(14, p_moe_up(args, F, 1))
    PH(15, p_moe_down(args, F, 1))
    PH(16, p_combine(args, F, 1))
#undef PH
}

constexpr unsigned MASK_A = (1u<<2)|(1u<<4)|(1u<<6)|(1u<<7)|(1u<<9)|(1u<<11)|(1u<<13)|(1u<<14), MASK_C = 1u << 3, MASK_D = 1u << 10, MASK_ALL = 0x1FFFFu, MASK_B = MASK_ALL & ~(MASK_A | MASK_C | MASK_D);
__host__ inline int kid_of(int p) { return ((MASK_A >> p) & 1u) ? 0 : ((MASK_C >> p) & 1u) ? 2 : ((MASK_D >> p) & 1u) ? 3 : 1; }
extern "C" void kernel_launch(void* const* d_in, const int* in_sizes, int n_in, void* d_out, int out_size, void* d_ws, size_t ws_size, hipStream_t stream) {
    static int grid = 0;
    if (grid == 0) {
        if (n_in != 37 || out_size != NT * D || ws_size < WS_END) { fprintf(stderr, "kernel_launch: unexpected shapes (n_in %d out %d ws %zu)\n", n_in, out_size, ws_size); grid = -1; return; }
        int dev = 0, cus = 0;
        if (hipGetDevice(&dev) != hipSuccess || hipDeviceGetAttribute(&cus, hipDeviceAttributeMultiprocessorCount, dev) != hipSuccess) { grid = -1; return; }
#ifndef MULTI_LAUNCH
        if (hipFuncSetAttribute((const void*)fwd<MASK_ALL>, hipFuncAttributeMaxDynamicSharedMemorySize, LDS_BYTES) != hipSuccess) { fprintf(stderr, "kernel_launch: hipFuncSetAttribute failed\n"); grid = -1; return; }
#else
        if (hipFuncSetAttribute((const void*)fwd<MASK_A>, hipFuncAttributeMaxDynamicSharedMemorySize, LDS_BYTES) != hipSuccess) { fprintf(stderr, "kernel_launch: hipFuncSetAttribute failed\n"); grid = -1; return; }
        if (hipFuncSetAttribute((const void*)fwd<MASK_B>, hipFuncAttributeMaxDynamicSharedMemorySize, LDS_BYTES) != hipSuccess) { fprintf(stderr, "kernel_launch: hipFuncSetAttribute failed\n"); grid = -1; return; }
        if (hipFuncSetAttribute((const void*)fwd<MASK_C>, hipFuncAttributeMaxDynamicSharedMemorySize, LDS_BYTES) != hipSuccess) { fprintf(stderr, "kernel_launch: hipFuncSetAttribute failed\n"); grid = -1; return; }
        if (hipFuncSetAttribute((const void*)fwd<MASK_D>, hipFuncAttributeMaxDynamicSharedMemorySize, LDS_BYTES) != hipSuccess) { fprintf(stderr, "kernel_launch: hipFuncSetAttribute failed\n"); grid = -1; return; }
#endif
        (void)hipGetLastError();
        grid = cus;
    }
    if (grid < 0) return;
    if (hipMemsetAsync((char*)d_ws + WS_CTL, 0, CTL_ZERO_BYTES, stream) != hipSuccess) return;
    Args a{};
    for (int i = 0; i < 37; ++i) a.in[i] = (const float*)d_in[i];
    a.out = (float*)d_out; a.ws = (unsigned char*)d_ws;
#ifdef MULTI_LAUNCH
    int p = 0, li = 0;
    while (p < NPHASE) {
        const int kid = kid_of(p); int q = p + 1;
        while (q < NPHASE && kid_of(q) == kid) ++q;
        a.ph_lo = p; a.ph_hi = q; a.li = li++;
        if (kid == 0) hipLaunchKernelGGL(fwd<MASK_A>, dim3(grid), dim3(NWAVES * 64), LDS_BYTES, stream, a);
        else if (kid == 1) hipLaunchKernelGGL(fwd<MASK_B>, dim3(grid), dim3(NWAVES * 64), LDS_BYTES, stream, a);
        else if (kid == 2) hipLaunchKernelGGL(fwd<MASK_C>, dim3(grid), dim3(NWAVES * 64), LDS_BYTES, stream, a);
        else hipLaunchKernelGGL(fwd<MASK_D>, dim3(grid), dim3(NWAVES * 64), LDS_BYTES, stream, a);
        p = q;
    }
#else
    a.ph_lo = 0; a.ph_hi = NPHASE; a.li = 0;
    hipLaunchKernelGGL(fwd<MASK_ALL>, dim3(grid), dim3(NWAVES * 64), LDS_BYTES, stream, a);
#endif
}
```

```cpp
#include <hip/hip_runtime.h>
#include <stdint.h>
#include <stdio.h>

constexpr int D = 1024, NB = 16, SEQ = 2048, NT = NB * SEQ, LC = 256, NC = NB * LC, R = NT + NC;
constexpr int NE = 32, CAP = R;
constexpr int NWAVES = 8;

typedef unsigned short bf16;
typedef short bf16x8 __attribute__((ext_vector_type(8)));
typedef float f32x4 __attribute__((ext_vector_type(4)));
typedef unsigned v4u __attribute__((ext_vector_type(4)));
#define LAS __attribute__((address_space(3)))
#define CAS __attribute__((address_space(4)))
#define RLX_AGENT __ATOMIC_RELAXED, __HIP_MEMORY_SCOPE_AGENT

constexpr size_t MiB = 1u << 20;
constexpr size_t WS_CTL = 0, CTL_ZERO_BYTES = 1 * MiB;
constexpr size_t WS_MOD = 1 * MiB;
constexpr size_t WS_WIN0 = 2 * MiB, WS_WOUT0 = 8 * MiB, WS_WIN1 = 10 * MiB, WS_WOUT1 = 14 * MiB, WS_WLRU = 16 * MiB;
constexpr size_t WS_TOKLIST = 18 * MiB;
constexpr size_t WS_SEL = 23 * MiB;
constexpr size_t WS_GATEV = 24 * MiB;
constexpr size_t WS_XC = 25 * MiB;
constexpr size_t WS_WEXP = 41 * MiB;
constexpr size_t WS_H = 233 * MiB;
constexpr size_t WS_P = 305 * MiB;
constexpr int PP = 2560;
constexpr size_t WS_A2 = 521 * MiB;
constexpr size_t WS_ACT = 593 * MiB;
constexpr size_t WS_YB = 305 * MiB;
constexpr size_t WS_G = 305 * MiB;
constexpr size_t WS_U = 369 * MiB;
constexpr size_t WS_UC = 441 * MiB;
constexpr size_t WS_AF = 513 * MiB;
constexpr size_t WS_AB = 657 * MiB;
constexpr size_t WS_HF = WS_AF;
constexpr size_t WS_A3 = WS_AB;
constexpr size_t WS_BF = 801 * MiB;
constexpr size_t WS_BB = 873 * MiB;
constexpr size_t WS_GS2 = 840 * MiB;
constexpr size_t WS_XB = 760 * MiB;
constexpr size_t WS_END = 945 * MiB;
constexpr int CW_BAR = 4096;
constexpr int CW_CNT = 65536;

__device__ __forceinline__ float bf2f(bf16 v) { return __uint_as_float(((unsigned)v) << 16); }
__device__ __forceinline__ bf16 f2bf(float f) { unsigned u = __float_as_uint(f); return (bf16)((u + 0x7fffu + ((u >> 16) & 1u)) >> 16); }
__device__ __forceinline__ unsigned pk2(float lo, float hi) { return (unsigned)f2bf(lo) | ((unsigned)f2bf(hi) << 16); }
__device__ __forceinline__ int lane_id_fresh() { int l; asm volatile("v_mbcnt_lo_u32_b32 %0, -1, 0\n\tv_mbcnt_hi_u32_b32 %0, -1, %0" : "=v"(l)); return l; }
__device__ __forceinline__ unsigned pk4_fp8(float a, float b, float c, float d) {
    a = fminf(fmaxf(a, -448.f), 448.f); b = fminf(fmaxf(b, -448.f), 448.f); c = fminf(fmaxf(c, -448.f), 448.f); d = fminf(fmaxf(d, -448.f), 448.f);
    unsigned w = 0u; w = __builtin_amdgcn_cvt_pk_fp8_f32(a, b, w, false); w = __builtin_amdgcn_cvt_pk_fp8_f32(c, d, w, true); return w;
}
constexpr float W8_SCALE = 32.0f, ACT8_SCALE = 4.0f, YB8_SCALE = 16.0f;
__device__ __forceinline__ float wave_sum(float v) {
#pragma unroll
    for (int o = 1; o < 64; o <<= 1) v += __shfl_xor(v, o);
    return v;
}
__device__ __forceinline__ float wave_max(float v) {
#pragma unroll
    for (int o = 1; o < 64; o <<= 1) v = fmaxf(v, __shfl_xor(v, o));
    return v;
}
__device__ __forceinline__ float sigmoidf_(float x) { return 1.0f / (1.0f + __expf(-x)); }
__device__ __forceinline__ float gelu_tanh(float x) { return 0.5f * x * (1.0f + tanhf(0.7978845608028654f * (x + 0.044715f * x * x * x))); }

#define XB_TMO      128
#define XB_XCNT(j)  (256  + 64 * (j))
#define XB_XSUB(j)  (1280 + 64 * (j))
#define XB_XGEN(j)  (2304 + 64 * (j))
#define XB_TOP      3328
#define XB_TOPGEN   3392
#define XCD_BAR_WORDS 3456
#define XB_SPIN_CAP (1u << 18)
__device__ __forceinline__ unsigned xb_ld(unsigned* p)              { return __hip_atomic_load(p, __ATOMIC_RELAXED, __HIP_MEMORY_SCOPE_AGENT); }
__device__ __forceinline__ unsigned xb_add(unsigned* p, unsigned v) { return __hip_atomic_fetch_add(p, v, __ATOMIC_RELAXED, __HIP_MEMORY_SCOPE_AGENT); }
__device__ __forceinline__ unsigned xb_xcc_id() { return (unsigned)__builtin_amdgcn_s_getreg((3 << 11) | 20) & 0xFu; }
#define XB_SPIN(cond, bar) do { unsigned _sp = 0; while (cond) { __builtin_amdgcn_s_sleep(1); \
    if ((++_sp & 255u) == 0u) { if (xb_ld(&(bar)[XB_TMO])) break; if (_sp > XB_SPIN_CAP) { atomicAdd(&(bar)[XB_TMO], 1u); break; } } } } while (0)
struct XcdBarrier { unsigned* bar; unsigned x; volatile LAS unsigned* st; };
__device__ __forceinline__ XcdBarrier xcd_barrier_post(unsigned* bar, volatile LAS unsigned* st, int tid) {
    XcdBarrier b; b.bar = bar; b.x = xb_xcc_id(); b.st = st;
    if (tid == 0) (void)xb_add(&bar[XB_XCNT(b.x)], 1u);
    return b;
}
__device__ __forceinline__ void xcd_barrier_complete(unsigned* bar, unsigned x, unsigned& nloc, unsigned& nx) {
    const unsigned G = gridDim.x * gridDim.y * gridDim.z;
    unsigned sum, cnt, mine, sp = 0u;
    for (;;) {
        sum = 0u; cnt = 0u; mine = 0u;
#pragma unroll
        for (unsigned j = 0; j < 16; ++j) { const unsigned c = xb_ld(&bar[XB_XCNT(j)]); sum += c; cnt += (c > 0u) ? 1u : 0u; mine = (j == x) ? c : mine; }
        if (sum == G) break;
        __builtin_amdgcn_s_sleep(1);
        if ((++sp & 255u) == 0u) { if (xb_ld(&bar[XB_TMO])) break; if (sp > XB_SPIN_CAP) { atomicAdd(&bar[XB_TMO], 1u); break; } }
    }
    nloc = mine > 0u ? mine : 1u; nx = cnt > 0u ? cnt : 1u;
}
__device__ __forceinline__ void xcd_barrier(const XcdBarrier& b, int tid) {
    asm volatile("s_waitcnt vmcnt(0)" ::: "memory");
    __syncthreads();
    if (tid == 0) {
        unsigned* bar = b.bar;
        __builtin_amdgcn_s_waitcnt(0);
        unsigned nloc = b.st[0], nx = b.st[1];
        if (nloc == 0u) { xcd_barrier_complete(bar, b.x, nloc, nx); b.st[0] = nloc; b.st[1] = nx; }
        const unsigned old = xb_add(&bar[XB_XSUB(b.x)], 1u);
        const unsigned gen = old / nloc;
        if (old + 1u == (gen + 1u) * nloc) {
            __builtin_amdgcn_fence(__ATOMIC_RELEASE, "agent");
            asm volatile("s_waitcnt vmcnt(0)" ::: "memory");
            const unsigned og = xb_add(&bar[XB_TOP], 1u);
            const unsigned tg = og / nx;
            if (og + 1u == (tg + 1u) * nx) xb_add(&bar[XB_TOPGEN], 1u);
            else XB_SPIN(xb_ld(&bar[XB_TOPGEN]) == tg, bar);
            __builtin_amdgcn_fence(__ATOMIC_ACQUIRE, "agent");
            xb_add(&bar[XB_XGEN(b.x)], 1u);
            asm volatile("s_waitcnt vmcnt(0)" ::: "memory");
        } else {
            XB_SPIN(xb_ld(&bar[XB_XGEN(b.x)]) == gen, bar);
            __builtin_amdgcn_fence(__ATOMIC_ACQUIRE, "agent");
            asm volatile("s_waitcnt vmcnt(0)" ::: "memory");
        }
    }
    __syncthreads();
}

struct Args { const float* in[37]; float* out; unsigned char* ws; int ph_lo, ph_hi, li, pad; };
struct Frame {
    unsigned char* lds;
    LAS unsigned char* ldsl;
    int tid, lane, wave, gw, ngw, G, bid;
};

template <int NS, class FA, class FB, class FS>
__device__ __forceinline__ void tile_gemm32(int K, FA arow, FB brow, FS store, int lane) {
    const int lr = lane & 15, lq = lane >> 4;
    const bf16* ap[2]; const bf16* bp[NS][2];
#pragma unroll
    for (int i = 0; i < 2; ++i) ap[i] = arow(16 * i + lr) + 8 * lq;
#pragma unroll
    for (int s = 0; s < NS; ++s)
#pragma unroll
        for (int j = 0; j < 2; ++j) bp[s][j] = brow(s, 16 * j + lr) + 8 * lq;
    f32x4 acc[NS][2][2];
#pragma unroll
    for (int s = 0; s < NS; ++s)
#pragma unroll
        for (int i = 0; i < 2; ++i)
#pragma unroll
            for (int j = 0; j < 2; ++j) acc[s][i][j] = (f32x4){0.f, 0.f, 0.f, 0.f};
#pragma nounroll
    for (int k0 = 0; k0 < K; k0 += 32) {
        bf16x8 a[2], b[NS][2];
#pragma unroll
        for (int i = 0; i < 2; ++i) a[i] = *(const bf16x8*)(ap[i] + k0);
#pragma unroll
        for (int s = 0; s < NS; ++s)
#pragma unroll
            for (int j = 0; j < 2; ++j) b[s][j] = *(const bf16x8*)(bp[s][j] + k0);
#pragma unroll
        for (int s = 0; s < NS; ++s)
#pragma unroll
            for (int i = 0; i < 2; ++i)
#pragma unroll
                for (int j = 0; j < 2; ++j) acc[s][i][j] = __builtin_amdgcn_mfma_f32_16x16x32_bf16(a[i], b[s][j], acc[s][i][j], 0, 0, 0);
    }
#pragma unroll
    for (int i = 0; i < 2; ++i)
#pragma unroll
        for (int j = 0; j < 2; ++j)
#pragma unroll
            for (int q = 0; q < 4; ++q) {
                float v[NS];
#pragma unroll
                for (int s = 0; s < NS; ++s) v[s] = acc[s][i][j][q];
                store(16 * i + 4 * lq + q, 16 * j + lr, v);
            }
}


namespace pg8 {
constexpr int BM = 256, BK = 64, HALF = 128, HTB = HALF * BK * 2, STAGE_BYTES = 8 * HTB;
__device__ __forceinline__ int lds_byte(int r, int c) { const int st = (r >> 4) * 2 + (c >> 5), rr = r & 15, cc = c & 31, ob = rr * 64 + cc * 2; return st * 1024 + (ob ^ (((ob >> 9) & 1) << 5)); }
__device__ __forceinline__ void stage_rc(int b, int& R_, int& C_) { const int st = b / 1024, sb = b % 1024, swz = sb ^ (((sb >> 9) & 1) << 5); R_ = (st >> 1) * 16 + swz / 64; C_ = (st & 1) * 32 + (swz % 64) / 2; }
__device__ __forceinline__ int perm32(int rho) { const int n = rho >> 4, i = rho & 15; return 8 * (i >> 2) + 4 * n + (i & 3); }
struct Unit { int pm, pn, e, rows, base, newe; };
typedef int v8i __attribute__((ext_vector_type(8)));
typedef int v4i __attribute__((ext_vector_type(4)));
__device__ __forceinline__ void mfma8(f32x4& acc, v8i a, v8i b, unsigned sc) {
    asm volatile("v_mfma_scale_f32_16x16x128_f8f6f4 %0, %1, %2, %0, %3, %3 op_sel_hi:[0,0,0]" : "+v"(acc) : "v"(a), "v"(b), "v"(sc));
}
__device__ __forceinline__ v8i cat8(bf16x8 a, bf16x8 b) { return __builtin_shufflevector(__builtin_bit_cast(v4i, a), __builtin_bit_cast(v4i, b), 0, 1, 2, 3, 4, 5, 6, 7); }
__device__ __forceinline__ unsigned cvt_pk_bf16(float lo, float hi) { unsigned r; asm volatile("v_cvt_pk_bf16_f32 %0, %1, %2" : "=v"(r) : "v"(lo), "v"(hi)); return r; }

template <int RB  , bool FP8, class Epi, class Sched>
__device__ __forceinline__ void gemm_phase(LAS unsigned char* lds, const Sched& S, const Epi& E, const int wave_id) {
    const int tid_ = wave_id * 64 + lane_id_fresh();
    const int tid = tid_, wid = wave_id, lane = tid & 63, wr = wid >> 2, wc = wid & 3, fr = lane & 15, fq = lane >> 4;
    constexpr int nt = RB / 128;
    unsigned voffA[2], voffB[2]; int rA[2];
#pragma unroll
    for (int i = 0; i < 2; ++i) { int R_, C_; stage_rc(tid * 16 + i * 8192, R_, C_); const int Rb = Epi::PERM ? ((R_ & ~31) + perm32(R_ & 31)) : R_;
        voffA[i] = Sched::GATHER ? (unsigned)C_ * 2u : (unsigned)(R_ * RB + C_ * 2); rA[i] = R_; voffB[i] = (unsigned)(Rb * RB + C_ * 2); }
    constexpr size_t kstep = (size_t)(BK * 2);
    constexpr size_t hstep = (size_t)HALF * RB;
    const unsigned ldsw = (unsigned)wid * 1024u;
    const int aoff = lds_byte(wr * 64 + fr, fq * 8), boff = lds_byte(wc * 32 + fr, fq * 8);
#define PG8_SA(b, h) (((b) * 2 + (h)) * HTB)
#define PG8_SB(b, h) ((4 + (b) * 2 + (h)) * HTB)
#define PG8_STAGE(bufoff, gbase, voff) do { _Pragma("unroll") for (int _i = 0; _i < 2; ++_i) \
        __builtin_amdgcn_global_load_lds((const unsigned*)((const char*)(gbase) + (voff)[_i]), (LAS unsigned*)(lds + (bufoff) + ldsw + _i * 8192), 16, 0, 0); } while (0)
#define PG8_STAGE_A(bufoff, ubase, uoff, h) do { if constexpr (Sched::GATHER) PG8_STAGE(bufoff, ubase, (uoff)[h]); else PG8_STAGE(bufoff, (ubase) + (h) * hstep, voffA); } while (0)
#define PG8_LDA(dst, b, h) do { _Pragma("unroll") for (int m = 0; m < 4; ++m) _Pragma("unroll") for (int k = 0; k < 2; ++k) dst[m][k] = *(const LAS bf16x8*)(lds + PG8_SA(b, h) + aoff + m * 2048 + k * 1024); } while (0)
#define PG8_LDB(dst, b, h) do { _Pragma("unroll") for (int n = 0; n < 2; ++n) _Pragma("unroll") for (int k = 0; k < 2; ++k) dst[n][k] = *(const LAS bf16x8*)(lds + PG8_SB(b, h) + boff + n * 2048 + k * 1024); } while (0)
#define PG8_MMA(ai, bj, At, Bt) do { __builtin_amdgcn_s_setprio(1); _Pragma("unroll") for (int m = 0; m < 4; ++m) _Pragma("unroll") for (int n = 0; n < 2; ++n) { \
        if constexpr (FP8) mfma8(acc[ai][bj][m][n], cat8(Bt[n][0], Bt[n][1]), cat8(At[m][0], At[m][1]), sc1); \
        else { _Pragma("unroll") for (int k = 0; k < 2; ++k) acc[ai][bj][m][n] = __builtin_amdgcn_mfma_f32_16x16x32_bf16(Bt[n][k], At[m][k], acc[ai][bj][m][n], 0, 0, 0); } } __builtin_amdgcn_s_setprio(0); } while (0)
#define PG8_WAIT_V(n) asm volatile("s_waitcnt vmcnt(" #n ")" ::: "memory")
#define PG8_WAIT_L(n) asm volatile("s_waitcnt lgkmcnt(" #n ")" ::: "memory")
#define PG8_BAR __builtin_amdgcn_s_barrier()
#define PG8_SCHED __builtin_amdgcn_sched_barrier(0)
#define PG8_KBODY(a1, a2, b2, off2) do { const char* _a1 = (a1); const char* _a2 = (a2); const char* _b2 = (b2); const char* _a3 = _a2 + kstep; const char* _b3 = _b2 + kstep; \
            asm volatile("" : "+s"(_a1), "+s"(_a2), "+s"(_b2), "+s"(_a3), "+s"(_b3));   \
            PG8_LDB(B0, 0, 0); PG8_LDB(B1, 0, 1); PG8_SCHED; PG8_LDA(At, 0, 0); PG8_STAGE_A(PG8_SA(1, 1), _a1, coff, 1); \
            PG8_WAIT_V(8); PG8_WAIT_L(0); PG8_BAR; PG8_MMA(0, 0, At, B0); PG8_MMA(0, 1, At, B1); PG8_BAR; PG8_SCHED; \
            PG8_LDA(At, 0, 1); PG8_STAGE(PG8_SB(0, 0), _b2, voffB); PG8_STAGE(PG8_SB(0, 1), _b2 + hstep, voffB); PG8_STAGE_A(PG8_SA(0, 0), _a2, off2, 0); \
            PG8_WAIT_V(8); PG8_WAIT_L(0); PG8_BAR; PG8_MMA(1, 0, At, B0); PG8_MMA(1, 1, At, B1); PG8_BAR; PG8_SCHED; \
            PG8_LDB(B0, 1, 0); PG8_LDB(B1, 1, 1); PG8_SCHED; PG8_LDA(At, 1, 0); PG8_STAGE_A(PG8_SA(0, 1), _a2, off2, 1); \
            PG8_WAIT_V(8); PG8_WAIT_L(0); PG8_BAR; PG8_MMA(0, 0, At, B0); PG8_MMA(0, 1, At, B1); PG8_BAR; PG8_SCHED; \
            PG8_LDA(At, 1, 1); PG8_STAGE(PG8_SB(1, 0), _b3, voffB); PG8_STAGE(PG8_SB(1, 1), _b3 + hstep, voffB); PG8_STAGE_A(PG8_SA(1, 0), _a3, off2, 0); \
            PG8_WAIT_V(8); PG8_WAIT_L(0); PG8_BAR; PG8_MMA(1, 0, At, B0); PG8_MMA(1, 1, At, B1); PG8_BAR; PG8_SCHED; } while (0)
    int ui = 0;
    const char* cA; const char* cB;
    if (!S.bases(0, cA, cB)) return;
    f32x4 acc[2][2][4][2];
#pragma unroll
    for (int a = 0; a < 2; ++a)
#pragma unroll
        for (int b = 0; b < 2; ++b)
#pragma unroll
            for (int m = 0; m < 4; ++m)
#pragma unroll
                for (int n = 0; n < 2; ++n) acc[a][b][m][n] = (f32x4){0.f, 0.f, 0.f, 0.f};
    bf16x8 At[4][2], B0[2][2], B1[2][2];
    unsigned sc1 = 0x7f7f7f7fu; asm volatile("" : "+v"(sc1));
    unsigned coff[2][2], noff[2][2];
    if constexpr (Sched::GATHER) S.aoffs(0, rA, voffA, coff);
    PG8_STAGE(PG8_SB(0, 0), cB, voffB); PG8_STAGE(PG8_SB(0, 1), cB + hstep, voffB); PG8_STAGE_A(PG8_SA(0, 0), cA, coff, 0); PG8_STAGE_A(PG8_SA(0, 1), cA, coff, 1);
    if (wr == 1) PG8_BAR;
    PG8_WAIT_V(2); PG8_BAR;
    PG8_STAGE(PG8_SB(1, 0), cB + kstep, voffB); PG8_STAGE_A(PG8_SA(1, 0), cA + kstep, coff, 0); PG8_STAGE(PG8_SB(1, 1), cB + hstep + kstep, voffB);
    PG8_WAIT_V(6); PG8_BAR;
    for (;;) {
        const char* nA; const char* nB;
        const bool has_next = S.bases(ui + 1, nA, nB);
        if (!has_next) { nA = cA; nB = cB; }
        int ntok[2][2];
        if constexpr (Sched::GATHER) { if (has_next) S.atoks(ui + 1, rA, ntok); }
#pragma nounroll
        for (int t = 0; t < nt - 2; t += 2) PG8_KBODY(cA + (size_t)(t + 1) * kstep, cA + (size_t)(t + 2) * kstep, cB + (size_t)(t + 2) * kstep, coff);
        if constexpr (Sched::GATHER) {
            if (has_next) { asm volatile("" : "+v"(ntok[0][0]), "+v"(ntok[0][1]), "+v"(ntok[1][0]), "+v"(ntok[1][1]));
#pragma unroll
                for (int h = 0; h < 2; ++h)
#pragma unroll
                    for (int i = 0; i < 2; ++i) noff[h][i] = (unsigned)ntok[h][i] * (unsigned)RB + voffA[i]; }
            else {
#pragma unroll
                for (int h = 0; h < 2; ++h)
#pragma unroll
                    for (int i = 0; i < 2; ++i) noff[h][i] = coff[h][i]; }
        }
        PG8_KBODY(cA + (size_t)(nt - 1) * kstep, nA, nB, noff);
        if (wr == 0) PG8_BAR;
        if constexpr (FP8) asm volatile("s_nop 15\n\ts_nop 3" ::: "memory");
        {
            const int t2 = lane_id_fresh();
            const int w2 = wave_id, l2 = t2 & 63;
            Unit cur; S.unit(ui, cur); E(acc, cur, w2 >> 2, w2 & 3, l2 & 15, l2 >> 4); }
        if (!has_next) break;
#pragma unroll
        for (int a = 0; a < 2; ++a)
#pragma unroll
            for (int b = 0; b < 2; ++b)
#pragma unroll
                for (int m = 0; m < 4; ++m)
#pragma unroll
                    for (int n = 0; n < 2; ++n) acc[a][b][m][n] = (f32x4){0.f, 0.f, 0.f, 0.f};
        cA = nA; cB = nB; ++ui;
        if constexpr (Sched::GATHER) {
#pragma unroll
            for (int h = 0; h < 2; ++h)
#pragma unroll
                for (int i = 0; i < 2; ++i) coff[h][i] = noff[h][i]; }
        if (wr == 1) PG8_BAR;
    }
    PG8_WAIT_V(0);
    PG8_BAR;
#undef PG8_SA
#undef PG8_SB
#undef PG8_STAGE
#undef PG8_STAGE_A
#undef PG8_KBODY
#undef PG8_LDA
#undef PG8_LDB
#undef PG8_MMA
#undef PG8_WAIT_V
#undef PG8_WAIT_L
#undef PG8_BAR
#undef PG8_SCHED
}
__device__ __forceinline__ int xcd_remap(long L, int nwg) { const int q = nwg / 8, r = nwg % 8, xcd = (int)(L % 8), off = (int)(L / 8); return (xcd < r ? xcd * (q + 1) : r * (q + 1) + (xcd - r) * q) + off; }
struct RectSched {
    static constexpr bool GATHER = false;
    const char* A; const char* B; int RB, nM, nN, G, c, nM2, nN2, pm2, pn2;
    __device__ __forceinline__ bool unit(int i, Unit& u) const {
        const int n1 = nM * nN, nwg = n1 + nM2 * nN2; const long L = (long)i * G + c; if (L >= nwg) return false;
        int w = xcd_remap(L, nwg); int rm = nM, rn = nN, pm0 = 0, pn0 = 0;
        if (w >= n1) { w -= n1; rm = nM2; rn = nN2; pm0 = pm2; pn0 = pn2; }
        const int nig = 8 * rn, gid = w / nig, fm = gid * 8, gsz = (rm - fm) < 8 ? (rm - fm) : 8;
        u.pm = pm0 + fm + ((w % nig) % gsz); u.pn = pn0 + (w % nig) / gsz; u.e = 0; u.rows = 256; u.base = u.pm * 256; u.newe = 0;
        return true;
    }
    __device__ __forceinline__ bool bases(int i, const char*& a, const char*& b) const {
        Unit u; if (!unit(i, u)) return false;
        a = A + (size_t)u.pm * 256 * RB; b = B + (size_t)u.pn * 256 * RB; return true;
    }
    __device__ __forceinline__ void aoffs(int, const int (&)[2], const unsigned (&)[2], unsigned (&)[2][2]) const {}
    __device__ __forceinline__ void atoks(int, const int (&)[2], int (&)[2][2]) const {}
};
}

template <class MapF>
__device__ __forceinline__ void transpose_item(const float* W, int K, int N, bf16* WT, MapF rowmap, float* scr, int item, int lane) {
    const int nblk = N / 32, kb = item / nblk, nb = item % nblk, k0 = 64 * kb, n0 = 32 * nb;
#pragma unroll 8
    for (int i = 0; i < 32; ++i) { const int kk = 2 * i + (lane >> 5); scr[kk * 33 + (lane & 31)] = W[(size_t)(k0 + kk) * N + n0 + (lane & 31)]; }
    asm volatile("s_waitcnt lgkmcnt(0)" ::: "memory");
    const int c = lane & 7;
#pragma unroll
    for (int j = 0; j < 4; ++j) { const int n = (lane >> 3) + 8 * j; const float* s = scr + (8 * c) * 33 + n;
        v4u o; o.x = pk2(s[0 * 33], s[1 * 33]); o.y = pk2(s[2 * 33], s[3 * 33]); o.z = pk2(s[4 * 33], s[5 * 33]); o.w = pk2(s[6 * 33], s[7 * 33]);
        *(v4u*)(WT + (size_t)rowmap(n0 + n) * K + k0 + 8 * c) = o; }
    asm volatile("s_waitcnt lgkmcnt(0)" ::: "memory");
}
constexpr int CV_E0 = 6, CV_E1 = 16, CV_E2 = 22, INP0_NC = 32, OUTP0_NC = 64, INP1_NC = 32, MOE_NC = 32;
__device__ __forceinline__ void item8_load(const float* W, int N, int item, int lane, f32x4 (&t)[16]) {
    const int nblk = N / 32, kb = item / nblk, nb = item % nblk, k0 = 128 * kb, n0 = 32 * nb;
    const int r8 = lane >> 3, c8 = lane & 7;
    const float* p = W + (size_t)(k0 + 16 * r8) * N + n0 + 4 * c8;
#pragma unroll
    for (int i = 0; i < 16; ++i) t[i] = __builtin_nontemporal_load((const f32x4*)(p + (size_t)i * N));
}
template <class MapF>
__device__ __forceinline__ void item8_store(const f32x4 (&t)[16], int K, int N, unsigned char* WT, MapF rowmap, int item, int lane) {
    const int nblk = N / 32, kb = item / nblk, nb = item % nblk, k0 = 128 * kb, n0 = 32 * nb;
    const int r8 = lane >> 3, c8 = lane & 7;
#pragma unroll
    for (int c = 0; c < 4; ++c) {
        v4u o;
        o.x = pk4_fp8(t[0][c] * W8_SCALE, t[1][c] * W8_SCALE, t[2][c] * W8_SCALE, t[3][c] * W8_SCALE);     o.y = pk4_fp8(t[4][c] * W8_SCALE, t[5][c] * W8_SCALE, t[6][c] * W8_SCALE, t[7][c] * W8_SCALE);
        o.z = pk4_fp8(t[8][c] * W8_SCALE, t[9][c] * W8_SCALE, t[10][c] * W8_SCALE, t[11][c] * W8_SCALE); o.w = pk4_fp8(t[12][c] * W8_SCALE, t[13][c] * W8_SCALE, t[14][c] * W8_SCALE, t[15][c] * W8_SCALE);
        *(v4u*)(WT + (size_t)rowmap(n0 + 4 * c8 + c) * K + k0 + 16 * r8) = o;
    }
}
struct ExpertConv {
    const CAS Args& a; int layer, wlo, nw, lane;
    static constexpr int IPM = 8 * 32;
    __device__ __forceinline__ void load(int it, f32x4 (&t)[16]) const {
        const int m = it / IPM, le = layer + m / nw, which = wlo + m % nw;
        item8_load((which == 0 ? a.in[31] : which == 1 ? a.in[33] : a.in[35]) + ((size_t)le << 20), D, it % IPM, lane, t); }
    __device__ __forceinline__ void store(int it, const f32x4 (&t)[16]) const {
        const int m = it / IPM, r = it % IPM, le = layer + m / nw, which = wlo + m % nw;
        unsigned char* dst = (unsigned char*)(a.ws + WS_WEXP) + (size_t)le * 3072 * 1024;
        if (which == 0) item8_store(t, D, D, dst, [](int n) { return ((n >> 7) << 8) + (n & 127); }, r, lane);
        else if (which == 1) item8_store(t, D, D, dst, [](int n) { return ((n >> 7) << 8) + 128 + (n & 127); }, r, lane);
        else item8_store(t, D, D, dst + (size_t)2048 * 1024,
            [](int f) { return (f & ~255) | (((f >> 3) & 1) << 7) | (((f >> 6) & 3) << 5) | (((f >> 4) & 3) << 3) | (f & 7); }, r, lane); }
};
__device__ __forceinline__ void convert_experts(const CAS Args& a, const Frame& F, int layer, int wlo, int whi, int gw, int ngw, int elo = 0, int ehi = NE) {
    const ExpertConv C{a, layer * NE + elo, wlo, whi - wlo, F.lane};
    const int total = (ehi - elo) * (whi - wlo) * ExpertConv::IPM;
    int it = gw; if (it >= total) return;
    f32x4 tA[16], tB[16];
    C.load(it, tA);
    for (;;) {
        int nit = it + ngw;
        if (nit < total) C.load(nit, tB);
        C.store(it, tA);
        if (nit >= total) break;
        it = nit; nit = it + ngw;
        if (nit < total) C.load(nit, tA);
        C.store(it, tB);
        if (nit >= total) break;
        it = nit;
    }
}
__device__ __forceinline__ void p0_prologue(const CAS Args& a, const Frame& F) {
    float* scr = (float*)(F.lds + F.wave * 8448);
    constexpr int I_IN0 = 16 * 96, I_O = 16 * 32, I_IN1 = 16 * 64, I_LRU1 = 4 * 8;
    constexpr int NSMALL = I_IN0 + I_O + I_IN1 + I_O + 16 * I_LRU1;
    for (int it = F.gw; it < NSMALL; it += F.ngw) {
        int r = it;
        if (r < I_IN0) {
            transpose_item(a.in[8], D, 3072, (bf16*)(a.ws + WS_WIN0), [](int f) {
                if (f < 2048) return (f & ~255) | (((f >> 5) & 1) << 7) | (((f >> 6) & 3) << 5) | (f & 31);
                if (f < 2560) { const int j = f - 2048; return (8 + (j >> 7)) * 256 + (j & 127); }
                const int j = f - 2560; return (8 + (j >> 7)) * 256 + 128 + (j & 127); }, scr, r, F.lane); continue; } r -= I_IN0;
        if (r < I_O) { transpose_item(a.in[9], D, D, (bf16*)(a.ws + WS_WOUT0), [](int n) { return n; }, scr, r, F.lane); continue; } r -= I_O;
        if (r < I_IN1) { transpose_item(a.in[15], D, 2048, (bf16*)(a.ws + WS_WIN1), [](int n) { return n; }, scr, r, F.lane); continue; } r -= I_IN1;
        if (r < I_O) { transpose_item(a.in[16], D, D, (bf16*)(a.ws + WS_WOUT1), [](int n) { return n; }, scr, r, F.lane); continue; } r -= I_O;
        const int gh = r / I_LRU1, rr = r % I_LRU1, g = gh >> 2, h = gh & 3;
        const float* W = (g == 0 ? a.in[19] : g == 1 ? a.in[21] : g == 2 ? a.in[24] : a.in[26]) + (size_t)h * 65536;
        transpose_item(W, 256, 256, (bf16*)(a.ws + WS_WLRU) + (size_t)h * 1024 * 256, [g](int n) { return g * 256 + n; }, scr, rr, F.lane);
    }
    __syncthreads();
    convert_experts(a, F, 0, 0, 2, F.gw, F.ngw, 0, CV_E0);
    __syncthreads();
    float* sc = (float*)F.lds;
    float* red = (float*)(F.lds + 17 * 1024 * 4);
    {
#pragma unroll
        for (int hbat = 0; hbat < 2; ++hbat) { float tv[17];
#pragma unroll
            for (int j = 0; j < 17; ++j) { const int i = F.tid + 512 * (17 * hbat + j); tv[j] = i < 16 * 1024 ? a.in[1][i] : a.in[3][i - 16 * 1024]; }
#pragma unroll
            for (int j = 0; j < 17; ++j) { const int i = F.tid + 512 * (17 * hbat + j); sc[i] = tv[j] / (1.0f + __expf(-tv[j])); } }
    }
    __syncthreads();
    float* MOD = (float*)(a.ws + WS_MOD);
    for (int u = F.bid; u < 192; u += F.G) {
        const int l = u / 96, n = (u % 96) * 64 + F.lane;
        const float* w = a.in[4] + (size_t)l * D * 6144 + n;
        float acc[17];
#pragma unroll
        for (int b = 0; b < 17; ++b) acc[b] = 0.f;
        for (int k0 = F.wave * 128; k0 < F.wave * 128 + 128; k0 += 16) {
            float wv[16];
#pragma unroll
            for (int q = 0; q < 16; ++q) wv[q] = __builtin_nontemporal_load(w + (size_t)(k0 + q) * 6144);
#pragma unroll
            for (int q = 0; q < 16; ++q)
#pragma unroll
                for (int b = 0; b < 17; ++b) acc[b] += sc[b * 1024 + k0 + q] * wv[q];
        }
#pragma unroll
        for (int b = 0; b < 17; ++b) red[(F.wave * 17 + b) * 64 + F.lane] = acc[b];
        __syncthreads();
        for (int i = F.tid; i < 17 * 64; i += NWAVES * 64) {
            const int b = i / 64, ln = i % 64; float s = 0.f;
#pragma unroll
            for (int w8 = 0; w8 < 8; ++w8) s += red[(w8 * 17 + b) * 64 + ln];
            const int nn = (u % 96) * 64 + ln;
            MOD[((size_t)l * 17 + b) * 6144 + nn] = s + a.in[5][l * 6144 + nn];
        }
        __syncthreads();
    }
}

__device__ __forceinline__ void load_row16(const float* row, int lane, float (&v)[16]) {
#pragma unroll
    for (int j = 0; j < 4; ++j) { const f32x4 t = *(const f32x4*)(row + 256 * j + 4 * lane); v[4 * j] = t.x; v[4 * j + 1] = t.y; v[4 * j + 2] = t.z; v[4 * j + 3] = t.w; }
}
__device__ __forceinline__ void load_row16_bf16(const bf16* row, int lane, float (&v)[16]) {
#pragma unroll
    for (int j = 0; j < 4; ++j) { const uint2 t = *(const uint2*)(row + 256 * j + 4 * lane); v[4 * j] = __uint_as_float(t.x << 16); v[4 * j + 1] = __uint_as_float(t.x & 0xffff0000u); v[4 * j + 2] = __uint_as_float(t.y << 16); v[4 * j + 3] = __uint_as_float(t.y & 0xffff0000u); }
}
__device__ __forceinline__ void store_row16_bf16(bf16* row, int lane, const float (&v)[16]) {
#pragma unroll
    for (int j = 0; j < 4; ++j) { uint2 o; o.x = pk2(v[4 * j], v[4 * j + 1]); o.y = pk2(v[4 * j + 2], v[4 * j + 3]); *(uint2*)(row + 256 * j + 4 * lane) = o; }
}
__device__ __forceinline__ void store_row16_f32(float* row, int lane, const float (&v)[16]) {
#pragma unroll
    for (int j = 0; j < 4; ++j) *(f32x4*)(row + 256 * j + 4 * lane) = (f32x4){v[4 * j], v[4 * j + 1], v[4 * j + 2], v[4 * j + 3]};
}
template <bool FP8OUT = false>
__device__ __forceinline__ void norm_mod(const float (&v)[16], const float* g, const float* sh, const float* sc, bf16* out, int lane, float (&hv)[16]) {
    float s = 0.f;
#pragma unroll
    for (int i = 0; i < 16; ++i) s += v[i] * v[i];
    const float rstd = rsqrtf(wave_sum(s) * (1.0f / D) + 1e-6f);
#pragma unroll
    for (int j = 0; j < 4; ++j) {
        const int e = 256 * j + 4 * lane;
        const f32x4 gg = *(const f32x4*)(g + e), ss = *(const f32x4*)(sh + e), cc = *(const f32x4*)(sc + e);
        hv[4 * j] = v[4 * j] * rstd * gg.x * (1.f + cc.x) + ss.x; hv[4 * j + 1] = v[4 * j + 1] * rstd * gg.y * (1.f + cc.y) + ss.y;
        hv[4 * j + 2] = v[4 * j + 2] * rstd * gg.z * (1.f + cc.z) + ss.z; hv[4 * j + 3] = v[4 * j + 3] * rstd * gg.w * (1.f + cc.w) + ss.w;
        if (FP8OUT) *(unsigned*)((unsigned char*)out + e) = pk4_fp8(hv[4 * j], hv[4 * j + 1], hv[4 * j + 2], hv[4 * j + 3]);
        else { uint2 o; o.x = pk2(hv[4 * j], hv[4 * j + 1]); o.y = pk2(hv[4 * j + 2], hv[4 * j + 3]); *(uint2*)(out + e) = o; }
    }
}
__device__ __forceinline__ int row_batch(int r) { return r < NT ? (r >> 11) : 16; }
__device__ __forceinline__ const float* mod_ptr(const CAS Args& a, int l, int r, int chunk) { return (const float*)(a.ws + WS_MOD) + ((size_t)l * 17 + row_batch(r)) * 6144 + chunk * D; }

__device__ __forceinline__ void p_norm1_l0(const CAS Args& a, const Frame& F) {
    bf16* H = (bf16*)(a.ws + WS_H);
    { float* GS2 = (float*)(a.ws + WS_GS2); const float* MOD = (const float*)(a.ws + WS_MOD);
      for (int i = F.gw * 64 + F.lane; i < 2 * 17 * D; i += F.ngw * 64) { const int l = i / (17 * D), bb = (i / D) % 17, k = i % D; GS2[i] = a.in[7][l * D + k] * (1.0f + MOD[((size_t)l * 17 + bb) * 6144 + 4 * D + k]); } }
    for (int r = F.gw; r < R; r += 3 * F.ngw) {
        float v[3][16], hv[16];
#pragma unroll
        for (int k = 0; k < 3; ++k) { const int rr = r + k * F.ngw; if (rr < R) load_row16(rr < NT ? a.in[0] + (size_t)rr * D : a.in[2] + (size_t)(rr - NT) * D, F.lane, v[k]); }
#pragma unroll
        for (int k = 0; k < 3; ++k) { const int rr = r + k * F.ngw; if (rr < R) norm_mod(v[k], a.in[6], mod_ptr(a, 0, rr, 0), mod_ptr(a, 0, rr, 1), H + (size_t)rr * D, F.lane, hv); }
    }
}

struct EpiInProj0 {
    static constexpr bool PERM = true;
    bf16* P; const float* qg; const float* kg;
    __device__ __forceinline__ void operator()(const f32x4 (&acc)[2][2][4][2], const pg8::Unit& u, int wr, int wc, int fr, int fq) const {
        const int row0 = u.pm * 256 + wr * 64 + fr, pn = u.pn;
        if (pn < 4) {
            const float* g = pn < 2 ? qg : kg; const float sc = pn < 2 ? 0.125f : 1.0f;
            f32x4 gv[2][2];
#pragma unroll
            for (int bj = 0; bj < 2; ++bj)
#pragma unroll
                for (int n = 0; n < 2; ++n) gv[bj][n] = *(const f32x4*)(g + 32 * bj + 8 * fq + 4 * n);
#pragma unroll
            for (int ai = 0; ai < 2; ++ai)
#pragma unroll
                for (int m = 0; m < 4; ++m) {
                    float ss = 0.f;
#pragma unroll
                    for (int bj = 0; bj < 2; ++bj)
#pragma unroll
                        for (int n = 0; n < 2; ++n) { const f32x4 x = acc[ai][bj][m][n]; ss += (x[0] * x[0] + x[1] * x[1]) + (x[2] * x[2] + x[3] * x[3]); }
                    ss += __shfl_xor(ss, 16); ss += __shfl_xor(ss, 32);
                    const float rs = rsqrtf(ss * (1.0f / 64.0f) + 1e-6f) * sc;
                    bf16* rowp = P + (size_t)(row0 + ai * 128 + m * 16) * PP + pn * 256 + wc * 64 + 8 * fq;
#pragma unroll
                    for (int bj = 0; bj < 2; ++bj) { const f32x4 v0 = acc[ai][bj][m][0] * rs * gv[bj][0], v1 = acc[ai][bj][m][1] * rs * gv[bj][1];
                        v4u w; w.x = pg8::cvt_pk_bf16(v0[0], v0[1]); w.y = pg8::cvt_pk_bf16(v0[2], v0[3]); w.z = pg8::cvt_pk_bf16(v1[0], v1[1]); w.w = pg8::cvt_pk_bf16(v1[2], v1[3]);
                        *(v4u*)(rowp + 32 * bj) = w; }
                }
        } else if (pn < 8) {
#pragma unroll
            for (int ai = 0; ai < 2; ++ai)
#pragma unroll
                for (int m = 0; m < 4; ++m) { bf16* rowp = P + (size_t)(row0 + ai * 128 + m * 16) * PP + pn * 256 + wc * 64 + 8 * fq;
#pragma unroll
                    for (int bj = 0; bj < 2; ++bj) { const f32x4 v0 = acc[ai][bj][m][0], v1 = acc[ai][bj][m][1];
                        v4u w; w.x = pg8::cvt_pk_bf16(v0[0], v0[1]); w.y = pg8::cvt_pk_bf16(v0[2], v0[3]); w.z = pg8::cvt_pk_bf16(v1[0], v1[1]); w.w = pg8::cvt_pk_bf16(v1[2], v1[3]);
                        *(v4u*)(rowp + 32 * bj) = w; } }
        } else {
#pragma unroll
            for (int ai = 0; ai < 2; ++ai)
#pragma unroll
                for (int m = 0; m < 4; ++m) { bf16* rowp = P + (size_t)(row0 + ai * 128 + m * 16) * PP + 2048 + (pn - 8) * 128 + wc * 32 + 8 * fq;
                    const f32x4 v0 = acc[ai][0][m][0] * acc[ai][1][m][0], v1 = acc[ai][0][m][1] * acc[ai][1][m][1];
                    v4u w; w.x = pg8::cvt_pk_bf16(v0[0], v0[1]); w.y = pg8::cvt_pk_bf16(v0[2], v0[3]); w.z = pg8::cvt_pk_bf16(v1[0], v1[1]); w.w = pg8::cvt_pk_bf16(v1[2], v1[3]);
                    *(v4u*)rowp = w; }
        }
    }
};
__device__ __forceinline__ void p_inproj0(const CAS Args& a, const Frame& F) {
    if (F.bid >= F.G - INP0_NC) { convert_experts(a, F, 0, 0, 2, (F.bid - (F.G - INP0_NC)) * NWAVES + F.wave, INP0_NC * NWAVES, CV_E1, NE); return; }
    pg8::RectSched S{(const char*)(a.ws + WS_H), (const char*)(a.ws + WS_WIN0), 2 * D, R / 256, 3072 / 256, F.G - INP0_NC, F.bid, 0, 0, 0, 0};
    EpiInProj0 E{(bf16*)(a.ws + WS_P), a.in[10], a.in[11]};
    pg8::gemm_phase<2 * D, false>(F.ldsl, S, E, F.wave);
}
typedef __bf16 bf16x2_t __attribute__((ext_vector_type(2)));
typedef float f32x2_t __attribute__((ext_vector_type(2)));
typedef short s16x4 __attribute__((ext_vector_type(4)));
__device__ __forceinline__ unsigned pk_bf16(float a, float b) { f32x2_t v = {a, b}; bf16x2_t r = __builtin_convertvector(v, bf16x2_t); return __builtin_bit_cast(unsigned, r); }
constexpr int AT_LAT = 0, AT_CK = 576 * 128, AT_CV = AT_CK + 256 * 128, AT_RPB = AT_CV + 256 * 128;
__device__ __forceinline__ int at_swz(int key) { return (key ^ (key >> 3)) & 7; }
__device__ __forceinline__ unsigned at_addr(int key, int chunk) { return (unsigned)(key * 128 + ((chunk ^ at_swz(key)) << 4)); }
template <class RowF>
__device__ __forceinline__ void at_stage(LAS unsigned char* dst, int npieces, RowF rowf, int colbyte, const bf16* P, int wave, int lane) {
    for (int p = wave; p < npieces; p += NWAVES) {
        const int key = 8 * p + (lane >> 3), c = (lane & 7) ^ at_swz(key);
        const char* src = (const char*)P + (size_t)rowf(key) * (PP * 2) + colbyte + 16 * c;
        __builtin_amdgcn_global_load_lds((const unsigned*)src, (LAS unsigned*)(dst + p * 1024), 16, 0, 0);
    }
}
__device__ __forceinline__ void at_tr8(unsigned a0, unsigned a1, unsigned a2, unsigned a3, unsigned a4, unsigned a5, unsigned a6, unsigned a7, s16x4 (&r)[8]) {
    asm volatile("ds_read_b64_tr_b16 %0, %8\n\tds_read_b64_tr_b16 %1, %9\n\tds_read_b64_tr_b16 %2, %10\n\tds_read_b64_tr_b16 %3, %11\n\t"
                 "ds_read_b64_tr_b16 %4, %12\n\tds_read_b64_tr_b16 %5, %13\n\tds_read_b64_tr_b16 %6, %14\n\tds_read_b64_tr_b16 %7, %15\n\ts_waitcnt lgkmcnt(0)"
                 : "=&v"(r[0]), "=&v"(r[1]), "=&v"(r[2]), "=&v"(r[3]), "=&v"(r[4]), "=&v"(r[5]), "=&v"(r[6]), "=&v"(r[7])
                 : "v"(a0), "v"(a1), "v"(a2), "v"(a3), "v"(a4), "v"(a5), "v"(a6), "v"(a7) : "memory");
}
__device__ __forceinline__ void p_attn(const CAS Args& a, const Frame& F) {
    const bf16* P = (const bf16*)(a.ws + WS_P); bf16* A2 = (bf16*)(a.ws + WS_A2);
    LAS unsigned char* lds = F.ldsl;
    const int lane = F.lane, wave = F.wave, rho = lane & 15, g = lane >> 4;
    for (int wu = F.bid; wu < NB * 8 * 2; wu += F.G) {
        const int half = wu & 1, hd = (wu >> 1) & 7, b = wu >> 4;
        __syncthreads();
        for (int i = F.tid; i < 465; i += NWAVES * 64) ((LAS float*)(lds + AT_RPB))[i] = a.in[12][hd * 465 + i];
        at_stage(lds + AT_CK, 32, [=](int key) { return NT + b * 256 + key; }, (512 + hd * 64) * 2, P, wave, lane);
        at_stage(lds + AT_CV, 32, [=](int key) { return NT + b * 256 + key; }, (1024 + hd * 64) * 2, P, wave, lane);
        for (int un = 0; un < 9; ++un) {
            const bool lat = un < 8;
            int r = 0, n = 0, qrow, krow_lo = 0;
            if (lat) { const int rp = half * 8 + un; r = 2 * rp + (wave >> 2); n = wave & 3; qrow = b * 2048 + r * 64 + 16 * n + rho; krow_lo = min(max(2 * rp - 4, 0), 24); }
            else qrow = NT + b * 256 + half * 128 + 16 * wave + rho;
            const int r0 = min(max(r - 4, 0), 24), ro = r0 - krow_lo, kc0 = min(max(16 * n - 8, 0), 32);
            const int c = 16 * n + rho, c0 = min(max(c - 8, 0), 48);
            if (lat) at_stage(lds + AT_LAT, 72, [=](int key) { return b * 2048 + min(krow_lo + (key >> 6), 31) * 64 + (key & 63); }, (512 + hd * 64) * 2, P, wave, lane);
            const bf16x8 q0 = *(const bf16x8*)(P + (size_t)qrow * PP + hd * 64 + 8 * g), q1 = *(const bf16x8*)(P + (size_t)qrow * PP + hd * 64 + 32 + 8 * g);
            asm volatile("s_waitcnt vmcnt(0)" ::: "memory");
            __syncthreads();
            const int pk = 8 * (rho >> 2) + (rho & 3);
            float mxb[2] = {-1e30f, -1e30f}, smb[2] = {0.f, 0.f}; v4u pf[16];
#pragma unroll
            for (int blk = 0; blk < 2; ++blk) {
                if (blk == 0 && !lat) {
#pragma unroll
                    for (int i = 0; i < 8; ++i) pf[i] = (v4u){0u, 0u, 0u, 0u};
                    continue; }
                f32x4 s[16];
#pragma unroll
                for (int i = 0; i < 8; ++i)
#pragma unroll
                    for (int t = 0; t < 2; ++t) {
                        const int key = (blk == 0 ? (ro + i) * 64 + kc0 : 32 * i) + pk + 4 * t;
                        const unsigned kbase = blk == 0 ? AT_LAT : AT_CK;
                        const bf16x8 k0 = *(const LAS bf16x8*)(lds + kbase + at_addr(key, g)), k1 = *(const LAS bf16x8*)(lds + kbase + at_addr(key, 4 + g));
                        f32x4 acc = __builtin_amdgcn_mfma_f32_16x16x32_bf16(k0, q0, (f32x4){0.f, 0.f, 0.f, 0.f}, 0, 0, 0);
                        acc = __builtin_amdgcn_mfma_f32_16x16x32_bf16(k1, q1, acc, 0, 0, 0);
                        if (blk == 0) {
                            const int dr = r0 + i - r + 7;
#pragma unroll
                            for (int jj = 0; jj < 4; ++jj) { const int kcol = kc0 + 8 * g + 4 * t + jj; const int dc = min(max(kcol - c + 15, 0), 30);
                                const float bias = ((const LAS float*)(lds + AT_RPB))[dr * 31 + dc];
                                acc[jj] = ((unsigned)(kcol - c0) < 16u) ? acc[jj] + bias : -1e30f; }
                        }
                        s[2 * i + t] = acc;
                    }
                float mx = -1e30f;
#pragma unroll
                for (int i = 0; i < 16; ++i) mx = fmaxf(fmaxf(mx, fmaxf(s[i][0], s[i][1])), fmaxf(s[i][2], s[i][3]));
                mx = fmaxf(mx, __shfl_xor(mx, 16)); mx = fmaxf(mx, __shfl_xor(mx, 32));
                float sum = 0.f;
#pragma unroll
                for (int i = 0; i < 8; ++i) {
                    float e[8];
#pragma unroll
                    for (int t = 0; t < 2; ++t)
#pragma unroll
                        for (int jj = 0; jj < 4; ++jj) { e[4 * t + jj] = __expf(s[2 * i + t][jj] - mx); sum += e[4 * t + jj]; }
                    pf[8 * blk + i].x = pk_bf16(e[0], e[1]); pf[8 * blk + i].y = pk_bf16(e[2], e[3]); pf[8 * blk + i].z = pk_bf16(e[4], e[5]); pf[8 * blk + i].w = pk_bf16(e[6], e[7]);
                }
                sum += __shfl_xor(sum, 16); sum += __shfl_xor(sum, 32);
                mxb[blk] = mx; smb[blk] = sum;
            }
            __syncthreads();
            if (lat) at_stage(lds + AT_LAT, 72, [=](int key) { return b * 2048 + min(krow_lo + (key >> 6), 31) * 64 + (key & 63); }, (1024 + hd * 64) * 2, P, wave, lane);
            asm volatile("s_waitcnt vmcnt(0)" ::: "memory");
            __syncthreads();
            f32x4 o[2][4];
#pragma unroll
            for (int blk = 0; blk < 2; ++blk)
#pragma unroll
                for (int db = 0; db < 4; ++db) o[blk][db] = (f32x4){0.f, 0.f, 0.f, 0.f};
            const int tq = rho >> 2, tp = rho & 3;
#pragma unroll
            for (int ch = 0; ch < 16; ++ch) {
                if (ch < 8 && !lat) continue;
                int zo = 0; asm volatile("" : "+v"(zo));
                const int kb = (ch < 8 ? (ro + ch) * 64 + kc0 + 8 * g + tq : 32 * (ch - 8) + 8 * g + tq) + zo;
                const unsigned base = (unsigned)(size_t)(lds + (ch < 8 ? AT_LAT : AT_CV));
                unsigned ad[8];
#pragma unroll
                for (int db = 0; db < 4; ++db) { ad[2 * db] = base + at_addr(kb, 2 * db + (tp >> 1)) + 8 * (tp & 1); ad[2 * db + 1] = base + at_addr(kb + 4, 2 * db + (tp >> 1)) + 8 * (tp & 1); }
                s16x4 vr[8]; at_tr8(ad[0], ad[1], ad[2], ad[3], ad[4], ad[5], ad[6], ad[7], vr);
#pragma unroll
                for (int db = 0; db < 4; ++db) { const bf16x8 vf = __builtin_shufflevector(vr[2 * db], vr[2 * db + 1], 0, 1, 2, 3, 4, 5, 6, 7);
                    o[ch >> 3][db] = __builtin_amdgcn_mfma_f32_16x16x32_bf16(vf, __builtin_bit_cast(bf16x8, pf[ch]), o[ch >> 3][db], 0, 0, 0); }
            }
            const float mxa = fmaxf(mxb[0], mxb[1]), f0 = __expf(mxb[0] - mxa), f1 = __expf(mxb[1] - mxa);
            const float inv = 1.0f / (f0 * smb[0] + f1 * smb[1]), g0 = f0 * inv, g1 = f1 * inv;
#pragma unroll
            for (int db = 0; db < 4; ++db) { uint2 w; w.x = pk_bf16(o[0][db][0] * g0 + o[1][db][0] * g1, o[0][db][1] * g0 + o[1][db][1] * g1); w.y = pk_bf16(o[0][db][2] * g0 + o[1][db][2] * g1, o[0][db][3] * g0 + o[1][db][3] * g1);
                *(uint2*)(A2 + (size_t)qrow * D + hd * 64 + 16 * db + 4 * g) = w; }
            __syncthreads();
        }
    }
    const float* cw = a.in[13]; const float* cb = a.in[14];
    const int j0 = 8 * lane;
    float w0[8], w1[8], w2[8], bb[8];
#pragma unroll
    for (int q = 0; q < 8; ++q) { w0[q] = cw[j0 + q]; w1[q] = cw[512 + j0 + q]; w2[q] = cw[1024 + j0 + q]; bb[q] = cb[j0 + q]; }
    for (int blk = F.gw; blk < R / 6; blk += F.ngw) {
        const int row0 = 6 * blk;
        v4u pw[8], bgw[6];
#pragma unroll
        for (int k = 0; k < 8; ++k) { const int rr = row0 + k - 1; pw[k] = (rr >= 0 && rr < R) ? *(const v4u*)(P + (size_t)rr * PP + 2048 + j0) : (v4u){0u, 0u, 0u, 0u}; }
#pragma unroll
        for (int k = 0; k < 6; ++k) bgw[k] = *(const v4u*)(P + (size_t)(row0 + k) * PP + 1536 + j0);
#pragma unroll
        for (int k = 0; k < 6; ++k) {
            const int row = row0 + k; const bool latr = row < NT; const int t = latr ? (row & 2047) : ((row - NT) & 255), len = latr ? 2048 : 256;
            const v4u pm = t > 0 ? pw[k] : (v4u){0u, 0u, 0u, 0u}, pc = pw[k + 1], pn = (t + 1 < len) ? pw[k + 2] : (v4u){0u, 0u, 0u, 0u}, bgv = bgw[k];
            const unsigned am[4] = {pm.x, pm.y, pm.z, pm.w}, ac[4] = {pc.x, pc.y, pc.z, pc.w}, an[4] = {pn.x, pn.y, pn.z, pn.w}, ab[4] = {bgv.x, bgv.y, bgv.z, bgv.w};
            unsigned ow[4];
#pragma unroll
            for (int q = 0; q < 4; ++q) {
                const float lo = __uint_as_float(ab[q] << 16) * (bb[2 * q] + w0[2 * q] * __uint_as_float(am[q] << 16) + w1[2 * q] * __uint_as_float(ac[q] << 16) + w2[2 * q] * __uint_as_float(an[q] << 16));
                const float hi = __uint_as_float(ab[q] & 0xffff0000u) * (bb[2 * q + 1] + w0[2 * q + 1] * __uint_as_float(am[q] & 0xffff0000u) + w1[2 * q + 1] * __uint_as_float(ac[q] & 0xffff0000u) + w2[2 * q + 1] * __uint_as_float(an[q] & 0xffff0000u));
                ow[q] = pk_bf16(lo, hi);
            }
            *(v4u*)(A2 + (size_t)row * D + 512 + j0) = (v4u){ow[0], ow[1], ow[2], ow[3]};
        }
    }
}
template <int L>
struct EpiOutProj {
    static constexpr bool PERM = true;
    const float* baseL; const float* baseC; bf16* XB; const float* MODl;
    __device__ __forceinline__ void operator()(const f32x4 (&acc)[2][2][4][2], const pg8::Unit& u, int wr, int wc, int fr, int fq) const {
        const bool lat = u.pm < NT / 256;
        const int mb = lat ? (u.pm >> 3) : 16;
        const int row0 = u.pm * 256 + wr * 64 + fr, col0 = u.pn * 256 + wc * 32 + 8 * fq;
        const float* g1 = MODl + (size_t)mb * 6144 + 2 * D + col0;
        f32x4 gv[2][2];
#pragma unroll
        for (int bj = 0; bj < 2; ++bj)
#pragma unroll
            for (int n = 0; n < 2; ++n) gv[bj][n] = *(const f32x4*)(g1 + bj * 128 + 4 * n);
#pragma unroll
        for (int ai = 0; ai < 2; ++ai)
#pragma unroll
            for (int m = 0; m < 4; ++m) { const int row = row0 + ai * 128 + m * 16;
#pragma unroll
                for (int bj = 0; bj < 2; ++bj) {
                    f32x4 b0, b1;
                    if (L == 0) { const float* bp = (lat ? baseL + (size_t)row * D : baseC + (size_t)(row - NT) * D) + col0 + bj * 128; b0 = *(const f32x4*)bp; b1 = *(const f32x4*)(bp + 4); }
                    else { const v4u w = *(const v4u*)(XB + (size_t)row * D + col0 + bj * 128);
                        b0 = (f32x4){__uint_as_float(w.x << 16), __uint_as_float(w.x & 0xffff0000u), __uint_as_float(w.y << 16), __uint_as_float(w.y & 0xffff0000u)};
                        b1 = (f32x4){__uint_as_float(w.z << 16), __uint_as_float(w.z & 0xffff0000u), __uint_as_float(w.w << 16), __uint_as_float(w.w & 0xffff0000u)}; }
                    const f32x4 v0 = b0 + gv[bj][0] * acc[ai][bj][m][0], v1 = b1 + gv[bj][1] * acc[ai][bj][m][1];
                    v4u o; o.x = pg8::cvt_pk_bf16(v0[0], v0[1]); o.y = pg8::cvt_pk_bf16(v0[2], v0[3]); o.z = pg8::cvt_pk_bf16(v1[0], v1[1]); o.w = pg8::cvt_pk_bf16(v1[2], v1[3]);
                    *(v4u*)(XB + (size_t)row * D + col0 + bj * 128) = o; }
                asm volatile("" ::: "memory"); }
    }
};
template <int L>
__device__ __forceinline__ void p_outproj(const CAS Args& a, const Frame& F) {
    const int nc = L == 0 ? OUTP0_NC : 0;
    if (F.bid >= F.G - nc) { convert_experts(a, F, 0, 0, 2, (F.bid - (F.G - nc)) * NWAVES + F.wave, nc * NWAVES, CV_E0, CV_E1); return; }
    pg8::RectSched S{(const char*)(a.ws + (L == 0 ? WS_A2 : WS_A3)), (const char*)(a.ws + (L == 0 ? WS_WOUT0 : WS_WOUT1)), 2 * D, (L == 0 ? R : NT) / 256, D / 256, F.G - nc, F.bid, 0, 0, 0, 0};
    EpiOutProj<L> E{a.in[0], a.in[2], (bf16*)(a.ws + WS_XB), (const float*)(a.ws + WS_MOD) + (size_t)L * 17 * 6144};
    pg8::gemm_phase<2 * D, false>(F.ldsl, S, E, F.wave);
}
#define RS_STEP(half, m) do { const bool up = (F.lane & (m)) != 0; _Pragma("unroll") for (int i = 0; i < (half); ++i) { \
        const float keep = up ? part[i + (half)] : part[i]; const float send = up ? part[i] : part[i + (half)]; part[i] = keep + __shfl_xor(send, (m)); } } while (0)
constexpr int RT_WH = 0, RT_WL = 65536, RT_GS = 131072, RT_LG = 139264, RT_CNT = 155648;
__device__ __forceinline__ void p_norm2_router(const CAS Args& a, const Frame& F, int l) {
    unsigned char* H8 = (unsigned char*)(a.ws + WS_H); const bf16* XB = (const bf16*)(a.ws + WS_XB);
    unsigned* ctl = (unsigned*)(a.ws + WS_CTL);
    int* toklist = (int*)(a.ws + WS_TOKLIST); int* sel = (int*)(a.ws + WS_SEL); float* gatev = (float*)(a.ws + WS_GATEV);
    const float* wr = a.in[29] + (size_t)l * D * NE; const float* br = a.in[30] + l * NE;
    const float* GS2 = (const float*)(a.ws + WS_GS2) + (size_t)l * 17 * D; const float* MODl = (const float*)(a.ws + WS_MOD) + (size_t)l * 17 * 6144;
    const int rows = l == 0 ? R : NT, rpw = rows / F.G, row_lo = F.bid * rpw, nblk = rpw / 16;
    LAS unsigned char* lds = F.ldsl;
    const int lane = F.lane, wave = F.wave, rho = lane & 15, g = lane >> 4;
    const int b_first = row_batch(row_lo);
    __syncthreads();
    {
        f32x4 wv[16];
#pragma unroll
        for (int j = 0; j < 16; ++j) wv[j] = *(const f32x4*)(wr + 4 * (F.tid + 512 * j));
#pragma unroll
        for (int j = 0; j < 16; ++j) { const int i0 = 4 * (F.tid + 512 * j), k = i0 >> 5;
#pragma unroll
            for (int q = 0; q < 4; ++q) { const int e = (i0 & 31) + q; const float w = wv[j][q]; const bf16 hi = f2bf(w), lo = f2bf(w - bf2f(hi));
                const int off = e * 2048 + 16 * ((k >> 3) ^ (e & 15)) + 2 * (k & 7);
                *(LAS bf16*)(lds + RT_WH + off) = hi; *(LAS bf16*)(lds + RT_WL + off) = lo; } }
    }
    for (int i = F.tid; i < 2 * D; i += NWAVES * 64) { const int s = i >> 10, k = i & 1023; const int bb = s == 0 ? b_first : row_batch(row_lo + rpw - 1); ((LAS float*)(lds + RT_GS))[i] = GS2[bb * D + k]; }
    LAS unsigned* wcnt = (LAS unsigned*)(lds + RT_CNT); LAS unsigned* wbase = wcnt + 32; LAS unsigned* stmp = wcnt + 64;
    if (F.tid < NE) wcnt[F.tid] = 0u;
    __syncthreads();
    for (int blk = wave; blk < nblk; blk += NWAVES) {
        const int r0 = row_lo + 16 * blk, row = r0 + rho, bb = row_batch(r0);
        const bf16* xr = XB + (size_t)row * D + 8 * g;
        float ss = 0.f;
#pragma unroll
        for (int kh = 0; kh < 2; ++kh) {
            v4u xw[16];
#pragma unroll
            for (int ks = 0; ks < 16; ++ks) xw[ks] = *(const v4u*)(xr + 32 * (16 * kh + ks));
#pragma unroll
            for (int ks = 0; ks < 16; ++ks) { const unsigned u4[4] = {xw[ks].x, xw[ks].y, xw[ks].z, xw[ks].w};
#pragma unroll
                for (int q = 0; q < 4; ++q) { const float x0 = __uint_as_float(u4[q] << 16), x1 = __uint_as_float(u4[q] & 0xffff0000u); ss += x0 * x0 + x1 * x1; } }
            asm volatile("" ::: "memory");
        }
        ss += __shfl_xor(ss, 16); ss += __shfl_xor(ss, 32);
        const float rstd = rsqrtf(ss * (1.0f / D) + 1e-6f);
        const LAS float* gs = (const LAS float*)(lds + RT_GS) + (bb == b_first ? 0 : D) + 8 * g;
        const float* sh = MODl + (size_t)bb * 6144 + 3 * D + 8 * g;
        f32x4 acc[2] = {(f32x4){0.f, 0.f, 0.f, 0.f}, (f32x4){0.f, 0.f, 0.f, 0.f}};
        int offb[4];
#pragma unroll
        for (int b4 = 0; b4 < 4; ++b4) offb[b4] = rho * 2048 + (((4 * (b4 ^ ((rho >> 2) & 3))) + (g ^ (rho & 3))) << 4);
        for (int k4 = 0; k4 < 8; ++k4) {
            v4u xw[4]; f32x4 sv[4][2];
#pragma unroll
            for (int b4 = 0; b4 < 4; ++b4) { const int ks = 4 * k4 + b4; xw[b4] = *(const v4u*)(xr + 32 * ks); sv[b4][0] = *(const f32x4*)(sh + 32 * ks); sv[b4][1] = *(const f32x4*)(sh + 32 * ks + 4); }
#pragma unroll
            for (int b4 = 0; b4 < 4; ++b4) {
                const int ks = 4 * k4 + b4;
                const unsigned u4[4] = {xw[b4].x, xw[b4].y, xw[b4].z, xw[b4].w};
                const f32x4 g0 = *(const LAS f32x4*)(gs + 32 * ks), g1 = *(const LAS f32x4*)(gs + 32 * ks + 4);
                const f32x4 s0 = sv[b4][0], s1 = sv[b4][1];
                float hv[8];
#pragma unroll
                for (int q = 0; q < 4; ++q) { const float x0 = __uint_as_float(u4[q] << 16) * rstd, x1 = __uint_as_float(u4[q] & 0xffff0000u) * rstd;
                    const float gg0 = q < 2 ? g0[2 * q] : g1[2 * q - 4], gg1 = q < 2 ? g0[2 * q + 1] : g1[2 * q - 3], t0 = q < 2 ? s0[2 * q] : s1[2 * q - 4], t1 = q < 2 ? s0[2 * q + 1] : s1[2 * q - 3];
                    hv[2 * q] = x0 * gg0 + t0; hv[2 * q + 1] = x1 * gg1 + t1; }
                v4u hi, lo;
#pragma unroll
                for (int q = 0; q < 4; ++q) { const unsigned p = pk_bf16(hv[2 * q], hv[2 * q + 1]); ((unsigned*)&hi)[q] = p;
                    ((unsigned*)&lo)[q] = pk_bf16(hv[2 * q] - __uint_as_float(p << 16), hv[2 * q + 1] - __uint_as_float(p & 0xffff0000u)); }
                { uint2 f8; unsigned t0 = 0u, t1 = 0u; t0 = __builtin_amdgcn_cvt_pk_fp8_f32(hv[0], hv[1], t0, false); t0 = __builtin_amdgcn_cvt_pk_fp8_f32(hv[2], hv[3], t0, true);
                  t1 = __builtin_amdgcn_cvt_pk_fp8_f32(hv[4], hv[5], t1, false); t1 = __builtin_amdgcn_cvt_pk_fp8_f32(hv[6], hv[7], t1, true); f8.x = t0; f8.y = t1;
                  *(uint2*)(H8 + (size_t)row * D + 32 * ks + 8 * g) = f8; }
#pragma unroll
                for (int nt = 0; nt < 2; ++nt) { const int off = nt * 32768 + k4 * 256 + offb[b4];
                    const bf16x8 bh = *(const LAS bf16x8*)(lds + RT_WH + off), bl = *(const LAS bf16x8*)(lds + RT_WL + off);
                    acc[nt] = __builtin_amdgcn_mfma_f32_16x16x32_bf16(__builtin_bit_cast(bf16x8, hi), bh, acc[nt], 0, 0, 0);
                    acc[nt] = __builtin_amdgcn_mfma_f32_16x16x32_bf16(__builtin_bit_cast(bf16x8, lo), bh, acc[nt], 0, 0, 0);
                    acc[nt] = __builtin_amdgcn_mfma_f32_16x16x32_bf16(__builtin_bit_cast(bf16x8, hi), bl, acc[nt], 0, 0, 0); }
            }
        }
        LAS float* lg = (LAS float*)(lds + RT_LG + wave * 2048);
#pragma unroll
        for (int nt = 0; nt < 2; ++nt)
#pragma unroll
            for (int jj = 0; jj < 4; ++jj) lg[(4 * g + jj) * 32 + 16 * nt + rho] = acc[nt][jj] + br[16 * nt + rho];
        {
            float mine[8], allv[32];
#pragma unroll
            for (int q = 0; q < 8; ++q) { const f32x4 t = *(const LAS f32x4*)(lg + rho * 32 + 4 * q); allv[4 * q] = t[0]; allv[4 * q + 1] = t[1]; allv[4 * q + 2] = t[2]; allv[4 * q + 3] = t[3]; }
#pragma unroll
            for (int q = 0; q < 8; ++q) mine[q] = g == 0 ? allv[q] : g == 1 ? allv[8 + q] : g == 2 ? allv[16 + q] : allv[24 + q];
            LAS float* rs = lg;
#pragma unroll
            for (int q = 0; q < 8; ++q) { const int e = 8 * g + q; int rank = 0;
#pragma unroll
                for (int jx = 0; jx < 32; ++jx) rank += (allv[jx] > mine[q] || (allv[jx] == mine[q] && jx < e)) ? 1 : 0;
                if (rank < 4) { rs[(rho * 4 + rank) * 2] = mine[q]; ((LAS int*)rs)[(rho * 4 + rank) * 2 + 1] = e; } }
            if (lane < 16) {
                const f32x4 q0 = *(const LAS f32x4*)(rs + lane * 8), q1 = *(const LAS f32x4*)(rs + lane * 8 + 4);
                const float tv0 = q0[0], tv1 = q0[2], tv2 = q1[0], tv3 = q1[2]; const int ti[4] = {__float_as_int(q0[1]), __float_as_int(q0[3]), __float_as_int(q1[1]), __float_as_int(q1[3])};
                const float e1 = __expf(tv1 - tv0), e2 = __expf(tv2 - tv0), e3 = __expf(tv3 - tv0), inv = 1.0f / (1.0f + e1 + e2 + e3);
                const float gk[4] = {inv, e1 * inv, e2 * inv, e3 * inv};
                const int rl = 16 * blk + lane;
#pragma unroll
                for (int k = 0; k < 4; ++k) { const unsigned p = __hip_atomic_fetch_add(wcnt + ti[k], 1u, __ATOMIC_RELAXED, __HIP_MEMORY_SCOPE_WORKGROUP);
                    stmp[(rl * 4 + k) * 2] = (p << 5) | (unsigned)ti[k]; stmp[(rl * 4 + k) * 2 + 1] = __float_as_uint(gk[k]); }
            }
        }
    }
    __syncthreads();
    if (F.tid < NE) { const unsigned c = wcnt[F.tid]; wbase[F.tid] = c ? __hip_atomic_fetch_add(ctl + CW_CNT + (l * 32 + F.tid) * 64, c, RLX_AGENT) : 0u; }
    __syncthreads();
    for (int i = F.tid; i < rpw * 4; i += NWAVES * 64) { const int rl = i >> 2, k = i & 3, r = row_lo + rl; const unsigned pe = stmp[i * 2], e = pe & 31u, pos = wbase[e] + (pe >> 5);
        toklist[(size_t)e * CAP + pos] = r; sel[r * 4 + k] = (int)((pos << 5) | e); gatev[r * 4 + k] = __uint_as_float(stmp[i * 2 + 1]); }
}
struct MoeTab { int cnt[NE], base[NE + 1], tpre[NE + 1]; };
__device__ __forceinline__ void moe_tab_build(const CAS Args& a, const Frame& F, int l, LAS MoeTab* tb) {
    unsigned* ctl = (unsigned*)(a.ws + WS_CTL);
    __syncthreads();
    if (F.tid < NE) tb->cnt[F.tid] = (int)__hip_atomic_load(ctl + CW_CNT + (l * 32 + F.tid) * 64, RLX_AGENT);
    __syncthreads();
    if (F.tid == 0) { int bs = 0, tp = 0; for (int e = 0; e < NE; ++e) { const int c = tb->cnt[e]; tb->base[e] = bs; tb->tpre[e] = tp; bs += c; tp += (c + 255) >> 8; } tb->base[NE] = bs; tb->tpre[NE] = tp; }
    __syncthreads();
}
constexpr int MOE_UT_MAX = 64;
template <bool UP>
struct MoeSched {
    static constexpr bool GATHER = UP;
    const LAS MoeTab* tb; const LAS int* ut; const char* A; const char* WE; const int* toklist; int G, c;
    static constexpr int NN = UP ? 8 : 4;
    static __device__ __forceinline__ int rfl(int v) { return __builtin_amdgcn_readfirstlane(v); }
    static __device__ __forceinline__ const char* ufy(const char* p) { const unsigned long long v = (unsigned long long)p; const unsigned lo = __builtin_amdgcn_readfirstlane((unsigned)v), hi = __builtin_amdgcn_readfirstlane((unsigned)(v >> 32)); return (const char*)(((unsigned long long)hi << 32) | lo); }
    __device__ __forceinline__ bool unit_search(int i, int& pm, int& pn, int& e_, int& rows, int& base) const {
        const int nwg = tb->tpre[NE] * NN; const long L = (long)i * G + c; if (L >= nwg) return false;
        const int w = pg8::xcd_remap(L, nwg);
        int e = 0; while (e < NE - 1 && w >= tb->tpre[e + 1] * NN) ++e;
        const int tp0 = tb->tpre[e], tp1 = tb->tpre[e + 1];
        const int q = w - tp0 * NN, nte = tp1 - tp0;
        const int nig = 8 * NN, gid = q / nig, fm = gid * 8, gsz = (nte - fm) < 8 ? (nte - fm) : 8;
        pm = fm + ((q % nig) % gsz); pn = (q % nig) / gsz; e_ = e; rows = min(256, tb->cnt[e] - pm * 256); base = tb->base[e] + pm * 256;
        return true;
    }
    __device__ __forceinline__ void build(LAS int* utw, int tid) const {
        if (tid < MOE_UT_MAX) { int pm = -1, pn = 0, e = 0, rows = 0, base = 0; unit_search(tid, pm, pn, e, rows, base);
            utw[tid * 8 + 0] = pm; utw[tid * 8 + 1] = pn; utw[tid * 8 + 2] = e; utw[tid * 8 + 3] = rows; utw[tid * 8 + 4] = base; }
    }
    __device__ __forceinline__ bool unit(int i, pg8::Unit& u) const {
        if (i >= MOE_UT_MAX) return false;
        const LAS int* p = ut + i * 8; const int pm = rfl(p[0]); if (pm < 0) return false;
        u.pm = pm; u.pn = rfl(p[1]); u.e = rfl(p[2]); u.rows = rfl(p[3]); u.base = rfl(p[4]); u.newe = (i == 0) || (rfl(p[2 - 8]) != u.e);
        return true;
    }
    __device__ __forceinline__ bool bases(int i, const char*& a, const char*& b) const {
        pg8::Unit u; if (!unit(i, u)) return false;
        a = UP ? A : A + (size_t)u.base * D;
        b = WE + (size_t)u.e * 3072 * 1024 + (UP ? 0 : (size_t)2048 * 1024) + (size_t)u.pn * 256 * 1024;
        a = ufy(a); b = ufy(b);
        return true;
    }
    __device__ __forceinline__ void atoks(int i, const int (&rA)[2], int (&tok)[2][2]) const {
        pg8::Unit u; unit(i, u);
        const int* tl = toklist + (size_t)u.e * CAP + u.pm * 256;
#pragma unroll
        for (int h = 0; h < 2; ++h)
#pragma unroll
            for (int i2 = 0; i2 < 2; ++i2) { const int rr = h * 128 + rA[i2]; tok[h][i2] = tl[rr < u.rows ? rr : 0]; }
    }
    __device__ __forceinline__ void aoffs(int i, const int (&rA)[2], const unsigned (&voffA)[2], unsigned (&off)[2][2]) const {
        pg8::Unit u; unit(i, u);
        const int* tl = toklist + (size_t)u.e * CAP + u.pm * 256;
#pragma unroll
        for (int h = 0; h < 2; ++h)
#pragma unroll
            for (int i2 = 0; i2 < 2; ++i2) { const int rr = h * 128 + rA[i2]; const int tok = tl[rr < u.rows ? rr : 0]; off[h][i2] = (unsigned)tok * (unsigned)D + voffA[i2]; }
    }
};
struct EpiMoeUp {
    static constexpr bool PERM = true;
    bf16* ACT; const float* bgate; const float* bup; LAS float* btab;
    __device__ __forceinline__ void operator()(const f32x4 (&acc)[2][2][4][2], const pg8::Unit& u, int wr, int wc, int fr, int fq) const {
        const int col0 = u.pn * 128 + wc * 32 + 8 * fq, rl0 = wr * 64 + fr;
        if (u.newe) { const int tid = (wr * 4 + wc) * 64 + fr + 16 * fq;
            const f32x4 t = *(const f32x4*)((tid < 256 ? bgate : bup) + u.e * D + 4 * (tid & 255));
            *(LAS f32x4*)(btab + 4 * tid) = t;
            asm volatile("s_waitcnt lgkmcnt(0)" ::: "memory"); __builtin_amdgcn_s_barrier(); asm volatile("" ::: "memory"); }
        f32x2_t bg[2][2], bu[2][2];
#pragma unroll
        for (int n = 0; n < 2; ++n) { const f32x4 g4 = *(const LAS f32x4*)(btab + col0 + 4 * n), u4 = *(const LAS f32x4*)(btab + 1024 + col0 + 4 * n);
            bg[n][0] = (f32x2_t){g4[0], g4[1]}; bg[n][1] = (f32x2_t){g4[2], g4[3]};
            bu[n][0] = (f32x2_t){u4[0], u4[1]} * ACT8_SCALE + ACT8_SCALE; bu[n][1] = (f32x2_t){u4[2], u4[3]} * ACT8_SCALE + ACT8_SCALE; }
#pragma unroll
        for (int ai = 0; ai < 2; ++ai)
#pragma unroll
            for (int m = 0; m < 4; ++m) { const int rl = rl0 + ai * 128 + m * 16;
                f32x2_t o[2][2];
#pragma unroll
                for (int n = 0; n < 2; ++n)
#pragma unroll
                    for (int p = 0; p < 2; ++p) {
                        f32x2_t gg = (f32x2_t){acc[ai][0][m][n][2 * p], acc[ai][0][m][n][2 * p + 1]} * (1.0f / W8_SCALE) + bg[n][p];
                        gg.x = fminf(gg.x, 7.0f); gg.y = fminf(gg.y, 7.0f);
                        const f32x2_t tt = gg * (-1.702f * 1.44269504f);
                        f32x2_t dd; dd.x = __builtin_amdgcn_exp2f(tt.x); dd.y = __builtin_amdgcn_exp2f(tt.y); dd = dd + 1.0f;
                        f32x2_t rr; rr.x = __builtin_amdgcn_rcpf(dd.x); rr.y = __builtin_amdgcn_rcpf(dd.y);
                        f32x2_t uu = (f32x2_t){acc[ai][1][m][n][2 * p], acc[ai][1][m][n][2 * p + 1]} * (ACT8_SCALE / W8_SCALE) + bu[n][p];
                        uu.x = __builtin_amdgcn_fmed3f(uu.x, -6.0f * ACT8_SCALE, 8.0f * ACT8_SCALE); uu.y = __builtin_amdgcn_fmed3f(uu.y, -6.0f * ACT8_SCALE, 8.0f * ACT8_SCALE);
                        o[n][p] = (gg * rr) * uu;
                    }
                if (rl < u.rows) { uint2 w; unsigned w0 = 0u, w1 = 0u;
                    w0 = __builtin_amdgcn_cvt_pk_fp8_f32(o[0][0].x, o[0][0].y, w0, false); w0 = __builtin_amdgcn_cvt_pk_fp8_f32(o[0][1].x, o[0][1].y, w0, true);
                    w1 = __builtin_amdgcn_cvt_pk_fp8_f32(o[1][0].x, o[1][0].y, w1, false); w1 = __builtin_amdgcn_cvt_pk_fp8_f32(o[1][1].x, o[1][1].y, w1, true);
                    w.x = w0; w.y = w1;
                    *(uint2*)((unsigned char*)ACT + (size_t)(u.base + rl) * D + col0) = w; } }
    }
};
struct EpiMoeDown {
    static constexpr bool PERM = true;
    unsigned char* YB; const float* bdown; LAS float* btab;
    __device__ __forceinline__ void operator()(const f32x4 (&acc)[2][2][4][2], const pg8::Unit& u, int wr, int wc, int fr, int fq) const {
        const int col0 = u.pn * 256 + wc * 64 + 16 * fq, rl0 = wr * 64 + fr;
        if (u.newe) { const int tid = (wr * 4 + wc) * 64 + fr + 16 * fq;
            if (tid < 256) { const f32x4 t = *(const f32x4*)(bdown + u.e * D + 4 * tid); *(LAS f32x4*)(btab + 4 * tid) = t; }
            asm volatile("s_waitcnt lgkmcnt(0)" ::: "memory"); __builtin_amdgcn_s_barrier(); asm volatile("" ::: "memory"); }
        f32x4 bv[2][2];
#pragma unroll
        for (int bj = 0; bj < 2; ++bj)
#pragma unroll
            for (int n = 0; n < 2; ++n) bv[bj][n] = *(const LAS f32x4*)(btab + col0 + 8 * bj + 4 * n) * YB8_SCALE;
#pragma unroll
        for (int ai = 0; ai < 2; ++ai)
#pragma unroll
            for (int m = 0; m < 4; ++m) { const int rl = rl0 + ai * 128 + m * 16;
                if (rl < u.rows) { v4u w;
                    { const f32x4 v = acc[ai][0][m][0] * (YB8_SCALE / (W8_SCALE * ACT8_SCALE)) + bv[0][0]; w.x = pk4_fp8(v[0], v[1], v[2], v[3]); }
                    { const f32x4 v = acc[ai][0][m][1] * (YB8_SCALE / (W8_SCALE * ACT8_SCALE)) + bv[0][1]; w.y = pk4_fp8(v[0], v[1], v[2], v[3]); }
                    { const f32x4 v = acc[ai][1][m][0] * (YB8_SCALE / (W8_SCALE * ACT8_SCALE)) + bv[1][0]; w.z = pk4_fp8(v[0], v[1], v[2], v[3]); }
                    { const f32x4 v = acc[ai][1][m][1] * (YB8_SCALE / (W8_SCALE * ACT8_SCALE)) + bv[1][1]; w.w = pk4_fp8(v[0], v[1], v[2], v[3]); }
                    *(v4u*)(YB + (size_t)(u.base + rl) * D + col0) = w; } }
    }
};
constexpr int LDS_TAB = 131072;
__device__ __forceinline__ void p_moe_up(const CAS Args& a, const Frame& F, int l) {
    const int nc = l == 0 ? MOE_NC : 0;
    if (F.bid >= F.G - nc) { const int cw = (F.bid - (F.G - nc)) * NWAVES + F.wave; convert_experts(a, F, 0, 2, 3, cw, nc * NWAVES); convert_experts(a, F, 1, 0, 2, cw, nc * NWAVES, 0, CV_E2); return; }
    LAS MoeTab* tb = (LAS MoeTab*)(F.ldsl + LDS_TAB); moe_tab_build(a, F, l, tb);
    LAS int* utw = (LAS int*)(F.ldsl + LDS_TAB + 1024);
    MoeSched<true> S{tb, utw, (const char*)(a.ws + WS_H), (const char*)(a.ws + WS_WEXP) + (size_t)l * NE * 3072 * 1024, (const int*)(a.ws + WS_TOKLIST), F.G - nc, F.bid};
    S.build(utw, F.tid); __syncthreads();
    EpiMoeUp E{(bf16*)(a.ws + WS_ACT), a.in[32] + (size_t)l * NE * D, a.in[34] + (size_t)l * NE * D, (LAS float*)(F.ldsl + LDS_TAB + 4096)};
    pg8::gemm_phase<D, true>(F.ldsl, S, E, F.wave);
}
__device__ __forceinline__ void p_moe_down(const CAS Args& a, const Frame& F, int l) {
    const int nc = l == 0 ? MOE_NC : 0;
    if (F.bid >= F.G - nc) { convert_experts(a, F, 1, 2, 3, (F.bid - (F.G - nc)) * NWAVES + F.wave, nc * NWAVES); return; }
    LAS MoeTab* tb = (LAS MoeTab*)(F.ldsl + LDS_TAB); moe_tab_build(a, F, l, tb);
    LAS int* utw = (LAS int*)(F.ldsl + LDS_TAB + 1024);
    MoeSched<false> S{tb, utw, (const char*)(a.ws + WS_ACT), (const char*)(a.ws + WS_WEXP) + (size_t)l * NE * 3072 * 1024, nullptr, F.G - nc, F.bid};
    S.build(utw, F.tid); __syncthreads();
    EpiMoeDown E{(unsigned char*)(a.ws + WS_YB), a.in[36] + (size_t)l * NE * D, (LAS float*)(F.ldsl + LDS_TAB + 4096)};
    pg8::gemm_phase<D, true>(F.ldsl, S, E, F.wave);
}
__device__ __forceinline__ void p_combine(const CAS Args& a, const Frame& F, int l) {
    const unsigned char* YB = (const unsigned char*)(a.ws + WS_YB); bf16* XB = (bf16*)(a.ws + WS_XB); bf16* H = (bf16*)(a.ws + WS_H);
    const int* sel = (const int*)(a.ws + WS_SEL); const float* gatev = (const float*)(a.ws + WS_GATEV);
    LAS MoeTab* tb = (LAS MoeTab*)(F.ldsl + LDS_TAB); moe_tab_build(a, F, l, tb);
    const int rows = l == 0 ? R : NT, lane = F.lane;
    for (int r = F.gw; r < rows; r += 2 * F.ngw) {
        v4u xw[2][2]; uint2 yw[2][4][2]; float gk[2][4];
#pragma unroll
        for (int t = 0; t < 2; ++t) { const int rr = r + t * F.ngw; if (rr < rows) {
#pragma unroll
            for (int jh = 0; jh < 2; ++jh) xw[t][jh] = *(const v4u*)(XB + (size_t)rr * D + 512 * jh + 8 * lane);
#pragma unroll
            for (int k = 0; k < 4; ++k) { const int sv = sel[rr * 4 + k]; gk[t][k] = gatev[rr * 4 + k]; const int e = sv & 31, pos = sv >> 5;
                const unsigned char* y = YB + (size_t)(tb->base[e] + pos) * D;
#pragma unroll
                for (int jh = 0; jh < 2; ++jh) yw[t][k][jh] = *(const uint2*)(y + 512 * jh + 8 * lane); } } }
#pragma unroll
        for (int t = 0; t < 2; ++t) { const int rr = r + t * F.ngw; if (rr < rows) {
            float m[16], v[16];
#pragma unroll
            for (int i = 0; i < 16; ++i) m[i] = 0.f;
#pragma unroll
            for (int k = 0; k < 4; ++k) { const float gg = gk[t][k] * (1.0f / YB8_SCALE);
#pragma unroll
                for (int jh = 0; jh < 2; ++jh) { const unsigned w2[2] = {yw[t][k][jh].x, yw[t][k][jh].y};
#pragma unroll
                    for (int q = 0; q < 2; ++q) { const f32x2_t lo = __builtin_amdgcn_cvt_pk_f32_fp8((int)w2[q], false), hi = __builtin_amdgcn_cvt_pk_f32_fp8((int)w2[q], true);
                        m[8 * jh + 4 * q] += gg * lo.x; m[8 * jh + 4 * q + 1] += gg * lo.y; m[8 * jh + 4 * q + 2] += gg * hi.x; m[8 * jh + 4 * q + 3] += gg * hi.y; } } }
#pragma unroll
            for (int jh = 0; jh < 2; ++jh) { const unsigned x4[4] = {xw[t][jh].x, xw[t][jh].y, xw[t][jh].z, xw[t][jh].w};
#pragma unroll
                for (int q = 0; q < 4; ++q) { v[8 * jh + 2 * q] = __uint_as_float(x4[q] << 16); v[8 * jh + 2 * q + 1] = __uint_as_float(x4[q] & 0xffff0000u); } }
            const float* g2 = mod_ptr(a, l, rr, 5);
#pragma unroll
            for (int jh = 0; jh < 2; ++jh)
#pragma unroll
                for (int q = 0; q < 2; ++q) { const f32x4 gg = *(const f32x4*)(g2 + 512 * jh + 8 * lane + 4 * q);
#pragma unroll
                    for (int c = 0; c < 4; ++c) v[8 * jh + 4 * q + c] += gg[c] * m[8 * jh + 4 * q + c]; }
            if (l == 0) {
#pragma unroll
                for (int jh = 0; jh < 2; ++jh) *(v4u*)(XB + (size_t)rr * D + 512 * jh + 8 * lane) = (v4u){pk_bf16(v[8 * jh], v[8 * jh + 1]), pk_bf16(v[8 * jh + 2], v[8 * jh + 3]), pk_bf16(v[8 * jh + 4], v[8 * jh + 5]), pk_bf16(v[8 * jh + 6], v[8 * jh + 7])};
                float s = 0.f;
#pragma unroll
                for (int i2 = 0; i2 < 16; ++i2) s += v[i2] * v[i2];
                const float rstd = rsqrtf(wave_sum(s) * (1.0f / D) + 1e-6f);
                const float* gp = a.in[6] + D; const float* shp = mod_ptr(a, 1, rr, 0); const float* scp = mod_ptr(a, 1, rr, 1);
#pragma unroll
                for (int jh = 0; jh < 2; ++jh) { float hv[8];
#pragma unroll
                    for (int q = 0; q < 2; ++q) { const int e0 = 512 * jh + 8 * lane + 4 * q; const f32x4 gg = *(const f32x4*)(gp + e0), ss = *(const f32x4*)(shp + e0), cc = *(const f32x4*)(scp + e0);
#pragma unroll
                        for (int c = 0; c < 4; ++c) hv[4 * q + c] = v[8 * jh + 4 * q + c] * rstd * gg[c] * (1.f + cc[c]) + ss[c]; }
                    *(v4u*)(H + (size_t)rr * D + 512 * jh + 8 * lane) = (v4u){pk_bf16(hv[0], hv[1]), pk_bf16(hv[2], hv[3]), pk_bf16(hv[4], hv[5]), pk_bf16(hv[6], hv[7])}; }
            } else {
#pragma unroll
                for (int jh = 0; jh < 2; ++jh)
#pragma unroll
                    for (int q = 0; q < 2; ++q) *(f32x4*)(a.out + (size_t)rr * D + 512 * jh + 8 * lane + 4 * q) = (f32x4){v[8 * jh + 4 * q], v[8 * jh + 4 * q + 1], v[8 * jh + 4 * q + 2], v[8 * jh + 4 * q + 3]};
            } } }
    }
}
struct EpiInProj1 {
    static constexpr bool PERM = true;
    bf16* Gt; bf16* U;
    __device__ __forceinline__ void operator()(const f32x4 (&acc)[2][2][4][2], const pg8::Unit& u, int wr, int wc, int fr, int fq) const {
        const int row0 = u.pm * 256 + wr * 64 + fr; const bool gate = u.pn < 4;
        bf16* dst = gate ? Gt : U; const int col0 = (u.pn & 3) * 256 + wc * 32 + 8 * fq;
#pragma unroll
        for (int ai = 0; ai < 2; ++ai)
#pragma unroll
            for (int m = 0; m < 4; ++m) { bf16* rowp = dst + (size_t)(row0 + ai * 128 + m * 16) * D + col0;
#pragma unroll
                for (int bj = 0; bj < 2; ++bj) { f32x4 v0 = acc[ai][bj][m][0], v1 = acc[ai][bj][m][1];
                    if (gate) {
#pragma unroll
                        for (int j = 0; j < 4; ++j) { const float x = v0[j]; v0[j] = x * __builtin_amdgcn_rcpf(1.0f + __expf(-1.5957691216f * (x + 0.044715f * x * x * x)));
                                                      const float y = v1[j]; v1[j] = y * __builtin_amdgcn_rcpf(1.0f + __expf(-1.5957691216f * (y + 0.044715f * y * y * y))); } }
                    v4u w; w.x = pg8::cvt_pk_bf16(v0[0], v0[1]); w.y = pg8::cvt_pk_bf16(v0[2], v0[3]); w.z = pg8::cvt_pk_bf16(v1[0], v1[1]); w.w = pg8::cvt_pk_bf16(v1[2], v1[3]);
                    *(v4u*)(rowp + bj * 128) = w; } }
    }
};
__device__ __forceinline__ void p_inproj1(const CAS Args& a, const Frame& F) {
    if (F.bid >= F.G - INP1_NC) { convert_experts(a, F, 1, 0, 2, (F.bid - (F.G - INP1_NC)) * NWAVES + F.wave, INP1_NC * NWAVES, CV_E2, NE); return; }
    pg8::RectSched S{(const char*)(a.ws + WS_H), (const char*)(a.ws + WS_WIN1), 2 * D, NT / 256, 8, F.G - INP1_NC, F.bid, NC / 256, 4, NT / 256, 4};
    EpiInProj1 E{(bf16*)(a.ws + WS_G), (bf16*)(a.ws + WS_U)};
    pg8::gemm_phase<2 * D, false>(F.ldsl, S, E, F.wave);
}
__device__ __forceinline__ void p_conv4(const CAS Args& a, const Frame& F) {
    const bf16* U = (const bf16*)(a.ws + WS_U); bf16* UC = (bf16*)(a.ws + WS_UC);
    for (int u = F.gw; u < (R / 8) * 2; u += F.ngw) {
        const int rb = u >> 1, ch0 = (u & 1) * 512 + 8 * F.lane, row0 = rb * 8;
        const bool lat = row0 < NT; const int t0 = lat ? (row0 & 2047) : ((row0 - NT) & 255), len = lat ? 2048 : 256;
        float cw[4][8], cbv[8];
#pragma unroll
        for (int q = 0; q < 8; ++q) { cbv[q] = a.in[18][ch0 + q];
#pragma unroll
            for (int k = 0; k < 4; ++k) cw[k][q] = a.in[17][k * D + ch0 + q]; }
        v4u uv[11];
#pragma unroll
        for (int k = 0; k < 11; ++k) { const int tt = t0 + k - 1; uv[k] = (tt >= 0 && tt < len) ? *(const v4u*)(U + (size_t)(row0 + k - 1) * D + ch0) : (v4u){0u, 0u, 0u, 0u}; }
#pragma unroll
        for (int i = 0; i < 8; ++i) {
            float acc[8];
#pragma unroll
            for (int q = 0; q < 8; ++q) acc[q] = cbv[q];
#pragma unroll
            for (int k = 0; k < 4; ++k) { const unsigned w[4] = {uv[i + k].x, uv[i + k].y, uv[i + k].z, uv[i + k].w};
#pragma unroll
                for (int q = 0; q < 4; ++q) { acc[2 * q] += cw[k][2 * q] * __uint_as_float(w[q] << 16); acc[2 * q + 1] += cw[k][2 * q + 1] * __uint_as_float(w[q] & 0xffff0000u); } }
            *(v4u*)(UC + (size_t)(row0 + i) * D + ch0) = (v4u){pk_bf16(acc[0], acc[1]), pk_bf16(acc[2], acc[3]), pk_bf16(acc[4], acc[5]), pk_bf16(acc[6], acc[7])};
        }
    }
}
constexpr int LR_A = 0, LR_SC = 65536, LR_AG = 131072, LR_CY = LR_AG + 8192;
__device__ __forceinline__ void p_lru(const CAS Args& a, const Frame& F) {
    const bf16* UC = (const bf16*)(a.ws + WS_UC); const bf16* WL = (const bf16*)(a.ws + WS_WLRU); const bf16* Gt = (const bf16*)(a.ws + WS_G);
    bf16* HF = (bf16*)(a.ws + WS_HF); bf16* A3 = (bf16*)(a.ws + WS_A3);
    LAS unsigned char* lds = F.ldsl;
    const int lane_ = F.lane, wave = F.wave, sub = wave & 3, th = wave >> 2;
    for (int wu = F.bid; wu < 256; wu += F.G) {
        const int b = wu >> 4, h = (wu >> 2) & 3, cg = wu & 3;
        for (int dir = 0; dir < 2; ++dir) {
            const int lane = lane_, rho = lane & 15, g = lane >> 4;
            bf16x8 bw[2][8];
#pragma unroll
            for (int n = 0; n < 2; ++n)
#pragma unroll
                for (int ks = 0; ks < 8; ++ks) bw[n][ks] = *(const bf16x8*)(WL + ((size_t)h * 1024 + (2 * dir + n) * 256 + cg * 64 + 16 * sub + rho) * 256 + 32 * ks + 8 * g);
            const int chc = h * 256 + cg * 64 + 16 * sub + rho;
            const float bav = (dir ? a.in[25] : a.in[20])[chc] * -1.44269504f, bxv = (dir ? a.in[27] : a.in[22])[chc] * -1.44269504f;
            const float lamv = (dir ? a.in[28] : a.in[23])[chc];
            const float L8 = -8.0f * log1pf(expf(-lamv)) * 1.44269504f;
            __syncthreads();
            if (wave == 0) ((LAS float*)(lds + LR_CY))[lane] = 0.f;
#define LR_GROW0(ck_) ((ck_) < 2 ? (size_t)(NT + b * 256 + 128 * (dir ? 1 - (ck_) : (ck_))) : (size_t)(b * 2048 + 128 * (dir ? 15 - ((ck_) - 2) : (ck_) - 2)))
#define LR_STAGE(ck_) do { const size_t g0_ = LR_GROW0(ck_); _Pragma("unroll") for (int p_ = 0; p_ < 8; ++p_) { const int pc_ = wave * 8 + p_, row_ = 2 * pc_ + (lane >> 5), c_ = (lane & 31) ^ (row_ & 15); \
                __builtin_amdgcn_global_load_lds((const unsigned*)((const char*)UC + (g0_ + row_) * (D * 2) + h * 512 + 16 * c_), (LAS unsigned*)(lds + LR_A + pc_ * 1024), 16, 0, 0); } } while (0)
            LR_STAGE(0);
            for (int ck = 0; ck < 18; ++ck) {
                const bool isctx = ck < 2;
                const size_t grow0 = LR_GROW0(ck);
                int lane = lane_; asm volatile("" : "+v"(lane)); const int rho = lane & 15, g = lane >> 4, chs = h * 256 + cg * 64 + lane, ucol = cg * 64 + 16 * sub + rho;
                asm volatile("s_waitcnt vmcnt(0)" ::: "memory");
                __syncthreads();
                const int row0 = dir ? 112 - 16 * wave : 16 * wave;
                v4u hfr[2], gtr[2];
                if (dir && !isctx) {
#pragma unroll
                    for (int t = 0; t < 2; ++t) { const int tk = lane + 64 * t; const size_t gi = (grow0 + row0 + (tk >> 3)) * D + h * 256 + cg * 64 + 8 * (tk & 7);
                        hfr[t] = *(const v4u*)(HF + gi); gtr[t] = *(const v4u*)(Gt + gi); } }
                {
                    f32x4 acc[4][2];
#pragma unroll
                    for (int m = 0; m < 4; ++m)
#pragma unroll
                        for (int n = 0; n < 2; ++n) acc[m][n] = (f32x4){0.f, 0.f, 0.f, 0.f};
#pragma unroll
                    for (int ks = 0; ks < 8; ++ks)
#pragma unroll
                        for (int m = 0; m < 4; ++m) { const int rw = 64 * th + 16 * m + rho; const bf16x8 af = *(const LAS bf16x8*)(lds + LR_A + rw * 512 + (((4 * ks + g) ^ (rw & 15)) << 4));
#pragma unroll
                            for (int n = 0; n < 2; ++n) acc[m][n] = __builtin_amdgcn_mfma_f32_16x16x32_bf16(af, bw[n][ks], acc[m][n], 0, 0, 0);
                            if (m == 3 && (ks & 1)) asm volatile("" ::: "memory"); }
#pragma unroll
                    for (int m = 0; m < 4; ++m)
#pragma unroll
                        for (int p = 0; p < 2; ++p) {
                            const int row = 64 * th + 16 * m + 4 * g + 2 * p;
                            f32x2_t uc;
                            uc.x = bf2f(*(const LAS bf16*)(lds + LR_A + row * 512 + (((ucol >> 3) ^ (row & 15)) << 4) + 2 * (ucol & 7)));
                            uc.y = bf2f(*(const LAS bf16*)(lds + LR_A + (row + 1) * 512 + (((ucol >> 3) ^ ((row + 1) & 15)) << 4) + 2 * (ucol & 7)));
                            const f32x2_t xa = (f32x2_t){acc[m][0][2 * p], acc[m][0][2 * p + 1]} * -1.44269504f + bav, xx = (f32x2_t){acc[m][1][2 * p], acc[m][1][2 * p + 1]} * -1.44269504f + bxv;
                            f32x2_t da, dx; da.x = __builtin_amdgcn_exp2f(xa.x); da.y = __builtin_amdgcn_exp2f(xa.y); dx.x = __builtin_amdgcn_exp2f(xx.x); dx.y = __builtin_amdgcn_exp2f(xx.y);
                            da = da + 1.0f; dx = dx + 1.0f;
                            f32x2_t rr, ii; rr.x = __builtin_amdgcn_rcpf(da.x); rr.y = __builtin_amdgcn_rcpf(da.y); ii.x = __builtin_amdgcn_rcpf(dx.x); ii.y = __builtin_amdgcn_rcpf(dx.y);
                            const f32x2_t la = rr * L8;
                            f32x2_t av; av.x = __builtin_amdgcn_exp2f(la.x); av.y = __builtin_amdgcn_exp2f(la.y);
                            f32x2_t tt = 1.0f - av * av; tt.x = fmaxf(tt.x, 0.f); tt.y = fmaxf(tt.y, 0.f);
                            f32x2_t sq; sq.x = __builtin_amdgcn_sqrtf(tt.x); sq.y = __builtin_amdgcn_sqrtf(tt.y);
                            const f32x2_t bv = sq * ii * uc;
                            *(LAS f32x2_t*)(lds + LR_SC + (row * 64 + 16 * sub + rho) * 8) = (f32x2_t){av.x, bv.x};
                            *(LAS f32x2_t*)(lds + LR_SC + ((row + 1) * 64 + 16 * sub + rho) * 8) = (f32x2_t){av.y, bv.y};
                        }
                }
                __syncthreads();
                if (ck + 1 < 18) LR_STAGE(ck + 1);
                f32x2_t ab[16];
                {
#pragma unroll
                    for (int q = 0; q < 16; ++q) { const int s = 16 * wave + q, row = dir ? 127 - s : s; ab[q] = *(const LAS f32x2_t*)(lds + LR_SC + (row * 64 + lane) * 8); }
                    float hl = 0.f, pr = 1.f;
#pragma unroll
                    for (int q = 0; q < 16; ++q) { hl = ab[q].x * hl + ab[q].y; pr *= ab[q].x; ab[q] = (f32x2_t){pr, hl}; }
                    *(LAS f32x2_t*)(lds + LR_AG + ((ck & 1) * 512 + wave * 64 + lane) * 8) = (f32x2_t){pr, hl};
                }
                __syncthreads();
                {
                    float c = ((const LAS float*)(lds + LR_CY))[(ck & 1) * 64 + lane], cin = 0.f;
#pragma unroll
                    for (int w2 = 0; w2 < 8; ++w2) { if (w2 == wave) cin = c; const f32x2_t ag = *(const LAS f32x2_t*)(lds + LR_AG + ((ck & 1) * 512 + w2 * 64 + lane) * 8); c = ag.x * c + ag.y; }
                    if (wave == 0) ((LAS float*)(lds + LR_CY))[((ck + 1) & 1) * 64 + lane] = c;
                    if (!isctx) {
                        LAS unsigned char* scr = lds + LR_SC + row0 * 512;
                        if (dir) {
#pragma unroll
                            for (int t = 0; t < 2; ++t) { const int tk = lane + 64 * t; *(LAS v4u*)(scr + tk * 16) = hfr[t]; *(LAS v4u*)(scr + 2048 + tk * 16) = gtr[t]; }
                        }
#pragma unroll
                        for (int q = 0; q < 16; ++q) { const int tr = dir ? 15 - q : q;
                            float hv = ab[q].y + ab[q].x * cin;
                            if (dir) hv = (bf2f(*(const LAS bf16*)(scr + (tr * 64 + lane) * 2)) + hv) * bf2f(*(const LAS bf16*)(scr + 2048 + (tr * 64 + lane) * 2));
                            *(LAS bf16*)(scr + 4096 + (tr * 64 + lane) * 2) = f2bf(hv); }
                        bf16* dstp = dir ? A3 : HF;
#pragma unroll
                        for (int t = 0; t < 2; ++t) { const int tk = lane + 64 * t; const size_t gi = (grow0 + row0 + (tk >> 3)) * D + h * 256 + cg * 64 + 8 * (tk & 7);
                            *(v4u*)(dstp + gi) = *(const LAS v4u*)(scr + 4096 + tk * 16); }
                    }
                }
            }
#undef LR_STAGE
#undef LR_GROW0
        }
    }
}

constexpr int LDS_BYTES = 163840;
constexpr int NPHASE = 17;
template <unsigned KMASK>
__global__ void __launch_bounds__(NWAVES * 64, 2) fwd(Args kargs) {
    extern __shared__ __attribute__((aligned(16))) unsigned char lds[];
    const int wave_s = __builtin_amdgcn_readfirstlane((int)threadIdx.x >> 6);
    const int tid0 = wave_s * 64 + lane_id_fresh();
    volatile LAS unsigned* misc = (volatile LAS unsigned*)((LAS unsigned char*)lds + (LDS_BYTES - 64));
    if (tid0 < 16) misc[tid0] = 0u;
    __syncthreads();
    const int lo = kargs.ph_lo, hi = kargs.ph_hi;
    XcdBarrier bar; bar.bar = (unsigned*)(kargs.ws + WS_CTL) + CW_BAR + kargs.li * XCD_BAR_WORDS; bar.x = 0; bar.st = misc;
    if (hi - lo > 1) bar = xcd_barrier_post((unsigned*)(kargs.ws + WS_CTL) + CW_BAR + kargs.li * XCD_BAR_WORDS, misc, tid0);
#ifndef ONLY_PHASE
#define ONLY_PHASE -1
#endif
#ifndef PHASE_MASK
#define PHASE_MASK 0xFFFFFFFFu
#endif
#ifndef REPMASK
#define REPMASK 0u
#endif
#define PH(k, body) if constexpr (((KMASK >> (k)) & 1u) != 0u) if ((ONLY_PHASE < 0 || ONLY_PHASE == (k)) && ((PHASE_MASK >> (k)) & 1u) && lo <= (k) && (k) < hi) { \
        const CAS Args* ap_ = (const CAS Args*)__builtin_amdgcn_kernarg_segment_ptr(); asm volatile("" : "+s"(ap_)); const CAS Args& args = *ap_; \
        Frame F; F.lds = lds; F.ldsl = (LAS unsigned char*)lds; F.wave = wave_s; F.lane = lane_id_fresh(); \
        F.tid = F.wave * 64 + F.lane; F.G = gridDim.x; F.bid = blockIdx.x; F.gw = F.bid * NWAVES + F.wave; F.ngw = F.G * NWAVES; \
        if (((REPMASK >> (k)) & 1u) == 0u) { body; } else { int nrep_ = 2; asm volatile("" : "+s"(nrep_)); for (int rep_ = 0; rep_ < nrep_; ++rep_) { body; asm volatile("s_waitcnt vmcnt(0)" ::: "memory"); __syncthreads(); } } if ((k) + 1 < hi) xcd_barrier(bar, F.tid); else { asm volatile("s_waitcnt vmcnt(0)" ::: "memory"); __syncthreads(); } }
    PH(0, p0_prologue(args, F))
    PH(1, p_norm1_l0(args, F))
    PH(2, p_inproj0(args, F))
    PH(3, p_attn(args, F))
    PH(4, p_outproj<0>(args, F))
    PH(5, p_norm2_router(args, F, 0))
    PH(6, p_moe_up(args, F, 0))
    PH(7, p_moe_down(args, F, 0))
    PH(8, p_combine(args, F, 0))
    PH(9, p_inproj1(args, F))
    PH(10, p_conv4(args, F))
    PH(11, p_lru(args, F))
    PH(12, p_outproj<1>(args, F))
    PH(13, p_norm2_router(args, F, 1))
    PH(14, p_moe_up(args, F, 1))
    PH(15, p_moe_down(args, F, 1))
    PH(16, p_combine(args, F, 1))
#undef PH
}

constexpr unsigned MASK_A = (1u<<2)|(1u<<4)|(1u<<6)|(1u<<7)|(1u<<9)|(1u<<11)|(1u<<13)|(1u<<14), MASK_C = 1u << 3, MASK_D = 1u << 10, MASK_ALL = 0x1FFFFu, MASK_B = MASK_ALL & ~(MASK_A | MASK_C | MASK_D);
__host__ inline int kid_of(int p) { return ((MASK_A >> p) & 1u) ? 0 : ((MASK_C >> p) & 1u) ? 2 : ((MASK_D >> p) & 1u) ? 3 : 1; }
extern "C" void kernel_launch(void* const* d_in, const int* in_sizes, int n_in, void* d_out, int out_size, void* d_ws, size_t ws_size, hipStream_t stream) {
    static int grid = 0;
    if (grid == 0) {
        if (n_in != 37 || out_size != NT * D || ws_size < WS_END) { fprintf(stderr, "kernel_launch: unexpected shapes (n_in %d out %d ws %zu)\n", n_in, out_size, ws_size); grid = -1; return; }
        int dev = 0, cus = 0;
        if (hipGetDevice(&dev) != hipSuccess || hipDeviceGetAttribute(&cus, hipDeviceAttributeMultiprocessorCount, dev) != hipSuccess) { grid = -1; return; }
#ifndef MULTI_LAUNCH
        if (hipFuncSetAttribute((const void*)fwd<MASK_ALL>, hipFuncAttributeMaxDynamicSharedMemorySize, LDS_BYTES) != hipSuccess) { fprintf(stderr, "kernel_launch: hipFuncSetAttribute failed\n"); grid = -1; return; }
#else
        if (hipFuncSetAttribute((const void*)fwd<MASK_A>, hipFuncAttributeMaxDynamicSharedMemorySize, LDS_BYTES) != hipSuccess) { fprintf(stderr, "kernel_launch: hipFuncSetAttribute failed\n"); grid = -1; return; }
        if (hipFuncSetAttribute((const void*)fwd<MASK_B>, hipFuncAttributeMaxDynamicSharedMemorySize, LDS_BYTES) != hipSuccess) { fprintf(stderr, "kernel_launch: hipFuncSetAttribute failed\n"); grid = -1; return; }
        if (hipFuncSetAttribute((const void*)fwd<MASK_C>, hipFuncAttributeMaxDynamicSharedMemorySize, LDS_BYTES) != hipSuccess) { fprintf(stderr, "kernel_launch: hipFuncSetAttribute failed\n"); grid = -1; return; }
        if (hipFuncSetAttribute((const void*)fwd<MASK_D>, hipFuncAttributeMaxDynamicSharedMemorySize, LDS_BYTES) != hipSuccess) { fprintf(stderr, "kernel_launch: hipFuncSetAttribute failed\n"); grid = -1; return; }
#endif
        (void)hipGetLastError();
        grid = cus;
    }
    if (grid < 0) return;
    if (hipMemsetAsync((char*)d_ws + WS_CTL, 0, CTL_ZERO_BYTES, stream) != hipSuccess) return;
    Args a{};
    for (int i = 0; i < 37; ++i) a.in[i] = (const float*)d_in[i];
    a.out = (float*)d_out; a.ws = (unsigned char*)d_ws;
#ifdef MULTI_LAUNCH
    int p = 0, li = 0;
    while (p < NPHASE) {
        const int kid = kid_of(p); int q = p + 1;
        while (q < NPHASE && kid_of(q) == kid) ++q;
        a.ph_lo = p; a.ph_hi = q; a.li = li++;
        if (kid == 0) hipLaunchKernelGGL(fwd<MASK_A>, dim3(grid), dim3(NWAVES * 64), LDS_BYTES, stream, a);
        else if (kid == 1) hipLaunchKernelGGL(fwd<MASK_B>, dim3(grid), dim3(NWAVES * 64), LDS_BYTES, stream, a);
        else if (kid == 2) hipLaunchKernelGGL(fwd<MASK_C>, dim3(grid), dim3(NWAVES * 64), LDS_BYTES, stream, a);
        else hipLaunchKernelGGL(fwd<MASK_D>, dim3(grid), dim3(NWAVES * 64), LDS_BYTES, stream, a);
        p = q;
    }
#else
    a.ph_lo = 0; a.ph_hi = NPHASE; a.li = 0;
    hipLaunchKernelGGL(fwd<MASK_ALL>, dim3(grid), dim3(NWAVES * 64), LDS_BYTES, stream, a);
#endif
}
```

```cpp
#include <hip/hip_runtime.h>
#include <stdint.h>
#include <stdio.h>

constexpr int D = 1024, NB = 16, SEQ = 2048, NT = NB * SEQ, LC = 256, NC = NB * LC, R = NT + NC;
constexpr int NE = 32, CAP = R;
constexpr int NWAVES = 8;

typedef unsigned short bf16;
typedef short bf16x8 __attribute__((ext_vector_type(8)));
typedef float f32x4 __attribute__((ext_vector_type(4)));
typedef unsigned v4u __attribute__((ext_vector_type(4)));
#define LAS __attribute__((address_space(3)))
#define CAS __attribute__((address_space(4)))
#define RLX_AGENT __ATOMIC_RELAXED, __HIP_MEMORY_SCOPE_AGENT

constexpr size_t MiB = 1u << 20;
constexpr size_t WS_CTL = 0, CTL_ZERO_BYTES = 1 * MiB;
constexpr size_t WS_MOD = 1 * MiB;
constexpr size_t WS_WIN0 = 2 * MiB, WS_WOUT0 = 8 * MiB, WS_WIN1 = 10 * MiB, WS_WOUT1 = 14 * MiB, WS_WLRU = 16 * MiB;
constexpr size_t WS_TOKLIST = 18 * MiB;
constexpr size_t WS_SEL = 23 * MiB;
constexpr size_t WS_GATEV = 24 * MiB;
constexpr size_t WS_XC = 25 * MiB;
constexpr size_t WS_WEXP = 41 * MiB;
constexpr size_t WS_H = 233 * MiB;
constexpr size_t WS_P = 305 * MiB;
constexpr int PP = 2560;
constexpr size_t WS_A2 = 521 * MiB;
constexpr size_t WS_ACT = 593 * MiB;
constexpr size_t WS_YB = 305 * MiB;
constexpr size_t WS_G = 305 * MiB;
constexpr size_t WS_U = 369 * MiB;
constexpr size_t WS_UC = 441 * MiB;
constexpr size_t WS_AF = 513 * MiB;
constexpr size_t WS_AB = 657 * MiB;
constexpr size_t WS_HF = WS_AF;
constexpr size_t WS_A3 = WS_AB;
constexpr size_t WS_BF = 801 * MiB;
constexpr size_t WS_BB = 873 * MiB;
constexpr size_t WS_GS2 = 840 * MiB;
constexpr size_t WS_XB = 760 * MiB;
constexpr size_t WS_END = 945 * MiB;
constexpr int CW_BAR = 4096;
constexpr int CW_CNT = 65536;

__device__ __forceinline__ float bf2f(bf16 v) { return __uint_as_float(((unsigned)v) << 16); }
__device__ __forceinline__ bf16 f2bf(float f) { unsigned u = __float_as_uint(f); return (bf16)((u + 0x7fffu + ((u >> 16) & 1u)) >> 16); }
__device__ __forceinline__ unsigned pk2(float lo, float hi) { return (unsigned)f2bf(lo) | ((unsigned)f2bf(hi) << 16); }
__device__ __forceinline__ int lane_id_fresh() { int l; asm volatile("v_mbcnt_lo_u32_b32 %0, -1, 0\n\tv_mbcnt_hi_u32_b32 %0, -1, %0" : "=v"(l)); return l; }
__device__ __forceinline__ unsigned pk4_fp8(float a, float b, float c, float d) {
    a = fminf(fmaxf(a, -448.f), 448.f); b = fminf(fmaxf(b, -448.f), 448.f); c = fminf(fmaxf(c, -448.f), 448.f); d = fminf(fmaxf(d, -448.f), 448.f);
    unsigned w = 0u; w = __builtin_amdgcn_cvt_pk_fp8_f32(a, b, w, false); w = __builtin_amdgcn_cvt_pk_fp8_f32(c, d, w, true); return w;
}
constexpr float W8_SCALE = 32.0f, ACT8_SCALE = 4.0f, YB8_SCALE = 16.0f;
__device__ __forceinline__ float wave_sum(float v) {
#pragma unroll
    for (int o = 1; o < 64; o <<= 1) v += __shfl_xor(v, o);
    return v;
}
__device__ __forceinline__ float wave_max(float v) {
#pragma unroll
    for (int o = 1; o < 64; o <<= 1) v = fmaxf(v, __shfl_xor(v, o));
    return v;
}
__device__ __forceinline__ float sigmoidf_(float x) { return 1.0f / (1.0f + __expf(-x)); }
__device__ __forceinline__ float gelu_tanh(float x) { return 0.5f * x * (1.0f + tanhf(0.7978845608028654f * (x + 0.044715f * x * x * x))); }

#define XB_TMO      128
#define XB_XCNT(j)  (256  + 64 * (j))
#define XB_XSUB(j)  (1280 + 64 * (j))
#define XB_XGEN(j)  (2304 + 64 * (j))
#define XB_TOP      3328
#define XB_TOPGEN   3392
#define XCD_BAR_WORDS 3456
#define XB_SPIN_CAP (1u << 18)
__device__ __forceinline__ unsigned xb_ld(unsigned* p)              { return __hip_atomic_load(p, __ATOMIC_RELAXED, __HIP_MEMORY_SCOPE_AGENT); }
__device__ __forceinline__ unsigned xb_add(unsigned* p, unsigned v) { return __hip_atomic_fetch_add(p, v, __ATOMIC_RELAXED, __HIP_MEMORY_SCOPE_AGENT); }
__device__ __forceinline__ unsigned xb_xcc_id() { return (unsigned)__builtin_amdgcn_s_getreg((3 << 11) | 20) & 0xFu; }
#define XB_SPIN(cond, bar) do { unsigned _sp = 0; while (cond) { __builtin_amdgcn_s_sleep(1); \
    if ((++_sp & 255u) == 0u) { if (xb_ld(&(bar)[XB_TMO])) break; if (_sp > XB_SPIN_CAP) { atomicAdd(&(bar)[XB_TMO], 1u); break; } } } } while (0)
struct XcdBarrier { unsigned* bar; unsigned x; volatile LAS unsigned* st; };
__device__ __forceinline__ XcdBarrier xcd_barrier_post(unsigned* bar, volatile LAS unsigned* st, int tid) {
    XcdBarrier b; b.bar = bar; b.x = xb_xcc_id(); b.st = st;
    if (tid == 0) (void)xb_add(&bar[XB_XCNT(b.x)], 1u);
    return b;
}
__device__ __forceinline__ void xcd_barrier_complete(unsigned* bar, unsigned x, unsigned& nloc, unsigned& nx) {
    const unsigned G = gridDim.x * gridDim.y * gridDim.z;
    unsigned sum, cnt, mine, sp = 0u;
    for (;;) {
        sum = 0u; cnt = 0u; mine = 0u;
#pragma unroll
        for (unsigned j = 0; j < 16; ++j) { const unsigned c = xb_ld(&bar[XB_XCNT(j)]); sum += c; cnt += (c > 0u) ? 1u : 0u; mine = (j == x) ? c : mine; }
        if (sum == G) break;
        __builtin_amdgcn_s_sleep(1);
        if ((++sp & 255u) == 0u) { if (xb_ld(&bar[XB_TMO])) break; if (sp > XB_SPIN_CAP) { atomicAdd(&bar[XB_TMO], 1u); break; } }
    }
    nloc = mine > 0u ? mine : 1u; nx = cnt > 0u ? cnt : 1u;
}
__device__ __forceinline__ void xcd_barrier(const XcdBarrier& b, int tid) {
    asm volatile("s_waitcnt vmcnt(0)" ::: "memory");
    __syncthreads();
    if (tid == 0) {
        unsigned* bar = b.bar;
        __builtin_amdgcn_s_waitcnt(0);
        unsigned nloc = b.st[0], nx = b.st[1];
        if (nloc == 0u) { xcd_barrier_complete(bar, b.x, nloc, nx); b.st[0] = nloc; b.st[1] = nx; }
        const unsigned old = xb_add(&bar[XB_XSUB(b.x)], 1u);
        const unsigned gen = old / nloc;
        if (old + 1u == (gen + 1u) * nloc) {
            __builtin_amdgcn_fence(__ATOMIC_RELEASE, "agent");
            asm volatile("s_waitcnt vmcnt(0)" ::: "memory");
            const unsigned og = xb_add(&bar[XB_TOP], 1u);
            const unsigned tg = og / nx;
            if (og + 1u == (tg + 1u) * nx) xb_add(&bar[XB_TOPGEN], 1u);
            else XB_SPIN(xb_ld(&bar[XB_TOPGEN]) == tg, bar);
            __builtin_amdgcn_fence(__ATOMIC_ACQUIRE, "agent");
            xb_add(&bar[XB_XGEN(b.x)], 1u);
            asm volatile("s_waitcnt vmcnt(0)" ::: "memory");
        } else {
            XB_SPIN(xb_ld(&bar[XB_XGEN(b.x)]) == gen, bar);
            __builtin_amdgcn_fence(__ATOMIC_ACQUIRE, "agent");
            asm volatile("s_waitcnt vmcnt(0)" ::: "memory");
        }
    }
    __syncthreads();
}

struct Args { const float* in[37]; float* out; unsigned char* ws; int ph_lo, ph_hi, li, pad; };
struct Frame {
    unsigned char* lds;
    LAS unsigned char* ldsl;
    int tid, lane, wave, gw, ngw, G, bid;
};

template <int NS, class FA, class FB, class FS>
__device__ __forceinline__ void tile_gemm32(int K, FA arow, FB brow, FS store, int lane) {
    const int lr = lane & 15, lq = lane >> 4;
    const bf16* ap[2]; const bf16* bp[NS][2];
#pragma unroll
    for (int i = 0; i < 2; ++i) ap[i] = arow(16 * i + lr) + 8 * lq;
#pragma unroll
    for (int s = 0; s < NS; ++s)
#pragma unroll
        for (int j = 0; j < 2; ++j) bp[s][j] = brow(s, 16 * j + lr) + 8 * lq;
    f32x4 acc[NS][2][2];
#pragma unroll
    for (int s = 0; s < NS; ++s)
#pragma unroll
        for (int i = 0; i < 2; ++i)
#pragma unroll
            for (int j = 0; j < 2; ++j) acc[s][i][j] = (f32x4){0.f, 0.f, 0.f, 0.f};
#pragma nounroll
    for (int k0 = 0; k0 < K; k0 += 32) {
        bf16x8 a[2], b[NS][2];
#pragma unroll
        for (int i = 0; i < 2; ++i) a[i] = *(const bf16x8*)(ap[i] + k0);
#pragma unroll
        for (int s = 0; s < NS; ++s)
#pragma unroll
            for (int j = 0; j < 2; ++j) b[s][j] = *(const bf16x8*)(bp[s][j] + k0);
#pragma unroll
        for (int s = 0; s < NS; ++s)
#pragma unroll
            for (int i = 0; i < 2; ++i)
#pragma unroll
                for (int j = 0; j < 2; ++j) acc[s][i][j] = __builtin_amdgcn_mfma_f32_16x16x32_bf16(a[i], b[s][j], acc[s][i][j], 0, 0, 0);
    }
#pragma unroll
    for (int i = 0; i < 2; ++i)
#pragma unroll
        for (int j = 0; j < 2; ++j)
#pragma unroll
            for (int q = 0; q < 4; ++q) {
                float v[NS];
#pragma unroll
                for (int s = 0; s < NS; ++s) v[s] = acc[s][i][j][q];
                store(16 * i + 4 * lq + q, 16 * j + lr, v);
            }
}


namespace pg8 {
constexpr int BM = 256, BK = 64, HALF = 128, HTB = HALF * BK * 2, STAGE_BYTES = 8 * HTB;
__device__ __forceinline__ int lds_byte(int r, int c) { const int st = (r >> 4) * 2 + (c >> 5), rr = r & 15, cc = c & 31, ob = rr * 64 + cc * 2; return st * 1024 + (ob ^ (((ob >> 9) & 1) << 5)); }
__device__ __forceinline__ void stage_rc(int b, int& R_, int& C_) { const int st = b / 1024, sb = b % 1024, swz = sb ^ (((sb >> 9) & 1) << 5); R_ = (st >> 1) * 16 + swz / 64; C_ = (st & 1) * 32 + (swz % 64) / 2; }
__device__ __forceinline__ int perm32(int rho) { const int n = rho >> 4, i = rho & 15; return 8 * (i >> 2) + 4 * n + (i & 3); }
struct Unit { int pm, pn, e, rows, base, newe; };
typedef int v8i __attribute__((ext_vector_type(8)));
typedef int v4i __attribute__((ext_vector_type(4)));
__device__ __forceinline__ void mfma8(f32x4& acc, v8i a, v8i b, unsigned sc) {
    asm volatile("v_mfma_scale_f32_16x16x128_f8f6f4 %0, %1, %2, %0, %3, %3 op_sel_hi:[0,0,0]" : "+v"(acc) : "v"(a), "v"(b), "v"(sc));
}
__device__ __forceinline__ v8i cat8(bf16x8 a, bf16x8 b) { return __builtin_shufflevector(__builtin_bit_cast(v4i, a), __builtin_bit_cast(v4i, b), 0, 1, 2, 3, 4, 5, 6, 7); }
__device__ __forceinline__ unsigned cvt_pk_bf16(float lo, float hi) { unsigned r; asm volatile("v_cvt_pk_bf16_f32 %0, %1, %2" : "=v"(r) : "v"(lo), "v"(hi)); return r; }

template <int RB  , bool FP8, class Epi, class Sched>
__device__ __forceinline__ void gemm_phase(LAS unsigned char* lds, const Sched& S, const Epi& E, const int wave_id) {
    const int tid_ = wave_id * 64 + lane_id_fresh();
    const int tid = tid_, wid = wave_id, lane = tid & 63, wr = wid >> 2, wc = wid & 3, fr = lane & 15, fq = lane >> 4;
    constexpr int nt = RB / 128;
    unsigned voffA[2], voffB[2]; int rA[2];
#pragma unroll
    for (int i = 0; i < 2; ++i) { int R_, C_; stage_rc(tid * 16 + i * 8192, R_, C_); const int Rb = Epi::PERM ? ((R_ & ~31) + perm32(R_ & 31)) : R_;
        voffA[i] = Sched::GATHER ? (unsigned)C_ * 2u : (unsigned)(R_ * RB + C_ * 2); rA[i] = R_; voffB[i] = (unsigned)(Rb * RB + C_ * 2); }
    constexpr size_t kstep = (size_t)(BK * 2);
    constexpr size_t hstep = (size_t)HALF * RB;
    const unsigned ldsw = (unsigned)wid * 1024u;
    const int aoff = lds_byte(wr * 64 + fr, fq * 8), boff = lds_byte(wc * 32 + fr, fq * 8);
#define PG8_SA(b, h) (((b) * 2 + (h)) * HTB)
#define PG8_SB(b, h) ((4 + (b) * 2 + (h)) * HTB)
#define PG8_STAGE(bufoff, gbase, voff) do { _Pragma("unroll") for (int _i = 0; _i < 2; ++_i) \
        __builtin_amdgcn_global_load_lds((const unsigned*)((const char*)(gbase) + (voff)[_i]), (LAS unsigned*)(lds + (bufoff) + ldsw + _i * 8192), 16, 0, 0); } while (0)
#define PG8_STAGE_A(bufoff, ubase, uoff, h) do { if constexpr (Sched::GATHER) PG8_STAGE(bufoff, ubase, (uoff)[h]); else PG8_STAGE(bufoff, (ubase) + (h) * hstep, voffA); } while (0)
#define PG8_LDA(dst, b, h) do { _Pragma("unroll") for (int m = 0; m < 4; ++m) _Pragma("unroll") for (int k = 0; k < 2; ++k) dst[m][k] = *(const LAS bf16x8*)(lds + PG8_SA(b, h) + aoff + m * 2048 + k * 1024); } while (0)
#define PG8_LDB(dst, b, h) do { _Pragma("unroll") for (int n = 0; n < 2; ++n) _Pragma("unroll") for (int k = 0; k < 2; ++k) dst[n][k] = *(const LAS bf16x8*)(lds + PG8_SB(b, h) + boff + n * 2048 + k * 1024); } while (0)
#define PG8_MMA(ai, bj, At, Bt) do { __builtin_amdgcn_s_setprio(1); _Pragma("unroll") for (int m = 0; m < 4; ++m) _Pragma("unroll") for (int n = 0; n < 2; ++n) { \
        if constexpr (FP8) mfma8(acc[ai][bj][m][n], cat8(Bt[n][0], Bt[n][1]), cat8(At[m][0], At[m][1]), sc1); \
        else { _Pragma("unroll") for (int k = 0; k < 2; ++k) acc[ai][bj][m][n] = __builtin_amdgcn_mfma_f32_16x16x32_bf16(Bt[n][k], At[m][k], acc[ai][bj][m][n], 0, 0, 0); } } __builtin_amdgcn_s_setprio(0); } while (0)
#define PG8_WAIT_V(n) asm volatile("s_waitcnt vmcnt(" #n ")" ::: "memory")
#define PG8_WAIT_L(n) asm volatile("s_waitcnt lgkmcnt(" #n ")" ::: "memory")
#define PG8_BAR __builtin_amdgcn_s_barrier()
#define PG8_SCHED __builtin_amdgcn_sched_barrier(0)
#define PG8_KBODY(a1, a2, b2, off2) do { const char* _a1 = (a1); const char* _a2 = (a2); const char* _b2 = (b2); const char* _a3 = _a2 + kstep; const char* _b3 = _b2 + kstep; \
            asm volatile("" : "+s"(_a1), "+s"(_a2), "+s"(_b2), "+s"(_a3), "+s"(_b3));   \
            PG8_LDB(B0, 0, 0); PG8_LDB(B1, 0, 1); PG8_SCHED; PG8_LDA(At, 0, 0); PG8_STAGE_A(PG8_SA(1, 1), _a1, coff, 1); \
            PG8_WAIT_V(8); PG8_WAIT_L(0); PG8_BAR; PG8_MMA(0, 0, At, B0); PG8_MMA(0, 1, At, B1); PG8_BAR; PG8_SCHED; \
            PG8_LDA(At, 0, 1); PG8_STAGE(PG8_SB(0, 0), _b2, voffB); PG8_STAGE(PG8_SB(0, 1), _b2 + hstep, voffB); PG8_STAGE_A(PG8_SA(0, 0), _a2, off2, 0); \
            PG8_WAIT_V(8); PG8_WAIT_L(0); PG8_BAR; PG8_MMA(1, 0, At, B0); PG8_MMA(1, 1, At, B1); PG8_BAR; PG8_SCHED; \
            PG8_LDB(B0, 1, 0); PG8_LDB(B1, 1, 1); PG8_SCHED; PG8_LDA(At, 1, 0); PG8_STAGE_A(PG8_SA(0, 1), _a2, off2, 1); \
            PG8_WAIT_V(8); PG8_WAIT_L(0); PG8_BAR; PG8_MMA(0, 0, At, B0); PG8_MMA(0, 1, At, B1); PG8_BAR; PG8_SCHED; \
            PG8_LDA(At, 1, 1); PG8_STAGE(PG8_SB(1, 0), _b3, voffB); PG8_STAGE(PG8_SB(1, 1), _b3 + hstep, voffB); PG8_STAGE_A(PG8_SA(1, 0), _a3, off2, 0); \
            PG8_WAIT_V(8); PG8_WAIT_L(0); PG8_BAR; PG8_MMA(1, 0, At, B0); PG8_MMA(1, 1, At, B1); PG8_BAR; PG8_SCHED; } while (0)
    int ui = 0;
    const char* cA; const char* cB;
    if (!S.bases(0, cA, cB)) return;
    f32x4 acc[2][2][4][2];
#pragma unroll
    for (int a = 0; a < 2; ++a)
#pragma unroll
        for (int b = 0; b < 2; ++b)
#pragma unroll
            for (int m = 0; m < 4; ++m)
#pragma unroll
                for (int n = 0; n < 2; ++n) acc[a][b][m][n] = (f32x4){0.f, 0.f, 0.f, 0.f};
    bf16x8 At[4][2], B0[2][2], B1[2][2];
    unsigned sc1 = 0x7f7f7f7fu; asm volatile("" : "+v"(sc1));
    unsigned coff[2][2], noff[2][2];
    if constexpr (Sched::GATHER) S.aoffs(0, rA, voffA, coff);
    PG8_STAGE(PG8_SB(0, 0), cB, voffB); PG8_STAGE(PG8_SB(0, 1), cB + hstep, voffB); PG8_STAGE_A(PG8_SA(0, 0), cA, coff, 0); PG8_STAGE_A(PG8_SA(0, 1), cA, coff, 1);
    if (wr == 1) PG8_BAR;
    PG8_WAIT_V(2); PG8_BAR;
    PG8_STAGE(PG8_SB(1, 0), cB + kstep, voffB); PG8_STAGE_A(PG8_SA(1, 0), cA + kstep, coff, 0); PG8_STAGE(PG8_SB(1, 1), cB + hstep + kstep, voffB);
    PG8_WAIT_V(6); PG8_BAR;
    for (;;) {
        const char* nA; const char* nB;
        const bool has_next = S.bases(ui + 1, nA, nB);
        if (!has_next) { nA = cA; nB = cB; }
        int ntok[2][2];
        if constexpr (Sched::GATHER) { if (has_next) S.atoks(ui + 1, rA, ntok); }
#pragma nounroll
        for (int t = 0; t < nt - 2; t += 2) PG8_KBODY(cA + (size_t)(t + 1) * kstep, cA + (size_t)(t + 2) * kstep, cB + (size_t)(t + 2) * kstep, coff);
        if constexpr (Sched::GATHER) {
            if (has_next) { asm volatile("" : "+v"(ntok[0][0]), "+v"(ntok[0][1]), "+v"(ntok[1][0]), "+v"(ntok[1][1]));
#pragma unroll
                for (int h = 0; h < 2; ++h)
#pragma unroll
                    for (int i = 0; i < 2; ++i) noff[h][i] = (unsigned)ntok[h][i] * (unsigned)RB + voffA[i]; }
            else {
#pragma unroll
                for (int h = 0; h < 2; ++h)
#pragma unroll
                    for (int i = 0; i < 2; ++i) noff[h][i] = coff[h][i]; }
        }
        PG8_KBODY(cA + (size_t)(nt - 1) * kstep, nA, nB, noff);
        if (wr == 0) PG8_BAR;
        if constexpr (FP8) asm volatile("s_nop 15\n\ts_nop 3" ::: "memory");
        {
            const int t2 = lane_id_fresh();
            const int w2 = wave_id, l2 = t2 & 63;
            Unit cur; S.unit(ui, cur); E(acc, cur, w2 >> 2, w2 & 3, l2 & 15, l2 >> 4); }
        if (!has_next) break;
#pragma unroll
        for (int a = 0; a < 2; ++a)
#pragma unroll
            for (int b = 0; b < 2; ++b)
#pragma unroll
                for (int m = 0; m < 4; ++m)
#pragma unroll
                    for (int n = 0; n < 2; ++n) acc[a][b][m][n] = (f32x4){0.f, 0.f, 0.f, 0.f};
        cA = nA; cB = nB; ++ui;
        if constexpr (Sched::GATHER) {
#pragma unroll
            for (int h = 0; h < 2; ++h)
#pragma unroll
                for (int i = 0; i < 2; ++i) coff[h][i] = noff[h][i]; }
        if (wr == 1) PG8_BAR;
    }
    PG8_WAIT_V(0);
    PG8_BAR;
#undef PG8_SA
#undef PG8_SB
#undef PG8_STAGE
#undef PG8_STAGE_A
#undef PG8_KBODY
#undef PG8_LDA
#undef PG8_LDB
#undef PG8_MMA
#undef PG8_WAIT_V
#undef PG8_WAIT_L
#undef PG8_BAR
#undef PG8_SCHED
}
__device__ __forceinline__ int xcd_remap(long L, int nwg) { const int q = nwg / 8, r = nwg % 8, xcd = (int)(L % 8), off = (int)(L / 8); return (xcd < r ? xcd * (q + 1) : r * (q + 1) + (xcd - r) * q) + off; }
struct RectSched {
    static constexpr bool GATHER = false;
    const char* A; const char* B; int RB, nM, nN, G, c, nM2, nN2, pm2, pn2;
    __device__ __forceinline__ bool unit(int i, Unit& u) const {
        const int n1 = nM * nN, nwg = n1 + nM2 * nN2; const long L = (long)i * G + c; if (L >= nwg) return false;
        int w = xcd_remap(L, nwg); int rm = nM, rn = nN, pm0 = 0, pn0 = 0;
        if (w >= n1) { w -= n1; rm = nM2; rn = nN2; pm0 = pm2; pn0 = pn2; }
        const int nig = 8 * rn, gid = w / nig, fm = gid * 8, gsz = (rm - fm) < 8 ? (rm - fm) : 8;
        u.pm = pm0 + fm + ((w % nig) % gsz); u.pn = pn0 + (w % nig) / gsz; u.e = 0; u.rows = 256; u.base = u.pm * 256; u.newe = 0;
        return true;
    }
    __device__ __forceinline__ bool bases(int i, const char*& a, const char*& b) const {
        Unit u; if (!unit(i, u)) return false;
        a = A + (size_t)u.pm * 256 * RB; b = B + (size_t)u.pn * 256 * RB; return true;
    }
    __device__ __forceinline__ void aoffs(int, const int (&)[2], const unsigned (&)[2], unsigned (&)[2][2]) const {}
    __device__ __forceinline__ void atoks(int, const int (&)[2], int (&)[2][2]) const {}
};
}

template <class MapF>
__device__ __forceinline__ void transpose_item(const float* W, int K, int N, bf16* WT, MapF rowmap, float* scr, int item, int lane) {
    const int nblk = N / 32, kb = item / nblk, nb = item % nblk, k0 = 64 * kb, n0 = 32 * nb;
#pragma unroll 8
    for (int i = 0; i < 32; ++i) { const int kk = 2 * i + (lane >> 5); scr[kk * 33 + (lane & 31)] = W[(size_t)(k0 + kk) * N + n0 + (lane & 31)]; }
    asm volatile("s_waitcnt lgkmcnt(0)" ::: "memory");
    const int c = lane & 7;
#pragma unroll
    for (int j = 0; j < 4; ++j) { const int n = (lane >> 3) + 8 * j; const float* s = scr + (8 * c) * 33 + n;
        v4u o; o.x = pk2(s[0 * 33], s[1 * 33]); o.y = pk2(s[2 * 33], s[3 * 33]); o.z = pk2(s[4 * 33], s[5 * 33]); o.w = pk2(s[6 * 33], s[7 * 33]);
        *(v4u*)(WT + (size_t)rowmap(n0 + n) * K + k0 + 8 * c) = o; }
    asm volatile("s_waitcnt lgkmcnt(0)" ::: "memory");
}
constexpr int CV_E0 = 2, CV_E1 = 12, CV_E2 = 22, CV_E3 = 18, INP0_NC = 40, OUTP0_NC = 64, INP1_NC = 32, MOE_NC = 32;
__device__ __forceinline__ void item8_load(const float* W, int N, int item, int lane, f32x4 (&t)[16]) {
    const int nblk = N / 32, kb = item / nblk, nb = item % nblk, k0 = 128 * kb, n0 = 32 * nb;
    const int r8 = lane >> 3, c8 = lane & 7;
    const float* p = W + (size_t)(k0 + 16 * r8) * N + n0 + 4 * c8;
#pragma unroll
    for (int i = 0; i < 16; ++i) t[i] = __builtin_nontemporal_load((const f32x4*)(p + (size_t)i * N));
}
template <class MapF>
__device__ __forceinline__ void item8_store(const f32x4 (&t)[16], int K, int N, unsigned char* WT, MapF rowmap, int item, int lane) {
    const int nblk = N / 32, kb = item / nblk, nb = item % nblk, k0 = 128 * kb, n0 = 32 * nb;
    const int r8 = lane >> 3, c8 = lane & 7;
#pragma unroll
    for (int c = 0; c < 4; ++c) {
        v4u o;
        o.x = pk4_fp8(t[0][c] * W8_SCALE, t[1][c] * W8_SCALE, t[2][c] * W8_SCALE, t[3][c] * W8_SCALE);     o.y = pk4_fp8(t[4][c] * W8_SCALE, t[5][c] * W8_SCALE, t[6][c] * W8_SCALE, t[7][c] * W8_SCALE);
        o.z = pk4_fp8(t[8][c] * W8_SCALE, t[9][c] * W8_SCALE, t[10][c] * W8_SCALE, t[11][c] * W8_SCALE); o.w = pk4_fp8(t[12][c] * W8_SCALE, t[13][c] * W8_SCALE, t[14][c] * W8_SCALE, t[15][c] * W8_SCALE);
        *(v4u*)(WT + (size_t)rowmap(n0 + 4 * c8 + c) * K + k0 + 16 * r8) = o;
    }
}
struct ExpertConv {
    const CAS Args& a; int layer, wlo, nw, lane;
    static constexpr int IPM = 8 * 32;
    __device__ __forceinline__ void load(int it, f32x4 (&t)[16]) const {
        const int m = it / IPM, le = layer + m / nw, which = wlo + m % nw;
        item8_load((which == 0 ? a.in[31] : which == 1 ? a.in[33] : a.in[35]) + ((size_t)le << 20), D, it % IPM, lane, t); }
    __device__ __forceinline__ void store(int it, const f32x4 (&t)[16]) const {
        const int m = it / IPM, r = it % IPM, le = layer + m / nw, which = wlo + m % nw;
        unsigned char* dst = (unsigned char*)(a.ws + WS_WEXP) + (size_t)le * 3072 * 1024;
        if (which == 0) item8_store(t, D, D, dst, [](int n) { return ((n >> 7) << 8) + (n & 127); }, r, lane);
        else if (which == 1) item8_store(t, D, D, dst, [](int n) { return ((n >> 7) << 8) + 128 + (n & 127); }, r, lane);
        else item8_store(t, D, D, dst + (size_t)2048 * 1024,
            [](int f) { return (f & ~255) | (((f >> 3) & 1) << 7) | (((f >> 6) & 3) << 5) | (((f >> 4) & 3) << 3) | (f & 7); }, r, lane); }
};
__device__ __forceinline__ void convert_experts(const CAS Args& a, const Frame& F, int layer, int wlo, int whi, int gw, int ngw, int elo = 0, int ehi = NE) {
    const ExpertConv C{a, layer * NE + elo, wlo, whi - wlo, F.lane};
    const int total = (ehi - elo) * (whi - wlo) * ExpertConv::IPM;
    int it = gw; if (it >= total) return;
    f32x4 tA[16], tB[16];
    C.load(it, tA);
    for (;;) {
        int nit = it + ngw;
        if (nit < total) C.load(nit, tB);
        C.store(it, tA);
        if (nit >= total) break;
        it = nit; nit = it + ngw;
        if (nit < total) C.load(nit, tA);
        C.store(it, tB);
        if (nit >= total) break;
        it = nit;
    }
}
__device__ __forceinline__ void p0_prologue(const CAS Args& a, const Frame& F) {
    float* scr = (float*)(F.lds + F.wave * 8448);
    constexpr int I_IN0 = 16 * 96, I_O = 16 * 32, I_IN1 = 16 * 64, I_LRU1 = 4 * 8;
    constexpr int NSMALL = I_IN0 + I_O + I_IN1 + I_O + 16 * I_LRU1;
    for (int it = F.gw; it < NSMALL; it += F.ngw) {
        int r = it;
        if (r < I_IN0) {
            transpose_item(a.in[8], D, 3072, (bf16*)(a.ws + WS_WIN0), [](int f) {
                if (f < 2048) return (f & ~255) | (((f >> 5) & 1) << 7) | (((f >> 6) & 3) << 5) | (f & 31);
                if (f < 2560) { const int j = f - 2048; return (8 + (j >> 7)) * 256 + (j & 127); }
                const int j = f - 2560; return (8 + (j >> 7)) * 256 + 128 + (j & 127); }, scr, r, F.lane); continue; } r -= I_IN0;
        if (r < I_O) { transpose_item(a.in[9], D, D, (bf16*)(a.ws + WS_WOUT0), [](int n) { return n; }, scr, r, F.lane); continue; } r -= I_O;
        if (r < I_IN1) { transpose_item(a.in[15], D, 2048, (bf16*)(a.ws + WS_WIN1), [](int n) { return n; }, scr, r, F.lane); continue; } r -= I_IN1;
        if (r < I_O) { transpose_item(a.in[16], D, D, (bf16*)(a.ws + WS_WOUT1), [](int n) { return n; }, scr, r, F.lane); continue; } r -= I_O;
        const int gh = r / I_LRU1, rr = r % I_LRU1, g = gh >> 2, h = gh & 3;
        const float* W = (g == 0 ? a.in[19] : g == 1 ? a.in[21] : g == 2 ? a.in[24] : a.in[26]) + (size_t)h * 65536;
        transpose_item(W, 256, 256, (bf16*)(a.ws + WS_WLRU) + (size_t)h * 1024 * 256, [g](int n) { return g * 256 + n; }, scr, rr, F.lane);
    }
    __syncthreads();
    convert_experts(a, F, 0, 0, 2, F.gw, F.ngw, 0, CV_E0);
    __syncthreads();
    float* sc = (float*)F.lds;
    float* red = (float*)(F.lds + 17 * 1024 * 4);
    {
#pragma unroll
        for (int hbat = 0; hbat < 2; ++hbat) { float tv[17];
#pragma unroll
            for (int j = 0; j < 17; ++j) { const int i = F.tid + 512 * (17 * hbat + j); tv[j] = i < 16 * 1024 ? a.in[1][i] : a.in[3][i - 16 * 1024]; }
#pragma unroll
            for (int j = 0; j < 17; ++j) { const int i = F.tid + 512 * (17 * hbat + j); sc[i] = tv[j] / (1.0f + __expf(-tv[j])); } }
    }
    __syncthreads();
    float* MOD = (float*)(a.ws + WS_MOD);
    for (int u = F.bid; u < 192; u += F.G) {
        const int l = u / 96, n = (u % 96) * 64 + F.lane;
        const float* w = a.in[4] + (size_t)l * D * 6144 + n;
        float acc[17];
#pragma unroll
        for (int b = 0; b < 17; ++b) acc[b] = 0.f;
        for (int k0 = F.wave * 128; k0 < F.wave * 128 + 128; k0 += 16) {
            float wv[16];
#pragma unroll
            for (int q = 0; q < 16; ++q) wv[q] = __builtin_nontemporal_load(w + (size_t)(k0 + q) * 6144);
#pragma unroll
            for (int q = 0; q < 16; ++q)
#pragma unroll
                for (int b = 0; b < 17; ++b) acc[b] += sc[b * 1024 + k0 + q] * wv[q];
        }
#pragma unroll
        for (int b = 0; b < 17; ++b) red[(F.wave * 17 + b) * 64 + F.lane] = acc[b];
        __syncthreads();
        for (int i = F.tid; i < 17 * 64; i += NWAVES * 64) {
            const int b = i / 64, ln = i % 64; float s = 0.f;
#pragma unroll
            for (int w8 = 0; w8 < 8; ++w8) s += red[(w8 * 17 + b) * 64 + ln];
            const int nn = (u % 96) * 64 + ln;
            MOD[((size_t)l * 17 + b) * 6144 + nn] = s + a.in[5][l * 6144 + nn];
        }
        __syncthreads();
    }
}

__device__ __forceinline__ void load_row16(const float* row, int lane, float (&v)[16]) {
#pragma unroll
    for (int j = 0; j < 4; ++j) { const f32x4 t = *(const f32x4*)(row + 256 * j + 4 * lane); v[4 * j] = t.x; v[4 * j + 1] = t.y; v[4 * j + 2] = t.z; v[4 * j + 3] = t.w; }
}
__device__ __forceinline__ void load_row16_bf16(const bf16* row, int lane, float (&v)[16]) {
#pragma unroll
    for (int j = 0; j < 4; ++j) { const uint2 t = *(const uint2*)(row + 256 * j + 4 * lane); v[4 * j] = __uint_as_float(t.x << 16); v[4 * j + 1] = __uint_as_float(t.x & 0xffff0000u); v[4 * j + 2] = __uint_as_float(t.y << 16); v[4 * j + 3] = __uint_as_float(t.y & 0xffff0000u); }
}
__device__ __forceinline__ void store_row16_bf16(bf16* row, int lane, const float (&v)[16]) {
#pragma unroll
    for (int j = 0; j < 4; ++j) { uint2 o; o.x = pk2(v[4 * j], v[4 * j + 1]); o.y = pk2(v[4 * j + 2], v[4 * j + 3]); *(uint2*)(row + 256 * j + 4 * lane) = o; }
}
__device__ __forceinline__ void store_row16_f32(float* row, int lane, const float (&v)[16]) {
#pragma unroll
    for (int j = 0; j < 4; ++j) *(f32x4*)(row + 256 * j + 4 * lane) = (f32x4){v[4 * j], v[4 * j + 1], v[4 * j + 2], v[4 * j + 3]};
}
template <bool FP8OUT = false>
__device__ __forceinline__ void norm_mod(const float (&v)[16], const float* g, const float* sh, const float* sc, bf16* out, int lane, float (&hv)[16]) {
    float s = 0.f;
#pragma unroll
    for (int i = 0; i < 16; ++i) s += v[i] * v[i];
    const float rstd = rsqrtf(wave_sum(s) * (1.0f / D) + 1e-6f);
#pragma unroll
    for (int j = 0; j < 4; ++j) {
        const int e = 256 * j + 4 * lane;
        const f32x4 gg = *(const f32x4*)(g + e), ss = *(const f32x4*)(sh + e), cc = *(const f32x4*)(sc + e);
        hv[4 * j] = v[4 * j] * rstd * gg.x * (1.f + cc.x) + ss.x; hv[4 * j + 1] = v[4 * j + 1] * rstd * gg.y * (1.f + cc.y) + ss.y;
        hv[4 * j + 2] = v[4 * j + 2] * rstd * gg.z * (1.f + cc.z) + ss.z; hv[4 * j + 3] = v[4 * j + 3] * rstd * gg.w * (1.f + cc.w) + ss.w;
        if (FP8OUT) *(unsigned*)((unsigned char*)out + e) = pk4_fp8(hv[4 * j], hv[4 * j + 1], hv[4 * j + 2], hv[4 * j + 3]);
        else { uint2 o; o.x = pk2(hv[4 * j], hv[4 * j + 1]); o.y = pk2(hv[4 * j + 2], hv[4 * j + 3]); *(uint2*)(out + e) = o; }
    }
}
__device__ __forceinline__ int row_batch(int r) { return r < NT ? (r >> 11) : 16; }
__device__ __forceinline__ const float* mod_ptr(const CAS Args& a, int l, int r, int chunk) { return (const float*)(a.ws + WS_MOD) + ((size_t)l * 17 + row_batch(r)) * 6144 + chunk * D; }

__device__ __forceinline__ void p_norm1_l0(const CAS Args& a, const Frame& F) {
    bf16* H = (bf16*)(a.ws + WS_H);
    { float* GS2 = (float*)(a.ws + WS_GS2); const float* MOD = (const float*)(a.ws + WS_MOD);
      for (int i = F.gw * 64 + F.lane; i < 2 * 17 * D; i += F.ngw * 64) { const int l = i / (17 * D), bb = (i / D) % 17, k = i % D; GS2[i] = a.in[7][l * D + k] * (1.0f + MOD[((size_t)l * 17 + bb) * 6144 + 4 * D + k]); } }
    for (int r = F.gw; r < R; r += 3 * F.ngw) {
        float v[3][16], hv[16];
#pragma unroll
        for (int k = 0; k < 3; ++k) { const int rr = r + k * F.ngw; if (rr < R) load_row16(rr < NT ? a.in[0] + (size_t)rr * D : a.in[2] + (size_t)(rr - NT) * D, F.lane, v[k]); }
#pragma unroll
        for (int k = 0; k < 3; ++k) { const int rr = r + k * F.ngw; if (rr < R) norm_mod(v[k], a.in[6], mod_ptr(a, 0, rr, 0), mod_ptr(a, 0, rr, 1), H + (size_t)rr * D, F.lane, hv); }
    }
}

struct EpiInProj0 {
    static constexpr bool PERM = true;
    bf16* P; const float* qg; const float* kg;
    __device__ __forceinline__ void operator()(const f32x4 (&acc)[2][2][4][2], const pg8::Unit& u, int wr, int wc, int fr, int fq) const {
        const int row0 = u.pm * 256 + wr * 64 + fr, pn = u.pn;
        if (pn < 4) {
            const float* g = pn < 2 ? qg : kg; const float sc = pn < 2 ? 0.125f : 1.0f;
            f32x4 gv[2][2];
#pragma unroll
            for (int bj = 0; bj < 2; ++bj)
#pragma unroll
                for (int n = 0; n < 2; ++n) gv[bj][n] = *(const f32x4*)(g + 32 * bj + 8 * fq + 4 * n);
#pragma unroll
            for (int ai = 0; ai < 2; ++ai)
#pragma unroll
                for (int m = 0; m < 4; ++m) {
                    float ss = 0.f;
#pragma unroll
                    for (int bj = 0; bj < 2; ++bj)
#pragma unroll
                        for (int n = 0; n < 2; ++n) { const f32x4 x = acc[ai][bj][m][n]; ss += (x[0] * x[0] + x[1] * x[1]) + (x[2] * x[2] + x[3] * x[3]); }
                    ss += __shfl_xor(ss, 16); ss += __shfl_xor(ss, 32);
                    const float rs = rsqrtf(ss * (1.0f / 64.0f) + 1e-6f) * sc;
                    bf16* rowp = P + (size_t)(row0 + ai * 128 + m * 16) * PP + pn * 256 + wc * 64 + 8 * fq;
#pragma unroll
                    for (int bj = 0; bj < 2; ++bj) { const f32x4 v0 = acc[ai][bj][m][0] * rs * gv[bj][0], v1 = acc[ai][bj][m][1] * rs * gv[bj][1];
                        v4u w; w.x = pg8::cvt_pk_bf16(v0[0], v0[1]); w.y = pg8::cvt_pk_bf16(v0[2], v0[3]); w.z = pg8::cvt_pk_bf16(v1[0], v1[1]); w.w = pg8::cvt_pk_bf16(v1[2], v1[3]);
                        *(v4u*)(rowp + 32 * bj) = w; }
                }
        } else if (pn < 8) {
#pragma unroll
            for (int ai = 0; ai < 2; ++ai)
#pragma unroll
                for (int m = 0; m < 4; ++m) { bf16* rowp = P + (size_t)(row0 + ai * 128 + m * 16) * PP + pn * 256 + wc * 64 + 8 * fq;
#pragma unroll
                    for (int bj = 0; bj < 2; ++bj) { const f32x4 v0 = acc[ai][bj][m][0], v1 = acc[ai][bj][m][1];
                        v4u w; w.x = pg8::cvt_pk_bf16(v0[0], v0[1]); w.y = pg8::cvt_pk_bf16(v0[2], v0[3]); w.z = pg8::cvt_pk_bf16(v1[0], v1[1]); w.w = pg8::cvt_pk_bf16(v1[2], v1[3]);
                        *(v4u*)(rowp + 32 * bj) = w; } }
        } else {
#pragma unroll
            for (int ai = 0; ai < 2; ++ai)
#pragma unroll
                for (int m = 0; m < 4; ++m) { bf16* rowp = P + (size_t)(row0 + ai * 128 + m * 16) * PP + 2048 + (pn - 8) * 128 + wc * 32 + 8 * fq;
                    const f32x4 v0 = acc[ai][0][m][0] * acc[ai][1][m][0], v1 = acc[ai][0][m][1] * acc[ai][1][m][1];
                    v4u w; w.x = pg8::cvt_pk_bf16(v0[0], v0[1]); w.y = pg8::cvt_pk_bf16(v0[2], v0[3]); w.z = pg8::cvt_pk_bf16(v1[0], v1[1]); w.w = pg8::cvt_pk_bf16(v1[2], v1[3]);
                    *(v4u*)rowp = w; }
        }
    }
};
__device__ __forceinline__ void p_inproj0(const CAS Args& a, const Frame& F) {
    if (F.bid >= F.G - INP0_NC) { convert_experts(a, F, 0, 0, 2, (F.bid - (F.G - INP0_NC)) * NWAVES + F.wave, INP0_NC * NWAVES, CV_E1, NE); return; }
    pg8::RectSched S{(const char*)(a.ws + WS_H), (const char*)(a.ws + WS_WIN0), 2 * D, R / 256, 3072 / 256, F.G - INP0_NC, F.bid, 0, 0, 0, 0};
    EpiInProj0 E{(bf16*)(a.ws + WS_P), a.in[10], a.in[11]};
    pg8::gemm_phase<2 * D, false>(F.ldsl, S, E, F.wave);
}
typedef __bf16 bf16x2_t __attribute__((ext_vector_type(2)));
typedef float f32x2_t __attribute__((ext_vector_type(2)));
typedef short s16x4 __attribute__((ext_vector_type(4)));
__device__ __forceinline__ unsigned pk_bf16(float a, float b) { f32x2_t v = {a, b}; bf16x2_t r = __builtin_convertvector(v, bf16x2_t); return __builtin_bit_cast(unsigned, r); }
constexpr int AT_LAT = 0, AT_CK = 576 * 128, AT_CV = AT_CK + 256 * 128, AT_RPB = AT_CV + 256 * 128;
__device__ __forceinline__ int at_swz(int key) { return (key ^ (key >> 3)) & 7; }
__device__ __forceinline__ unsigned at_addr(int key, int chunk) { return (unsigned)(key * 128 + ((chunk ^ at_swz(key)) << 4)); }
template <class RowF>
__device__ __forceinline__ void at_stage(LAS unsigned char* dst, int npieces, RowF rowf, int colbyte, const bf16* P, int wave, int lane) {
    for (int p = wave; p < npieces; p += NWAVES) {
        const int key = 8 * p + (lane >> 3), c = (lane & 7) ^ at_swz(key);
        const char* src = (const char*)P + (size_t)rowf(key) * (PP * 2) + colbyte + 16 * c;
        __builtin_amdgcn_global_load_lds((const unsigned*)src, (LAS unsigned*)(dst + p * 1024), 16, 0, 0);
    }
}
__device__ __forceinline__ void at_tr8(unsigned a0, unsigned a1, unsigned a2, unsigned a3, unsigned a4, unsigned a5, unsigned a6, unsigned a7, s16x4 (&r)[8]) {
    asm volatile("ds_read_b64_tr_b16 %0, %8\n\tds_read_b64_tr_b16 %1, %9\n\tds_read_b64_tr_b16 %2, %10\n\tds_read_b64_tr_b16 %3, %11\n\t"
                 "ds_read_b64_tr_b16 %4, %12\n\tds_read_b64_tr_b16 %5, %13\n\tds_read_b64_tr_b16 %6, %14\n\tds_read_b64_tr_b16 %7, %15\n\ts_waitcnt lgkmcnt(0)"
                 : "=&v"(r[0]), "=&v"(r[1]), "=&v"(r[2]), "=&v"(r[3]), "=&v"(r[4]), "=&v"(r[5]), "=&v"(r[6]), "=&v"(r[7])
                 : "v"(a0), "v"(a1), "v"(a2), "v"(a3), "v"(a4), "v"(a5), "v"(a6), "v"(a7) : "memory");
}
__device__ __forceinline__ void p_attn(const CAS Args& a, const Frame& F) {
    const bf16* P = (const bf16*)(a.ws + WS_P); bf16* A2 = (bf16*)(a.ws + WS_A2);
    LAS unsigned char* lds = F.ldsl;
    const int lane = F.lane, wave = F.wave, rho = lane & 15, g = lane >> 4;
    for (int wu = F.bid; wu < NB * 8 * 2; wu += F.G) {
        const int half = wu & 1, hd = (wu >> 1) & 7, b = wu >> 4;
        __syncthreads();
        for (int i = F.tid; i < 465; i += NWAVES * 64) ((LAS float*)(lds + AT_RPB))[i] = a.in[12][hd * 465 + i];
        at_stage(lds + AT_CK, 32, [=](int key) { return NT + b * 256 + key; }, (512 + hd * 64) * 2, P, wave, lane);
        at_stage(lds + AT_CV, 32, [=](int key) { return NT + b * 256 + key; }, (1024 + hd * 64) * 2, P, wave, lane);
        for (int un = 0; un < 9; ++un) {
            const bool lat = un < 8;
            int r = 0, n = 0, qrow, krow_lo = 0;
            if (lat) { const int rp = half * 8 + un; r = 2 * rp + (wave >> 2); n = wave & 3; qrow = b * 2048 + r * 64 + 16 * n + rho; krow_lo = min(max(2 * rp - 4, 0), 24); }
            else qrow = NT + b * 256 + half * 128 + 16 * wave + rho;
            const int r0 = min(max(r - 4, 0), 24), ro = r0 - krow_lo, kc0 = min(max(16 * n - 8, 0), 32);
            const int c = 16 * n + rho, c0 = min(max(c - 8, 0), 48);
            if (lat) at_stage(lds + AT_LAT, 72, [=](int key) { return b * 2048 + min(krow_lo + (key >> 6), 31) * 64 + (key & 63); }, (512 + hd * 64) * 2, P, wave, lane);
            const bf16x8 q0 = *(const bf16x8*)(P + (size_t)qrow * PP + hd * 64 + 8 * g), q1 = *(const bf16x8*)(P + (size_t)qrow * PP + hd * 64 + 32 + 8 * g);
            asm volatile("s_waitcnt vmcnt(0)" ::: "memory");
            __syncthreads();
            const int pk = 8 * (rho >> 2) + (rho & 3);
            float mxb[2] = {-1e30f, -1e30f}, smb[2] = {0.f, 0.f}; v4u pf[16];
#pragma unroll
            for (int blk = 0; blk < 2; ++blk) {
                if (blk == 0 && !lat) {
#pragma unroll
                    for (int i = 0; i < 8; ++i) pf[i] = (v4u){0u, 0u, 0u, 0u};
                    continue; }
                f32x4 s[16];
#pragma unroll
                for (int i = 0; i < 8; ++i)
#pragma unroll
                    for (int t = 0; t < 2; ++t) {
                        const int key = (blk == 0 ? (ro + i) * 64 + kc0 : 32 * i) + pk + 4 * t;
                        const unsigned kbase = blk == 0 ? AT_LAT : AT_CK;
                        const bf16x8 k0 = *(const LAS bf16x8*)(lds + kbase + at_addr(key, g)), k1 = *(const LAS bf16x8*)(lds + kbase + at_addr(key, 4 + g));
                        f32x4 acc = __builtin_amdgcn_mfma_f32_16x16x32_bf16(k0, q0, (f32x4){0.f, 0.f, 0.f, 0.f}, 0, 0, 0);
                        acc = __builtin_amdgcn_mfma_f32_16x16x32_bf16(k1, q1, acc, 0, 0, 0);
                        if (blk == 0) {
                            const int dr = r0 + i - r + 7;
#pragma unroll
                            for (int jj = 0; jj < 4; ++jj) { const int kcol = kc0 + 8 * g + 4 * t + jj; const int dc = min(max(kcol - c + 15, 0), 30);
                                const float bias = ((const LAS float*)(lds + AT_RPB))[dr * 31 + dc];
                                acc[jj] = ((unsigned)(kcol - c0) < 16u) ? acc[jj] + bias : -1e30f; }
                        }
                        s[2 * i + t] = acc;
                    }
                float mx = -1e30f;
#pragma unroll
                for (int i = 0; i < 16; ++i) mx = fmaxf(fmaxf(mx, fmaxf(s[i][0], s[i][1])), fmaxf(s[i][2], s[i][3]));
                mx = fmaxf(mx, __shfl_xor(mx, 16)); mx = fmaxf(mx, __shfl_xor(mx, 32));
                float sum = 0.f;
#pragma unroll
                for (int i = 0; i < 8; ++i) {
                    float e[8];
#pragma unroll
                    for (int t = 0; t < 2; ++t)
#pragma unroll
                        for (int jj = 0; jj < 4; ++jj) { e[4 * t + jj] = __expf(s[2 * i + t][jj] - mx); sum += e[4 * t + jj]; }
                    pf[8 * blk + i].x = pk_bf16(e[0], e[1]); pf[8 * blk + i].y = pk_bf16(e[2], e[3]); pf[8 * blk + i].z = pk_bf16(e[4], e[5]); pf[8 * blk + i].w = pk_bf16(e[6], e[7]);
                }
                sum += __shfl_xor(sum, 16); sum += __shfl_xor(sum, 32);
                mxb[blk] = mx; smb[blk] = sum;
            }
            __syncthreads();
            if (lat) at_stage(lds + AT_LAT, 72, [=](int key) { return b * 2048 + min(krow_lo + (key >> 6), 31) * 64 + (key & 63); }, (1024 + hd * 64) * 2, P, wave, lane);
            asm volatile("s_waitcnt vmcnt(0)" ::: "memory");
            __syncthreads();
            f32x4 o[2][4];
#pragma unroll
            for (int blk = 0; blk < 2; ++blk)
#pragma unroll
                for (int db = 0; db < 4; ++db) o[blk][db] = (f32x4){0.f, 0.f, 0.f, 0.f};
            const int tq = rho >> 2, tp = rho & 3;
#pragma unroll
            for (int ch = 0; ch < 16; ++ch) {
                if (ch < 8 && !lat) continue;
                int zo = 0; asm volatile("" : "+v"(zo));
                const int kb = (ch < 8 ? (ro + ch) * 64 + kc0 + 8 * g + tq : 32 * (ch - 8) + 8 * g + tq) + zo;
                const unsigned base = (unsigned)(size_t)(lds + (ch < 8 ? AT_LAT : AT_CV));
                unsigned ad[8];
#pragma unroll
                for (int db = 0; db < 4; ++db) { ad[2 * db] = base + at_addr(kb, 2 * db + (tp >> 1)) + 8 * (tp & 1); ad[2 * db + 1] = base + at_addr(kb + 4, 2 * db + (tp >> 1)) + 8 * (tp & 1); }
                s16x4 vr[8]; at_tr8(ad[0], ad[1], ad[2], ad[3], ad[4], ad[5], ad[6], ad[7], vr);
#pragma unroll
                for (int db = 0; db < 4; ++db) { const bf16x8 vf = __builtin_shufflevector(vr[2 * db], vr[2 * db + 1], 0, 1, 2, 3, 4, 5, 6, 7);
                    o[ch >> 3][db] = __builtin_amdgcn_mfma_f32_16x16x32_bf16(vf, __builtin_bit_cast(bf16x8, pf[ch]), o[ch >> 3][db], 0, 0, 0); }
            }
            const float mxa = fmaxf(mxb[0], mxb[1]), f0 = __expf(mxb[0] - mxa), f1 = __expf(mxb[1] - mxa);
            const float inv = 1.0f / (f0 * smb[0] + f1 * smb[1]), g0 = f0 * inv, g1 = f1 * inv;
#pragma unroll
            for (int db = 0; db < 4; ++db) { uint2 w; w.x = pk_bf16(o[0][db][0] * g0 + o[1][db][0] * g1, o[0][db][1] * g0 + o[1][db][1] * g1); w.y = pk_bf16(o[0][db][2] * g0 + o[1][db][2] * g1, o[0][db][3] * g0 + o[1][db][3] * g1);
                *(uint2*)(A2 + (size_t)qrow * D + hd * 64 + 16 * db + 4 * g) = w; }
            __syncthreads();
        }
    }
    const float* cw = a.in[13]; const float* cb = a.in[14];
    const int j0 = 8 * lane;
    float w0[8], w1[8], w2[8], bb[8];
#pragma unroll
    for (int q = 0; q < 8; ++q) { w0[q] = cw[j0 + q]; w1[q] = cw[512 + j0 + q]; w2[q] = cw[1024 + j0 + q]; bb[q] = cb[j0 + q]; }
    for (int blk = F.gw; blk < R / 6; blk += F.ngw) {
        const int row0 = 6 * blk;
        v4u pw[8], bgw[6];
#pragma unroll
        for (int k = 0; k < 8; ++k) { const int rr = row0 + k - 1; pw[k] = (rr >= 0 && rr < R) ? *(const v4u*)(P + (size_t)rr * PP + 2048 + j0) : (v4u){0u, 0u, 0u, 0u}; }
#pragma unroll
        for (int k = 0; k < 6; ++k) bgw[k] = *(const v4u*)(P + (size_t)(row0 + k) * PP + 1536 + j0);
#pragma unroll
        for (int k = 0; k < 6; ++k) {
            const int row = row0 + k; const bool latr = row < NT; const int t = latr ? (row & 2047) : ((row - NT) & 255), len = latr ? 2048 : 256;
            const v4u pm = t > 0 ? pw[k] : (v4u){0u, 0u, 0u, 0u}, pc = pw[k + 1], pn = (t + 1 < len) ? pw[k + 2] : (v4u){0u, 0u, 0u, 0u}, bgv = bgw[k];
            const unsigned am[4] = {pm.x, pm.y, pm.z, pm.w}, ac[4] = {pc.x, pc.y, pc.z, pc.w}, an[4] = {pn.x, pn.y, pn.z, pn.w}, ab[4] = {bgv.x, bgv.y, bgv.z, bgv.w};
            unsigned ow[4];
#pragma unroll
            for (int q = 0; q < 4; ++q) {
                const float lo = __uint_as_float(ab[q] << 16) * (bb[2 * q] + w0[2 * q] * __uint_as_float(am[q] << 16) + w1[2 * q] * __uint_as_float(ac[q] << 16) + w2[2 * q] * __uint_as_float(an[q] << 16));
                const float hi = __uint_as_float(ab[q] & 0xffff0000u) * (bb[2 * q + 1] + w0[2 * q + 1] * __uint_as_float(am[q] & 0xffff0000u) + w1[2 * q + 1] * __uint_as_float(ac[q] & 0xffff0000u) + w2[2 * q + 1] * __uint_as_float(an[q] & 0xffff0000u));
                ow[q] = pk_bf16(lo, hi);
            }
            *(v4u*)(A2 + (size_t)row * D + 512 + j0) = (v4u){ow[0], ow[1], ow[2], ow[3]};
        }
    }
}
template <int L>
struct EpiOutProj {
    static constexpr bool PERM = true;
    const float* baseL; const float* baseC; bf16* XB; const float* MODl;
    __device__ __forceinline__ void operator()(const f32x4 (&acc)[2][2][4][2], const pg8::Unit& u, int wr, int wc, int fr, int fq) const {
        const bool lat = u.pm < NT / 256;
        const int mb = lat ? (u.pm >> 3) : 16;
        const int row0 = u.pm * 256 + wr * 64 + fr, col0 = u.pn * 256 + wc * 32 + 8 * fq;
        const float* g1 = MODl + (size_t)mb * 6144 + 2 * D + col0;
        f32x4 gv[2][2];
#pragma unroll
        for (int bj = 0; bj < 2; ++bj)
#pragma unroll
            for (int n = 0; n < 2; ++n) gv[bj][n] = *(const f32x4*)(g1 + bj * 128 + 4 * n);
#pragma unroll
        for (int ai = 0; ai < 2; ++ai)
#pragma unroll
            for (int m = 0; m < 4; ++m) { const int row = row0 + ai * 128 + m * 16;
#pragma unroll
                for (int bj = 0; bj < 2; ++bj) {
                    f32x4 b0, b1;
                    if (L == 0) { const float* bp = (lat ? baseL + (size_t)row * D : baseC + (size_t)(row - NT) * D) + col0 + bj * 128; b0 = *(const f32x4*)bp; b1 = *(const f32x4*)(bp + 4); }
                    else { const v4u w = *(const v4u*)(XB + (size_t)row * D + col0 + bj * 128);
                        b0 = (f32x4){__uint_as_float(w.x << 16), __uint_as_float(w.x & 0xffff0000u), __uint_as_float(w.y << 16), __uint_as_float(w.y & 0xffff0000u)};
                        b1 = (f32x4){__uint_as_float(w.z << 16), __uint_as_float(w.z & 0xffff0000u), __uint_as_float(w.w << 16), __uint_as_float(w.w & 0xffff0000u)}; }
                    const f32x4 v0 = b0 + gv[bj][0] * acc[ai][bj][m][0], v1 = b1 + gv[bj][1] * acc[ai][bj][m][1];
                    v4u o; o.x = pg8::cvt_pk_bf16(v0[0], v0[1]); o.y = pg8::cvt_pk_bf16(v0[2], v0[3]); o.z = pg8::cvt_pk_bf16(v1[0], v1[1]); o.w = pg8::cvt_pk_bf16(v1[2], v1[3]);
                    *(v4u*)(XB + (size_t)row * D + col0 + bj * 128) = o; }
                asm volatile("" ::: "memory"); }
    }
};
template <int L>
__device__ __forceinline__ void p_outproj(const CAS Args& a, const Frame& F) {
    const int nc = L == 0 ? OUTP0_NC : 0;
    if (F.bid >= F.G - nc) { convert_experts(a, F, 0, 0, 2, (F.bid - (F.G - nc)) * NWAVES + F.wave, nc * NWAVES, CV_E0, CV_E1); return; }
    pg8::RectSched S{(const char*)(a.ws + (L == 0 ? WS_A2 : WS_A3)), (const char*)(a.ws + (L == 0 ? WS_WOUT0 : WS_WOUT1)), 2 * D, (L == 0 ? R : NT) / 256, D / 256, F.G - nc, F.bid, 0, 0, 0, 0};
    EpiOutProj<L> E{a.in[0], a.in[2], (bf16*)(a.ws + WS_XB), (const float*)(a.ws + WS_MOD) + (size_t)L * 17 * 6144};
    pg8::gemm_phase<2 * D, false>(F.ldsl, S, E, F.wave);
}
#define RS_STEP(half, m) do { const bool up = (F.lane & (m)) != 0; _Pragma("unroll") for (int i = 0; i < (half); ++i) { \
        const float keep = up ? part[i + (half)] : part[i]; const float send = up ? part[i] : part[i + (half)]; part[i] = keep + __shfl_xor(send, (m)); } } while (0)
constexpr int RT_WH = 0, RT_WL = 65536, RT_GS = 131072, RT_LG = 139264, RT_CNT = 155648;
__device__ __forceinline__ void p_norm2_router(const CAS Args& a, const Frame& F, int l) {
    unsigned char* H8 = (unsigned char*)(a.ws + WS_H); const bf16* XB = (const bf16*)(a.ws + WS_XB);
    unsigned* ctl = (unsigned*)(a.ws + WS_CTL);
    int* toklist = (int*)(a.ws + WS_TOKLIST); int* sel = (int*)(a.ws + WS_SEL); float* gatev = (float*)(a.ws + WS_GATEV);
    const float* wr = a.in[29] + (size_t)l * D * NE; const float* br = a.in[30] + l * NE;
    const float* GS2 = (const float*)(a.ws + WS_GS2) + (size_t)l * 17 * D; const float* MODl = (const float*)(a.ws + WS_MOD) + (size_t)l * 17 * 6144;
    const int rows = l == 0 ? R : NT, rpw = rows / F.G, row_lo = F.bid * rpw, nblk = rpw / 16;
    LAS unsigned char* lds = F.ldsl;
    const int lane = F.lane, wave = F.wave, rho = lane & 15, g = lane >> 4;
    const int b_first = row_batch(row_lo);
    __syncthreads();
    {
        f32x4 wv[16];
#pragma unroll
        for (int j = 0; j < 16; ++j) wv[j] = *(const f32x4*)(wr + 4 * (F.tid + 512 * j));
#pragma unroll
        for (int j = 0; j < 16; ++j) { const int i0 = 4 * (F.tid + 512 * j), k = i0 >> 5;
#pragma unroll
            for (int q = 0; q < 4; ++q) { const int e = (i0 & 31) + q; const float w = wv[j][q]; const bf16 hi = f2bf(w), lo = f2bf(w - bf2f(hi));
                const int off = e * 2048 + 16 * ((k >> 3) ^ (e & 15)) + 2 * (k & 7);
                *(LAS bf16*)(lds + RT_WH + off) = hi; *(LAS bf16*)(lds + RT_WL + off) = lo; } }
    }
    for (int i = F.tid; i < 2 * D; i += NWAVES * 64) { const int s = i >> 10, k = i & 1023; const int bb = s == 0 ? b_first : row_batch(row_lo + rpw - 1); ((LAS float*)(lds + RT_GS))[i] = GS2[bb * D + k]; }
    LAS unsigned* wcnt = (LAS unsigned*)(lds + RT_CNT); LAS unsigned* wbase = wcnt + 32; LAS unsigned* stmp = wcnt + 64;
    if (F.tid < NE) wcnt[F.tid] = 0u;
    __syncthreads();
    for (int blk = wave; blk < nblk; blk += NWAVES) {
        const int r0 = row_lo + 16 * blk, row = r0 + rho, bb = row_batch(r0);
        const bf16* xr = XB + (size_t)row * D + 8 * g;
        float ss = 0.f;
#pragma unroll
        for (int kh = 0; kh < 2; ++kh) {
            v4u xw[16];
#pragma unroll
            for (int ks = 0; ks < 16; ++ks) xw[ks] = *(const v4u*)(xr + 32 * (16 * kh + ks));
#pragma unroll
            for (int ks = 0; ks < 16; ++ks) { const unsigned u4[4] = {xw[ks].x, xw[ks].y, xw[ks].z, xw[ks].w};
#pragma unroll
                for (int q = 0; q < 4; ++q) { const float x0 = __uint_as_float(u4[q] << 16), x1 = __uint_as_float(u4[q] & 0xffff0000u); ss += x0 * x0 + x1 * x1; } }
            asm volatile("" ::: "memory");
        }
        ss += __shfl_xor(ss, 16); ss += __shfl_xor(ss, 32);
        const float rstd = rsqrtf(ss * (1.0f / D) + 1e-6f);
        const LAS float* gs = (const LAS float*)(lds + RT_GS) + (bb == b_first ? 0 : D) + 8 * g;
        const float* sh = MODl + (size_t)bb * 6144 + 3 * D + 8 * g;
        f32x4 acc[2] = {(f32x4){0.f, 0.f, 0.f, 0.f}, (f32x4){0.f, 0.f, 0.f, 0.f}};
        int offb[4];
#pragma unroll
        for (int b4 = 0; b4 < 4; ++b4) offb[b4] = rho * 2048 + (((4 * (b4 ^ ((rho >> 2) & 3))) + (g ^ (rho & 3))) << 4);
        for (int k4 = 0; k4 < 8; ++k4) {
            v4u xw[4]; f32x4 sv[4][2];
#pragma unroll
            for (int b4 = 0; b4 < 4; ++b4) { const int ks = 4 * k4 + b4; xw[b4] = *(const v4u*)(xr + 32 * ks); sv[b4][0] = *(const f32x4*)(sh + 32 * ks); sv[b4][1] = *(const f32x4*)(sh + 32 * ks + 4); }
#pragma unroll
            for (int b4 = 0; b4 < 4; ++b4) {
                const int ks = 4 * k4 + b4;
                const unsigned u4[4] = {xw[b4].x, xw[b4].y, xw[b4].z, xw[b4].w};
                const f32x4 g0 = *(const LAS f32x4*)(gs + 32 * ks), g1 = *(const LAS f32x4*)(gs + 32 * ks + 4);
                const f32x4 s0 = sv[b4][0], s1 = sv[b4][1];
                float hv[8];
#pragma unroll
                for (int q = 0; q < 4; ++q) { const float x0 = __uint_as_float(u4[q] << 16) * rstd, x1 = __uint_as_float(u4[q] & 0xffff0000u) * rstd;
                    const float gg0 = q < 2 ? g0[2 * q] : g1[2 * q - 4], gg1 = q < 2 ? g0[2 * q + 1] : g1[2 * q - 3], t0 = q < 2 ? s0[2 * q] : s1[2 * q - 4], t1 = q < 2 ? s0[2 * q + 1] : s1[2 * q - 3];
                    hv[2 * q] = x0 * gg0 + t0; hv[2 * q + 1] = x1 * gg1 + t1; }
                v4u hi, lo;
#pragma unroll
                for (int q = 0; q < 4; ++q) { const unsigned p = pk_bf16(hv[2 * q], hv[2 * q + 1]); ((unsigned*)&hi)[q] = p;
                    ((unsigned*)&lo)[q] = pk_bf16(hv[2 * q] - __uint_as_float(p << 16), hv[2 * q + 1] - __uint_as_float(p & 0xffff0000u)); }
                { uint2 f8; unsigned t0 = 0u, t1 = 0u; t0 = __builtin_amdgcn_cvt_pk_fp8_f32(hv[0], hv[1], t0, false); t0 = __builtin_amdgcn_cvt_pk_fp8_f32(hv[2], hv[3], t0, true);
                  t1 = __builtin_amdgcn_cvt_pk_fp8_f32(hv[4], hv[5], t1, false); t1 = __builtin_amdgcn_cvt_pk_fp8_f32(hv[6], hv[7], t1, true); f8.x = t0; f8.y = t1;
                  *(uint2*)(H8 + (size_t)row * D + 32 * ks + 8 * g) = f8; }
#pragma unroll
                for (int nt = 0; nt < 2; ++nt) { const int off = nt * 32768 + k4 * 256 + offb[b4];
                    const bf16x8 bh = *(const LAS bf16x8*)(lds + RT_WH + off), bl = *(const LAS bf16x8*)(lds + RT_WL + off);
                    acc[nt] = __builtin_amdgcn_mfma_f32_16x16x32_bf16(__builtin_bit_cast(bf16x8, hi), bh, acc[nt], 0, 0, 0);
                    acc[nt] = __builtin_amdgcn_mfma_f32_16x16x32_bf16(__builtin_bit_cast(bf16x8, lo), bh, acc[nt], 0, 0, 0);
                    acc[nt] = __builtin_amdgcn_mfma_f32_16x16x32_bf16(__builtin_bit_cast(bf16x8, hi), bl, acc[nt], 0, 0, 0); }
            }
        }
        LAS float* lg = (LAS float*)(lds + RT_LG + wave * 2048);
#pragma unroll
        for (int nt = 0; nt < 2; ++nt)
#pragma unroll
            for (int jj = 0; jj < 4; ++jj) lg[(4 * g + jj) * 32 + 16 * nt + rho] = acc[nt][jj] + br[16 * nt + rho];
        {
            float mine[8], allv[32];
#pragma unroll
            for (int q = 0; q < 8; ++q) { const f32x4 t = *(const LAS f32x4*)(lg + rho * 32 + 4 * q); allv[4 * q] = t[0]; allv[4 * q + 1] = t[1]; allv[4 * q + 2] = t[2]; allv[4 * q + 3] = t[3]; }
#pragma unroll
            for (int q = 0; q < 8; ++q) mine[q] = g == 0 ? allv[q] : g == 1 ? allv[8 + q] : g == 2 ? allv[16 + q] : allv[24 + q];
            LAS float* rs = lg;
#pragma unroll
            for (int q = 0; q < 8; ++q) { const int e = 8 * g + q; int rank = 0;
#pragma unroll
                for (int jx = 0; jx < 32; ++jx) rank += (allv[jx] > mine[q] || (allv[jx] == mine[q] && jx < e)) ? 1 : 0;
                if (rank < 4) { rs[(rho * 4 + rank) * 2] = mine[q]; ((LAS int*)rs)[(rho * 4 + rank) * 2 + 1] = e; } }
            if (lane < 16) {
                const f32x4 q0 = *(const LAS f32x4*)(rs + lane * 8), q1 = *(const LAS f32x4*)(rs + lane * 8 + 4);
                const float tv0 = q0[0], tv1 = q0[2], tv2 = q1[0], tv3 = q1[2]; const int ti[4] = {__float_as_int(q0[1]), __float_as_int(q0[3]), __float_as_int(q1[1]), __float_as_int(q1[3])};
                const float e1 = __expf(tv1 - tv0), e2 = __expf(tv2 - tv0), e3 = __expf(tv3 - tv0), inv = 1.0f / (1.0f + e1 + e2 + e3);
                const float gk[4] = {inv, e1 * inv, e2 * inv, e3 * inv};
                const int rl = 16 * blk + lane;
#pragma unroll
                for (int k = 0; k < 4; ++k) { const unsigned p = __hip_atomic_fetch_add(wcnt + ti[k], 1u, __ATOMIC_RELAXED, __HIP_MEMORY_SCOPE_WORKGROUP);
                    stmp[(rl * 4 + k) * 2] = (p << 5) | (unsigned)ti[k]; stmp[(rl * 4 + k) * 2 + 1] = __float_as_uint(gk[k]); }
            }
        }
    }
    __syncthreads();
    if (F.tid < NE) { const unsigned c = wcnt[F.tid]; wbase[F.tid] = c ? __hip_atomic_fetch_add(ctl + CW_CNT + (l * 32 + F.tid) * 64, c, RLX_AGENT) : 0u; }
    __syncthreads();
    for (int i = F.tid; i < rpw * 4; i += NWAVES * 64) { const int rl = i >> 2, k = i & 3, r = row_lo + rl; const unsigned pe = stmp[i * 2], e = pe & 31u, pos = wbase[e] + (pe >> 5);
        toklist[(size_t)e * CAP + pos] = r; sel[r * 4 + k] = (int)((pos << 5) | e); gatev[r * 4 + k] = __uint_as_float(stmp[i * 2 + 1]); }
}
struct MoeTab { int cnt[NE], base[NE + 1], tpre[NE + 1]; };
__device__ __forceinline__ void moe_tab_build(const CAS Args& a, const Frame& F, int l, LAS MoeTab* tb) {
    unsigned* ctl = (unsigned*)(a.ws + WS_CTL);
    __syncthreads();
    if (F.tid < NE) tb->cnt[F.tid] = (int)__hip_atomic_load(ctl + CW_CNT + (l * 32 + F.tid) * 64, RLX_AGENT);
    __syncthreads();
    if (F.tid == 0) { int bs = 0, tp = 0; for (int e = 0; e < NE; ++e) { const int c = tb->cnt[e]; tb->base[e] = bs; tb->tpre[e] = tp; bs += c; tp += (c + 255) >> 8; } tb->base[NE] = bs; tb->tpre[NE] = tp; }
    __syncthreads();
}
constexpr int MOE_UT_MAX = 64;
template <bool UP>
struct MoeSched {
    static constexpr bool GATHER = UP;
    const LAS MoeTab* tb; const LAS int* ut; const char* A; const char* WE; const int* toklist; int G, c;
    static constexpr int NN = UP ? 8 : 4;
    static __device__ __forceinline__ int rfl(int v) { return __builtin_amdgcn_readfirstlane(v); }
    static __device__ __forceinline__ const char* ufy(const char* p) { const unsigned long long v = (unsigned long long)p; const unsigned lo = __builtin_amdgcn_readfirstlane((unsigned)v), hi = __builtin_amdgcn_readfirstlane((unsigned)(v >> 32)); return (const char*)(((unsigned long long)hi << 32) | lo); }
    __device__ __forceinline__ bool unit_search(int i, int& pm, int& pn, int& e_, int& rows, int& base) const {
        const int nwg = tb->tpre[NE] * NN; const long L = (long)i * G + c; if (L >= nwg) return false;
        const int w = pg8::xcd_remap(L, nwg);
        int e = 0; while (e < NE - 1 && w >= tb->tpre[e + 1] * NN) ++e;
        const int tp0 = tb->tpre[e], tp1 = tb->tpre[e + 1];
        const int q = w - tp0 * NN, nte = tp1 - tp0;
        const int nig = 8 * NN, gid = q / nig, fm = gid * 8, gsz = (nte - fm) < 8 ? (nte - fm) : 8;
        pm = fm + ((q % nig) % gsz); pn = (q % nig) / gsz; e_ = e; rows = min(256, tb->cnt[e] - pm * 256); base = tb->base[e] + pm * 256;
        return true;
    }
    __device__ __forceinline__ void build(LAS int* utw, int tid) const {
        if (tid < MOE_UT_MAX) { int pm = -1, pn = 0, e = 0, rows = 0, base = 0; unit_search(tid, pm, pn, e, rows, base);
            utw[tid * 8 + 0] = pm; utw[tid * 8 + 1] = pn; utw[tid * 8 + 2] = e; utw[tid * 8 + 3] = rows; utw[tid * 8 + 4] = base; }
    }
    __device__ __forceinline__ bool unit(int i, pg8::Unit& u) const {
        if (i >= MOE_UT_MAX) return false;
        const LAS int* p = ut + i * 8; const int pm = rfl(p[0]); if (pm < 0) return false;
        u.pm = pm; u.pn = rfl(p[1]); u.e = rfl(p[2]); u.rows = rfl(p[3]); u.base = rfl(p[4]); u.newe = (i == 0) || (rfl(p[2 - 8]) != u.e);
        return true;
    }
    __device__ __forceinline__ bool bases(int i, const char*& a, const char*& b) const {
        pg8::Unit u; if (!unit(i, u)) return false;
        a = UP ? A : A + (size_t)u.base * D;
        b = WE + (size_t)u.e * 3072 * 1024 + (UP ? 0 : (size_t)2048 * 1024) + (size_t)u.pn * 256 * 1024;
        a = ufy(a); b = ufy(b);
        return true;
    }
    __device__ __forceinline__ void atoks(int i, const int (&rA)[2], int (&tok)[2][2]) const {
        pg8::Unit u; unit(i, u);
        const int* tl = toklist + (size_t)u.e * CAP + u.pm * 256;
#pragma unroll
        for (int h = 0; h < 2; ++h)
#pragma unroll
            for (int i2 = 0; i2 < 2; ++i2) { const int rr = h * 128 + rA[i2]; tok[h][i2] = tl[rr < u.rows ? rr : 0]; }
    }
    __device__ __forceinline__ void aoffs(int i, const int (&rA)[2], const unsigned (&voffA)[2], unsigned (&off)[2][2]) const {
        pg8::Unit u; unit(i, u);
        const int* tl = toklist + (size_t)u.e * CAP + u.pm * 256;
#pragma unroll
        for (int h = 0; h < 2; ++h)
#pragma unroll
            for (int i2 = 0; i2 < 2; ++i2) { const int rr = h * 128 + rA[i2]; const int tok = tl[rr < u.rows ? rr : 0]; off[h][i2] = (unsigned)tok * (unsigned)D + voffA[i2]; }
    }
};
struct EpiMoeUp {
    static constexpr bool PERM = true;
    bf16* ACT; const float* bgate; const float* bup; LAS float* btab;
    __device__ __forceinline__ void operator()(const f32x4 (&acc)[2][2][4][2], const pg8::Unit& u, int wr, int wc, int fr, int fq) const {
        const int col0 = u.pn * 128 + wc * 32 + 8 * fq, rl0 = wr * 64 + fr;
        if (u.newe) { const int tid = (wr * 4 + wc) * 64 + fr + 16 * fq;
            const f32x4 t = *(const f32x4*)((tid < 256 ? bgate : bup) + u.e * D + 4 * (tid & 255));
            *(LAS f32x4*)(btab + 4 * tid) = t;
            asm volatile("s_waitcnt lgkmcnt(0)" ::: "memory"); __builtin_amdgcn_s_barrier(); asm volatile("" ::: "memory"); }
        f32x2_t bg[2][2], bu[2][2];
#pragma unroll
        for (int n = 0; n < 2; ++n) { const f32x4 g4 = *(const LAS f32x4*)(btab + col0 + 4 * n), u4 = *(const LAS f32x4*)(btab + 1024 + col0 + 4 * n);
            bg[n][0] = (f32x2_t){g4[0], g4[1]}; bg[n][1] = (f32x2_t){g4[2], g4[3]};
            bu[n][0] = (f32x2_t){u4[0], u4[1]} * ACT8_SCALE + ACT8_SCALE; bu[n][1] = (f32x2_t){u4[2], u4[3]} * ACT8_SCALE + ACT8_SCALE; }
#pragma unroll
        for (int ai = 0; ai < 2; ++ai)
#pragma unroll
            for (int m = 0; m < 4; ++m) { const int rl = rl0 + ai * 128 + m * 16;
                f32x2_t o[2][2];
#pragma unroll
                for (int n = 0; n < 2; ++n)
#pragma unroll
                    for (int p = 0; p < 2; ++p) {
                        f32x2_t gg = (f32x2_t){acc[ai][0][m][n][2 * p], acc[ai][0][m][n][2 * p + 1]} * (1.0f / W8_SCALE) + bg[n][p];
                        gg.x = fminf(gg.x, 7.0f); gg.y = fminf(gg.y, 7.0f);
                        const f32x2_t tt = gg * (-1.702f * 1.44269504f);
                        f32x2_t dd; dd.x = __builtin_amdgcn_exp2f(tt.x); dd.y = __builtin_amdgcn_exp2f(tt.y); dd = dd + 1.0f;
                        f32x2_t rr; rr.x = __builtin_amdgcn_rcpf(dd.x); rr.y = __builtin_amdgcn_rcpf(dd.y);
                        f32x2_t uu = (f32x2_t){acc[ai][1][m][n][2 * p], acc[ai][1][m][n][2 * p + 1]} * (ACT8_SCALE / W8_SCALE) + bu[n][p];
                        uu.x = __builtin_amdgcn_fmed3f(uu.x, -6.0f * ACT8_SCALE, 8.0f * ACT8_SCALE); uu.y = __builtin_amdgcn_fmed3f(uu.y, -6.0f * ACT8_SCALE, 8.0f * ACT8_SCALE);
                        o[n][p] = (gg * rr) * uu;
                    }
                if (rl < u.rows) { uint2 w; unsigned w0 = 0u, w1 = 0u;
                    w0 = __builtin_amdgcn_cvt_pk_fp8_f32(o[0][0].x, o[0][0].y, w0, false); w0 = __builtin_amdgcn_cvt_pk_fp8_f32(o[0][1].x, o[0][1].y, w0, true);
                    w1 = __builtin_amdgcn_cvt_pk_fp8_f32(o[1][0].x, o[1][0].y, w1, false); w1 = __builtin_amdgcn_cvt_pk_fp8_f32(o[1][1].x, o[1][1].y, w1, true);
                    w.x = w0; w.y = w1;
                    *(uint2*)((unsigned char*)ACT + (size_t)(u.base + rl) * D + col0) = w; } }
    }
};
struct EpiMoeDown {
    static constexpr bool PERM = true;
    unsigned char* YB; const float* bdown; LAS float* btab;
    __device__ __forceinline__ void operator()(const f32x4 (&acc)[2][2][4][2], const pg8::Unit& u, int wr, int wc, int fr, int fq) const {
        const int col0 = u.pn * 256 + wc * 64 + 16 * fq, rl0 = wr * 64 + fr;
        if (u.newe) { const int tid = (wr * 4 + wc) * 64 + fr + 16 * fq;
            if (tid < 256) { const f32x4 t = *(const f32x4*)(bdown + u.e * D + 4 * tid); *(LAS f32x4*)(btab + 4 * tid) = t; }
            asm volatile("s_waitcnt lgkmcnt(0)" ::: "memory"); __builtin_amdgcn_s_barrier(); asm volatile("" ::: "memory"); }
        f32x4 bv[2][2];
#pragma unroll
        for (int bj = 0; bj < 2; ++bj)
#pragma unroll
            for (int n = 0; n < 2; ++n) bv[bj][n] = *(const LAS f32x4*)(btab + col0 + 8 * bj + 4 * n) * YB8_SCALE;
#pragma unroll
        for (int ai = 0; ai < 2; ++ai)
#pragma unroll
            for (int m = 0; m < 4; ++m) { const int rl = rl0 + ai * 128 + m * 16;
                if (rl < u.rows) { v4u w;
                    { const f32x4 v = acc[ai][0][m][0] * (YB8_SCALE / (W8_SCALE * ACT8_SCALE)) + bv[0][0]; w.x = pk4_fp8(v[0], v[1], v[2], v[3]); }
                    { const f32x4 v = acc[ai][0][m][1] * (YB8_SCALE / (W8_SCALE * ACT8_SCALE)) + bv[0][1]; w.y = pk4_fp8(v[0], v[1], v[2], v[3]); }
                    { const f32x4 v = acc[ai][1][m][0] * (YB8_SCALE / (W8_SCALE * ACT8_SCALE)) + bv[1][0]; w.z = pk4_fp8(v[0], v[1], v[2], v[3]); }
                    { const f32x4 v = acc[ai][1][m][1] * (YB8_SCALE / (W8_SCALE * ACT8_SCALE)) + bv[1][1]; w.w = pk4_fp8(v[0], v[1], v[2], v[3]); }
                    *(v4u*)(YB + (size_t)(u.base + rl) * D + col0) = w; } }
    }
};
constexpr int LDS_TAB = 131072;
__device__ __forceinline__ void p_moe_up(const CAS Args& a, const Frame& F, int l) {
    const int nc = l == 0 ? MOE_NC : 0;
    if (F.bid >= F.G - nc) { const int cw = (F.bid - (F.G - nc)) * NWAVES + F.wave; convert_experts(a, F, 0, 2, 3, cw, nc * NWAVES); convert_experts(a, F, 1, 0, 2, cw, nc * NWAVES, 0, CV_E3); return; }
    LAS MoeTab* tb = (LAS MoeTab*)(F.ldsl + LDS_TAB); moe_tab_build(a, F, l, tb);
    LAS int* utw = (LAS int*)(F.ldsl + LDS_TAB + 1024);
    MoeSched<true> S{tb, utw, (const char*)(a.ws + WS_H), (const char*)(a.ws + WS_WEXP) + (size_t)l * NE * 3072 * 1024, (const int*)(a.ws + WS_TOKLIST), F.G - nc, F.bid};
    S.build(utw, F.tid); __syncthreads();
    EpiMoeUp E{(bf16*)(a.ws + WS_ACT), a.in[32] + (size_t)l * NE * D, a.in[34] + (size_t)l * NE * D, (LAS float*)(F.ldsl + LDS_TAB + 4096)};
    pg8::gemm_phase<D, true>(F.ldsl, S, E, F.wave);
}
__device__ __forceinline__ void p_moe_down(const CAS Args& a, const Frame& F, int l) {
    const int nc = l == 0 ? MOE_NC : 0;
    if (F.bid >= F.G - nc) { const int cw = (F.bid - (F.G - nc)) * NWAVES + F.wave; convert_experts(a, F, 1, 2, 3, cw, nc * NWAVES); convert_experts(a, F, 1, 0, 2, cw, nc * NWAVES, CV_E3, CV_E2); return; }
    LAS MoeTab* tb = (LAS MoeTab*)(F.ldsl + LDS_TAB); moe_tab_build(a, F, l, tb);
    LAS int* utw = (LAS int*)(F.ldsl + LDS_TAB + 1024);
    MoeSched<false> S{tb, utw, (const char*)(a.ws + WS_ACT), (const char*)(a.ws + WS_WEXP) + (size_t)l * NE * 3072 * 1024, nullptr, F.G - nc, F.bid};
    S.build(utw, F.tid); __syncthreads();
    EpiMoeDown E{(unsigned char*)(a.ws + WS_YB), a.in[36] + (size_t)l * NE * D, (LAS float*)(F.ldsl + LDS_TAB + 4096)};
    pg8::gemm_phase<D, true>(F.ldsl, S, E, F.wave);
}
__device__ __forceinline__ void p_combine(const CAS Args& a, const Frame& F, int l) {
    const unsigned char* YB = (const unsigned char*)(a.ws + WS_YB); bf16* XB = (bf16*)(a.ws + WS_XB); bf16* H = (bf16*)(a.ws + WS_H);
    const int* sel = (const int*)(a.ws + WS_SEL); const float* gatev = (const float*)(a.ws + WS_GATEV);
    LAS MoeTab* tb = (LAS MoeTab*)(F.ldsl + LDS_TAB); moe_tab_build(a, F, l, tb);
    const int rows = l == 0 ? R : NT, lane = F.lane;
    for (int r = F.gw; r < rows; r += 2 * F.ngw) {
        v4u xw[2][2]; uint2 yw[2][4][2]; float gk[2][4];
#pragma unroll
        for (int t = 0; t < 2; ++t) { const int rr = r + t * F.ngw; if (rr < rows) {
#pragma unroll
            for (int jh = 0; jh < 2; ++jh) xw[t][jh] = *(const v4u*)(XB + (size_t)rr * D + 512 * jh + 8 * lane);
#pragma unroll
            for (int k = 0; k < 4; ++k) { const int sv = sel[rr * 4 + k]; gk[t][k] = gatev[rr * 4 + k]; const int e = sv & 31, pos = sv >> 5;
                const unsigned char* y = YB + (size_t)(tb->base[e] + pos) * D;
#pragma unroll
                for (int jh = 0; jh < 2; ++jh) yw[t][k][jh] = *(const uint2*)(y + 512 * jh + 8 * lane); } } }
#pragma unroll
        for (int t = 0; t < 2; ++t) { const int rr = r + t * F.ngw; if (rr < rows) {
            float m[16], v[16];
#pragma unroll
            for (int i = 0; i < 16; ++i) m[i] = 0.f;
#pragma unroll
            for (int k = 0; k < 4; ++k) { const float gg = gk[t][k] * (1.0f / YB8_SCALE);
#pragma unroll
                for (int jh = 0; jh < 2; ++jh) { const unsigned w2[2] = {yw[t][k][jh].x, yw[t][k][jh].y};
#pragma unroll
                    for (int q = 0; q < 2; ++q) { const f32x2_t lo = __builtin_amdgcn_cvt_pk_f32_fp8((int)w2[q], false), hi = __builtin_amdgcn_cvt_pk_f32_fp8((int)w2[q], true);
                        m[8 * jh + 4 * q] += gg * lo.x; m[8 * jh + 4 * q + 1] += gg * lo.y; m[8 * jh + 4 * q + 2] += gg * hi.x; m[8 * jh + 4 * q + 3] += gg * hi.y; } } }
#pragma unroll
            for (int jh = 0; jh < 2; ++jh) { const unsigned x4[4] = {xw[t][jh].x, xw[t][jh].y, xw[t][jh].z, xw[t][jh].w};
#pragma unroll
                for (int q = 0; q < 4; ++q) { v[8 * jh + 2 * q] = __uint_as_float(x4[q] << 16); v[8 * jh + 2 * q + 1] = __uint_as_float(x4[q] & 0xffff0000u); } }
            const float* g2 = mod_ptr(a, l, rr, 5);
#pragma unroll
            for (int jh = 0; jh < 2; ++jh)
#pragma unroll
                for (int q = 0; q < 2; ++q) { const f32x4 gg = *(const f32x4*)(g2 + 512 * jh + 8 * lane + 4 * q);
#pragma unroll
                    for (int c = 0; c < 4; ++c) v[8 * jh + 4 * q + c] += gg[c] * m[8 * jh + 4 * q + c]; }
            if (l == 0) {
#pragma unroll
                for (int jh = 0; jh < 2; ++jh) *(v4u*)(XB + (size_t)rr * D + 512 * jh + 8 * lane) = (v4u){pk_bf16(v[8 * jh], v[8 * jh + 1]), pk_bf16(v[8 * jh + 2], v[8 * jh + 3]), pk_bf16(v[8 * jh + 4], v[8 * jh + 5]), pk_bf16(v[8 * jh + 6], v[8 * jh + 7])};
                float s = 0.f;
#pragma unroll
                for (int i2 = 0; i2 < 16; ++i2) s += v[i2] * v[i2];
                const float rstd = rsqrtf(wave_sum(s) * (1.0f / D) + 1e-6f);
                const float* gp = a.in[6] + D; const float* shp = mod_ptr(a, 1, rr, 0); const float* scp = mod_ptr(a, 1, rr, 1);
#pragma unroll
                for (int jh = 0; jh < 2; ++jh) { float hv[8];
#pragma unroll
                    for (int q = 0; q < 2; ++q) { const int e0 = 512 * jh + 8 * lane + 4 * q; const f32x4 gg = *(const f32x4*)(gp + e0), ss = *(const f32x4*)(shp + e0), cc = *(const f32x4*)(scp + e0);
#pragma unroll
                        for (int c = 0; c < 4; ++c) hv[4 * q + c] = v[8 * jh + 4 * q + c] * rstd * gg[c] * (1.f + cc[c]) + ss[c]; }
                    *(v4u*)(H + (size_t)rr * D + 512 * jh + 8 * lane) = (v4u){pk_bf16(hv[0], hv[1]), pk_bf16(hv[2], hv[3]), pk_bf16(hv[4], hv[5]), pk_bf16(hv[6], hv[7])}; }
            } else {
#pragma unroll
                for (int jh = 0; jh < 2; ++jh)
#pragma unroll
                    for (int q = 0; q < 2; ++q) *(f32x4*)(a.out + (size_t)rr * D + 512 * jh + 8 * lane + 4 * q) = (f32x4){v[8 * jh + 4 * q], v[8 * jh + 4 * q + 1], v[8 * jh + 4 * q + 2], v[8 * jh + 4 * q + 3]};
            } } }
    }
}
struct EpiInProj1 {
    static constexpr bool PERM = true;
    bf16* Gt; bf16* U;
    __device__ __forceinline__ void operator()(const f32x4 (&acc)[2][2][4][2], const pg8::Unit& u, int wr, int wc, int fr, int fq) const {
        const int row0 = u.pm * 256 + wr * 64 + fr; const bool gate = u.pn < 4;
        bf16* dst = gate ? Gt : U; const int col0 = (u.pn & 3) * 256 + wc * 32 + 8 * fq;
#pragma unroll
        for (int ai = 0; ai < 2; ++ai)
#pragma unroll
            for (int m = 0; m < 4; ++m) { bf16* rowp = dst + (size_t)(row0 + ai * 128 + m * 16) * D + col0;
#pragma unroll
                for (int bj = 0; bj < 2; ++bj) { f32x4 v0 = acc[ai][bj][m][0], v1 = acc[ai][bj][m][1];
                    if (gate) {
#pragma unroll
                        for (int j = 0; j < 4; ++j) { const float x = v0[j]; v0[j] = x * __builtin_amdgcn_rcpf(1.0f + __expf(-1.5957691216f * (x + 0.044715f * x * x * x)));
                                                      const float y = v1[j]; v1[j] = y * __builtin_amdgcn_rcpf(1.0f + __expf(-1.5957691216f * (y + 0.044715f * y * y * y))); } }
                    v4u w; w.x = pg8::cvt_pk_bf16(v0[0], v0[1]); w.y = pg8::cvt_pk_bf16(v0[2], v0[3]); w.z = pg8::cvt_pk_bf16(v1[0], v1[1]); w.w = pg8::cvt_pk_bf16(v1[2], v1[3]);
                    *(v4u*)(rowp + bj * 128) = w; } }
    }
};
__device__ __forceinline__ void p_inproj1(const CAS Args& a, const Frame& F) {
    if (F.bid >= F.G - INP1_NC) { convert_experts(a, F, 1, 0, 2, (F.bid - (F.G - INP1_NC)) * NWAVES + F.wave, INP1_NC * NWAVES, CV_E2, NE); return; }
    pg8::RectSched S{(const char*)(a.ws + WS_H), (const char*)(a.ws + WS_WIN1), 2 * D, NT / 256, 8, F.G - INP1_NC, F.bid, NC / 256, 4, NT / 256, 4};
    EpiInProj1 E{(bf16*)(a.ws + WS_G), (bf16*)(a.ws + WS_U)};
    pg8::gemm_phase<2 * D, false>(F.ldsl, S, E, F.wave);
}
__device__ __forceinline__ void p_conv4(const CAS Args& a, const Frame& F) {
    const bf16* U = (const bf16*)(a.ws + WS_U); bf16* UC = (bf16*)(a.ws + WS_UC);
    for (int u = F.gw; u < (R / 8) * 2; u += F.ngw) {
        const int rb = u >> 1, ch0 = (u & 1) * 512 + 8 * F.lane, row0 = rb * 8;
        const bool lat = row0 < NT; const int t0 = lat ? (row0 & 2047) : ((row0 - NT) & 255), len = lat ? 2048 : 256;
        float cw[4][8], cbv[8];
#pragma unroll
        for (int q = 0; q < 8; ++q) { cbv[q] = a.in[18][ch0 + q];
#pragma unroll
            for (int k = 0; k < 4; ++k) cw[k][q] = a.in[17][k * D + ch0 + q]; }
        v4u uv[11];
#pragma unroll
        for (int k = 0; k < 11; ++k) { const int tt = t0 + k - 1; uv[k] = (tt >= 0 && tt < len) ? *(const v4u*)(U + (size_t)(row0 + k - 1) * D + ch0) : (v4u){0u, 0u, 0u, 0u}; }
#pragma unroll
        for (int i = 0; i < 8; ++i) {
            float acc[8];
#pragma unroll
            for (int q = 0; q < 8; ++q) acc[q] = cbv[q];
#pragma unroll
            for (int k = 0; k < 4; ++k) { const unsigned w[4] = {uv[i + k].x, uv[i + k].y, uv[i + k].z, uv[i + k].w};
#pragma unroll
                for (int q = 0; q < 4; ++q) { acc[2 * q] += cw[k][2 * q] * __uint_as_float(w[q] << 16); acc[2 * q + 1] += cw[k][2 * q + 1] * __uint_as_float(w[q] & 0xffff0000u); } }
            *(v4u*)(UC + (size_t)(row0 + i) * D + ch0) = (v4u){pk_bf16(acc[0], acc[1]), pk_bf16(acc[2], acc[3]), pk_bf16(acc[4], acc[5]), pk_bf16(acc[6], acc[7])};
        }
    }
}
constexpr int LR_A = 0, LR_SC = 65536, LR_AG = 131072, LR_CY = LR_AG + 8192;
__device__ __forceinline__ void p_lru(const CAS Args& a, const Frame& F) {
    const bf16* UC = (const bf16*)(a.ws + WS_UC); const bf16* WL = (const bf16*)(a.ws + WS_WLRU); const bf16* Gt = (const bf16*)(a.ws + WS_G);
    bf16* HF = (bf16*)(a.ws + WS_HF); bf16* A3 = (bf16*)(a.ws + WS_A3);
    LAS unsigned char* lds = F.ldsl;
    const int lane_ = F.lane, wave = F.wave, sub = wave & 3, th = wave >> 2;
    for (int wu = F.bid; wu < 256; wu += F.G) {
        const int b = wu >> 4, h = (wu >> 2) & 3, cg = wu & 3;
        for (int dir = 0; dir < 2; ++dir) {
            const int lane = lane_, rho = lane & 15, g = lane >> 4;
            bf16x8 bw[2][8];
#pragma unroll
            for (int n = 0; n < 2; ++n)
#pragma unroll
                for (int ks = 0; ks < 8; ++ks) bw[n][ks] = *(const bf16x8*)(WL + ((size_t)h * 1024 + (2 * dir + n) * 256 + cg * 64 + 16 * sub + rho) * 256 + 32 * ks + 8 * g);
            const int chc = h * 256 + cg * 64 + 16 * sub + rho;
            const float bav = (dir ? a.in[25] : a.in[20])[chc] * -1.44269504f, bxv = (dir ? a.in[27] : a.in[22])[chc] * -1.44269504f;
            const float lamv = (dir ? a.in[28] : a.in[23])[chc];
            const float L8 = -8.0f * log1pf(expf(-lamv)) * 1.44269504f;
            __syncthreads();
            if (wave == 0) ((LAS float*)(lds + LR_CY))[lane] = 0.f;
#define LR_GROW0(ck_) ((ck_) < 2 ? (size_t)(NT + b * 256 + 128 * (dir ? 1 - (ck_) : (ck_))) : (size_t)(b * 2048 + 128 * (dir ? 15 - ((ck_) - 2) : (ck_) - 2)))
#define LR_STAGE(ck_) do { const size_t g0_ = LR_GROW0(ck_); _Pragma("unroll") for (int p_ = 0; p_ < 8; ++p_) { const int pc_ = wave * 8 + p_, row_ = 2 * pc_ + (lane >> 5), c_ = (lane & 31) ^ (row_ & 15); \
                __builtin_amdgcn_global_load_lds((const unsigned*)((const char*)UC + (g0_ + row_) * (D * 2) + h * 512 + 16 * c_), (LAS unsigned*)(lds + LR_A + pc_ * 1024), 16, 0, 0); } } while (0)
            LR_STAGE(0);
            for (int ck = 0; ck < 18; ++ck) {
                const bool isctx = ck < 2;
                const size_t grow0 = LR_GROW0(ck);
                int lane = lane_; asm volatile("" : "+v"(lane)); const int rho = lane & 15, g = lane >> 4, chs = h * 256 + cg * 64 + lane, ucol = cg * 64 + 16 * sub + rho;
                asm volatile("s_waitcnt vmcnt(0)" ::: "memory");
                __syncthreads();
                const int row0 = dir ? 112 - 16 * wave : 16 * wave;
                v4u hfr[2], gtr[2];
                if (dir && !isctx) {
#pragma unroll
                    for (int t = 0; t < 2; ++t) { const int tk = lane + 64 * t; const size_t gi = (grow0 + row0 + (tk >> 3)) * D + h * 256 + cg * 64 + 8 * (tk & 7);
                        hfr[t] = *(const v4u*)(HF + gi); gtr[t] = *(const v4u*)(Gt + gi); } }
                {
                    f32x4 acc[4][2];
#pragma unroll
                    for (int m = 0; m < 4; ++m)
#pragma unroll
                        for (int n = 0; n < 2; ++n) acc[m][n] = (f32x4){0.f, 0.f, 0.f, 0.f};
#pragma unroll
                    for (int ks = 0; ks < 8; ++ks)
#pragma unroll
                        for (int m = 0; m < 4; ++m) { const int rw = 64 * th + 16 * m + rho; const bf16x8 af = *(const LAS bf16x8*)(lds + LR_A + rw * 512 + (((4 * ks + g) ^ (rw & 15)) << 4));
#pragma unroll
                            for (int n = 0; n < 2; ++n) acc[m][n] = __builtin_amdgcn_mfma_f32_16x16x32_bf16(af, bw[n][ks], acc[m][n], 0, 0, 0);
                            if (m == 3 && (ks & 1)) asm volatile("" ::: "memory"); }
#pragma unroll
                    for (int m = 0; m < 4; ++m)
#pragma unroll
                        for (int p = 0; p < 2; ++p) {
                            const int row = 64 * th + 16 * m + 4 * g + 2 * p;
                            f32x2_t uc;
                            uc.x = bf2f(*(const LAS bf16*)(lds + LR_A + row * 512 + (((ucol >> 3) ^ (row & 15)) << 4) + 2 * (ucol & 7)));
                            uc.y = bf2f(*(const LAS bf16*)(lds + LR_A + (row + 1) * 512 + (((ucol >> 3) ^ ((row + 1) & 15)) << 4) + 2 * (ucol & 7)));
                            const f32x2_t xa = (f32x2_t){acc[m][0][2 * p], acc[m][0][2 * p + 1]} * -1.44269504f + bav, xx = (f32x2_t){acc[m][1][2 * p], acc[m][1][2 * p + 1]} * -1.44269504f + bxv;
                            f32x2_t da, dx; da.x = __builtin_amdgcn_exp2f(xa.x); da.y = __builtin_amdgcn_exp2f(xa.y); dx.x = __builtin_amdgcn_exp2f(xx.x); dx.y = __builtin_amdgcn_exp2f(xx.y);
                            da = da + 1.0f; dx = dx + 1.0f;
                            f32x2_t rr, ii; rr.x = __builtin_amdgcn_rcpf(da.x); rr.y = __builtin_amdgcn_rcpf(da.y); ii.x = __builtin_amdgcn_rcpf(dx.x); ii.y = __builtin_amdgcn_rcpf(dx.y);
                            const f32x2_t la = rr * L8;
                            f32x2_t av; av.x = __builtin_amdgcn_exp2f(la.x); av.y = __builtin_amdgcn_exp2f(la.y);
                            f32x2_t tt = 1.0f - av * av; tt.x = fmaxf(tt.x, 0.f); tt.y = fmaxf(tt.y, 0.f);
                            f32x2_t sq; sq.x = __builtin_amdgcn_sqrtf(tt.x); sq.y = __builtin_amdgcn_sqrtf(tt.y);
                            const f32x2_t bv = sq * ii * uc;
                            *(LAS f32x2_t*)(lds + LR_SC + (row * 64 + 16 * sub + rho) * 8) = (f32x2_t){av.x, bv.x};
                            *(LAS f32x2_t*)(lds + LR_SC + ((row + 1) * 64 + 16 * sub + rho) * 8) = (f32x2_t){av.y, bv.y};
                        }
                }
                __syncthreads();
                if (ck + 1 < 18) LR_STAGE(ck + 1);
                f32x2_t ab[16];
                {
#pragma unroll
                    for (int q = 0; q < 16; ++q) { const int s = 16 * wave + q, row = dir ? 127 - s : s; ab[q] = *(const LAS f32x2_t*)(lds + LR_SC + (row * 64 + lane) * 8); }
                    float hl = 0.f, pr = 1.f;
#pragma unroll
                    for (int q = 0; q < 16; ++q) { hl = ab[q].x * hl + ab[q].y; pr *= ab[q].x; ab[q] = (f32x2_t){pr, hl}; }
                    *(LAS f32x2_t*)(lds + LR_AG + ((ck & 1) * 512 + wave * 64 + lane) * 8) = (f32x2_t){pr, hl};
                }
                __syncthreads();
                {
                    float c = ((const LAS float*)(lds + LR_CY))[(ck & 1) * 64 + lane], cin = 0.f;
#pragma unroll
                    for (int w2 = 0; w2 < 8; ++w2) { if (w2 == wave) cin = c; const f32x2_t ag = *(const LAS f32x2_t*)(lds + LR_AG + ((ck & 1) * 512 + w2 * 64 + lane) * 8); c = ag.x * c + ag.y; }
                    if (wave == 0) ((LAS float*)(lds + LR_CY))[((ck + 1) & 1) * 64 + lane] = c;
                    if (!isctx) {
                        LAS unsigned char* scr = lds + LR_SC + row0 * 512;
                        if (dir) {
#pragma unroll
                            for (int t = 0; t < 2; ++t) { const int tk = lane + 64 * t; *(LAS v4u*)(scr + tk * 16) = hfr[t]; *(LAS v4u*)(scr + 2048 + tk * 16) = gtr[t]; }
                        }
#pragma unroll
                        for (int q = 0; q < 16; ++q) { const int tr = dir ? 15 - q : q;
                            float hv = ab[q].y + ab[q].x * cin;
                            if (dir) hv = (bf2f(*(const LAS bf16*)(scr + (tr * 64 + lane) * 2)) + hv) * bf2f(*(const LAS bf16*)(scr + 2048 + (tr * 64 + lane) * 2));
                            *(LAS bf16*)(scr + 4096 + (tr * 64 + lane) * 2) = f2bf(hv); }
                        bf16* dstp = dir ? A3 : HF;
#pragma unroll
                        for (int t = 0; t < 2; ++t) { const int tk = lane + 64 * t; const size_t gi = (grow0 + row0 + (tk >> 3)) * D + h * 256 + cg * 64 + 8 * (tk & 7);
                            *(v4u*)(dstp + gi) = *(const LAS v4u*)(scr + 4096 + tk * 16); }
                    }
                }
            }
#undef LR_STAGE
#undef LR_GROW0
        }
    }
}

constexpr int LDS_BYTES = 163840;
constexpr int NPHASE = 17;
template <unsigned KMASK>
__global__ void __launch_bounds__(NWAVES * 64, 2) fwd(Args kargs) {
    extern __shared__ __attribute__((aligned(16))) unsigned char lds[];
    const int wave_s = __builtin_amdgcn_readfirstlane((int)threadIdx.x >> 6);
    const int tid0 = wave_s * 64 + lane_id_fresh();
    volatile LAS unsigned* misc = (volatile LAS unsigned*)((LAS unsigned char*)lds + (LDS_BYTES - 64));
    if (tid0 < 16) misc[tid0] = 0u;
    __syncthreads();
    const int lo = kargs.ph_lo, hi = kargs.ph_hi;
    XcdBarrier bar; bar.bar = (unsigned*)(kargs.ws + WS_CTL) + CW_BAR + kargs.li * XCD_BAR_WORDS; bar.x = 0; bar.st = misc;
    if (hi - lo > 1) bar = xcd_barrier_post((unsigned*)(kargs.ws + WS_CTL) + CW_BAR + kargs.li * XCD_BAR_WORDS, misc, tid0);
#ifndef ONLY_PHASE
#define ONLY_PHASE -1
#endif
#ifndef PHASE_MASK
#define PHASE_MASK 0xFFFFFFFFu
#endif
#ifndef REPMASK
#define REPMASK 0u
#endif
#define PH(k, body) if constexpr (((KMASK >> (k)) & 1u) != 0u) if ((ONLY_PHASE < 0 || ONLY_PHASE == (k)) && ((PHASE_MASK >> (k)) & 1u) && lo <= (k) && (k) < hi) { \
        const CAS Args* ap_ = (const CAS Args*)__builtin_amdgcn_kernarg_segment_ptr(); asm volatile("" : "+s"(ap_)); const CAS Args& args = *ap_; \
        Frame F; F.lds = lds; F.ldsl = (LAS unsigned char*)lds; F.wave = wave_s; F.lane = lane_id_fresh(); \
        F.tid = F.wave * 64 + F.lane; F.G = gridDim.x; F.bid = blockIdx.x; F.gw = F.bid * NWAVES + F.wave; F.ngw = F.G * NWAVES; \
        if (((REPMASK >> (k)) & 1u) == 0u) { body; } else { int nrep_ = 2; asm volatile("" : "+s"(nrep_)); for (int rep_ = 0; rep_ < nrep_; ++rep_) { body; asm volatile("s_waitcnt vmcnt(0)" ::: "memory"); __syncthreads(); } } if ((k) + 1 < hi) xcd_barrier(bar, F.tid); else { asm volatile("s_waitcnt vmcnt(0)" ::: "memory"); __syncthreads(); } }
    PH(0, p0_prologue(args, F))
    PH(1, p_norm1_l0(args, F))
    PH(2, p_inproj0(args, F))
    PH(3, p_attn(args, F))
    PH(4, p_outproj<0>(args, F))
    PH(5, p_norm2_router(args, F, 0))
    PH(6, p_moe_up(args, F, 0))
    PH(7, p_moe_down(args, F, 0))
    PH(8, p_combine(args, F, 0))
    PH(9, p_inproj1(args, F))
    PH(10, p_conv4(args, F))
    PH(11, p_lru(args, F))
    PH(12, p_outproj<1>(args, F))
    PH(13, p_norm2_router(args, F, 1))
    PH(14, p_moe_up(args, F, 1))
    PH(15, p_moe_down(args, F, 1))
    PH(16, p_combine(args, F, 1))
#undef PH
}

constexpr unsigned MASK_A = (1u<<2)|(1u<<4)|(1u<<6)|(1u<<7)|(1u<<9)|(1u<<11)|(1u<<13)|(1u<<14), MASK_C = 1u << 3, MASK_D = 1u << 10, MASK_ALL = 0x1FFFFu, MASK_B = MASK_ALL & ~(MASK_A | MASK_C | MASK_D);
__host__ inline int kid_of(int p) { return ((MASK_A >> p) & 1u) ? 0 : ((MASK_C >> p) & 1u) ? 2 : ((MASK_D >> p) & 1u) ? 3 : 1; }
extern "C" void kernel_launch(void* const* d_in, const int* in_sizes, int n_in, void* d_out, int out_size, void* d_ws, size_t ws_size, hipStream_t stream) {
    static int grid = 0;
    if (grid == 0) {
        if (n_in != 37 || out_size != NT * D || ws_size < WS_END) { fprintf(stderr, "kernel_launch: unexpected shapes (n_in %d out %d ws %zu)\n", n_in, out_size, ws_size); grid = -1; return; }
        int dev = 0, cus = 0;
        if (hipGetDevice(&dev) != hipSuccess || hipDeviceGetAttribute(&cus, hipDeviceAttributeMultiprocessorCount, dev) != hipSuccess) { grid = -1; return; }
#ifndef MULTI_LAUNCH
        if (hipFuncSetAttribute((const void*)fwd<MASK_ALL>, hipFuncAttributeMaxDynamicSharedMemorySize, LDS_BYTES) != hipSuccess) { fprintf(stderr, "kernel_launch: hipFuncSetAttribute failed\n"); grid = -1; return; }
#else
        if (hipFuncSetAttribute((const void*)fwd<MASK_A>, hipFuncAttributeMaxDynamicSharedMemorySize, LDS_BYTES) != hipSuccess) { fprintf(stderr, "kernel_launch: hipFuncSetAttribute failed\n"); grid = -1; return; }
        if (hipFuncSetAttribute((const void*)fwd<MASK_B>, hipFuncAttributeMaxDynamicSharedMemorySize, LDS_BYTES) != hipSuccess) { fprintf(stderr, "kernel_launch: hipFuncSetAttribute failed\n"); grid = -1; return; }
        if (hipFuncSetAttribute((const void*)fwd<MASK_C>, hipFuncAttributeMaxDynamicSharedMemorySize, LDS_BYTES) != hipSuccess) { fprintf(stderr, "kernel_launch: hipFuncSetAttribute failed\n"); grid = -1; return; }
        if (hipFuncSetAttribute((const void*)fwd<MASK_D>, hipFuncAttributeMaxDynamicSharedMemorySize, LDS_BYTES) != hipSuccess) { fprintf(stderr, "kernel_launch: hipFuncSetAttribute failed\n"); grid = -1; return; }
#endif
        (void)hipGetLastError();
        grid = cus;
    }
    if (grid < 0) return;
    if (hipMemsetAsync((char*)d_ws + WS_CTL, 0, CTL_ZERO_BYTES, stream) != hipSuccess) return;
    Args a{};
    for (int i = 0; i < 37; ++i) a.in[i] = (const float*)d_in[i];
    a.out = (float*)d_out; a.ws = (unsigned char*)d_ws;
#ifdef MULTI_LAUNCH
    int p = 0, li = 0;
    while (p < NPHASE) {
        const int kid = kid_of(p); int q = p + 1;
        while (q < NPHASE && kid_of(q) == kid) ++q;
        a.ph_lo = p; a.ph_hi = q; a.li = li++;
        if (kid == 0) hipLaunchKernelGGL(fwd<MASK_A>, dim3(grid), dim3(NWAVES * 64), LDS_BYTES, stream, a);
        else if (kid == 1) hipLaunchKernelGGL(fwd<MASK_B>, dim3(grid), dim3(NWAVES * 64), LDS_BYTES, stream, a);
        else if (kid == 2) hipLaunchKernelGGL(fwd<MASK_C>, dim3(grid), dim3(NWAVES * 64), LDS_BYTES, stream, a);
        else hipLaunchKernelGGL(fwd<MASK_D>, dim3(grid), dim3(NWAVES * 64), LDS_BYTES, stream, a);
        p = q;
    }
#else
    a.ph_lo = 0; a.ph_hi = NPHASE; a.li = 0;
    hipLaunchKernelGGL(fwd<MASK_ALL>, dim3(grid), dim3(NWAVES * 64), LDS_BYTES, stream, a);
#endif
}
```

```cpp
#include <hip/hip_runtime.h>
#include <stdint.h>
#include <stdio.h>

constexpr int D = 1024, NB = 16, SEQ = 2048, NT = NB * SEQ, LC = 256, NC = NB * LC, R = NT + NC;
constexpr int NE = 32, CAP = R;
constexpr int NWAVES = 8;

typedef unsigned short bf16;
typedef short bf16x8 __attribute__((ext_vector_type(8)));
typedef float f32x4 __attribute__((ext_vector_type(4)));
typedef unsigned v4u __attribute__((ext_vector_type(4)));
#define LAS __attribute__((address_space(3)))
#define CAS __attribute__((address_space(4)))
#define RLX_AGENT __ATOMIC_RELAXED, __HIP_MEMORY_SCOPE_AGENT

constexpr size_t MiB = 1u << 20;
constexpr size_t WS_CTL = 0, CTL_ZERO_BYTES = 1 * MiB;
constexpr size_t WS_MOD = 1 * MiB;
constexpr size_t WS_WIN0 = 2 * MiB, WS_WOUT0 = 8 * MiB, WS_WIN1 = 10 * MiB, WS_WOUT1 = 14 * MiB, WS_WLRU = 16 * MiB;
constexpr size_t WS_TOKLIST = 18 * MiB;
constexpr size_t WS_SEL = 23 * MiB;
constexpr size_t WS_GATEV = 24 * MiB;
constexpr size_t WS_XC = 25 * MiB;
constexpr size_t WS_WEXP = 41 * MiB;
constexpr size_t WS_H = 233 * MiB;
constexpr size_t WS_P = 305 * MiB;
constexpr int PP = 2560;
constexpr size_t WS_A2 = 521 * MiB;
constexpr size_t WS_ACT = 593 * MiB;
constexpr size_t WS_YB = 305 * MiB;
constexpr size_t WS_G = 305 * MiB;
constexpr size_t WS_U = 369 * MiB;
constexpr size_t WS_UC = 441 * MiB;
constexpr size_t WS_AF = 513 * MiB;
constexpr size_t WS_AB = 657 * MiB;
constexpr size_t WS_HF = WS_AF;
constexpr size_t WS_A3 = WS_AB;
constexpr size_t WS_BF = 801 * MiB;
constexpr size_t WS_BB = 873 * MiB;
constexpr size_t WS_GS2 = 840 * MiB;
constexpr size_t WS_XB = 760 * MiB;
constexpr size_t WS_END = 945 * MiB;
constexpr int CW_BAR = 4096;
constexpr int CW_CNT = 65536;

__device__ __forceinline__ float bf2f(bf16 v) { return __uint_as_float(((unsigned)v) << 16); }
__device__ __forceinline__ bf16 f2bf(float f) { unsigned u = __float_as_uint(f); return (bf16)((u + 0x7fffu + ((u >> 16) & 1u)) >> 16); }
__device__ __forceinline__ unsigned pk2(float lo, float hi) { return (unsigned)f2bf(lo) | ((unsigned)f2bf(hi) << 16); }
__device__ __forceinline__ int lane_id_fresh() { int l; asm volatile("v_mbcnt_lo_u32_b32 %0, -1, 0\n\tv_mbcnt_hi_u32_b32 %0, -1, %0" : "=v"(l)); return l; }
__device__ __forceinline__ unsigned pk4_fp8(float a, float b, float c, float d) {
    a = fminf(fmaxf(a, -448.f), 448.f); b = fminf(fmaxf(b, -448.f), 448.f); c = fminf(fmaxf(c, -448.f), 448.f); d = fminf(fmaxf(d, -448.f), 448.f);
    unsigned w = 0u; w = __builtin_amdgcn_cvt_pk_fp8_f32(a, b, w, false); w = __builtin_amdgcn_cvt_pk_fp8_f32(c, d, w, true); return w;
}
constexpr float W8_SCALE = 32.0f, ACT8_SCALE = 4.0f, YB8_SCALE = 16.0f;
__device__ __forceinline__ float wave_sum(float v) {
#pragma unroll
    for (int o = 1; o < 64; o <<= 1) v += __shfl_xor(v, o);
    return v;
}
__device__ __forceinline__ float wave_max(float v) {
#pragma unroll
    for (int o = 1; o < 64; o <<= 1) v = fmaxf(v, __shfl_xor(v, o));
    return v;
}
__device__ __forceinline__ float sigmoidf_(float x) { return 1.0f / (1.0f + __expf(-x)); }
__device__ __forceinline__ float gelu_tanh(float x) { return 0.5f * x * (1.0f + tanhf(0.7978845608028654f * (x + 0.044715f * x * x * x))); }

#define XB_TMO      128
#define XB_XCNT(j)  (256  + 64 * (j))
#define XB_XSUB(j)  (1280 + 64 * (j))
#define XB_XGEN(j)  (2304 + 64 * (j))
#define XB_TOP      3328
#define XB_TOPGEN   3392
#define XCD_BAR_WORDS 3456
#define XB_SPIN_CAP (1u << 18)
__device__ __forceinline__ unsigned xb_ld(unsigned* p)              { return __hip_atomic_load(p, __ATOMIC_RELAXED, __HIP_MEMORY_SCOPE_AGENT); }
__device__ __forceinline__ unsigned xb_add(unsigned* p, unsigned v) { return __hip_atomic_fetch_add(p, v, __ATOMIC_RELAXED, __HIP_MEMORY_SCOPE_AGENT); }
__device__ __forceinline__ unsigned xb_xcc_id() { return (unsigned)__builtin_amdgcn_s_getreg((3 << 11) | 20) & 0xFu; }
#define XB_SPIN(cond, bar) do { unsigned _sp = 0; while (cond) { __builtin_amdgcn_s_sleep(1); \
    if ((++_sp & 255u) == 0u) { if (xb_ld(&(bar)[XB_TMO])) break; if (_sp > XB_SPIN_CAP) { atomicAdd(&(bar)[XB_TMO], 1u); break; } } } } while (0)
struct XcdBarrier { unsigned* bar; unsigned x; volatile LAS unsigned* st; };
__device__ __forceinline__ XcdBarrier xcd_barrier_post(unsigned* bar, volatile LAS unsigned* st, int tid) {
    XcdBarrier b; b.bar = bar; b.x = xb_xcc_id(); b.st = st;
    if (tid == 0) (void)xb_add(&bar[XB_XCNT(b.x)], 1u);
    return b;
}
__device__ __forceinline__ void xcd_barrier_complete(unsigned* bar, unsigned x, unsigned& nloc, unsigned& nx) {
    const unsigned G = gridDim.x * gridDim.y * gridDim.z;
    unsigned sum, cnt, mine, sp = 0u;
    for (;;) {
        sum = 0u; cnt = 0u; mine = 0u;
#pragma unroll
        for (unsigned j = 0; j < 16; ++j) { const unsigned c = xb_ld(&bar[XB_XCNT(j)]); sum += c; cnt += (c > 0u) ? 1u : 0u; mine = (j == x) ? c : mine; }
        if (sum == G) break;
        __builtin_amdgcn_s_sleep(1);
        if ((++sp & 255u) == 0u) { if (xb_ld(&bar[XB_TMO])) break; if (sp > XB_SPIN_CAP) { atomicAdd(&bar[XB_TMO], 1u); break; } }
    }
    nloc = mine > 0u ? mine : 1u; nx = cnt > 0u ? cnt : 1u;
}
__device__ __forceinline__ void xcd_barrier(const XcdBarrier& b, int tid) {
    asm volatile("s_waitcnt vmcnt(0)" ::: "memory");
    __syncthreads();
    if (tid == 0) {
        unsigned* bar = b.bar;
        __builtin_amdgcn_s_waitcnt(0);
        unsigned nloc = b.st[0], nx = b.st[1];
        if (nloc == 0u) { xcd_barrier_complete(bar, b.x, nloc, nx); b.st[0] = nloc; b.st[1] = nx; }
        const unsigned old = xb_add(&bar[XB_XSUB(b.x)], 1u);
        const unsigned gen = old / nloc;
        if (old + 1u == (gen + 1u) * nloc) {
            __builtin_amdgcn_fence(__ATOMIC_RELEASE, "agent");
            asm volatile("s_waitcnt vmcnt(0)" ::: "memory");
            const unsigned og = xb_add(&bar[XB_TOP], 1u);
            const unsigned tg = og / nx;
            if (og + 1u == (tg + 1u) * nx) xb_add(&bar[XB_TOPGEN], 1u);
            else XB_SPIN(xb_ld(&bar[XB_TOPGEN]) == tg, bar);
            __builtin_amdgcn_fence(__ATOMIC_ACQUIRE, "agent");
            xb_add(&bar[XB_XGEN(b.x)], 1u);
            asm volatile("s_waitcnt vmcnt(0)" ::: "memory");
        } else {
            XB_SPIN(xb_ld(&bar[XB_XGEN(b.x)]) == gen, bar);
            __builtin_amdgcn_fence(__ATOMIC_ACQUIRE, "agent");
            asm volatile("s_waitcnt vmcnt(0)" ::: "memory");
        }
    }
    __syncthreads();
}

struct Args { const float* in[37]; float* out; unsigned char* ws; int ph_lo, ph_hi, li, pad; };
struct Frame {
    unsigned char* lds;
    LAS unsigned char* ldsl;
    int tid, lane, wave, gw, ngw, G, bid;
};

template <int NS, class FA, class FB, class FS>
__device__ __forceinline__ void tile_gemm32(int K, FA arow, FB brow, FS store, int lane) {
    const int lr = lane & 15, lq = lane >> 4;
    const bf16* ap[2]; const bf16* bp[NS][2];
#pragma unroll
    for (int i = 0; i < 2; ++i) ap[i] = arow(16 * i + lr) + 8 * lq;
#pragma unroll
    for (int s = 0; s < NS; ++s)
#pragma unroll
        for (int j = 0; j < 2; ++j) bp[s][j] = brow(s, 16 * j + lr) + 8 * lq;
    f32x4 acc[NS][2][2];
#pragma unroll
    for (int s = 0; s < NS; ++s)
#pragma unroll
        for (int i = 0; i < 2; ++i)
#pragma unroll
            for (int j = 0; j < 2; ++j) acc[s][i][j] = (f32x4){0.f, 0.f, 0.f, 0.f};
#pragma nounroll
    for (int k0 = 0; k0 < K; k0 += 32) {
        bf16x8 a[2], b[NS][2];
#pragma unroll
        for (int i = 0; i < 2; ++i) a[i] = *(const bf16x8*)(ap[i] + k0);
#pragma unroll
        for (int s = 0; s < NS; ++s)
#pragma unroll
            for (int j = 0; j < 2; ++j) b[s][j] = *(const bf16x8*)(bp[s][j] + k0);
#pragma unroll
        for (int s = 0; s < NS; ++s)
#pragma unroll
            for (int i = 0; i < 2; ++i)
#pragma unroll
                for (int j = 0; j < 2; ++j) acc[s][i][j] = __builtin_amdgcn_mfma_f32_16x16x32_bf16(a[i], b[s][j], acc[s][i][j], 0, 0, 0);
    }
#pragma unroll
    for (int i = 0; i < 2; ++i)
#pragma unroll
        for (int j = 0; j < 2; ++j)
#pragma unroll
            for (int q = 0; q < 4; ++q) {
                float v[NS];
#pragma unroll
                for (int s = 0; s < NS; ++s) v[s] = acc[s][i][j][q];
                store(16 * i + 4 * lq + q, 16 * j + lr, v);
            }
}


namespace pg8 {
constexpr int BM = 256, BK = 64, HALF = 128, HTB = HALF * BK * 2, STAGE_BYTES = 8 * HTB;
__device__ __forceinline__ int lds_byte(int r, int c) { const int st = (r >> 4) * 2 + (c >> 5), rr = r & 15, cc = c & 31, ob = rr * 64 + cc * 2; return st * 1024 + (ob ^ (((ob >> 9) & 1) << 5)); }
__device__ __forceinline__ void stage_rc(int b, int& R_, int& C_) { const int st = b / 1024, sb = b % 1024, swz = sb ^ (((sb >> 9) & 1) << 5); R_ = (st >> 1) * 16 + swz / 64; C_ = (st & 1) * 32 + (swz % 64) / 2; }
__device__ __forceinline__ int perm32(int rho) { const int n = rho >> 4, i = rho & 15; return 8 * (i >> 2) + 4 * n + (i & 3); }
struct Unit { int pm, pn, e, rows, base, newe; };
typedef int v8i __attribute__((ext_vector_type(8)));
typedef int v4i __attribute__((ext_vector_type(4)));
__device__ __forceinline__ void mfma8(f32x4& acc, v8i a, v8i b, unsigned sc) {
    asm volatile("v_mfma_scale_f32_16x16x128_f8f6f4 %0, %1, %2, %0, %3, %3 op_sel_hi:[0,0,0]" : "+v"(acc) : "v"(a), "v"(b), "v"(sc));
}
__device__ __forceinline__ v8i cat8(bf16x8 a, bf16x8 b) { return __builtin_shufflevector(__builtin_bit_cast(v4i, a), __builtin_bit_cast(v4i, b), 0, 1, 2, 3, 4, 5, 6, 7); }
__device__ __forceinline__ unsigned cvt_pk_bf16(float lo, float hi) { unsigned r; asm volatile("v_cvt_pk_bf16_f32 %0, %1, %2" : "=v"(r) : "v"(lo), "v"(hi)); return r; }

template <int RB  , bool FP8, class Epi, class Sched>
__device__ __forceinline__ void gemm_phase(LAS unsigned char* lds, const Sched& S, const Epi& E, const int wave_id) {
    const int tid_ = wave_id * 64 + lane_id_fresh();
    const int tid = tid_, wid = wave_id, lane = tid & 63, wr = wid >> 2, wc = wid & 3, fr = lane & 15, fq = lane >> 4;
    constexpr int nt = RB / 128;
    unsigned voffA[2], voffB[2]; int rA[2];
#pragma unroll
    for (int i = 0; i < 2; ++i) { int R_, C_; stage_rc(tid * 16 + i * 8192, R_, C_); const int Rb = Epi::PERM ? ((R_ & ~31) + perm32(R_ & 31)) : R_;
        voffA[i] = Sched::GATHER ? (unsigned)C_ * 2u : (unsigned)(R_ * RB + C_ * 2); rA[i] = R_; voffB[i] = (unsigned)(Rb * RB + C_ * 2); }
    constexpr size_t kstep = (size_t)(BK * 2);
    constexpr size_t hstep = (size_t)HALF * RB;
    const unsigned ldsw = (unsigned)wid * 1024u;
    const int aoff = lds_byte(wr * 64 + fr, fq * 8), boff = lds_byte(wc * 32 + fr, fq * 8);
#define PG8_SA(b, h) (((b) * 2 + (h)) * HTB)
#define PG8_SB(b, h) ((4 + (b) * 2 + (h)) * HTB)
#define PG8_STAGE(bufoff, gbase, voff) do { _Pragma("unroll") for (int _i = 0; _i < 2; ++_i) \
        __builtin_amdgcn_global_load_lds((const unsigned*)((const char*)(gbase) + (voff)[_i]), (LAS unsigned*)(lds + (bufoff) + ldsw + _i * 8192), 16, 0, 0); } while (0)
#define PG8_STAGE_A(bufoff, ubase, uoff, h) do { if constexpr (Sched::GATHER) PG8_STAGE(bufoff, ubase, (uoff)[h]); else PG8_STAGE(bufoff, (ubase) + (h) * hstep, voffA); } while (0)
#define PG8_LDA(dst, b, h) do { _Pragma("unroll") for (int m = 0; m < 4; ++m) _Pragma("unroll") for (int k = 0; k < 2; ++k) dst[m][k] = *(const LAS bf16x8*)(lds + PG8_SA(b, h) + aoff + m * 2048 + k * 1024); } while (0)
#define PG8_LDB(dst, b, h) do { _Pragma("unroll") for (int n = 0; n < 2; ++n) _Pragma("unroll") for (int k = 0; k < 2; ++k) dst[n][k] = *(const LAS bf16x8*)(lds + PG8_SB(b, h) + boff + n * 2048 + k * 1024); } while (0)
#define PG8_MMA(ai, bj, At, Bt) do { __builtin_amdgcn_s_setprio(1); _Pragma("unroll") for (int m = 0; m < 4; ++m) _Pragma("unroll") for (int n = 0; n < 2; ++n) { \
        if constexpr (FP8) mfma8(acc[ai][bj][m][n], cat8(Bt[n][0], Bt[n][1]), cat8(At[m][0], At[m][1]), sc1); \
        else { _Pragma("unroll") for (int k = 0; k < 2; ++k) acc[ai][bj][m][n] = __builtin_amdgcn_mfma_f32_16x16x32_bf16(Bt[n][k], At[m][k], acc[ai][bj][m][n], 0, 0, 0); } } __builtin_amdgcn_s_setprio(0); } while (0)
#define PG8_WAIT_V(n) asm volatile("s_waitcnt vmcnt(" #n ")" ::: "memory")
#define PG8_WAIT_L(n) asm volatile("s_waitcnt lgkmcnt(" #n ")" ::: "memory")
#define PG8_BAR __builtin_amdgcn_s_barrier()
#define PG8_SCHED __builtin_amdgcn_sched_barrier(0)
#define PG8_KBODY(a1, a2, b2, off2) do { const char* _a1 = (a1); const char* _a2 = (a2); const char* _b2 = (b2); const char* _a3 = _a2 + kstep; const char* _b3 = _b2 + kstep; \
            asm volatile("" : "+s"(_a1), "+s"(_a2), "+s"(_b2), "+s"(_a3), "+s"(_b3));   \
            PG8_LDB(B0, 0, 0); PG8_LDB(B1, 0, 1); PG8_SCHED; PG8_LDA(At, 0, 0); PG8_STAGE_A(PG8_SA(1, 1), _a1, coff, 1); \
            PG8_WAIT_V(8); PG8_WAIT_L(0); PG8_BAR; PG8_MMA(0, 0, At, B0); PG8_MMA(0, 1, At, B1); PG8_BAR; PG8_SCHED; \
            PG8_LDA(At, 0, 1); PG8_STAGE(PG8_SB(0, 0), _b2, voffB); PG8_STAGE(PG8_SB(0, 1), _b2 + hstep, voffB); PG8_STAGE_A(PG8_SA(0, 0), _a2, off2, 0); \
            PG8_WAIT_V(8); PG8_WAIT_L(0); PG8_BAR; PG8_MMA(1, 0, At, B0); PG8_MMA(1, 1, At, B1); PG8_BAR; PG8_SCHED; \
            PG8_LDB(B0, 1, 0); PG8_LDB(B1, 1, 1); PG8_SCHED; PG8_LDA(At, 1, 0); PG8_STAGE_A(PG8_SA(0, 1), _a2, off2, 1); \
            PG8_WAIT_V(8); PG8_WAIT_L(0); PG8_BAR; PG8_MMA(0, 0, At, B0); PG8_MMA(0, 1, At, B1); PG8_BAR; PG8_SCHED; \
            PG8_LDA(At, 1, 1); PG8_STAGE(PG8_SB(1, 0), _b3, voffB); PG8_STAGE(PG8_SB(1, 1), _b3 + hstep, voffB); PG8_STAGE_A(PG8_SA(1, 0), _a3, off2, 0); \
            PG8_WAIT_V(8); PG8_WAIT_L(0); PG8_BAR; PG8_MMA(1, 0, At, B0); PG8_MMA(1, 1, At, B1); PG8_BAR; PG8_SCHED; } while (0)
    int ui = 0;
    const char* cA; const char* cB;
    if (!S.bases(0, cA, cB)) return;
    f32x4 acc[2][2][4][2];
#pragma unroll
    for (int a = 0; a < 2; ++a)
#pragma unroll
        for (int b = 0; b < 2; ++b)
#pragma unroll
            for (int m = 0; m < 4; ++m)
#pragma unroll
                for (int n = 0; n < 2; ++n) acc[a][b][m][n] = (f32x4){0.f, 0.f, 0.f, 0.f};
    bf16x8 At[4][2], B0[2][2], B1[2][2];
    unsigned sc1 = 0x7f7f7f7fu; asm volatile("" : "+v"(sc1));
    unsigned coff[2][2], noff[2][2];
    if constexpr (Sched::GATHER) S.aoffs(0, rA, voffA, coff);
    PG8_STAGE(PG8_SB(0, 0), cB, voffB); PG8_STAGE(PG8_SB(0, 1), cB + hstep, voffB); PG8_STAGE_A(PG8_SA(0, 0), cA, coff, 0); PG8_STAGE_A(PG8_SA(0, 1), cA, coff, 1);
    if (wr == 1) PG8_BAR;
    PG8_WAIT_V(2); PG8_BAR;
    PG8_STAGE(PG8_SB(1, 0), cB + kstep, voffB); PG8_STAGE_A(PG8_SA(1, 0), cA + kstep, coff, 0); PG8_STAGE(PG8_SB(1, 1), cB + hstep + kstep, voffB);
    PG8_WAIT_V(6); PG8_BAR;
    for (;;) {
        const char* nA; const char* nB;
        const bool has_next = S.bases(ui + 1, nA, nB);
        if (!has_next) { nA = cA; nB = cB; }
        int ntok[2][2];
        if constexpr (Sched::GATHER) { if (has_next) S.atoks(ui + 1, rA, ntok); }
#pragma nounroll
        for (int t = 0; t < nt - 2; t += 2) PG8_KBODY(cA + (size_t)(t + 1) * kstep, cA + (size_t)(t + 2) * kstep, cB + (size_t)(t + 2) * kstep, coff);
        if constexpr (Sched::GATHER) {
            if (has_next) { asm volatile("" : "+v"(ntok[0][0]), "+v"(ntok[0][1]), "+v"(ntok[1][0]), "+v"(ntok[1][1]));
#pragma unroll
                for (int h = 0; h < 2; ++h)
#pragma unroll
                    for (int i = 0; i < 2; ++i) noff[h][i] = (unsigned)ntok[h][i] * (unsigned)RB + voffA[i]; }
            else {
#pragma unroll
                for (int h = 0; h < 2; ++h)
#pragma unroll
                    for (int i = 0; i < 2; ++i) noff[h][i] = coff[h][i]; }
        }
        PG8_KBODY(cA + (size_t)(nt - 1) * kstep, nA, nB, noff);
        if (wr == 0) PG8_BAR;
        if constexpr (FP8) asm volatile("s_nop 15\n\ts_nop 3" ::: "memory");
        {
            const int t2 = lane_id_fresh();
            const int w2 = wave_id, l2 = t2 & 63;
            Unit cur; S.unit(ui, cur); E(acc, cur, w2 >> 2, w2 & 3, l2 & 15, l2 >> 4); }
        if (!has_next) break;
#pragma unroll
        for (int a = 0; a < 2; ++a)
#pragma unroll
            for (int b = 0; b < 2; ++b)
#pragma unroll
                for (int m = 0; m < 4; ++m)
#pragma unroll
                    for (int n = 0; n < 2; ++n) acc[a][b][m][n] = (f32x4){0.f, 0.f, 0.f, 0.f};
        cA = nA; cB = nB; ++ui;
        if constexpr (Sched::GATHER) {
#pragma unroll
            for (int h = 0; h < 2; ++h)
#pragma unroll
                for (int i = 0; i < 2; ++i) coff[h][i] = noff[h][i]; }
        if (wr == 1) PG8_BAR;
    }
    PG8_WAIT_V(0);
    PG8_BAR;
#undef PG8_SA
#undef PG8_SB
#undef PG8_STAGE
#undef PG8_STAGE_A
#undef PG8_KBODY
#undef PG8_LDA
#undef PG8_LDB
#undef PG8_MMA
#undef PG8_WAIT_V
#undef PG8_WAIT_L
#undef PG8_BAR
#undef PG8_SCHED
}
__device__ __forceinline__ int xcd_remap(long L, int nwg) { const int q = nwg / 8, r = nwg % 8, xcd = (int)(L % 8), off = (int)(L / 8); return (xcd < r ? xcd * (q + 1) : r * (q + 1) + (xcd - r) * q) + off; }
struct RectSched {
    static constexpr bool GATHER = false;
    const char* A; const char* B; int RB, nM, nN, G, c, nM2, nN2, pm2, pn2;
    __device__ __forceinline__ bool unit(int i, Unit& u) const {
        const int n1 = nM * nN, nwg = n1 + nM2 * nN2; const long L = (long)i * G + c; if (L >= nwg) return false;
        int w = xcd_remap(L, nwg); int rm = nM, rn = nN, pm0 = 0, pn0 = 0;
        if (w >= n1) { w -= n1; rm = nM2; rn = nN2; pm0 = pm2; pn0 = pn2; }
        const int nig = 8 * rn, gid = w / nig, fm = gid * 8, gsz = (rm - fm) < 8 ? (rm - fm) : 8;
        u.pm = pm0 + fm + ((w % nig) % gsz); u.pn = pn0 + (w % nig) / gsz; u.e = 0; u.rows = 256; u.base = u.pm * 256; u.newe = 0;
        return true;
    }
    __device__ __forceinline__ bool bases(int i, const char*& a, const char*& b) const {
        Unit u; if (!unit(i, u)) return false;
        a = A + (size_t)u.pm * 256 * RB; b = B + (size_t)u.pn * 256 * RB; return true;
    }
    __device__ __forceinline__ void aoffs(int, const int (&)[2], const unsigned (&)[2], unsigned (&)[2][2]) const {}
    __device__ __forceinline__ void atoks(int, const int (&)[2], int (&)[2][2]) const {}
};
}

template <class MapF>
__device__ __forceinline__ void transpose_item(const float* W, int K, int N, bf16* WT, MapF rowmap, float* scr, int item, int lane) {
    const int nblk = N / 32, kb = item / nblk, nb = item % nblk, k0 = 64 * kb, n0 = 32 * nb;
#pragma unroll 8
    for (int i = 0; i < 32; ++i) { const int kk = 2 * i + (lane >> 5); scr[kk * 33 + (lane & 31)] = W[(size_t)(k0 + kk) * N + n0 + (lane & 31)]; }
    asm volatile("s_waitcnt lgkmcnt(0)" ::: "memory");
    const int c = lane & 7;
#pragma unroll
    for (int j = 0; j < 4; ++j) { const int n = (lane >> 3) + 8 * j; const float* s = scr + (8 * c) * 33 + n;
        v4u o; o.x = pk2(s[0 * 33], s[1 * 33]); o.y = pk2(s[2 * 33], s[3 * 33]); o.z = pk2(s[4 * 33], s[5 * 33]); o.w = pk2(s[6 * 33], s[7 * 33]);
        *(v4u*)(WT + (size_t)rowmap(n0 + n) * K + k0 + 8 * c) = o; }
    asm volatile("s_waitcnt lgkmcnt(0)" ::: "memory");
}
constexpr int CV_E0 = 2, CV_E1 = 12, CV_E2 = 22, CV_E3 = 18, INP0_NC = 40, OUTP0_NC = 64, INP1_NC = 32, MOE_NC = 32;
__device__ __forceinline__ void item8_load(const float* W, int N, int item, int lane, f32x4 (&t)[16]) {
    const int nblk = N / 32, kb = item / nblk, nb = item % nblk, k0 = 128 * kb, n0 = 32 * nb;
    const int r8 = lane >> 3, c8 = lane & 7;
    const float* p = W + (size_t)(k0 + 16 * r8) * N + n0 + 4 * c8;
#pragma unroll
    for (int i = 0; i < 16; ++i) t[i] = __builtin_nontemporal_load((const f32x4*)(p + (size_t)i * N));
}
template <class MapF>
__device__ __forceinline__ void item8_store(const f32x4 (&t)[16], int K, int N, unsigned char* WT, MapF rowmap, int item, int lane) {
    const int nblk = N / 32, kb = item / nblk, nb = item % nblk, k0 = 128 * kb, n0 = 32 * nb;
    const int r8 = lane >> 3, c8 = lane & 7;
#pragma unroll
    for (int c = 0; c < 4; ++c) {
        v4u o;
        o.x = pk4_fp8(t[0][c] * W8_SCALE, t[1][c] * W8_SCALE, t[2][c] * W8_SCALE, t[3][c] * W8_SCALE);     o.y = pk4_fp8(t[4][c] * W8_SCALE, t[5][c] * W8_SCALE, t[6][c] * W8_SCALE, t[7][c] * W8_SCALE);
        o.z = pk4_fp8(t[8][c] * W8_SCALE, t[9][c] * W8_SCALE, t[10][c] * W8_SCALE, t[11][c] * W8_SCALE); o.w = pk4_fp8(t[12][c] * W8_SCALE, t[13][c] * W8_SCALE, t[14][c] * W8_SCALE, t[15][c] * W8_SCALE);
        *(v4u*)(WT + (size_t)rowmap(n0 + 4 * c8 + c) * K + k0 + 16 * r8) = o;
    }
}
struct ExpertConv {
    const CAS Args& a; int layer, wlo, nw, lane;
    static constexpr int IPM = 8 * 32;
    __device__ __forceinline__ void load(int it, f32x4 (&t)[16]) const {
        const int m = it / IPM, le = layer + m / nw, which = wlo + m % nw;
        item8_load((which == 0 ? a.in[31] : which == 1 ? a.in[33] : a.in[35]) + ((size_t)le << 20), D, it % IPM, lane, t); }
    __device__ __forceinline__ void store(int it, const f32x4 (&t)[16]) const {
        const int m = it / IPM, r = it % IPM, le = layer + m / nw, which = wlo + m % nw;
        unsigned char* dst = (unsigned char*)(a.ws + WS_WEXP) + (size_t)le * 3072 * 1024;
        if (which == 0) item8_store(t, D, D, dst, [](int n) { return ((n >> 7) << 8) + (n & 127); }, r, lane);
        else if (which == 1) item8_store(t, D, D, dst, [](int n) { return ((n >> 7) << 8) + 128 + (n & 127); }, r, lane);
        else item8_store(t, D, D, dst + (size_t)2048 * 1024,
            [](int f) { return (f & ~255) | (((f >> 3) & 1) << 7) | (((f >> 6) & 3) << 5) | (((f >> 4) & 3) << 3) | (f & 7); }, r, lane); }
};
__device__ __forceinline__ void convert_experts(const CAS Args& a, const Frame& F, int layer, int wlo, int whi, int gw, int ngw, int elo = 0, int ehi = NE) {
    const ExpertConv C{a, layer * NE + elo, wlo, whi - wlo, F.lane};
    const int total = (ehi - elo) * (whi - wlo) * ExpertConv::IPM;
    int it = gw; if (it >= total) return;
    f32x4 tA[16], tB[16];
    C.load(it, tA);
    for (;;) {
        int nit = it + ngw;
        if (nit < total) C.load(nit, tB);
        C.store(it, tA);
        if (nit >= total) break;
        it = nit; nit = it + ngw;
        if (nit < total) C.load(nit, tA);
        C.store(it, tB);
        if (nit >= total) break;
        it = nit;
    }
}
__device__ __forceinline__ void p0_prologue(const CAS Args& a, const Frame& F) {
    float* scr = (float*)(F.lds + F.wave * 8448);
    constexpr int I_IN0 = 16 * 96, I_O = 16 * 32, I_IN1 = 16 * 64, I_LRU1 = 4 * 8;
    constexpr int NSMALL = I_IN0 + I_O + I_IN1 + I_O + 16 * I_LRU1;
    for (int it = F.gw; it < NSMALL; it += F.ngw) {
        int r = it;
        if (r < I_IN0) {
            transpose_item(a.in[8], D, 3072, (bf16*)(a.ws + WS_WIN0), [](int f) {
                if (f < 2048) return (f & ~255) | (((f >> 5) & 1) << 7) | (((f >> 6) & 3) << 5) | (f & 31);
                if (f < 2560) { const int j = f - 2048; return (8 + (j >> 7)) * 256 + (j & 127); }
                const int j = f - 2560; return (8 + (j >> 7)) * 256 + 128 + (j & 127); }, scr, r, F.lane); continue; } r -= I_IN0;
        if (r < I_O) { transpose_item(a.in[9], D, D, (bf16*)(a.ws + WS_WOUT0), [](int n) { return n; }, scr, r, F.lane); continue; } r -= I_O;
        if (r < I_IN1) { transpose_item(a.in[15], D, 2048, (bf16*)(a.ws + WS_WIN1), [](int n) { return n; }, scr, r, F.lane); continue; } r -= I_IN1;
        if (r < I_O) { transpose_item(a.in[16], D, D, (bf16*)(a.ws + WS_WOUT1), [](int n) { return n; }, scr, r, F.lane); continue; } r -= I_O;
        const int gh = r / I_LRU1, rr = r % I_LRU1, g = gh >> 2, h = gh & 3;
        const float* W = (g == 0 ? a.in[19] : g == 1 ? a.in[21] : g == 2 ? a.in[24] : a.in[26]) + (size_t)h * 65536;
        transpose_item(W, 256, 256, (bf16*)(a.ws + WS_WLRU) + (size_t)h * 1024 * 256, [g](int n) { return g * 256 + n; }, scr, rr, F.lane);
    }
    __syncthreads();
    convert_experts(a, F, 0, 0, 2, F.gw, F.ngw, 0, CV_E0);
    __syncthreads();
    float* sc = (float*)F.lds;
    float* red = (float*)(F.lds + 17 * 1024 * 4);
    {
#pragma unroll
        for (int hbat = 0; hbat < 2; ++hbat) { float tv[17];
#pragma unroll
            for (int j = 0; j < 17; ++j) { const int i = F.tid + 512 * (17 * hbat + j); tv[j] = i < 16 * 1024 ? a.in[1][i] : a.in[3][i - 16 * 1024]; }
#pragma unroll
            for (int j = 0; j < 17; ++j) { const int i = F.tid + 512 * (17 * hbat + j); sc[i] = tv[j] / (1.0f + __expf(-tv[j])); } }
    }
    __syncthreads();
    float* MOD = (float*)(a.ws + WS_MOD);
    for (int u = F.bid; u < 192; u += F.G) {
        const int l = u / 96, n = (u % 96) * 64 + F.lane;
        const float* w = a.in[4] + (size_t)l * D * 6144 + n;
        float acc[17];
#pragma unroll
        for (int b = 0; b < 17; ++b) acc[b] = 0.f;
        for (int k0 = F.wave * 128; k0 < F.wave * 128 + 128; k0 += 16) {
            float wv[16];
#pragma unroll
            for (int q = 0; q < 16; ++q) wv[q] = __builtin_nontemporal_load(w + (size_t)(k0 + q) * 6144);
#pragma unroll
            for (int q = 0; q < 16; ++q)
#pragma unroll
                for (int b = 0; b < 17; ++b) acc[b] += sc[b * 1024 + k0 + q] * wv[q];
        }
#pragma unroll
        for (int b = 0; b < 17; ++b) red[(F.wave * 17 + b) * 64 + F.lane] = acc[b];
        __syncthreads();
        for (int i = F.tid; i < 17 * 64; i += NWAVES * 64) {
            const int b = i / 64, ln = i % 64; float s = 0.f;
#pragma unroll
            for (int w8 = 0; w8 < 8; ++w8) s += red[(w8 * 17 + b) * 64 + ln];
            const int nn = (u % 96) * 64 + ln;
            MOD[((size_t)l * 17 + b) * 6144 + nn] = s + a.in[5][l * 6144 + nn];
        }
        __syncthreads();
    }
}

__device__ __forceinline__ void load_row16(const float* row, int lane, float (&v)[16]) {
#pragma unroll
    for (int j = 0; j < 4; ++j) { const f32x4 t = *(const f32x4*)(row + 256 * j + 4 * lane); v[4 * j] = t.x; v[4 * j + 1] = t.y; v[4 * j + 2] = t.z; v[4 * j + 3] = t.w; }
}
__device__ __forceinline__ void load_row16_bf16(const bf16* row, int lane, float (&v)[16]) {
#pragma unroll
    for (int j = 0; j < 4; ++j) { const uint2 t = *(const uint2*)(row + 256 * j + 4 * lane); v[4 * j] = __uint_as_float(t.x << 16); v[4 * j + 1] = __uint_as_float(t.x & 0xffff0000u); v[4 * j + 2] = __uint_as_float(t.y << 16); v[4 * j + 3] = __uint_as_float(t.y & 0xffff0000u); }
}
__device__ __forceinline__ void store_row16_bf16(bf16* row, int lane, const float (&v)[16]) {
#pragma unroll
    for (int j = 0; j < 4; ++j) { uint2 o; o.x = pk2(v[4 * j], v[4 * j + 1]); o.y = pk2(v[4 * j + 2], v[4 * j + 3]); *(uint2*)(row + 256 * j + 4 * lane) = o; }
}
__device__ __forceinline__ void store_row16_f32(float* row, int lane, const float (&v)[16]) {
#pragma unroll
    for (int j = 0; j < 4; ++j) *(f32x4*)(row + 256 * j + 4 * lane) = (f32x4){v[4 * j], v[4 * j + 1], v[4 * j + 2], v[4 * j + 3]};
}
template <bool FP8OUT = false>
__device__ __forceinline__ void norm_mod(const float (&v)[16], const float* g, const float* sh, const float* sc, bf16* out, int lane, float (&hv)[16]) {
    float s = 0.f;
#pragma unroll
    for (int i = 0; i < 16; ++i) s += v[i] * v[i];
    const float rstd = rsqrtf(wave_sum(s) * (1.0f / D) + 1e-6f);
#pragma unroll
    for (int j = 0; j < 4; ++j) {
        const int e = 256 * j + 4 * lane;
        const f32x4 gg = *(const f32x4*)(g + e), ss = *(const f32x4*)(sh + e), cc = *(const f32x4*)(sc + e);
        hv[4 * j] = v[4 * j] * rstd * gg.x * (1.f + cc.x) + ss.x; hv[4 * j + 1] = v[4 * j + 1] * rstd * gg.y * (1.f + cc.y) + ss.y;
        hv[4 * j + 2] = v[4 * j + 2] * rstd * gg.z * (1.f + cc.z) + ss.z; hv[4 * j + 3] = v[4 * j + 3] * rstd * gg.w * (1.f + cc.w) + ss.w;
        if (FP8OUT) *(unsigned*)((unsigned char*)out + e) = pk4_fp8(hv[4 * j], hv[4 * j + 1], hv[4 * j + 2], hv[4 * j + 3]);
        else { uint2 o; o.x = pk2(hv[4 * j], hv[4 * j + 1]); o.y = pk2(hv[4 * j + 2], hv[4 * j + 3]); *(uint2*)(out + e) = o; }
    }
}
__device__ __forceinline__ int row_batch(int r) { return r < NT ? (r >> 11) : 16; }
__device__ __forceinline__ const float* mod_ptr(const CAS Args& a, int l, int r, int chunk) { return (const float*)(a.ws + WS_MOD) + ((size_t)l * 17 + row_batch(r)) * 6144 + chunk * D; }

__device__ __forceinline__ void p_norm1_l0(const CAS Args& a, const Frame& F) {
    bf16* H = (bf16*)(a.ws + WS_H);
    { float* GS2 = (float*)(a.ws + WS_GS2); const float* MOD = (const float*)(a.ws + WS_MOD);
      for (int i = F.gw * 64 + F.lane; i < 2 * 17 * D; i += F.ngw * 64) { const int l = i / (17 * D), bb = (i / D) % 17, k = i % D; GS2[i] = a.in[7][l * D + k] * (1.0f + MOD[((size_t)l * 17 + bb) * 6144 + 4 * D + k]); } }
    for (int r = F.gw; r < R; r += 3 * F.ngw) {
        float v[3][16], hv[16];
#pragma unroll
        for (int k = 0; k < 3; ++k) { const int rr = r + k * F.ngw; if (rr < R) load_row16(rr < NT ? a.in[0] + (size_t)rr * D : a.in[2] + (size_t)(rr - NT) * D, F.lane, v[k]); }
#pragma unroll
        for (int k = 0; k < 3; ++k) { const int rr = r + k * F.ngw; if (rr < R) norm_mod(v[k], a.in[6], mod_ptr(a, 0, rr, 0), mod_ptr(a, 0, rr, 1), H + (size_t)rr * D, F.lane, hv); }
    }
}

struct EpiInProj0 {
    static constexpr bool PERM = true;
    bf16* P; const float* qg; const float* kg;
    __device__ __forceinline__ void operator()(const f32x4 (&acc)[2][2][4][2], const pg8::Unit& u, int wr, int wc, int fr, int fq) const {
        const int row0 = u.pm * 256 + wr * 64 + fr, pn = u.pn;
        if (pn < 4) {
            const float* g = pn < 2 ? qg : kg; const float sc = pn < 2 ? 0.125f : 1.0f;
            f32x4 gv[2][2];
#pragma unroll
            for (int bj = 0; bj < 2; ++bj)
#pragma unroll
                for (int n = 0; n < 2; ++n) gv[bj][n] = *(const f32x4*)(g + 32 * bj + 8 * fq + 4 * n);
#pragma unroll
            for (int ai = 0; ai < 2; ++ai)
#pragma unroll
                for (int m = 0; m < 4; ++m) {
                    float ss = 0.f;
#pragma unroll
                    for (int bj = 0; bj < 2; ++bj)
#pragma unroll
                        for (int n = 0; n < 2; ++n) { const f32x4 x = acc[ai][bj][m][n]; ss += (x[0] * x[0] + x[1] * x[1]) + (x[2] * x[2] + x[3] * x[3]); }
                    ss += __shfl_xor(ss, 16); ss += __shfl_xor(ss, 32);
                    const float rs = rsqrtf(ss * (1.0f / 64.0f) + 1e-6f) * sc;
                    bf16* rowp = P + (size_t)(row0 + ai * 128 + m * 16) * PP + pn * 256 + wc * 64 + 8 * fq;
#pragma unroll
                    for (int bj = 0; bj < 2; ++bj) { const f32x4 v0 = acc[ai][bj][m][0] * rs * gv[bj][0], v1 = acc[ai][bj][m][1] * rs * gv[bj][1];
                        v4u w; w.x = pg8::cvt_pk_bf16(v0[0], v0[1]); w.y = pg8::cvt_pk_bf16(v0[2], v0[3]); w.z = pg8::cvt_pk_bf16(v1[0], v1[1]); w.w = pg8::cvt_pk_bf16(v1[2], v1[3]);
                        *(v4u*)(rowp + 32 * bj) = w; }
                }
        } else if (pn < 8) {
#pragma unroll
            for (int ai = 0; ai < 2; ++ai)
#pragma unroll
                for (int m = 0; m < 4; ++m) { bf16* rowp = P + (size_t)(row0 + ai * 128 + m * 16) * PP + pn * 256 + wc * 64 + 8 * fq;
#pragma unroll
                    for (int bj = 0; bj < 2; ++bj) { const f32x4 v0 = acc[ai][bj][m][0], v1 = acc[ai][bj][m][1];
                        v4u w; w.x = pg8::cvt_pk_bf16(v0[0], v0[1]); w.y = pg8::cvt_pk_bf16(v0[2], v0[3]); w.z = pg8::cvt_pk_bf16(v1[0], v1[1]); w.w = pg8::cvt_pk_bf16(v1[2], v1[3]);
                        *(v4u*)(rowp + 32 * bj) = w; } }
        } else {
#pragma unroll
            for (int ai = 0; ai < 2; ++ai)
#pragma unroll
                for (int m = 0; m < 4; ++m) { bf16* rowp = P + (size_t)(row0 + ai * 128 + m * 16) * PP + 2048 + (pn - 8) * 128 + wc * 32 + 8 * fq;
                    const f32x4 v0 = acc[ai][0][m][0] * acc[ai][1][m][0], v1 = acc[ai][0][m][1] * acc[ai][1][m][1];
                    v4u w; w.x = pg8::cvt_pk_bf16(v0[0], v0[1]); w.y = pg8::cvt_pk_bf16(v0[2], v0[3]); w.z = pg8::cvt_pk_bf16(v1[0], v1[1]); w.w = pg8::cvt_pk_bf16(v1[2], v1[3]);
                    *(v4u*)rowp = w; }
        }
    }
};
__device__ __forceinline__ void p_inproj0(const CAS Args& a, const Frame& F) {
    if (F.bid >= F.G - INP0_NC) { convert_experts(a, F, 0, 0, 2, (F.bid - (F.G - INP0_NC)) * NWAVES + F.wave, INP0_NC * NWAVES, CV_E1, NE); return; }
    pg8::RectSched S{(const char*)(a.ws + WS_H), (const char*)(a.ws + WS_WIN0), 2 * D, R / 256, 3072 / 256, F.G - INP0_NC, F.bid, 0, 0, 0, 0};
    EpiInProj0 E{(bf16*)(a.ws + WS_P), a.in[10], a.in[11]};
    pg8::gemm_phase<2 * D, false>(F.ldsl, S, E, F.wave);
}
typedef __bf16 bf16x2_t __attribute__((ext_vector_type(2)));
typedef float f32x2_t __attribute__((ext_vector_type(2)));
typedef short s16x4 __attribute__((ext_vector_type(4)));
__device__ __forceinline__ unsigned pk_bf16(float a, float b) { f32x2_t v = {a, b}; bf16x2_t r = __builtin_convertvector(v, bf16x2_t); return __builtin_bit_cast(unsigned, r); }
constexpr int AT_LAT = 0, AT_CK = 576 * 128, AT_CV = AT_CK + 256 * 128, AT_RPB = AT_CV + 256 * 128;
__device__ __forceinline__ int at_swz(int key) { return (key ^ (key >> 3)) & 7; }
__device__ __forceinline__ unsigned at_addr(int key, int chunk) { return (unsigned)(key * 128 + ((chunk ^ at_swz(key)) << 4)); }
template <class RowF>
__device__ __forceinline__ void at_stage(LAS unsigned char* dst, int npieces, RowF rowf, int colbyte, const bf16* P, int wave, int lane) {
    for (int p = wave; p < npieces; p += NWAVES) {
        const int key = 8 * p + (lane >> 3), c = (lane & 7) ^ at_swz(key);
        const char* src = (const char*)P + (size_t)rowf(key) * (PP * 2) + colbyte + 16 * c;
        __builtin_amdgcn_global_load_lds((const unsigned*)src, (LAS unsigned*)(dst + p * 1024), 16, 0, 0);
    }
}
__device__ __forceinline__ void at_tr8(unsigned a0, unsigned a1, unsigned a2, unsigned a3, unsigned a4, unsigned a5, unsigned a6, unsigned a7, s16x4 (&r)[8]) {
    asm volatile("ds_read_b64_tr_b16 %0, %8\n\tds_read_b64_tr_b16 %1, %9\n\tds_read_b64_tr_b16 %2, %10\n\tds_read_b64_tr_b16 %3, %11\n\t"
                 "ds_read_b64_tr_b16 %4, %12\n\tds_read_b64_tr_b16 %5, %13\n\tds_read_b64_tr_b16 %6, %14\n\tds_read_b64_tr_b16 %7, %15\n\ts_waitcnt lgkmcnt(0)"
                 : "=&v"(r[0]), "=&v"(r[1]), "=&v"(r[2]), "=&v"(r[3]), "=&v"(r[4]), "=&v"(r[5]), "=&v"(r[6]), "=&v"(r[7])
                 : "v"(a0), "v"(a1), "v"(a2), "v"(a3), "v"(a4), "v"(a5), "v"(a6), "v"(a7) : "memory");
}
__device__ __forceinline__ void p_attn(const CAS Args& a, const Frame& F) {
    const bf16* P = (const bf16*)(a.ws + WS_P); bf16* A2 = (bf16*)(a.ws + WS_A2);
    LAS unsigned char* lds = F.ldsl;
    const int lane = F.lane, wave = F.wave, rho = lane & 15, g = lane >> 4;
    for (int wu = F.bid; wu < NB * 8 * 2; wu += F.G) {
        const int half = wu & 1, hd = (wu >> 1) & 7, b = wu >> 4;
        __syncthreads();
        for (int i = F.tid; i < 465; i += NWAVES * 64) ((LAS float*)(lds + AT_RPB))[i] = a.in[12][hd * 465 + i];
        at_stage(lds + AT_CK, 32, [=](int key) { return NT + b * 256 + key; }, (512 + hd * 64) * 2, P, wave, lane);
        at_stage(lds + AT_CV, 32, [=](int key) { return NT + b * 256 + key; }, (1024 + hd * 64) * 2, P, wave, lane);
        for (int un = 0; un < 9; ++un) {
            const bool lat = un < 8;
            int r = 0, n = 0, qrow, krow_lo = 0;
            if (lat) { const int rp = half * 8 + un; r = 2 * rp + (wave >> 2); n = wave & 3; qrow = b * 2048 + r * 64 + 16 * n + rho; krow_lo = min(max(2 * rp - 4, 0), 24); }
            else qrow = NT + b * 256 + half * 128 + 16 * wave + rho;
            const int r0 = min(max(r - 4, 0), 24), ro = r0 - krow_lo, kc0 = min(max(16 * n - 8, 0), 32);
            const int c = 16 * n + rho, c0 = min(max(c - 8, 0), 48);
            if (lat) at_stage(lds + AT_LAT, 72, [=](int key) { return b * 2048 + min(krow_lo + (key >> 6), 31) * 64 + (key & 63); }, (512 + hd * 64) * 2, P, wave, lane);
            const bf16x8 q0 = *(const bf16x8*)(P + (size_t)qrow * PP + hd * 64 + 8 * g), q1 = *(const bf16x8*)(P + (size_t)qrow * PP + hd * 64 + 32 + 8 * g);
            asm volatile("s_waitcnt vmcnt(0)" ::: "memory");
            __syncthreads();
            const int pk = 8 * (rho >> 2) + (rho & 3);
            float mxb[2] = {-1e30f, -1e30f}, smb[2] = {0.f, 0.f}; v4u pf[16];
#pragma unroll
            for (int blk = 0; blk < 2; ++blk) {
                if (blk == 0 && !lat) {
#pragma unroll
                    for (int i = 0; i < 8; ++i) pf[i] = (v4u){0u, 0u, 0u, 0u};
                    continue; }
                f32x4 s[16];
#pragma unroll
                for (int i = 0; i < 8; ++i)
#pragma unroll
                    for (int t = 0; t < 2; ++t) {
                        const int key = (blk == 0 ? (ro + i) * 64 + kc0 : 32 * i) + pk + 4 * t;
                        const unsigned kbase = blk == 0 ? AT_LAT : AT_CK;
                        const bf16x8 k0 = *(const LAS bf16x8*)(lds + kbase + at_addr(key, g)), k1 = *(const LAS bf16x8*)(lds + kbase + at_addr(key, 4 + g));
                        f32x4 acc = __builtin_amdgcn_mfma_f32_16x16x32_bf16(k0, q0, (f32x4){0.f, 0.f, 0.f, 0.f}, 0, 0, 0);
                        acc = __builtin_amdgcn_mfma_f32_16x16x32_bf16(k1, q1, acc, 0, 0, 0);
                        if (blk == 0) {
                            const int dr = r0 + i - r + 7;
#pragma unroll
                            for (int jj = 0; jj < 4; ++jj) { const int kcol = kc0 + 8 * g + 4 * t + jj; const int dc = min(max(kcol - c + 15, 0), 30);
                                const float bias = ((const LAS float*)(lds + AT_RPB))[dr * 31 + dc];
                                acc[jj] = ((unsigned)(kcol - c0) < 16u) ? acc[jj] + bias : -1e30f; }
                        }
                        s[2 * i + t] = acc;
                    }
                float mx = -1e30f;
#pragma unroll
                for (int i = 0; i < 16; ++i) mx = fmaxf(fmaxf(mx, fmaxf(s[i][0], s[i][1])), fmaxf(s[i][2], s[i][3]));
                mx = fmaxf(mx, __shfl_xor(mx, 16)); mx = fmaxf(mx, __shfl_xor(mx, 32));
                float sum = 0.f;
#pragma unroll
                for (int i = 0; i < 8; ++i) {
                    float e[8];
#pragma unroll
                    for (int t = 0; t < 2; ++t)
#pragma unroll
                        for (int jj = 0; jj < 4; ++jj) { e[4 * t + jj] = __expf(s[2 * i + t][jj] - mx); sum += e[4 * t + jj]; }
                    pf[8 * blk + i].x = pk_bf16(e[0], e[1]); pf[8 * blk + i].y = pk_bf16(e[2], e[3]); pf[8 * blk + i].z = pk_bf16(e[4], e[5]); pf[8 * blk + i].w = pk_bf16(e[6], e[7]);
                }
                sum += __shfl_xor(sum, 16); sum += __shfl_xor(sum, 32);
                mxb[blk] = mx; smb[blk] = sum;
            }
            __syncthreads();
            if (lat) at_stage(lds + AT_LAT, 72, [=](int key) { return b * 2048 + min(krow_lo + (key >> 6), 31) * 64 + (key & 63); }, (1024 + hd * 64) * 2, P, wave, lane);
            asm volatile("s_waitcnt vmcnt(0)" ::: "memory");
            __syncthreads();
            f32x4 o[2][4];
#pragma unroll
            for (int blk = 0; blk < 2; ++blk)
#pragma unroll
                for (int db = 0; db < 4; ++db) o[blk][db] = (f32x4){0.f, 0.f, 0.f, 0.f};
            const int tq = rho >> 2, tp = rho & 3;
#pragma unroll
            for (int ch = 0; ch < 16; ++ch) {
                if (ch < 8 && !lat) continue;
                int zo = 0; asm volatile("" : "+v"(zo));
                const int kb = (ch < 8 ? (ro + ch) * 64 + kc0 + 8 * g + tq : 32 * (ch - 8) + 8 * g + tq) + zo;
                const unsigned base = (unsigned)(size_t)(lds + (ch < 8 ? AT_LAT : AT_CV));
                unsigned ad[8];
#pragma unroll
                for (int db = 0; db < 4; ++db) { ad[2 * db] = base + at_addr(kb, 2 * db + (tp >> 1)) + 8 * (tp & 1); ad[2 * db + 1] = base + at_addr(kb + 4, 2 * db + (tp >> 1)) + 8 * (tp & 1); }
                s16x4 vr[8]; at_tr8(ad[0], ad[1], ad[2], ad[3], ad[4], ad[5], ad[6], ad[7], vr);
#pragma unroll
                for (int db = 0; db < 4; ++db) { const bf16x8 vf = __builtin_shufflevector(vr[2 * db], vr[2 * db + 1], 0, 1, 2, 3, 4, 5, 6, 7);
                    o[ch >> 3][db] = __builtin_amdgcn_mfma_f32_16x16x32_bf16(vf, __builtin_bit_cast(bf16x8, pf[ch]), o[ch >> 3][db], 0, 0, 0); }
            }
            const float mxa = fmaxf(mxb[0], mxb[1]), f0 = __expf(mxb[0] - mxa), f1 = __expf(mxb[1] - mxa);
            const float inv = 1.0f / (f0 * smb[0] + f1 * smb[1]), g0 = f0 * inv, g1 = f1 * inv;
#pragma unroll
            for (int db = 0; db < 4; ++db) { uint2 w; w.x = pk_bf16(o[0][db][0] * g0 + o[1][db][0] * g1, o[0][db][1] * g0 + o[1][db][1] * g1); w.y = pk_bf16(o[0][db][2] * g0 + o[1][db][2] * g1, o[0][db][3] * g0 + o[1][db][3] * g1);
                *(uint2*)(A2 + (size_t)qrow * D + hd * 64 + 16 * db + 4 * g) = w; }
            __syncthreads();
        }
    }
    const float* cw = a.in[13]; const float* cb = a.in[14];
    const int j0 = 8 * lane;
    float w0[8], w1[8], w2[8], bb[8];
#pragma unroll
    for (int q = 0; q < 8; ++q) { w0[q] = cw[j0 + q]; w1[q] = cw[512 + j0 + q]; w2[q] = cw[1024 + j0 + q]; bb[q] = cb[j0 + q]; }
    for (int blk = F.gw; blk < R / 6; blk += F.ngw) {
        const int row0 = 6 * blk;
        v4u pw[8], bgw[6];
#pragma unroll
        for (int k = 0; k < 8; ++k) { const int rr = row0 + k - 1; pw[k] = (rr >= 0 && rr < R) ? *(const v4u*)(P + (size_t)rr * PP + 2048 + j0) : (v4u){0u, 0u, 0u, 0u}; }
#pragma unroll
        for (int k = 0; k < 6; ++k) bgw[k] = *(const v4u*)(P + (size_t)(row0 + k) * PP + 1536 + j0);
#pragma unroll
        for (int k = 0; k < 6; ++k) {
            const int row = row0 + k; const bool latr = row < NT; const int t = latr ? (row & 2047) : ((row - NT) & 255), len = latr ? 2048 : 256;
            const v4u pm = t > 0 ? pw[k] : (v4u){0u, 0u, 0u, 0u}, pc = pw[k + 1], pn = (t + 1 < len) ? pw[k + 2] : (v4u){0u, 0u, 0u, 0u}, bgv = bgw[k];
            const unsigned am[4] = {pm.x, pm.y, pm.z, pm.w}, ac[4] = {pc.x, pc.y, pc.z, pc.w}, an[4] = {pn.x, pn.y, pn.z, pn.w}, ab[4] = {bgv.x, bgv.y, bgv.z, bgv.w};
            unsigned ow[4];
#pragma unroll
            for (int q = 0; q < 4; ++q) {
                const float lo = __uint_as_float(ab[q] << 16) * (bb[2 * q] + w0[2 * q] * __uint_as_float(am[q] << 16) + w1[2 * q] * __uint_as_float(ac[q] << 16) + w2[2 * q] * __uint_as_float(an[q] << 16));
                const float hi = __uint_as_float(ab[q] & 0xffff0000u) * (bb[2 * q + 1] + w0[2 * q + 1] * __uint_as_float(am[q] & 0xffff0000u) + w1[2 * q + 1] * __uint_as_float(ac[q] & 0xffff0000u) + w2[2 * q + 1] * __uint_as_float(an[q] & 0xffff0000u));
                ow[q] = pk_bf16(lo, hi);
            }
            *(v4u*)(A2 + (size_t)row * D + 512 + j0) = (v4u){ow[0], ow[1], ow[2], ow[3]};
        }
    }
}
template <int L>
struct EpiOutProj {
    static constexpr bool PERM = true;
    const float* baseL; const float* baseC; bf16* XB; const float* MODl;
    __device__ __forceinline__ void operator()(const f32x4 (&acc)[2][2][4][2], const pg8::Unit& u, int wr, int wc, int fr, int fq) const {
        const bool lat = u.pm < NT / 256;
        const int mb = lat ? (u.pm >> 3) : 16;
        const int row0 = u.pm * 256 + wr * 64 + fr, col0 = u.pn * 256 + wc * 32 + 8 * fq;
        const float* g1 = MODl + (size_t)mb * 6144 + 2 * D + col0;
        f32x4 gv[2][2];
#pragma unroll
        for (int bj = 0; bj < 2; ++bj)
#pragma unroll
            for (int n = 0; n < 2; ++n) gv[bj][n] = *(const f32x4*)(g1 + bj * 128 + 4 * n);
#pragma unroll
        for (int ai = 0; ai < 2; ++ai)
#pragma unroll
            for (int m = 0; m < 4; ++m) { const int row = row0 + ai * 128 + m * 16;
#pragma unroll
                for (int bj = 0; bj < 2; ++bj) {
                    f32x4 b0, b1;
                    if (L == 0) { const float* bp = (lat ? baseL + (size_t)row * D : baseC + (size_t)(row - NT) * D) + col0 + bj * 128; b0 = *(const f32x4*)bp; b1 = *(const f32x4*)(bp + 4); }
                    else { const v4u w = *(const v4u*)(XB + (size_t)row * D + col0 + bj * 128);
                        b0 = (f32x4){__uint_as_float(w.x << 16), __uint_as_float(w.x & 0xffff0000u), __uint_as_float(w.y << 16), __uint_as_float(w.y & 0xffff0000u)};
                        b1 = (f32x4){__uint_as_float(w.z << 16), __uint_as_float(w.z & 0xffff0000u), __uint_as_float(w.w << 16), __uint_as_float(w.w & 0xffff0000u)}; }
                    const f32x4 v0 = b0 + gv[bj][0] * acc[ai][bj][m][0], v1 = b1 + gv[bj][1] * acc[ai][bj][m][1];
                    v4u o; o.x = pg8::cvt_pk_bf16(v0[0], v0[1]); o.y = pg8::cvt_pk_bf16(v0[2], v0[3]); o.z = pg8::cvt_pk_bf16(v1[0], v1[1]); o.w = pg8::cvt_pk_bf16(v1[2], v1[3]);
                    *(v4u*)(XB + (size_t)row * D + col0 + bj * 128) = o; }
                asm volatile("" ::: "memory"); }
    }
};
template <int L>
__device__ __forceinline__ void p_outproj(const CAS Args& a, const Frame& F) {
    const int nc = L == 0 ? OUTP0_NC : 0;
    if (F.bid >= F.G - nc) { convert_experts(a, F, 0, 0, 2, (F.bid - (F.G - nc)) * NWAVES + F.wave, nc * NWAVES, CV_E0, CV_E1); return; }
    pg8::RectSched S{(const char*)(a.ws + (L == 0 ? WS_A2 : WS_A3)), (const char*)(a.ws + (L == 0 ? WS_WOUT0 : WS_WOUT1)), 2 * D, (L == 0 ? R : NT) / 256, D / 256, F.G - nc, F.bid, 0, 0, 0, 0};
    EpiOutProj<L> E{a.in[0], a.in[2], (bf16*)(a.ws + WS_XB), (const float*)(a.ws + WS_MOD) + (size_t)L * 17 * 6144};
    pg8::gemm_phase<2 * D, false>(F.ldsl, S, E, F.wave);
}
#define RS_STEP(half, m) do { const bool up = (F.lane & (m)) != 0; _Pragma("unroll") for (int i = 0; i < (half); ++i) { \
        const float keep = up ? part[i + (half)] : part[i]; const float send = up ? part[i] : part[i + (half)]; part[i] = keep + __shfl_xor(send, (m)); } } while (0)
constexpr int RT_WH = 0, RT_WL = 65536, RT_GS = 131072, RT_LG = 139264, RT_CNT = 155648;
__device__ __forceinline__ void p_norm2_router(const CAS Args& a, const Frame& F, int l) {
    unsigned char* H8 = (unsigned char*)(a.ws + WS_H); const bf16* XB = (const bf16*)(a.ws + WS_XB);
    unsigned* ctl = (unsigned*)(a.ws + WS_CTL);
    int* toklist = (int*)(a.ws + WS_TOKLIST); int* sel = (int*)(a.ws + WS_SEL); float* gatev = (float*)(a.ws + WS_GATEV);
    const float* wr = a.in[29] + (size_t)l * D * NE; const float* br = a.in[30] + l * NE;
    const float* GS2 = (const float*)(a.ws + WS_GS2) + (size_t)l * 17 * D; const float* MODl = (const float*)(a.ws + WS_MOD) + (size_t)l * 17 * 6144;
    const int rows = l == 0 ? R : NT, rpw = rows / F.G, row_lo = F.bid * rpw, nblk = rpw / 16;
    LAS unsigned char* lds = F.ldsl;
    const int lane = F.lane, wave = F.wave, rho = lane & 15, g = lane >> 4;
    const int b_first = row_batch(row_lo);
    __syncthreads();
    {
        f32x4 wv[16];
#pragma unroll
        for (int j = 0; j < 16; ++j) wv[j] = *(const f32x4*)(wr + 4 * (F.tid + 512 * j));
#pragma unroll
        for (int j = 0; j < 16; ++j) { const int i0 = 4 * (F.tid + 512 * j), k = i0 >> 5;
#pragma unroll
            for (int q = 0; q < 4; ++q) { const int e = (i0 & 31) + q; const float w = wv[j][q]; const bf16 hi = f2bf(w), lo = f2bf(w - bf2f(hi));
                const int off = e * 2048 + 16 * ((k >> 3) ^ (e & 15)) + 2 * (k & 7);
                *(LAS bf16*)(lds + RT_WH + off) = hi; *(LAS bf16*)(lds + RT_WL + off) = lo; } }
    }
    for (int i = F.tid; i < 2 * D; i += NWAVES * 64) { const int s = i >> 10, k = i & 1023; const int bb = s == 0 ? b_first : row_batch(row_lo + rpw - 1); ((LAS float*)(lds + RT_GS))[i] = GS2[bb * D + k]; }
    LAS unsigned* wcnt = (LAS unsigned*)(lds + RT_CNT); LAS unsigned* wbase = wcnt + 32; LAS unsigned* stmp = wcnt + 64;
    if (F.tid < NE) wcnt[F.tid] = 0u;
    __syncthreads();
    for (int blk = wave; blk < nblk; blk += NWAVES) {
        const int r0 = row_lo + 16 * blk, row = r0 + rho, bb = row_batch(r0);
        const bf16* xr = XB + (size_t)row * D + 8 * g;
        float ss = 0.f;
#pragma unroll
        for (int kh = 0; kh < 2; ++kh) {
            v4u xw[16];
#pragma unroll
            for (int ks = 0; ks < 16; ++ks) xw[ks] = *(const v4u*)(xr + 32 * (16 * kh + ks));
#pragma unroll
            for (int ks = 0; ks < 16; ++ks) { const unsigned u4[4] = {xw[ks].x, xw[ks].y, xw[ks].z, xw[ks].w};
#pragma unroll
                for (int q = 0; q < 4; ++q) { const float x0 = __uint_as_float(u4[q] << 16), x1 = __uint_as_float(u4[q] & 0xffff0000u); ss += x0 * x0 + x1 * x1; } }
            asm volatile("" ::: "memory");
        }
        ss += __shfl_xor(ss, 16); ss += __shfl_xor(ss, 32);
        const float rstd = rsqrtf(ss * (1.0f / D) + 1e-6f);
        const LAS float* gs = (const LAS float*)(lds + RT_GS) + (bb == b_first ? 0 : D) + 8 * g;
        const float* sh = MODl + (size_t)bb * 6144 + 3 * D + 8 * g;
        f32x4 acc[2] = {(f32x4){0.f, 0.f, 0.f, 0.f}, (f32x4){0.f, 0.f, 0.f, 0.f}};
        int offb[4];
#pragma unroll
        for (int b4 = 0; b4 < 4; ++b4) offb[b4] = rho * 2048 + (((4 * (b4 ^ ((rho >> 2) & 3))) + (g ^ (rho & 3))) << 4);
        for (int k4 = 0; k4 < 8; ++k4) {
            v4u xw[4]; f32x4 sv[4][2];
#pragma unroll
            for (int b4 = 0; b4 < 4; ++b4) { const int ks = 4 * k4 + b4; xw[b4] = *(const v4u*)(xr + 32 * ks); sv[b4][0] = *(const f32x4*)(sh + 32 * ks); sv[b4][1] = *(const f32x4*)(sh + 32 * ks + 4); }
#pragma unroll
            for (int b4 = 0; b4 < 4; ++b4) {
                const int ks = 4 * k4 + b4;
                const unsigned u4[4] = {xw[b4].x, xw[b4].y, xw[b4].z, xw[b4].w};
                const f32x4 g0 = *(const LAS f32x4*)(gs + 32 * ks), g1 = *(const LAS f32x4*)(gs + 32 * ks + 4);
                const f32x4 s0 = sv[b4][0], s1 = sv[b4][1];
                float hv[8];
#pragma unroll
                for (int q = 0; q < 4; ++q) { const float x0 = __uint_as_float(u4[q] << 16) * rstd, x1 = __uint_as_float(u4[q] & 0xffff0000u) * rstd;
                    const float gg0 = q < 2 ? g0[2 * q] : g1[2 * q - 4], gg1 = q < 2 ? g0[2 * q + 1] : g1[2 * q - 3], t0 = q < 2 ? s0[2 * q] : s1[2 * q - 4], t1 = q < 2 ? s0[2 * q + 1] : s1[2 * q - 3];
                    hv[2 * q] = x0 * gg0 + t0; hv[2 * q + 1] = x1 * gg1 + t1; }
                v4u hi, lo;
#pragma unroll
                for (int q = 0; q < 4; ++q) { const unsigned p = pk_bf16(hv[2 * q], hv[2 * q + 1]); ((unsigned*)&hi)[q] = p;
                    ((unsigned*)&lo)[q] = pk_bf16(hv[2 * q] - __uint_as_float(p << 16), hv[2 * q + 1] - __uint_as_float(p & 0xffff0000u)); }
                { uint2 f8; unsigned t0 = 0u, t1 = 0u; t0 = __builtin_amdgcn_cvt_pk_fp8_f32(hv[0], hv[1], t0, false); t0 = __builtin_amdgcn_cvt_pk_fp8_f32(hv[2], hv[3], t0, true);
                  t1 = __builtin_amdgcn_cvt_pk_fp8_f32(hv[4], hv[5], t1, false); t1 = __builtin_amdgcn_cvt_pk_fp8_f32(hv[6], hv[7], t1, true); f8.x = t0; f8.y = t1;
                  *(uint2*)(H8 + (size_t)row * D + 32 * ks + 8 * g) = f8; }
#pragma unroll
                for (int nt = 0; nt < 2; ++nt) { const int off = nt * 32768 + k4 * 256 + offb[b4];
                    const bf16x8 bh = *(const LAS bf16x8*)(lds + RT_WH + off), bl = *(const LAS bf16x8*)(lds + RT_WL + off);
                    acc[nt] = __builtin_amdgcn_mfma_f32_16x16x32_bf16(__builtin_bit_cast(bf16x8, hi), bh, acc[nt], 0, 0, 0);
                    acc[nt] = __builtin_amdgcn_mfma_f32_16x16x32_bf16(__builtin_bit_cast(bf16x8, lo), bh, acc[nt], 0, 0, 0);
                    acc[nt] = __builtin_amdgcn_mfma_f32_16x16x32_bf16(__builtin_bit_cast(bf16x8, hi), bl, acc[nt], 0, 0, 0); }
            }
        }
        LAS float* lg = (LAS float*)(lds + RT_LG + wave * 2048);
#pragma unroll
        for (int nt = 0; nt < 2; ++nt)
#pragma unroll
            for (int jj = 0; jj < 4; ++jj) lg[(4 * g + jj) * 32 + 16 * nt + rho] = acc[nt][jj] + br[16 * nt + rho];
        {
            float mine[8], allv[32];
#pragma unroll
            for (int q = 0; q < 8; ++q) { const f32x4 t = *(const LAS f32x4*)(lg + rho * 32 + 4 * q); allv[4 * q] = t[0]; allv[4 * q + 1] = t[1]; allv[4 * q + 2] = t[2]; allv[4 * q + 3] = t[3]; }
#pragma unroll
            for (int q = 0; q < 8; ++q) mine[q] = g == 0 ? allv[q] : g == 1 ? allv[8 + q] : g == 2 ? allv[16 + q] : allv[24 + q];
            LAS float* rs = lg;
#pragma unroll
            for (int q = 0; q < 8; ++q) { const int e = 8 * g + q; int rank = 0;
#pragma unroll
                for (int jx = 0; jx < 32; ++jx) rank += (allv[jx] > mine[q] || (allv[jx] == mine[q] && jx < e)) ? 1 : 0;
                if (rank < 4) { rs[(rho * 4 + rank) * 2] = mine[q]; ((LAS int*)rs)[(rho * 4 + rank) * 2 + 1] = e; } }
            if (lane < 16) {
                const f32x4 q0 = *(const LAS f32x4*)(rs + lane * 8), q1 = *(const LAS f32x4*)(rs + lane * 8 + 4);
                const float tv0 = q0[0], tv1 = q0[2], tv2 = q1[0], tv3 = q1[2]; const int ti[4] = {__float_as_int(q0[1]), __float_as_int(q0[3]), __float_as_int(q1[1]), __float_as_int(q1[3])};
                const float e1 = __expf(tv1 - tv0), e2 = __expf(tv2 - tv0), e3 = __expf(tv3 - tv0), inv = 1.0f / (1.0f + e1 + e2 + e3);
                const float gk[4] = {inv, e1 * inv, e2 * inv, e3 * inv};
                const int rl = 16 * blk + lane;
#pragma unroll
                for (int k = 0; k < 4; ++k) { const unsigned p = __hip_atomic_fetch_add(wcnt + ti[k], 1u, __ATOMIC_RELAXED, __HIP_MEMORY_SCOPE_WORKGROUP);
                    stmp[(rl * 4 + k) * 2] = (p << 5) | (unsigned)ti[k]; stmp[(rl * 4 + k) * 2 + 1] = __float_as_uint(gk[k]); }
            }
        }
    }
    __syncthreads();
    if (F.tid < NE) { const unsigned c = wcnt[F.tid]; wbase[F.tid] = c ? __hip_atomic_fetch_add(ctl + CW_CNT + (l * 32 + F.tid) * 64, c, RLX_AGENT) : 0u; }
    __syncthreads();
    for (int i = F.tid; i < rpw * 4; i += NWAVES * 64) { const int rl = i >> 2, k = i & 3, r = row_lo + rl; const unsigned pe = stmp[i * 2], e = pe & 31u, pos = wbase[e] + (pe >> 5);
        toklist[(size_t)e * CAP + pos] = r; sel[r * 4 + k] = (int)((pos << 5) | e); gatev[r * 4 + k] = __uint_as_float(stmp[i * 2 + 1]); }
}
struct MoeTab { int cnt[NE], base[NE + 1], tpre[NE + 1]; };
__device__ __forceinline__ void moe_tab_build(const CAS Args& a, const Frame& F, int l, LAS MoeTab* tb) {
    unsigned* ctl = (unsigned*)(a.ws + WS_CTL);
    __syncthreads();
    if (F.tid < NE) tb->cnt[F.tid] = (int)__hip_atomic_load(ctl + CW_CNT + (l * 32 + F.tid) * 64, RLX_AGENT);
    __syncthreads();
    if (F.tid == 0) { int bs = 0, tp = 0; for (int e = 0; e < NE; ++e) { const int c = tb->cnt[e]; tb->base[e] = bs; tb->tpre[e] = tp; bs += c; tp += (c + 255) >> 8; } tb->base[NE] = bs; tb->tpre[NE] = tp; }
    __syncthreads();
}
constexpr int MOE_UT_MAX = 64;
template <bool UP>
struct MoeSched {
    static constexpr bool GATHER = UP;
    const LAS MoeTab* tb; const LAS int* ut; const char* A; const char* WE; const int* toklist; int G, c;
    static constexpr int NN = UP ? 8 : 4;
    static __device__ __forceinline__ int rfl(int v) { return __builtin_amdgcn_readfirstlane(v); }
    static __device__ __forceinline__ const char* ufy(const char* p) { const unsigned long long v = (unsigned long long)p; const unsigned lo = __builtin_amdgcn_readfirstlane((unsigned)v), hi = __builtin_amdgcn_readfirstlane((unsigned)(v >> 32)); return (const char*)(((unsigned long long)hi << 32) | lo); }
    __device__ __forceinline__ bool unit_search(int i, int& pm, int& pn, int& e_, int& rows, int& base) const {
        const int nwg = tb->tpre[NE] * NN; const long L = (long)i * G + c; if (L >= nwg) return false;
        const int w = pg8::xcd_remap(L, nwg);
        int e = 0; while (e < NE - 1 && w >= tb->tpre[e + 1] * NN) ++e;
        const int tp0 = tb->tpre[e], tp1 = tb->tpre[e + 1];
        const int q = w - tp0 * NN, nte = tp1 - tp0;
        const int nig = 8 * NN, gid = q / nig, fm = gid * 8, gsz = (nte - fm) < 8 ? (nte - fm) : 8;
        pm = fm + ((q % nig) % gsz); pn = (q % nig) / gsz; e_ = e; rows = min(256, tb->cnt[e] - pm * 256); base = tb->base[e] + pm * 256;
        return true;
    }
    __device__ __forceinline__ void build(LAS int* utw, int tid) const {
        if (tid < MOE_UT_MAX) { int pm = -1, pn = 0, e = 0, rows = 0, base = 0; unit_search(tid, pm, pn, e, rows, base);
            utw[tid * 8 + 0] = pm; utw[tid * 8 + 1] = pn; utw[tid * 8 + 2] = e; utw[tid * 8 + 3] = rows; utw[tid * 8 + 4] = base; }
    }
    __device__ __forceinline__ bool unit(int i, pg8::Unit& u) const {
        if (i >= MOE_UT_MAX) return false;
        const LAS int* p = ut + i * 8; const int pm = rfl(p[0]); if (pm < 0) return false;
        u.pm = pm; u.pn = rfl(p[1]); u.e = rfl(p[2]); u.rows = rfl(p[3]); u.base = rfl(p[4]); u.newe = (i == 0) || (rfl(p[2 - 8]) != u.e);
        return true;
    }
    __device__ __forceinline__ bool bases(int i, const char*& a, const char*& b) const {
        pg8::Unit u; if (!unit(i, u)) return false;
        a = UP ? A : A + (size_t)u.base * D;
        b = WE + (size_t)u.e * 3072 * 1024 + (UP ? 0 : (size_t)2048 * 1024) + (size_t)u.pn * 256 * 1024;
        a = ufy(a); b = ufy(b);
        return true;
    }
    __device__ __forceinline__ void atoks(int i, const int (&rA)[2], int (&tok)[2][2]) const {
        pg8::Unit u; unit(i, u);
        const int* tl = toklist + (size_t)u.e * CAP + u.pm * 256;
#pragma unroll
        for (int h = 0; h < 2; ++h)
#pragma unroll
            for (int i2 = 0; i2 < 2; ++i2) { const int rr = h * 128 + rA[i2]; tok[h][i2] = tl[rr < u.rows ? rr : 0]; }
    }
    __device__ __forceinline__ void aoffs(int i, const int (&rA)[2], const unsigned (&voffA)[2], unsigned (&off)[2][2]) const {
        pg8::Unit u; unit(i, u);
        const int* tl = toklist + (size_t)u.e * CAP + u.pm * 256;
#pragma unroll
        for (int h = 0; h < 2; ++h)
#pragma unroll
            for (int i2 = 0; i2 < 2; ++i2) { const int rr = h * 128 + rA[i2]; const int tok = tl[rr < u.rows ? rr : 0]; off[h][i2] = (unsigned)tok * (unsigned)D + voffA[i2]; }
    }
};
struct EpiMoeUp {
    static constexpr bool PERM = true;
    bf16* ACT; const float* bgate; const float* bup; LAS float* btab;
    __device__ __forceinline__ void operator()(const f32x4 (&acc)[2][2][4][2], const pg8::Unit& u, int wr, int wc, int fr, int fq) const {
        const int col0 = u.pn * 128 + wc * 32 + 8 * fq, rl0 = wr * 64 + fr;
        if (u.newe) { const int tid = (wr * 4 + wc) * 64 + fr + 16 * fq;
            const f32x4 t = *(const f32x4*)((tid < 256 ? bgate : bup) + u.e * D + 4 * (tid & 255));
            *(LAS f32x4*)(btab + 4 * tid) = t;
            asm volatile("s_waitcnt lgkmcnt(0)" ::: "memory"); __builtin_amdgcn_s_barrier(); asm volatile("" ::: "memory"); }
        f32x2_t bg[2][2], bu[2][2];
#pragma unroll
        for (int n = 0; n < 2; ++n) { const f32x4 g4 = *(const LAS f32x4*)(btab + col0 + 4 * n), u4 = *(const LAS f32x4*)(btab + 1024 + col0 + 4 * n);
            bg[n][0] = (f32x2_t){g4[0], g4[1]}; bg[n][1] = (f32x2_t){g4[2], g4[3]};
            bu[n][0] = (f32x2_t){u4[0], u4[1]} * ACT8_SCALE + ACT8_SCALE; bu[n][1] = (f32x2_t){u4[2], u4[3]} * ACT8_SCALE + ACT8_SCALE; }
#pragma unroll
        for (int ai = 0; ai < 2; ++ai)
#pragma unroll
            for (int m = 0; m < 4; ++m) { const int rl = rl0 + ai * 128 + m * 16;
                f32x2_t o[2][2];
#pragma unroll
                for (int n = 0; n < 2; ++n)
#pragma unroll
                    for (int p = 0; p < 2; ++p) {
                        f32x2_t gg = (f32x2_t){acc[ai][0][m][n][2 * p], acc[ai][0][m][n][2 * p + 1]} * (1.0f / W8_SCALE) + bg[n][p];
                        gg.x = fminf(gg.x, 7.0f); gg.y = fminf(gg.y, 7.0f);
                        const f32x2_t tt = gg * (-1.702f * 1.44269504f);
                        f32x2_t dd; dd.x = __builtin_amdgcn_exp2f(tt.x); dd.y = __builtin_amdgcn_exp2f(tt.y); dd = dd + 1.0f;
                        f32x2_t rr; rr.x = __builtin_amdgcn_rcpf(dd.x); rr.y = __builtin_amdgcn_rcpf(dd.y);
                        f32x2_t uu = (f32x2_t){acc[ai][1][m][n][2 * p], acc[ai][1][m][n][2 * p + 1]} * (ACT8_SCALE / W8_SCALE) + bu[n][p];
                        uu.x = __builtin_amdgcn_fmed3f(uu.x, -6.0f * ACT8_SCALE, 8.0f * ACT8_SCALE); uu.y = __builtin_amdgcn_fmed3f(uu.y, -6.0f * ACT8_SCALE, 8.0f * ACT8_SCALE);
                        o[n][p] = (gg * rr) * uu;
                    }
                if (rl < u.rows) { uint2 w; unsigned w0 = 0u, w1 = 0u;
                    w0 = __builtin_amdgcn_cvt_pk_fp8_f32(o[0][0].x, o[0][0].y, w0, false); w0 = __builtin_amdgcn_cvt_pk_fp8_f32(o[0][1].x, o[0][1].y, w0, true);
                    w1 = __builtin_amdgcn_cvt_pk_fp8_f32(o[1][0].x, o[1][0].y, w1, false); w1 = __builtin_amdgcn_cvt_pk_fp8_f32(o[1][1].x, o[1][1].y, w1, true);
                    w.x = w0; w.y = w1;
                    *(uint2*)((unsigned char*)ACT + (size_t)(u.base + rl) * D + col0) = w; } }
    }
};
struct EpiMoeDown {
    static constexpr bool PERM = true;
    unsigned char* YB; const float* bdown; LAS float* btab;
    __device__ __forceinline__ void operator()(const f32x4 (&acc)[2][2][4][2], const pg8::Unit& u, int wr, int wc, int fr, int fq) const {
        const int col0 = u.pn * 256 + wc * 64 + 16 * fq, rl0 = wr * 64 + fr;
        if (u.newe) { const int tid = (wr * 4 + wc) * 64 + fr + 16 * fq;
            if (tid < 256) { const f32x4 t = *(const f32x4*)(bdown + u.e * D + 4 * tid); *(LAS f32x4*)(btab + 4 * tid) = t; }
            asm volatile("s_waitcnt lgkmcnt(0)" ::: "memory"); __builtin_amdgcn_s_barrier(); asm volatile("" ::: "memory"); }
        f32x4 bv[2][2];
#pragma unroll
        for (int bj = 0; bj < 2; ++bj)
#pragma unroll
            for (int n = 0; n < 2; ++n) bv[bj][n] = *(const LAS f32x4*)(btab + col0 + 8 * bj + 4 * n) * YB8_SCALE;
#pragma unroll
        for (int ai = 0; ai < 2; ++ai)
#pragma unroll
            for (int m = 0; m < 4; ++m) { const int rl = rl0 + ai * 128 + m * 16;
                if (rl < u.rows) { v4u w;
                    { const f32x4 v = acc[ai][0][m][0] * (YB8_SCALE / (W8_SCALE * ACT8_SCALE)) + bv[0][0]; w.x = pk4_fp8(v[0], v[1], v[2], v[3]); }
                    { const f32x4 v = acc[ai][0][m][1] * (YB8_SCALE / (W8_SCALE * ACT8_SCALE)) + bv[0][1]; w.y = pk4_fp8(v[0], v[1], v[2], v[3]); }
                    { const f32x4 v = acc[ai][1][m][0] * (YB8_SCALE / (W8_SCALE * ACT8_SCALE)) + bv[1][0]; w.z = pk4_fp8(v[0], v[1], v[2], v[3]); }
                    { const f32x4 v = acc[ai][1][m][1] * (YB8_SCALE / (W8_SCALE * ACT8_SCALE)) + bv[1][1]; w.w = pk4_fp8(v[0], v[1], v[2], v[3]); }
                    *(v4u*)(YB + (size_t)(u.base + rl) * D + col0) = w; } }
    }
};
constexpr int LDS_TAB = 131072;
__device__ __forceinline__ void p_moe_up(const CAS Args& a, const Frame& F, int l) {
    const int nc = l == 0 ? MOE_NC : 0;
    if (F.bid >= F.G - nc) { const int cw = (F.bid - (F.G - nc)) * NWAVES + F.wave; convert_experts(a, F, 0, 2, 3, cw, nc * NWAVES); convert_experts(a, F, 1, 0, 2, cw, nc * NWAVES, 0, CV_E3); return; }
    LAS MoeTab* tb = (LAS MoeTab*)(F.ldsl + LDS_TAB); moe_tab_build(a, F, l, tb);
    LAS int* utw = (LAS int*)(F.ldsl + LDS_TAB + 1024);
    MoeSched<true> S{tb, utw, (const char*)(a.ws + WS_H), (const char*)(a.ws + WS_WEXP) + (size_t)l * NE * 3072 * 1024, (const int*)(a.ws + WS_TOKLIST), F.G - nc, F.bid};
    S.build(utw, F.tid); __syncthreads();
    EpiMoeUp E{(bf16*)(a.ws + WS_ACT), a.in[32] + (size_t)l * NE * D, a.in[34] + (size_t)l * NE * D, (LAS float*)(F.ldsl + LDS_TAB + 4096)};
    pg8::gemm_phase<D, true>(F.ldsl, S, E, F.wave);
}
__device__ __forceinline__ void p_moe_down(const CAS Args& a, const Frame& F, int l) {
    const int nc = l == 0 ? MOE_NC : 0;
    if (F.bid >= F.G - nc) { const int cw = (F.bid - (F.G - nc)) * NWAVES + F.wave; convert_experts(a, F, 1, 2, 3, cw, nc * NWAVES); convert_experts(a, F, 1, 0, 2, cw, nc * NWAVES, CV_E3, CV_E2); return; }
    LAS MoeTab* tb = (LAS MoeTab*)(F.ldsl + LDS_TAB); moe_tab_build(a, F, l, tb);
    LAS int* utw = (LAS int*)(F.ldsl + LDS_TAB + 1024);
    MoeSched<false> S{tb, utw, (const char*)(a.ws + WS_ACT), (const char*)(a.ws + WS_WEXP) + (size_t)l * NE * 3072 * 1024, nullptr, F.G - nc, F.bid};
    S.build(utw, F.tid); __syncthreads();
    EpiMoeDown E{(unsigned char*)(a.ws + WS_YB), a.in[36] + (size_t)l * NE * D, (LAS float*)(F.ldsl + LDS_TAB + 4096)};
    pg8::gemm_phase<D, true>(F.ldsl, S, E, F.wave);
}
__device__ __forceinline__ void p_combine(const CAS Args& a, const Frame& F, int l) {
    const unsigned char* YB = (const unsigned char*)(a.ws + WS_YB); bf16* XB = (bf16*)(a.ws + WS_XB); bf16* H = (bf16*)(a.ws + WS_H);
    const int* sel = (const int*)(a.ws + WS_SEL); const float* gatev = (const float*)(a.ws + WS_GATEV);
    LAS MoeTab* tb = (LAS MoeTab*)(F.ldsl + LDS_TAB); moe_tab_build(a, F, l, tb);
    const int rows = l == 0 ? R : NT, lane = F.lane;
    for (int r = F.gw; r < rows; r += 2 * F.ngw) {
        v4u xw[2][2]; uint2 yw[2][4][2]; float gk[2][4];
#pragma unroll
        for (int t = 0; t < 2; ++t) { const int rr = r + t * F.ngw; if (rr < rows) {
#pragma unroll
            for (int jh = 0; jh < 2; ++jh) xw[t][jh] = *(const v4u*)(XB + (size_t)rr * D + 512 * jh + 8 * lane);
#pragma unroll
            for (int k = 0; k < 4; ++k) { const int sv = sel[rr * 4 + k]; gk[t][k] = gatev[rr * 4 + k]; const int e = sv & 31, pos = sv >> 5;
                const unsigned char* y = YB + (size_t)(tb->base[e] + pos) * D;
#pragma unroll
                for (int jh = 0; jh < 2; ++jh) yw[t][k][jh] = *(const uint2*)(y + 512 * jh + 8 * lane); } } }
#pragma unroll
        for (int t = 0; t < 2; ++t) { const int rr = r + t * F.ngw; if (rr < rows) {
            float m[16], v[16];
#pragma unroll
            for (int i = 0; i < 16; ++i) m[i] = 0.f;
#pragma unroll
            for (int k = 0; k < 4; ++k) { const float gg = gk[t][k] * (1.0f / YB8_SCALE);
#pragma unroll
                for (int jh = 0; jh < 2; ++jh) { const unsigned w2[2] = {yw[t][k][jh].x, yw[t][k][jh].y};
#pragma unroll
                    for (int q = 0; q < 2; ++q) { const f32x2_t lo = __builtin_amdgcn_cvt_pk_f32_fp8((int)w2[q], false), hi = __builtin_amdgcn_cvt_pk_f32_fp8((int)w2[q], true);
                        m[8 * jh + 4 * q] += gg * lo.x; m[8 * jh + 4 * q + 1] += gg * lo.y; m[8 * jh + 4 * q + 2] += gg * hi.x; m[8 * jh + 4 * q + 3] += gg * hi.y; } } }
#pragma unroll
            for (int jh = 0; jh < 2; ++jh) { const unsigned x4[4] = {xw[t][jh].x, xw[t][jh].y, xw[t][jh].z, xw[t][jh].w};
#pragma unroll
                for (int q = 0; q < 4; ++q) { v[8 * jh + 2 * q] = __uint_as_float(x4[q] << 16); v[8 * jh + 2 * q + 1] = __uint_as_float(x4[q] & 0xffff0000u); } }
            const float* g2 = mod_ptr(a, l, rr, 5);
#pragma unroll
            for (int jh = 0; jh < 2; ++jh)
#pragma unroll
                for (int q = 0; q < 2; ++q) { const f32x4 gg = *(const f32x4*)(g2 + 512 * jh + 8 * lane + 4 * q);
#pragma unroll
                    for (int c = 0; c < 4; ++c) v[8 * jh + 4 * q + c] += gg[c] * m[8 * jh + 4 * q + c]; }
            if (l == 0) {
#pragma unroll
                for (int jh = 0; jh < 2; ++jh) *(v4u*)(XB + (size_t)rr * D + 512 * jh + 8 * lane) = (v4u){pk_bf16(v[8 * jh], v[8 * jh + 1]), pk_bf16(v[8 * jh + 2], v[8 * jh + 3]), pk_bf16(v[8 * jh + 4], v[8 * jh + 5]), pk_bf16(v[8 * jh + 6], v[8 * jh + 7])};
                float s = 0.f;
#pragma unroll
                for (int i2 = 0; i2 < 16; ++i2) s += v[i2] * v[i2];
                const float rstd = rsqrtf(wave_sum(s) * (1.0f / D) + 1e-6f);
                const float* gp = a.in[6] + D; const float* shp = mod_ptr(a, 1, rr, 0); const float* scp = mod_ptr(a, 1, rr, 1);
#pragma unroll
                for (int jh = 0; jh < 2; ++jh) { float hv[8];
#pragma unroll
                    for (int q = 0; q < 2; ++q) { const int e0 = 512 * jh + 8 * lane + 4 * q; const f32x4 gg = *(const f32x4*)(gp + e0), ss = *(const f32x4*)(shp + e0), cc = *(const f32x4*)(scp + e0);
#pragma unroll
                        for (int c = 0; c < 4; ++c) hv[4 * q + c] = v[8 * jh + 4 * q + c] * rstd * gg[c] * (1.f + cc[c]) + ss[c]; }
                    *(v4u*)(H + (size_t)rr * D + 512 * jh + 8 * lane) = (v4u){pk_bf16(hv[0], hv[1]), pk_bf16(hv[2], hv[3]), pk_bf16(hv[4], hv[5]), pk_bf16(hv[6], hv[7])}; }
            } else {
#pragma unroll
                for (int jh = 0; jh < 2; ++jh)
#pragma unroll
                    for (int q = 0; q < 2; ++q) *(f32x4*)(a.out + (size_t)rr * D + 512 * jh + 8 * lane + 4 * q) = (f32x4){v[8 * jh + 4 * q], v[8 * jh + 4 * q + 1], v[8 * jh + 4 * q + 2], v[8 * jh + 4 * q + 3]};
            } } }
    }
}
struct EpiInProj1 {
    static constexpr bool PERM = true;
    bf16* Gt; bf16* U;
    __device__ __forceinline__ void operator()(const f32x4 (&acc)[2][2][4][2], const pg8::Unit& u, int wr, int wc, int fr, int fq) const {
        const int row0 = u.pm * 256 + wr * 64 + fr; const bool gate = u.pn < 4;
        bf16* dst = gate ? Gt : U; const int col0 = (u.pn & 3) * 256 + wc * 32 + 8 * fq;
#pragma unroll
        for (int ai = 0; ai < 2; ++ai)
#pragma unroll
            for (int m = 0; m < 4; ++m) { bf16* rowp = dst + (size_t)(row0 + ai * 128 + m * 16) * D + col0;
#pragma unroll
                for (int bj = 0; bj < 2; ++bj) { f32x4 v0 = acc[ai][bj][m][0], v1 = acc[ai][bj][m][1];
                    if (gate) {
#pragma unroll
                        for (int j = 0; j < 4; ++j) { const float x = v0[j]; v0[j] = x * __builtin_amdgcn_rcpf(1.0f + __expf(-1.5957691216f * (x + 0.044715f * x * x * x)));
                                                      const float y = v1[j]; v1[j] = y * __builtin_amdgcn_rcpf(1.0f + __expf(-1.5957691216f * (y + 0.044715f * y * y * y))); } }
                    v4u w; w.x = pg8::cvt_pk_bf16(v0[0], v0[1]); w.y = pg8::cvt_pk_bf16(v0[2], v0[3]); w.z = pg8::cvt_pk_bf16(v1[0], v1[1]); w.w = pg8::cvt_pk_bf16(v1[2], v1[3]);
                    *(v4u*)(rowp + bj * 128) = w; } }
    }
};
__device__ __forceinline__ void p_inproj1(const CAS Args& a, const Frame& F) {
    if (F.bid >= F.G - INP1_NC) { convert_experts(a, F, 1, 0, 2, (F.bid - (F.G - INP1_NC)) * NWAVES + F.wave, INP1_NC * NWAVES, CV_E2, NE); return; }
    pg8::RectSched S{(const char*)(a.ws + WS_H), (const char*)(a.ws + WS_WIN1), 2 * D, NT / 256, 8, F.G - INP1_NC, F.bid, NC / 256, 4, NT / 256, 4};
    EpiInProj1 E{(bf16*)(a.ws + WS_G), (bf16*)(a.ws + WS_U)};
    pg8::gemm_phase<2 * D, false>(F.ldsl, S, E, F.wave);
}
__device__ __forceinline__ void p_conv4(const CAS Args& a, const Frame& F) {
    const bf16* U = (const bf16*)(a.ws + WS_U); bf16* UC = (bf16*)(a.ws + WS_UC);
    for (int u = F.gw; u < (R / 8) * 2; u += F.ngw) {
        const int rb = u >> 1, ch0 = (u & 1) * 512 + 8 * F.lane, row0 = rb * 8;
        const bool lat = row0 < NT; const int t0 = lat ? (row0 & 2047) : ((row0 - NT) & 255), len = lat ? 2048 : 256;
        float cw[4][8], cbv[8];
#pragma unroll
        for (int q = 0; q < 8; ++q) { cbv[q] = a.in[18][ch0 + q];
#pragma unroll
            for (int k = 0; k < 4; ++k) cw[k][q] = a.in[17][k * D + ch0 + q]; }
        v4u uv[11];
#pragma unroll
        for (int k = 0; k < 11; ++k) { const int tt = t0 + k - 1; uv[k] = (tt >= 0 && tt < len) ? *(const v4u*)(U + (size_t)(row0 + k - 1) * D + ch0) : (v4u){0u, 0u, 0u, 0u}; }
#pragma unroll
        for (int i = 0; i < 8; ++i) {
            float acc[8];
#pragma unroll
            for (int q = 0; q < 8; ++q) acc[q] = cbv[q];
#pragma unroll
            for (int k = 0; k < 4; ++k) { const unsigned w[4] = {uv[i + k].x, uv[i + k].y, uv[i + k].z, uv[i + k].w};
#pragma unroll
                for (int q = 0; q < 4; ++q) { acc[2 * q] += cw[k][2 * q] * __uint_as_float(w[q] << 16); acc[2 * q + 1] += cw[k][2 * q + 1] * __uint_as_float(w[q] & 0xffff0000u); } }
            *(v4u*)(UC + (size_t)(row0 + i) * D + ch0) = (v4u){pk_bf16(acc[0], acc[1]), pk_bf16(acc[2], acc[3]), pk_bf16(acc[4], acc[5]), pk_bf16(acc[6], acc[7])};
        }
    }
}
constexpr int LR_A = 0, LR_SC = 65536, LR_AG = 131072, LR_CY = LR_AG + 8192;
__device__ __forceinline__ void p_lru(const CAS Args& a, const Frame& F) {
    const bf16* UC = (const bf16*)(a.ws + WS_UC); const bf16* WL = (const bf16*)(a.ws + WS_WLRU); const bf16* Gt = (const bf16*)(a.ws + WS_G);
    bf16* HF = (bf16*)(a.ws + WS_HF); bf16* A3 = (bf16*)(a.ws + WS_A3);
    LAS unsigned char* lds = F.ldsl;
    const int lane_ = F.lane, wave = F.wave, sub = wave & 3, th = wave >> 2;
    for (int wu = F.bid; wu < 256; wu += F.G) {
        const int b = wu >> 4, h = (wu >> 2) & 3, cg = wu & 3;
        for (int dir = 0; dir < 2; ++dir) {
            const int lane = lane_, rho = lane & 15, g = lane >> 4;
            bf16x8 bw[2][8];
#pragma unroll
            for (int n = 0; n < 2; ++n)
#pragma unroll
                for (int ks = 0; ks < 8; ++ks) bw[n][ks] = *(const bf16x8*)(WL + ((size_t)h * 1024 + (2 * dir + n) * 256 + cg * 64 + 16 * sub + rho) * 256 + 32 * ks + 8 * g);
            const int chc = h * 256 + cg * 64 + 16 * sub + rho;
            const float bav = (dir ? a.in[25] : a.in[20])[chc] * -1.44269504f, bxv = (dir ? a.in[27] : a.in[22])[chc] * -1.44269504f;
            const float lamv = (dir ? a.in[28] : a.in[23])[chc];
            const float L8 = -8.0f * log1pf(expf(-lamv)) * 1.44269504f;
            __syncthreads();
            if (wave == 0) ((LAS float*)(lds + LR_CY))[lane] = 0.f;
#define LR_GROW0(ck_) ((ck_) < 2 ? (size_t)(NT + b * 256 + 128 * (dir ? 1 - (ck_) : (ck_))) : (size_t)(b * 2048 + 128 * (dir ? 15 - ((ck_) - 2) : (ck_) - 2)))
#define LR_STAGE(ck_) do { const size_t g0_ = LR_GROW0(ck_); _Pragma("unroll") for (int p_ = 0; p_ < 8; ++p_) { const int pc_ = wave * 8 + p_, row_ = 2 * pc_ + (lane >> 5), c_ = (lane & 31) ^ (row_ & 15); \
                __builtin_amdgcn_global_load_lds((const unsigned*)((const char*)UC + (g0_ + row_) * (D * 2) + h * 512 + 16 * c_), (LAS unsigned*)(lds + LR_A + pc_ * 1024), 16, 0, 0); } } while (0)
            LR_STAGE(0);
            for (int ck = 0; ck < 18; ++ck) {
                const bool isctx = ck < 2;
                const size_t grow0 = LR_GROW0(ck);
                int lane = lane_; asm volatile("" : "+v"(lane)); const int rho = lane & 15, g = lane >> 4, chs = h * 256 + cg * 64 + lane, ucol = cg * 64 + 16 * sub + rho;
                asm volatile("s_waitcnt vmcnt(0)" ::: "memory");
                __syncthreads();
                const int row0 = dir ? 112 - 16 * wave : 16 * wave;
                v4u hfr[2] = {(v4u){0u, 0u, 0u, 0u}, (v4u){0u, 0u, 0u, 0u}}, gtr[2] = {(v4u){0u, 0u, 0u, 0u}, (v4u){0u, 0u, 0u, 0u}};
                if (dir && !isctx) {
#pragma unroll
                    for (int t = 0; t < 2; ++t) { const int tk = lane + 64 * t; const size_t gi = (grow0 + row0 + (tk >> 3)) * D + h * 256 + cg * 64 + 8 * (tk & 7);
                        hfr[t] = *(const v4u*)(HF + gi); gtr[t] = *(const v4u*)(Gt + gi); } }
                {
                    f32x4 acc[4][2];
#pragma unroll
                    for (int m = 0; m < 4; ++m)
#pragma unroll
                        for (int n = 0; n < 2; ++n) acc[m][n] = (f32x4){0.f, 0.f, 0.f, 0.f};
#pragma unroll
                    for (int ks = 0; ks < 8; ++ks)
#pragma unroll
                        for (int m = 0; m < 4; ++m) { const int rw = 64 * th + 16 * m + rho; const bf16x8 af = *(const LAS bf16x8*)(lds + LR_A + rw * 512 + (((4 * ks + g) ^ (rw & 15)) << 4));
#pragma unroll
                            for (int n = 0; n < 2; ++n) acc[m][n] = __builtin_amdgcn_mfma_f32_16x16x32_bf16(af, bw[n][ks], acc[m][n], 0, 0, 0);
                            if (m == 3 && (ks & 1)) asm volatile("" ::: "memory"); }
#pragma unroll
                    for (int m = 0; m < 4; ++m)
#pragma unroll
                        for (int p = 0; p < 2; ++p) {
                            const int row = 64 * th + 16 * m + 4 * g + 2 * p;
                            f32x2_t uc;
                            uc.x = bf2f(*(const LAS bf16*)(lds + LR_A + row * 512 + (((ucol >> 3) ^ (row & 15)) << 4) + 2 * (ucol & 7)));
                            uc.y = bf2f(*(const LAS bf16*)(lds + LR_A + (row + 1) * 512 + (((ucol >> 3) ^ ((row + 1) & 15)) << 4) + 2 * (ucol & 7)));
                            const f32x2_t xa = (f32x2_t){acc[m][0][2 * p], acc[m][0][2 * p + 1]} * -1.44269504f + bav, xx = (f32x2_t){acc[m][1][2 * p], acc[m][1][2 * p + 1]} * -1.44269504f + bxv;
                            f32x2_t da, dx; da.x = __builtin_amdgcn_exp2f(xa.x); da.y = __builtin_amdgcn_exp2f(xa.y); dx.x = __builtin_amdgcn_exp2f(xx.x); dx.y = __builtin_amdgcn_exp2f(xx.y);
                            da = da + 1.0f; dx = dx + 1.0f;
                            f32x2_t rr, ii; rr.x = __builtin_amdgcn_rcpf(da.x); rr.y = __builtin_amdgcn_rcpf(da.y); ii.x = __builtin_amdgcn_rcpf(dx.x); ii.y = __builtin_amdgcn_rcpf(dx.y);
                            const f32x2_t la = rr * L8;
                            f32x2_t av; av.x = __builtin_amdgcn_exp2f(la.x); av.y = __builtin_amdgcn_exp2f(la.y);
                            f32x2_t tt = 1.0f - av * av; tt.x = fmaxf(tt.x, 0.f); tt.y = fmaxf(tt.y, 0.f);
                            f32x2_t sq; sq.x = __builtin_amdgcn_sqrtf(tt.x); sq.y = __builtin_amdgcn_sqrtf(tt.y);
                            const f32x2_t bv = sq * ii * uc;
                            *(LAS f32x2_t*)(lds + LR_SC + (row * 64 + 16 * sub + rho) * 8) = (f32x2_t){av.x, bv.x};
                            *(LAS f32x2_t*)(lds + LR_SC + ((row + 1) * 64 + 16 * sub + rho) * 8) = (f32x2_t){av.y, bv.y};
                        }
                }
                __syncthreads();
                asm volatile("s_waitcnt vmcnt(0)" : "+v"(hfr[0]), "+v"(hfr[1]), "+v"(gtr[0]), "+v"(gtr[1]) :: "memory");
                if (ck + 1 < 18) LR_STAGE(ck + 1);
                f32x2_t ab[16];
                {
#pragma unroll
                    for (int q = 0; q < 16; ++q) { const int s = 16 * wave + q, row = dir ? 127 - s : s; ab[q] = *(const LAS f32x2_t*)(lds + LR_SC + (row * 64 + lane) * 8); }
                    float hl = 0.f, pr = 1.f;
#pragma unroll
                    for (int q = 0; q < 16; ++q) { hl = ab[q].x * hl + ab[q].y; pr *= ab[q].x; ab[q] = (f32x2_t){pr, hl}; }
                    *(LAS f32x2_t*)(lds + LR_AG + ((ck & 1) * 512 + wave * 64 + lane) * 8) = (f32x2_t){pr, hl};
                }
                asm volatile("s_waitcnt lgkmcnt(0)" ::: "memory"); __builtin_amdgcn_s_barrier(); asm volatile("" ::: "memory");
                {
                    float c = ((const LAS float*)(lds + LR_CY))[(ck & 1) * 64 + lane], cin = 0.f;
#pragma unroll
                    for (int w2 = 0; w2 < 8; ++w2) { if (w2 == wave) cin = c; const f32x2_t ag = *(const LAS f32x2_t*)(lds + LR_AG + ((ck & 1) * 512 + w2 * 64 + lane) * 8); c = ag.x * c + ag.y; }
                    if (wave == 0) ((LAS float*)(lds + LR_CY))[((ck + 1) & 1) * 64 + lane] = c;
                    if (!isctx) {
                        LAS unsigned char* scr = lds + LR_SC + row0 * 512;
                        if (dir) {
#pragma unroll
                            for (int t = 0; t < 2; ++t) { const int tk = lane + 64 * t; *(LAS v4u*)(scr + tk * 16) = hfr[t]; *(LAS v4u*)(scr + 2048 + tk * 16) = gtr[t]; }
                        }
#pragma unroll
                        for (int q = 0; q < 16; ++q) { const int tr = dir ? 15 - q : q;
                            float hv = ab[q].y + ab[q].x * cin;
                            if (dir) hv = (bf2f(*(const LAS bf16*)(scr + (tr * 64 + lane) * 2)) + hv) * bf2f(*(const LAS bf16*)(scr + 2048 + (tr * 64 + lane) * 2));
                            *(LAS bf16*)(scr + 4096 + (tr * 64 + lane) * 2) = f2bf(hv); }
                        bf16* dstp = dir ? A3 : HF;
#pragma unroll
                        for (int t = 0; t < 2; ++t) { const int tk = lane + 64 * t; const size_t gi = (grow0 + row0 + (tk >> 3)) * D + h * 256 + cg * 64 + 8 * (tk & 7);
                            *(v4u*)(dstp + gi) = *(const LAS v4u*)(scr + 4096 + tk * 16); }
                    }
                }
            }
#undef LR_STAGE
#undef LR_GROW0
        }
    }
}

constexpr int LDS_BYTES = 163840;
constexpr int NPHASE = 17;
template <unsigned KMASK>
__global__ void __launch_bounds__(NWAVES * 64, 2) fwd(Args kargs) {
    extern __shared__ __attribute__((aligned(16))) unsigned char lds[];
    const int wave_s = __builtin_amdgcn_readfirstlane((int)threadIdx.x >> 6);
    const int tid0 = wave_s * 64 + lane_id_fresh();
    volatile LAS unsigned* misc = (volatile LAS unsigned*)((LAS unsigned char*)lds + (LDS_BYTES - 64));
    if (tid0 < 16) misc[tid0] = 0u;
    __syncthreads();
    const int lo = kargs.ph_lo, hi = kargs.ph_hi;
    XcdBarrier bar; bar.bar = (unsigned*)(kargs.ws + WS_CTL) + CW_BAR + kargs.li * XCD_BAR_WORDS; bar.x = 0; bar.st = misc;
    if (hi - lo > 1) bar = xcd_barrier_post((unsigned*)(kargs.ws + WS_CTL) + CW_BAR + kargs.li * XCD_BAR_WORDS, misc, tid0);
#ifndef ONLY_PHASE
#define ONLY_PHASE -1
#endif
#ifndef PHASE_MASK
#define PHASE_MASK 0xFFFFFFFFu
#endif
#ifndef REPMASK
#define REPMASK 0u
#endif
#define PH(k, body) if constexpr (((KMASK >> (k)) & 1u) != 0u) if ((ONLY_PHASE < 0 || ONLY_PHASE == (k)) && ((PHASE_MASK >> (k)) & 1u) && lo <= (k) && (k) < hi) { \
        const CAS Args* ap_ = (const CAS Args*)__builtin_amdgcn_kernarg_segment_ptr(); asm volatile("" : "+s"(ap_)); const CAS Args& args = *ap_; \
        Frame F; F.lds = lds; F.ldsl = (LAS unsigned char*)lds; F.wave = wave_s; F.lane = lane_id_fresh(); \
        F.tid = F.wave * 64 + F.lane; F.G = gridDim.x; F.bid = blockIdx.x; F.gw = F.bid * NWAVES + F.wave; F.ngw = F.G * NWAVES; \
        if (((REPMASK >> (k)) & 1u) == 0u) { body; } else { int nrep_ = 2; asm volatile("" : "+s"(nrep_)); for (int rep_ = 0; rep_ < nrep_; ++rep_) { body; asm volatile("s_waitcnt vmcnt(0)" ::: "memory"); __syncthreads(); } } if ((k) + 1 < hi) xcd_barrier(bar, F.tid); else { asm volatile("s_waitcnt vmcnt(0)" ::: "memory"); __syncthreads(); } }
    PH(0, p0_prologue(args, F))
    PH(1, p_norm1_l0(args, F))
    PH(2, p_inproj0(args, F))
    PH(3, p_attn(args, F))
    PH(4, p_outproj<0>(args, F))
    PH(5, p_norm2_router(args, F, 0))
    PH(6, p_moe_up(args, F, 0))
    PH(7, p_moe_down(args, F, 0))
    PH(8, p_combine(args, F, 0))
    PH(9, p_inproj1(args, F))
    PH(10, p_conv4(args, F))
    PH(11, p_lru(args, F))
    PH(12, p_outproj<1>(args, F))
    PH(13, p_norm2_router(args, F, 1))
    PH(14, p_moe_up(args, F, 1))
    PH(15, p_moe_down(args, F, 1))
    PH(16, p_combine(args, F, 1))
#undef PH
}

constexpr unsigned MASK_A = (1u<<2)|(1u<<4)|(1u<<6)|(1u<<7)|(1u<<9)|(1u<<11)|(1u<<13)|(1u<<14), MASK_C = 1u << 3, MASK_D = 1u << 10, MASK_ALL = 0x1FFFFu, MASK_B = MASK_ALL & ~(MASK_A | MASK_C | MASK_D);
__host__ inline int kid_of(int p) { return ((MASK_A >> p) & 1u) ? 0 : ((MASK_C >> p) & 1u) ? 2 : ((MASK_D >> p) & 1u) ? 3 : 1; }
extern "C" void kernel_launch(void* const* d_in, const int* in_sizes, int n_in, void* d_out, int out_size, void* d_ws, size_t ws_size, hipStream_t stream) {
    static int grid = 0;
    if (grid == 0) {
        if (n_in != 37 || out_size != NT * D || ws_size < WS_END) { fprintf(stderr, "kernel_launch: unexpected shapes (n_in %d out %d ws %zu)\n", n_in, out_size, ws_size); grid = -1; return; }
        int dev = 0, cus = 0;
        if (hipGetDevice(&dev) != hipSuccess || hipDeviceGetAttribute(&cus, hipDeviceAttributeMultiprocessorCount, dev) != hipSuccess) { grid = -1; return; }
#ifndef MULTI_LAUNCH
        if (hipFuncSetAttribute((const void*)fwd<MASK_ALL>, hipFuncAttributeMaxDynamicSharedMemorySize, LDS_BYTES) != hipSuccess) { fprintf(stderr, "kernel_launch: hipFuncSetAttribute failed\n"); grid = -1; return; }
#else
        if (hipFuncSetAttribute((const void*)fwd<MASK_A>, hipFuncAttributeMaxDynamicSharedMemorySize, LDS_BYTES) != hipSuccess) { fprintf(stderr, "kernel_launch: hipFuncSetAttribute failed\n"); grid = -1; return; }
        if (hipFuncSetAttribute((const void*)fwd<MASK_B>, hipFuncAttributeMaxDynamicSharedMemorySize, LDS_BYTES) != hipSuccess) { fprintf(stderr, "kernel_launch: hipFuncSetAttribute failed\n"); grid = -1; return; }
        if (hipFuncSetAttribute((const void*)fwd<MASK_C>, hipFuncAttributeMaxDynamicSharedMemorySize, LDS_BYTES) != hipSuccess) { fprintf(stderr, "kernel_launch: hipFuncSetAttribute failed\n"); grid = -1; return; }
        if (hipFuncSetAttribute((const void*)fwd<MASK_D>, hipFuncAttributeMaxDynamicSharedMemorySize, LDS_BYTES) != hipSuccess) { fprintf(stderr, "kernel_launch: hipFuncSetAttribute failed\n"); grid = -1; return; }
#endif
        (void)hipGetLastError();
        grid = cus;
    }
    if (grid < 0) return;
    if (hipMemsetAsync((char*)d_ws + WS_CTL, 0, CTL_ZERO_BYTES, stream) != hipSuccess) return;
    Args a{};
    for (int i = 0; i < 37; ++i) a.in[i] = (const float*)d_in[i];
    a.out = (float*)d_out; a.ws = (unsigned char*)d_ws;
#ifdef MULTI_LAUNCH
    int p = 0, li = 0;
    while (p < NPHASE) {
        const int kid = kid_of(p); int q = p + 1;
        while (q < NPHASE && kid_of(q) == kid) ++q;
        a.ph_lo = p; a.ph_hi = q; a.li = li++;
        if (kid == 0) hipLaunchKernelGGL(fwd<MASK_A>, dim3(grid), dim3(NWAVES * 64), LDS_BYTES, stream, a);
        else if (kid == 1) hipLaunchKernelGGL(fwd<MASK_B>, dim3(grid), dim3(NWAVES * 64), LDS_BYTES, stream, a);
        else if (kid == 2) hipLaunchKernelGGL(fwd<MASK_C>, dim3(grid), dim3(NWAVES * 64), LDS_BYTES, stream, a);
        else hipLaunchKernelGGL(fwd<MASK_D>, dim3(grid), dim3(NWAVES * 64), LDS_BYTES, stream, a);
        p = q;
    }
#else
    a.ph_lo = 0; a.ph_hi = NPHASE; a.li = 0;
    hipLaunchKernelGGL(fwd<MASK_ALL>, dim3(grid), dim3(NWAVES * 64), LDS_BYTES, stream, a);
#endif
}
```

```cpp
#include <hip/hip_runtime.h>
#include <stdint.h>
#include <stdio.h>

constexpr int D = 1024, NB = 16, SEQ = 2048, NT = NB * SEQ, LC = 256, NC = NB * LC, R = NT + NC;
constexpr int NE = 32, CAP = R;
constexpr int NWAVES = 8;

typedef unsigned short bf16;
typedef short bf16x8 __attribute__((ext_vector_type(8)));
typedef float f32x4 __attribute__((ext_vector_type(4)));
typedef unsigned v4u __attribute__((ext_vector_type(4)));
#define LAS __attribute__((address_space(3)))
#define CAS __attribute__((address_space(4)))
#define RLX_AGENT __ATOMIC_RELAXED, __HIP_MEMORY_SCOPE_AGENT

constexpr size_t MiB = 1u << 20;
constexpr size_t WS_CTL = 0, CTL_ZERO_BYTES = 1 * MiB;
constexpr size_t WS_MOD = 1 * MiB;
constexpr size_t WS_WIN0 = 2 * MiB, WS_WOUT0 = 8 * MiB, WS_WIN1 = 10 * MiB, WS_WOUT1 = 14 * MiB, WS_WLRU = 16 * MiB;
constexpr size_t WS_TOKLIST = 18 * MiB;
constexpr size_t WS_SEL = 23 * MiB;
constexpr size_t WS_GATEV = 24 * MiB;
constexpr size_t WS_XC = 25 * MiB;
constexpr size_t WS_WEXP = 41 * MiB;
constexpr size_t WS_H = 233 * MiB;
constexpr size_t WS_P = 305 * MiB;
constexpr int PP = 2560;
constexpr size_t WS_A2 = 521 * MiB;
constexpr size_t WS_ACT = 593 * MiB;
constexpr size_t WS_YB = 305 * MiB;
constexpr size_t WS_G = 305 * MiB;
constexpr size_t WS_U = 369 * MiB;
constexpr size_t WS_UC = 441 * MiB;
constexpr size_t WS_AF = 513 * MiB;
constexpr size_t WS_AB = 657 * MiB;
constexpr size_t WS_HF = WS_AF;
constexpr size_t WS_A3 = WS_AB;
constexpr size_t WS_BF = 801 * MiB;
constexpr size_t WS_BB = 873 * MiB;
constexpr size_t WS_GS2 = 840 * MiB;
constexpr size_t WS_XB = 760 * MiB;
constexpr size_t WS_END = 945 * MiB;
constexpr int CW_BAR = 4096;
constexpr int CW_CNT = 65536;

__device__ __forceinline__ float bf2f(bf16 v) { return __uint_as_float(((unsigned)v) << 16); }
__device__ __forceinline__ bf16 f2bf(float f) { unsigned u = __float_as_uint(f); return (bf16)((u + 0x7fffu + ((u >> 16) & 1u)) >> 16); }
__device__ __forceinline__ unsigned pk2(float lo, float hi) { return (unsigned)f2bf(lo) | ((unsigned)f2bf(hi) << 16); }
__device__ __forceinline__ int lane_id_fresh() { int l; asm volatile("v_mbcnt_lo_u32_b32 %0, -1, 0\n\tv_mbcnt_hi_u32_b32 %0, -1, %0" : "=v"(l)); return l; }
__device__ __forceinline__ unsigned pk4_fp8(float a, float b, float c, float d) {
    a = fminf(fmaxf(a, -448.f), 448.f); b = fminf(fmaxf(b, -448.f), 448.f); c = fminf(fmaxf(c, -448.f), 448.f); d = fminf(fmaxf(d, -448.f), 448.f);
    unsigned w = 0u; w = __builtin_amdgcn_cvt_pk_fp8_f32(a, b, w, false); w = __builtin_amdgcn_cvt_pk_fp8_f32(c, d, w, true); return w;
}
constexpr float W8_SCALE = 32.0f, ACT8_SCALE = 4.0f, YB8_SCALE = 16.0f;
__device__ __forceinline__ float wave_sum(float v) {
#pragma unroll
    for (int o = 1; o < 64; o <<= 1) v += __shfl_xor(v, o);
    return v;
}
__device__ __forceinline__ float wave_max(float v) {
#pragma unroll
    for (int o = 1; o < 64; o <<= 1) v = fmaxf(v, __shfl_xor(v, o));
    return v;
}
__device__ __forceinline__ float sigmoidf_(float x) { return 1.0f / (1.0f + __expf(-x)); }
__device__ __forceinline__ float gelu_tanh(float x) { return 0.5f * x * (1.0f + tanhf(0.7978845608028654f * (x + 0.044715f * x * x * x))); }

#define XB_TMO      128
#define XB_XCNT(j)  (256  + 64 * (j))
#define XB_XSUB(j)  (1280 + 64 * (j))
#define XB_XGEN(j)  (2304 + 64 * (j))
#define XB_TOP      3328
#define XB_TOPGEN   3392
#define XCD_BAR_WORDS 3456
#define XB_SPIN_CAP (1u << 18)
__device__ __forceinline__ unsigned xb_ld(unsigned* p)              { return __hip_atomic_load(p, __ATOMIC_RELAXED, __HIP_MEMORY_SCOPE_AGENT); }
__device__ __forceinline__ unsigned xb_add(unsigned* p, unsigned v) { return __hip_atomic_fetch_add(p, v, __ATOMIC_RELAXED, __HIP_MEMORY_SCOPE_AGENT); }
__device__ __forceinline__ unsigned xb_xcc_id() { return (unsigned)__builtin_amdgcn_s_getreg((3 << 11) | 20) & 0xFu; }
#define XB_SPIN(cond, bar) do { unsigned _sp = 0; while (cond) { __builtin_amdgcn_s_sleep(1); \
    if ((++_sp & 255u) == 0u) { if (xb_ld(&(bar)[XB_TMO])) break; if (_sp > XB_SPIN_CAP) { atomicAdd(&(bar)[XB_TMO], 1u); break; } } } } while (0)
struct XcdBarrier { unsigned* bar; unsigned x; volatile LAS unsigned* st; };
__device__ __forceinline__ XcdBarrier xcd_barrier_post(unsigned* bar, volatile LAS unsigned* st, int tid) {
    XcdBarrier b; b.bar = bar; b.x = xb_xcc_id(); b.st = st;
    if (tid == 0) (void)xb_add(&bar[XB_XCNT(b.x)], 1u);
    return b;
}
__device__ __forceinline__ void xcd_barrier_complete(unsigned* bar, unsigned x, unsigned& nloc, unsigned& nx) {
    const unsigned G = gridDim.x * gridDim.y * gridDim.z;
    unsigned sum, cnt, mine, sp = 0u;
    for (;;) {
        sum = 0u; cnt = 0u; mine = 0u;
#pragma unroll
        for (unsigned j = 0; j < 16; ++j) { const unsigned c = xb_ld(&bar[XB_XCNT(j)]); sum += c; cnt += (c > 0u) ? 1u : 0u; mine = (j == x) ? c : mine; }
        if (sum == G) break;
        __builtin_amdgcn_s_sleep(1);
        if ((++sp & 255u) == 0u) { if (xb_ld(&bar[XB_TMO])) break; if (sp > XB_SPIN_CAP) { atomicAdd(&bar[XB_TMO], 1u); break; } }
    }
    nloc = mine > 0u ? mine : 1u; nx = cnt > 0u ? cnt : 1u;
}
__device__ __forceinline__ void xcd_barrier(const XcdBarrier& b, int tid) {
    asm volatile("s_waitcnt vmcnt(0)" ::: "memory");
    __syncthreads();
    if (tid == 0) {
        unsigned* bar = b.bar;
        __builtin_amdgcn_s_waitcnt(0);
        unsigned nloc = b.st[0], nx = b.st[1];
        if (nloc == 0u) { xcd_barrier_complete(bar, b.x, nloc, nx); b.st[0] = nloc; b.st[1] = nx; }
        const unsigned old = xb_add(&bar[XB_XSUB(b.x)], 1u);
        const unsigned gen = old / nloc;
        if (old + 1u == (gen + 1u) * nloc) {
            __builtin_amdgcn_fence(__ATOMIC_RELEASE, "agent");
            asm volatile("s_waitcnt vmcnt(0)" ::: "memory");
            const unsigned og = xb_add(&bar[XB_TOP], 1u);
            const unsigned tg = og / nx;
            if (og + 1u == (tg + 1u) * nx) xb_add(&bar[XB_TOPGEN], 1u);
            else XB_SPIN(xb_ld(&bar[XB_TOPGEN]) == tg, bar);
            __builtin_amdgcn_fence(__ATOMIC_ACQUIRE, "agent");
            xb_add(&bar[XB_XGEN(b.x)], 1u);
            asm volatile("s_waitcnt vmcnt(0)" ::: "memory");
        } else {
            XB_SPIN(xb_ld(&bar[XB_XGEN(b.x)]) == gen, bar);
            __builtin_amdgcn_fence(__ATOMIC_ACQUIRE, "agent");
            asm volatile("s_waitcnt vmcnt(0)" ::: "memory");
        }
    }
    __syncthreads();
}

struct Args { const float* in[37]; float* out; unsigned char* ws; int ph_lo, ph_hi, li, pad; };
struct Frame {
    unsigned char* lds;
    LAS unsigned char* ldsl;
    int tid, lane, wave, gw, ngw, G, bid;
};

template <int NS, class FA, class FB, class FS>
__device__ __forceinline__ void tile_gemm32(int K, FA arow, FB brow, FS store, int lane) {
    const int lr = lane & 15, lq = lane >> 4;
    const bf16* ap[2]; const bf16* bp[NS][2];
#pragma unroll
    for (int i = 0; i < 2; ++i) ap[i] = arow(16 * i + lr) + 8 * lq;
#pragma unroll
    for (int s = 0; s < NS; ++s)
#pragma unroll
        for (int j = 0; j < 2; ++j) bp[s][j] = brow(s, 16 * j + lr) + 8 * lq;
    f32x4 acc[NS][2][2];
#pragma unroll
    for (int s = 0; s < NS; ++s)
#pragma unroll
        for (int i = 0; i < 2; ++i)
#pragma unroll
            for (int j = 0; j < 2; ++j) acc[s][i][j] = (f32x4){0.f, 0.f, 0.f, 0.f};
#pragma nounroll
    for (int k0 = 0; k0 < K; k0 += 32) {
        bf16x8 a[2], b[NS][2];
#pragma unroll
        for (int i = 0; i < 2; ++i) a[i] = *(const bf16x8*)(ap[i] + k0);
#pragma unroll
        for (int s = 0; s < NS; ++s)
#pragma unroll
            for (int j = 0; j < 2; ++j) b[s][j] = *(const bf16x8*)(bp[s][j] + k0);
#pragma unroll
        for (int s = 0; s < NS; ++s)
#pragma unroll
            for (int i = 0; i < 2; ++i)
#pragma unroll
                for (int j = 0; j < 2; ++j) acc[s][i][j] = __builtin_amdgcn_mfma_f32_16x16x32_bf16(a[i], b[s][j], acc[s][i][j], 0, 0, 0);
    }
#pragma unroll
    for (int i = 0; i < 2; ++i)
#pragma unroll
        for (int j = 0; j < 2; ++j)
#pragma unroll
            for (int q = 0; q < 4; ++q) {
                float v[NS];
#pragma unroll
                for (int s = 0; s < NS; ++s) v[s] = acc[s][i][j][q];
                store(16 * i + 4 * lq + q, 16 * j + lr, v);
            }
}


namespace pg8 {
constexpr int BM = 256, BK = 64, HALF = 128, HTB = HALF * BK * 2, STAGE_BYTES = 8 * HTB;
__device__ __forceinline__ int lds_byte(int r, int c) { const int st = (r >> 4) * 2 + (c >> 5), rr = r & 15, cc = c & 31, ob = rr * 64 + cc * 2; return st * 1024 + (ob ^ (((ob >> 9) & 1) << 5)); }
__device__ __forceinline__ void stage_rc(int b, int& R_, int& C_) { const int st = b / 1024, sb = b % 1024, swz = sb ^ (((sb >> 9) & 1) << 5); R_ = (st >> 1) * 16 + swz / 64; C_ = (st & 1) * 32 + (swz % 64) / 2; }
__device__ __forceinline__ int perm32(int rho) { const int n = rho >> 4, i = rho & 15; return 8 * (i >> 2) + 4 * n + (i & 3); }
struct Unit { int pm, pn, e, rows, base, newe; };
typedef int v8i __attribute__((ext_vector_type(8)));
typedef int v4i __attribute__((ext_vector_type(4)));
__device__ __forceinline__ void mfma8(f32x4& acc, v8i a, v8i b, unsigned sc) {
    asm volatile("v_mfma_scale_f32_16x16x128_f8f6f4 %0, %1, %2, %0, %3, %3 op_sel_hi:[0,0,0]" : "+v"(acc) : "v"(a), "v"(b), "v"(sc));
}
__device__ __forceinline__ v8i cat8(bf16x8 a, bf16x8 b) { return __builtin_shufflevector(__builtin_bit_cast(v4i, a), __builtin_bit_cast(v4i, b), 0, 1, 2, 3, 4, 5, 6, 7); }
__device__ __forceinline__ unsigned cvt_pk_bf16(float lo, float hi) { unsigned r; asm volatile("v_cvt_pk_bf16_f32 %0, %1, %2" : "=v"(r) : "v"(lo), "v"(hi)); return r; }

template <int RB  , bool FP8, class Epi, class Sched>
__device__ __forceinline__ void gemm_phase(LAS unsigned char* lds, const Sched& S, const Epi& E, const int wave_id) {
    const int tid_ = wave_id * 64 + lane_id_fresh();
    const int tid = tid_, wid = wave_id, lane = tid & 63, wr = wid >> 2, wc = wid & 3, fr = lane & 15, fq = lane >> 4;
    constexpr int nt = RB / 128;
    unsigned voffA[2], voffB[2]; int rA[2];
#pragma unroll
    for (int i = 0; i < 2; ++i) { int R_, C_; stage_rc(tid * 16 + i * 8192, R_, C_); const int Rb = Epi::PERM ? ((R_ & ~31) + perm32(R_ & 31)) : R_;
        voffA[i] = Sched::GATHER ? (unsigned)C_ * 2u : (unsigned)(R_ * RB + C_ * 2); rA[i] = R_; voffB[i] = (unsigned)(Rb * RB + C_ * 2); }
    constexpr size_t kstep = (size_t)(BK * 2);
    constexpr size_t hstep = (size_t)HALF * RB;
    const unsigned ldsw = (unsigned)wid * 1024u;
    const int aoff = lds_byte(wr * 64 + fr, fq * 8), boff = lds_byte(wc * 32 + fr, fq * 8);
#define PG8_SA(b, h) (((b) * 2 + (h)) * HTB)
#define PG8_SB(b, h) ((4 + (b) * 2 + (h)) * HTB)
#define PG8_STAGE(bufoff, gbase, voff) do { _Pragma("unroll") for (int _i = 0; _i < 2; ++_i) \
        __builtin_amdgcn_global_load_lds((const unsigned*)((const char*)(gbase) + (voff)[_i]), (LAS unsigned*)(lds + (bufoff) + ldsw + _i * 8192), 16, 0, 0); } while (0)
#define PG8_STAGE_A(bufoff, ubase, uoff, h) do { if constexpr (Sched::GATHER) PG8_STAGE(bufoff, ubase, (uoff)[h]); else PG8_STAGE(bufoff, (ubase) + (h) * hstep, voffA); } while (0)
#define PG8_LDA(dst, b, h) do { _Pragma("unroll") for (int m = 0; m < 4; ++m) _Pragma("unroll") for (int k = 0; k < 2; ++k) dst[m][k] = *(const LAS bf16x8*)(lds + PG8_SA(b, h) + aoff + m * 2048 + k * 1024); } while (0)
#define PG8_LDB(dst, b, h) do { _Pragma("unroll") for (int n = 0; n < 2; ++n) _Pragma("unroll") for (int k = 0; k < 2; ++k) dst[n][k] = *(const LAS bf16x8*)(lds + PG8_SB(b, h) + boff + n * 2048 + k * 1024); } while (0)
#define PG8_MMA(ai, bj, At, Bt) do { __builtin_amdgcn_s_setprio(1); _Pragma("unroll") for (int m = 0; m < 4; ++m) _Pragma("unroll") for (int n = 0; n < 2; ++n) { \
        if constexpr (FP8) mfma8(acc[ai][bj][m][n], cat8(Bt[n][0], Bt[n][1]), cat8(At[m][0], At[m][1]), sc1); \
        else { _Pragma("unroll") for (int k = 0; k < 2; ++k) acc[ai][bj][m][n] = __builtin_amdgcn_mfma_f32_16x16x32_bf16(Bt[n][k], At[m][k], acc[ai][bj][m][n], 0, 0, 0); } } __builtin_amdgcn_s_setprio(0); } while (0)
#define PG8_WAIT_V(n) asm volatile("s_waitcnt vmcnt(" #n ")" ::: "memory")
#define PG8_WAIT_L(n) asm volatile("s_waitcnt lgkmcnt(" #n ")" ::: "memory")
#define PG8_BAR __builtin_amdgcn_s_barrier()
#define PG8_SCHED __builtin_amdgcn_sched_barrier(0)
#define PG8_KBODY(a1, a2, b2, off2) do { const char* _a1 = (a1); const char* _a2 = (a2); const char* _b2 = (b2); const char* _a3 = _a2 + kstep; const char* _b3 = _b2 + kstep; \
            asm volatile("" : "+s"(_a1), "+s"(_a2), "+s"(_b2), "+s"(_a3), "+s"(_b3));   \
            PG8_LDB(B0, 0, 0); PG8_LDB(B1, 0, 1); PG8_SCHED; PG8_LDA(At, 0, 0); PG8_STAGE_A(PG8_SA(1, 1), _a1, coff, 1); \
            PG8_WAIT_V(8); PG8_WAIT_L(0); PG8_BAR; PG8_MMA(0, 0, At, B0); PG8_MMA(0, 1, At, B1); PG8_BAR; PG8_SCHED; \
            PG8_LDA(At, 0, 1); PG8_STAGE(PG8_SB(0, 0), _b2, voffB); PG8_STAGE(PG8_SB(0, 1), _b2 + hstep, voffB); PG8_STAGE_A(PG8_SA(0, 0), _a2, off2, 0); \
            PG8_WAIT_V(8); PG8_WAIT_L(0); PG8_BAR; PG8_MMA(1, 0, At, B0); PG8_MMA(1, 1, At, B1); PG8_BAR; PG8_SCHED; \
            PG8_LDB(B0, 1, 0); PG8_LDB(B1, 1, 1); PG8_SCHED; PG8_LDA(At, 1, 0); PG8_STAGE_A(PG8_SA(0, 1), _a2, off2, 1); \
            PG8_WAIT_V(8); PG8_WAIT_L(0); PG8_BAR; PG8_MMA(0, 0, At, B0); PG8_MMA(0, 1, At, B1); PG8_BAR; PG8_SCHED; \
            PG8_LDA(At, 1, 1); PG8_STAGE(PG8_SB(1, 0), _b3, voffB); PG8_STAGE(PG8_SB(1, 1), _b3 + hstep, voffB); PG8_STAGE_A(PG8_SA(1, 0), _a3, off2, 0); \
            PG8_WAIT_V(8); PG8_WAIT_L(0); PG8_BAR; PG8_MMA(1, 0, At, B0); PG8_MMA(1, 1, At, B1); PG8_BAR; PG8_SCHED; } while (0)
    int ui = 0;
    const char* cA; const char* cB;
    if (!S.bases(0, cA, cB)) return;
    f32x4 acc[2][2][4][2];
#pragma unroll
    for (int a = 0; a < 2; ++a)
#pragma unroll
        for (int b = 0; b < 2; ++b)
#pragma unroll
            for (int m = 0; m < 4; ++m)
#pragma unroll
                for (int n = 0; n < 2; ++n) acc[a][b][m][n] = (f32x4){0.f, 0.f, 0.f, 0.f};
    bf16x8 At[4][2], B0[2][2], B1[2][2];
    unsigned sc1 = 0x7f7f7f7fu; asm volatile("" : "+v"(sc1));
    unsigned coff[2][2], noff[2][2];
    if constexpr (Sched::GATHER) S.aoffs(0, rA, voffA, coff);
    PG8_STAGE(PG8_SB(0, 0), cB, voffB); PG8_STAGE(PG8_SB(0, 1), cB + hstep, voffB); PG8_STAGE_A(PG8_SA(0, 0), cA, coff, 0); PG8_STAGE_A(PG8_SA(0, 1), cA, coff, 1);
    if (wr == 1) PG8_BAR;
    PG8_WAIT_V(2); PG8_BAR;
    PG8_STAGE(PG8_SB(1, 0), cB + kstep, voffB); PG8_STAGE_A(PG8_SA(1, 0), cA + kstep, coff, 0); PG8_STAGE(PG8_SB(1, 1), cB + hstep + kstep, voffB);
    PG8_WAIT_V(6); PG8_BAR;
    for (;;) {
        const char* nA; const char* nB;
        const bool has_next = S.bases(ui + 1, nA, nB);
        if (!has_next) { nA = cA; nB = cB; }
        int ntok[2][2];
        if constexpr (Sched::GATHER) { if (has_next) S.atoks(ui + 1, rA, ntok); }
#pragma nounroll
        for (int t = 0; t < nt - 2; t += 2) PG8_KBODY(cA + (size_t)(t + 1) * kstep, cA + (size_t)(t + 2) * kstep, cB + (size_t)(t + 2) * kstep, coff);
        if constexpr (Sched::GATHER) {
            if (has_next) { asm volatile("" : "+v"(ntok[0][0]), "+v"(ntok[0][1]), "+v"(ntok[1][0]), "+v"(ntok[1][1]));
#pragma unroll
                for (int h = 0; h < 2; ++h)
#pragma unroll
                    for (int i = 0; i < 2; ++i) noff[h][i] = (unsigned)ntok[h][i] * (unsigned)RB + voffA[i]; }
            else {
#pragma unroll
                for (int h = 0; h < 2; ++h)
#pragma unroll
                    for (int i = 0; i < 2; ++i) noff[h][i] = coff[h][i]; }
        }
        PG8_KBODY(cA + (size_t)(nt - 1) * kstep, nA, nB, noff);
        if (wr == 0) PG8_BAR;
        if constexpr (FP8) asm volatile("s_nop 15\n\ts_nop 3" ::: "memory");
        {
            const int t2 = lane_id_fresh();
            const int w2 = wave_id, l2 = t2 & 63;
            Unit cur; S.unit(ui, cur); E(acc, cur, w2 >> 2, w2 & 3, l2 & 15, l2 >> 4); }
        if (!has_next) break;
#pragma unroll
        for (int a = 0; a < 2; ++a)
#pragma unroll
            for (int b = 0; b < 2; ++b)
#pragma unroll
                for (int m = 0; m < 4; ++m)
#pragma unroll
                    for (int n = 0; n < 2; ++n) acc[a][b][m][n] = (f32x4){0.f, 0.f, 0.f, 0.f};
        cA = nA; cB = nB; ++ui;
        if constexpr (Sched::GATHER) {
#pragma unroll
            for (int h = 0; h < 2; ++h)
#pragma unroll
                for (int i = 0; i < 2; ++i) coff[h][i] = noff[h][i]; }
        if (wr == 1) PG8_BAR;
    }
    PG8_WAIT_V(0);
    PG8_BAR;
#undef PG8_SA
#undef PG8_SB
#undef PG8_STAGE
#undef PG8_STAGE_A
#undef PG8_KBODY
#undef PG8_LDA
#undef PG8_LDB
#undef PG8_MMA
#undef PG8_WAIT_V
#undef PG8_WAIT_L
#undef PG8_BAR
#undef PG8_SCHED
}
__device__ __forceinline__ int xcd_remap(long L, int nwg) { const int q = nwg / 8, r = nwg % 8, xcd = (int)(L % 8), off = (int)(L / 8); return (xcd < r ? xcd * (q + 1) : r * (q + 1) + (xcd - r) * q) + off; }
struct RectSched {
    static constexpr bool GATHER = false;
    const char* A; const char* B; int RB, nM, nN, G, c, nM2, nN2, pm2, pn2;
    __device__ __forceinline__ bool unit(int i, Unit& u) const {
        const int n1 = nM * nN, nwg = n1 + nM2 * nN2; const long L = (long)i * G + c; if (L >= nwg) return false;
        int w = xcd_remap(L, nwg); int rm = nM, rn = nN, pm0 = 0, pn0 = 0;
        if (w >= n1) { w -= n1; rm = nM2; rn = nN2; pm0 = pm2; pn0 = pn2; }
        const int nig = 8 * rn, gid = w / nig, fm = gid * 8, gsz = (rm - fm) < 8 ? (rm - fm) : 8;
        u.pm = pm0 + fm + ((w % nig) % gsz); u.pn = pn0 + (w % nig) / gsz; u.e = 0; u.rows = 256; u.base = u.pm * 256; u.newe = 0;
        return true;
    }
    __device__ __forceinline__ bool bases(int i, const char*& a, const char*& b) const {
        Unit u; if (!unit(i, u)) return false;
        a = A + (size_t)u.pm * 256 * RB; b = B + (size_t)u.pn * 256 * RB; return true;
    }
    __device__ __forceinline__ void aoffs(int, const int (&)[2], const unsigned (&)[2], unsigned (&)[2][2]) const {}
    __device__ __forceinline__ void atoks(int, const int (&)[2], int (&)[2][2]) const {}
};
}

template <class MapF>
__device__ __forceinline__ void transpose_item(const float* W, int K, int N, bf16* WT, MapF rowmap, float* scr, int item, int lane) {
    const int nblk = N / 32, kb = item / nblk, nb = item % nblk, k0 = 64 * kb, n0 = 32 * nb;
#pragma unroll 8
    for (int i = 0; i < 32; ++i) { const int kk = 2 * i + (lane >> 5); scr[kk * 33 + (lane & 31)] = W[(size_t)(k0 + kk) * N + n0 + (lane & 31)]; }
    asm volatile("s_waitcnt lgkmcnt(0)" ::: "memory");
    const int c = lane & 7;
#pragma unroll
    for (int j = 0; j < 4; ++j) { const int n = (lane >> 3) + 8 * j; const float* s = scr + (8 * c) * 33 + n;
        v4u o; o.x = pk2(s[0 * 33], s[1 * 33]); o.y = pk2(s[2 * 33], s[3 * 33]); o.z = pk2(s[4 * 33], s[5 * 33]); o.w = pk2(s[6 * 33], s[7 * 33]);
        *(v4u*)(WT + (size_t)rowmap(n0 + n) * K + k0 + 8 * c) = o; }
    asm volatile("s_waitcnt lgkmcnt(0)" ::: "memory");
}
constexpr int CV_E0 = 2, CV_E1 = 12, CV_E2 = 22, CV_E3 = 18, INP0_NC = 40, OUTP0_NC = 64, INP1_NC = 32, MOE_NC = 32;
__device__ __forceinline__ void item8_load(const float* W, int N, int item, int lane, f32x4 (&t)[16]) {
    const int nblk = N / 32, kb = item / nblk, nb = item % nblk, k0 = 128 * kb, n0 = 32 * nb;
    const int r8 = lane >> 3, c8 = lane & 7;
    const float* p = W + (size_t)(k0 + 16 * r8) * N + n0 + 4 * c8;
#pragma unroll
    for (int i = 0; i < 16; ++i) t[i] = __builtin_nontemporal_load((const f32x4*)(p + (size_t)i * N));
}
template <class MapF>
__device__ __forceinline__ void item8_store(const f32x4 (&t)[16], int K, int N, unsigned char* WT, MapF rowmap, int item, int lane) {
    const int nblk = N / 32, kb = item / nblk, nb = item % nblk, k0 = 128 * kb, n0 = 32 * nb;
    const int r8 = lane >> 3, c8 = lane & 7;
#pragma unroll
    for (int c = 0; c < 4; ++c) {
        v4u o;
        o.x = pk4_fp8(t[0][c] * W8_SCALE, t[1][c] * W8_SCALE, t[2][c] * W8_SCALE, t[3][c] * W8_SCALE);     o.y = pk4_fp8(t[4][c] * W8_SCALE, t[5][c] * W8_SCALE, t[6][c] * W8_SCALE, t[7][c] * W8_SCALE);
        o.z = pk4_fp8(t[8][c] * W8_SCALE, t[9][c] * W8_SCALE, t[10][c] * W8_SCALE, t[11][c] * W8_SCALE); o.w = pk4_fp8(t[12][c] * W8_SCALE, t[13][c] * W8_SCALE, t[14][c] * W8_SCALE, t[15][c] * W8_SCALE);
        *(v4u*)(WT + (size_t)rowmap(n0 + 4 * c8 + c) * K + k0 + 16 * r8) = o;
    }
}
struct ExpertConv {
    const CAS Args& a; int layer, wlo, nw, lane;
    static constexpr int IPM = 8 * 32;
    __device__ __forceinline__ void load(int it, f32x4 (&t)[16]) const {
        const int m = it / IPM, le = layer + m / nw, which = wlo + m % nw;
        item8_load((which == 0 ? a.in[31] : which == 1 ? a.in[33] : a.in[35]) + ((size_t)le << 20), D, it % IPM, lane, t); }
    __device__ __forceinline__ void store(int it, const f32x4 (&t)[16]) const {
        const int m = it / IPM, r = it % IPM, le = layer + m / nw, which = wlo + m % nw;
        unsigned char* dst = (unsigned char*)(a.ws + WS_WEXP) + (size_t)le * 3072 * 1024;
        if (which == 0) item8_store(t, D, D, dst, [](int n) { return ((n >> 7) << 8) + (n & 127); }, r, lane);
        else if (which == 1) item8_store(t, D, D, dst, [](int n) { return ((n >> 7) << 8) + 128 + (n & 127); }, r, lane);
        else item8_store(t, D, D, dst + (size_t)2048 * 1024,
            [](int f) { return (f & ~255) | (((f >> 3) & 1) << 7) | (((f >> 6) & 3) << 5) | (((f >> 4) & 3) << 3) | (f & 7); }, r, lane); }
};
__device__ __forceinline__ void convert_experts(const CAS Args& a, const Frame& F, int layer, int wlo, int whi, int gw, int ngw, int elo = 0, int ehi = NE) {
    const ExpertConv C{a, layer * NE + elo, wlo, whi - wlo, F.lane};
    const int total = (ehi - elo) * (whi - wlo) * ExpertConv::IPM;
    int it = gw; if (it >= total) return;
    f32x4 tA[16], tB[16];
    C.load(it, tA);
    for (;;) {
        int nit = it + ngw;
        if (nit < total) C.load(nit, tB);
        C.store(it, tA);
        if (nit >= total) break;
        it = nit; nit = it + ngw;
        if (nit < total) C.load(nit, tA);
        C.store(it, tB);
        if (nit >= total) break;
        it = nit;
    }
}
__device__ __forceinline__ void p0_prologue(const CAS Args& a, const Frame& F) {
    float* scr = (float*)(F.lds + F.wave * 8448);
    constexpr int I_IN0 = 16 * 96, I_O = 16 * 32, I_IN1 = 16 * 64, I_LRU1 = 4 * 8;
    constexpr int NSMALL = I_IN0 + I_O + I_IN1 + I_O + 16 * I_LRU1;
    for (int it = F.gw; it < NSMALL; it += F.ngw) {
        int r = it;
        if (r < I_IN0) {
            transpose_item(a.in[8], D, 3072, (bf16*)(a.ws + WS_WIN0), [](int f) {
                if (f < 2048) return (f & ~255) | (((f >> 5) & 1) << 7) | (((f >> 6) & 3) << 5) | (f & 31);
                if (f < 2560) { const int j = f - 2048; return (8 + (j >> 7)) * 256 + (j & 127); }
                const int j = f - 2560; return (8 + (j >> 7)) * 256 + 128 + (j & 127); }, scr, r, F.lane); continue; } r -= I_IN0;
        if (r < I_O) { transpose_item(a.in[9], D, D, (bf16*)(a.ws + WS_WOUT0), [](int n) { return n; }, scr, r, F.lane); continue; } r -= I_O;
        if (r < I_IN1) { transpose_item(a.in[15], D, 2048, (bf16*)(a.ws + WS_WIN1), [](int n) { return n; }, scr, r, F.lane); continue; } r -= I_IN1;
        if (r < I_O) { transpose_item(a.in[16], D, D, (bf16*)(a.ws + WS_WOUT1), [](int n) { return n; }, scr, r, F.lane); continue; } r -= I_O;
        const int gh = r / I_LRU1, rr = r % I_LRU1, g = gh >> 2, h = gh & 3;
        const float* W = (g == 0 ? a.in[19] : g == 1 ? a.in[21] : g == 2 ? a.in[24] : a.in[26]) + (size_t)h * 65536;
        transpose_item(W, 256, 256, (bf16*)(a.ws + WS_WLRU) + (size_t)h * 1024 * 256, [g](int n) { return g * 256 + n; }, scr, rr, F.lane);
    }
    __syncthreads();
    convert_experts(a, F, 0, 0, 2, F.gw, F.ngw, 0, CV_E0);
    __syncthreads();
    float* sc = (float*)F.lds;
    float* red = (float*)(F.lds + 17 * 1024 * 4);
    {
#pragma unroll
        for (int hbat = 0; hbat < 2; ++hbat) { float tv[17];
#pragma unroll
            for (int j = 0; j < 17; ++j) { const int i = F.tid + 512 * (17 * hbat + j); tv[j] = i < 16 * 1024 ? a.in[1][i] : a.in[3][i - 16 * 1024]; }
#pragma unroll
            for (int j = 0; j < 17; ++j) { const int i = F.tid + 512 * (17 * hbat + j); sc[i] = tv[j] / (1.0f + __expf(-tv[j])); } }
    }
    __syncthreads();
    float* MOD = (float*)(a.ws + WS_MOD);
    for (int u = F.bid; u < 192; u += F.G) {
        const int l = u / 96, n = (u % 96) * 64 + F.lane;
        const float* w = a.in[4] + (size_t)l * D * 6144 + n;
        float acc[17];
#pragma unroll
        for (int b = 0; b < 17; ++b) acc[b] = 0.f;
        for (int k0 = F.wave * 128; k0 < F.wave * 128 + 128; k0 += 16) {
            float wv[16];
#pragma unroll
            for (int q = 0; q < 16; ++q) wv[q] = __builtin_nontemporal_load(w + (size_t)(k0 + q) * 6144);
#pragma unroll
            for (int q = 0; q < 16; ++q)
#pragma unroll
                for (int b = 0; b < 17; ++b) acc[b] += sc[b * 1024 + k0 + q] * wv[q];
        }
#pragma unroll
        for (int b = 0; b < 17; ++b) red[(F.wave * 17 + b) * 64 + F.lane] = acc[b];
        __syncthreads();
        for (int i = F.tid; i < 17 * 64; i += NWAVES * 64) {
            const int b = i / 64, ln = i % 64; float s = 0.f;
#pragma unroll
            for (int w8 = 0; w8 < 8; ++w8) s += red[(w8 * 17 + b) * 64 + ln];
            const int nn = (u % 96) * 64 + ln;
            MOD[((size_t)l * 17 + b) * 6144 + nn] = s + a.in[5][l * 6144 + nn];
        }
        __syncthreads();
    }
}

__device__ __forceinline__ void load_row16(const float* row, int lane, float (&v)[16]) {
#pragma unroll
    for (int j = 0; j < 4; ++j) { const f32x4 t = *(const f32x4*)(row + 256 * j + 4 * lane); v[4 * j] = t.x; v[4 * j + 1] = t.y; v[4 * j + 2] = t.z; v[4 * j + 3] = t.w; }
}
__device__ __forceinline__ void load_row16_bf16(const bf16* row, int lane, float (&v)[16]) {
#pragma unroll
    for (int j = 0; j < 4; ++j) { const uint2 t = *(const uint2*)(row + 256 * j + 4 * lane); v[4 * j] = __uint_as_float(t.x << 16); v[4 * j + 1] = __uint_as_float(t.x & 0xffff0000u); v[4 * j + 2] = __uint_as_float(t.y << 16); v[4 * j + 3] = __uint_as_float(t.y & 0xffff0000u); }
}
__device__ __forceinline__ void store_row16_bf16(bf16* row, int lane, const float (&v)[16]) {
#pragma unroll
    for (int j = 0; j < 4; ++j) { uint2 o; o.x = pk2(v[4 * j], v[4 * j + 1]); o.y = pk2(v[4 * j + 2], v[4 * j + 3]); *(uint2*)(row + 256 * j + 4 * lane) = o; }
}
__device__ __forceinline__ void store_row16_f32(float* row, int lane, const float (&v)[16]) {
#pragma unroll
    for (int j = 0; j < 4; ++j) *(f32x4*)(row + 256 * j + 4 * lane) = (f32x4){v[4 * j], v[4 * j + 1], v[4 * j + 2], v[4 * j + 3]};
}
template <bool FP8OUT = false>
__device__ __forceinline__ void norm_mod(const float (&v)[16], const float* g, const float* sh, const float* sc, bf16* out, int lane, float (&hv)[16]) {
    float s = 0.f;
#pragma unroll
    for (int i = 0; i < 16; ++i) s += v[i] * v[i];
    const float rstd = rsqrtf(wave_sum(s) * (1.0f / D) + 1e-6f);
#pragma unroll
    for (int j = 0; j < 4; ++j) {
        const int e = 256 * j + 4 * lane;
        const f32x4 gg = *(const f32x4*)(g + e), ss = *(const f32x4*)(sh + e), cc = *(const f32x4*)(sc + e);
        hv[4 * j] = v[4 * j] * rstd * gg.x * (1.f + cc.x) + ss.x; hv[4 * j + 1] = v[4 * j + 1] * rstd * gg.y * (1.f + cc.y) + ss.y;
        hv[4 * j + 2] = v[4 * j + 2] * rstd * gg.z * (1.f + cc.z) + ss.z; hv[4 * j + 3] = v[4 * j + 3] * rstd * gg.w * (1.f + cc.w) + ss.w;
        if (FP8OUT) *(unsigned*)((unsigned char*)out + e) = pk4_fp8(hv[4 * j], hv[4 * j + 1], hv[4 * j + 2], hv[4 * j + 3]);
        else { uint2 o; o.x = pk2(hv[4 * j], hv[4 * j + 1]); o.y = pk2(hv[4 * j + 2], hv[4 * j + 3]); *(uint2*)(out + e) = o; }
    }
}
__device__ __forceinline__ int row_batch(int r) { return r < NT ? (r >> 11) : 16; }
__device__ __forceinline__ const float* mod_ptr(const CAS Args& a, int l, int r, int chunk) { return (const float*)(a.ws + WS_MOD) + ((size_t)l * 17 + row_batch(r)) * 6144 + chunk * D; }

__device__ __forceinline__ void p_norm1_l0(const CAS Args& a, const Frame& F) {
    bf16* H = (bf16*)(a.ws + WS_H);
    { float* GS2 = (float*)(a.ws + WS_GS2); const float* MOD = (const float*)(a.ws + WS_MOD);
      for (int i = F.gw * 64 + F.lane; i < 2 * 17 * D; i += F.ngw * 64) { const int l = i / (17 * D), bb = (i / D) % 17, k = i % D; GS2[i] = a.in[7][l * D + k] * (1.0f + MOD[((size_t)l * 17 + bb) * 6144 + 4 * D + k]); } }
    for (int r = F.gw; r < R; r += 3 * F.ngw) {
        float v[3][16], hv[16];
#pragma unroll
        for (int k = 0; k < 3; ++k) { const int rr = r + k * F.ngw; if (rr < R) load_row16(rr < NT ? a.in[0] + (size_t)rr * D : a.in[2] + (size_t)(rr - NT) * D, F.lane, v[k]); }
#pragma unroll
        for (int k = 0; k < 3; ++k) { const int rr = r + k * F.ngw; if (rr < R) norm_mod(v[k], a.in[6], mod_ptr(a, 0, rr, 0), mod_ptr(a, 0, rr, 1), H + (size_t)rr * D, F.lane, hv); }
    }
}

struct EpiInProj0 {
    static constexpr bool PERM = true;
    bf16* P; const float* qg; const float* kg;
    __device__ __forceinline__ void operator()(const f32x4 (&acc)[2][2][4][2], const pg8::Unit& u, int wr, int wc, int fr, int fq) const {
        const int row0 = u.pm * 256 + wr * 64 + fr, pn = u.pn;
        if (pn < 4) {
            const float* g = pn < 2 ? qg : kg; const float sc = pn < 2 ? 0.125f : 1.0f;
            f32x4 gv[2][2];
#pragma unroll
            for (int bj = 0; bj < 2; ++bj)
#pragma unroll
                for (int n = 0; n < 2; ++n) gv[bj][n] = *(const f32x4*)(g + 32 * bj + 8 * fq + 4 * n);
#pragma unroll
            for (int ai = 0; ai < 2; ++ai)
#pragma unroll
                for (int m = 0; m < 4; ++m) {
                    float ss = 0.f;
#pragma unroll
                    for (int bj = 0; bj < 2; ++bj)
#pragma unroll
                        for (int n = 0; n < 2; ++n) { const f32x4 x = acc[ai][bj][m][n]; ss += (x[0] * x[0] + x[1] * x[1]) + (x[2] * x[2] + x[3] * x[3]); }
                    ss += __shfl_xor(ss, 16); ss += __shfl_xor(ss, 32);
                    const float rs = rsqrtf(ss * (1.0f / 64.0f) + 1e-6f) * sc;
                    bf16* rowp = P + (size_t)(row0 + ai * 128 + m * 16) * PP + pn * 256 + wc * 64 + 8 * fq;
#pragma unroll
                    for (int bj = 0; bj < 2; ++bj) { const f32x4 v0 = acc[ai][bj][m][0] * rs * gv[bj][0], v1 = acc[ai][bj][m][1] * rs * gv[bj][1];
                        v4u w; w.x = pg8::cvt_pk_bf16(v0[0], v0[1]); w.y = pg8::cvt_pk_bf16(v0[2], v0[3]); w.z = pg8::cvt_pk_bf16(v1[0], v1[1]); w.w = pg8::cvt_pk_bf16(v1[2], v1[3]);
                        *(v4u*)(rowp + 32 * bj) = w; }
                }
        } else if (pn < 8) {
#pragma unroll
            for (int ai = 0; ai < 2; ++ai)
#pragma unroll
                for (int m = 0; m < 4; ++m) { bf16* rowp = P + (size_t)(row0 + ai * 128 + m * 16) * PP + pn * 256 + wc * 64 + 8 * fq;
#pragma unroll
                    for (int bj = 0; bj < 2; ++bj) { const f32x4 v0 = acc[ai][bj][m][0], v1 = acc[ai][bj][m][1];
                        v4u w; w.x = pg8::cvt_pk_bf16(v0[0], v0[1]); w.y = pg8::cvt_pk_bf16(v0[2], v0[3]); w.z = pg8::cvt_pk_bf16(v1[0], v1[1]); w.w = pg8::cvt_pk_bf16(v1[2], v1[3]);
                        *(v4u*)(rowp + 32 * bj) = w; } }
        } else {
#pragma unroll
            for (int ai = 0; ai < 2; ++ai)
#pragma unroll
                for (int m = 0; m < 4; ++m) { bf16* rowp = P + (size_t)(row0 + ai * 128 + m * 16) * PP + 2048 + (pn - 8) * 128 + wc * 32 + 8 * fq;
                    const f32x4 v0 = acc[ai][0][m][0] * acc[ai][1][m][0], v1 = acc[ai][0][m][1] * acc[ai][1][m][1];
                    v4u w; w.x = pg8::cvt_pk_bf16(v0[0], v0[1]); w.y = pg8::cvt_pk_bf16(v0[2], v0[3]); w.z = pg8::cvt_pk_bf16(v1[0], v1[1]); w.w = pg8::cvt_pk_bf16(v1[2], v1[3]);
                    *(v4u*)rowp = w; }
        }
    }
};
__device__ __forceinline__ void p_inproj0(const CAS Args& a, const Frame& F) {
    if (F.bid >= F.G - INP0_NC) { convert_experts(a, F, 0, 0, 2, (F.bid - (F.G - INP0_NC)) * NWAVES + F.wave, INP0_NC * NWAVES, CV_E1, NE); return; }
    pg8::RectSched S{(const char*)(a.ws + WS_H), (const char*)(a.ws + WS_WIN0), 2 * D, R / 256, 3072 / 256, F.G - INP0_NC, F.bid, 0, 0, 0, 0};
    EpiInProj0 E{(bf16*)(a.ws + WS_P), a.in[10], a.in[11]};
    pg8::gemm_phase<2 * D, false>(F.ldsl, S, E, F.wave);
}
typedef __bf16 bf16x2_t __attribute__((ext_vector_type(2)));
typedef float f32x2_t __attribute__((ext_vector_type(2)));
typedef short s16x4 __attribute__((ext_vector_type(4)));
__device__ __forceinline__ unsigned pk_bf16(float a, float b) { f32x2_t v = {a, b}; bf16x2_t r = __builtin_convertvector(v, bf16x2_t); return __builtin_bit_cast(unsigned, r); }
constexpr int AT_LAT = 0, AT_CK = 576 * 128, AT_CV = AT_CK + 256 * 128, AT_RPB = AT_CV + 256 * 128;
__device__ __forceinline__ int at_swz(int key) { return (key ^ (key >> 3)) & 7; }
__device__ __forceinline__ unsigned at_addr(int key, int chunk) { return (unsigned)(key * 128 + ((chunk ^ at_swz(key)) << 4)); }
template <class RowF>
__device__ __forceinline__ void at_stage(LAS unsigned char* dst, int npieces, RowF rowf, int colbyte, const bf16* P, int wave, int lane) {
    for (int p = wave; p < npieces; p += NWAVES) {
        const int key = 8 * p + (lane >> 3), c = (lane & 7) ^ at_swz(key);
        const char* src = (const char*)P + (size_t)rowf(key) * (PP * 2) + colbyte + 16 * c;
        __builtin_amdgcn_global_load_lds((const unsigned*)src, (LAS unsigned*)(dst + p * 1024), 16, 0, 0);
    }
}
template <int OFF>
__device__ __forceinline__ void at_tr8o(unsigned a0, unsigned a1, unsigned a2, unsigned a3, unsigned a4, unsigned a5, unsigned a6, unsigned a7, s16x4 (&r)[8]) {
    asm volatile("ds_read_b64_tr_b16 %0, %8 offset:%16\n\tds_read_b64_tr_b16 %1, %9 offset:%16\n\tds_read_b64_tr_b16 %2, %10 offset:%16\n\tds_read_b64_tr_b16 %3, %11 offset:%16\n\t"
                 "ds_read_b64_tr_b16 %4, %12 offset:%16\n\tds_read_b64_tr_b16 %5, %13 offset:%16\n\tds_read_b64_tr_b16 %6, %14 offset:%16\n\tds_read_b64_tr_b16 %7, %15 offset:%16\n\ts_waitcnt lgkmcnt(0)"
                 : "=&v"(r[0]), "=&v"(r[1]), "=&v"(r[2]), "=&v"(r[3]), "=&v"(r[4]), "=&v"(r[5]), "=&v"(r[6]), "=&v"(r[7])
                 : "v"(a0), "v"(a1), "v"(a2), "v"(a3), "v"(a4), "v"(a5), "v"(a6), "v"(a7), "n"(OFF) : "memory");
}
__device__ __forceinline__ void at_tr8(unsigned a0, unsigned a1, unsigned a2, unsigned a3, unsigned a4, unsigned a5, unsigned a6, unsigned a7, s16x4 (&r)[8]) {
    asm volatile("ds_read_b64_tr_b16 %0, %8\n\tds_read_b64_tr_b16 %1, %9\n\tds_read_b64_tr_b16 %2, %10\n\tds_read_b64_tr_b16 %3, %11\n\t"
                 "ds_read_b64_tr_b16 %4, %12\n\tds_read_b64_tr_b16 %5, %13\n\tds_read_b64_tr_b16 %6, %14\n\tds_read_b64_tr_b16 %7, %15\n\ts_waitcnt lgkmcnt(0)"
                 : "=&v"(r[0]), "=&v"(r[1]), "=&v"(r[2]), "=&v"(r[3]), "=&v"(r[4]), "=&v"(r[5]), "=&v"(r[6]), "=&v"(r[7])
                 : "v"(a0), "v"(a1), "v"(a2), "v"(a3), "v"(a4), "v"(a5), "v"(a6), "v"(a7) : "memory");
}
__device__ __forceinline__ void p_attn(const CAS Args& a, const Frame& F) {
    const bf16* P = (const bf16*)(a.ws + WS_P); bf16* A2 = (bf16*)(a.ws + WS_A2);
    LAS unsigned char* lds = F.ldsl;
    const int lane = F.lane, wave = F.wave, rho = lane & 15, g = lane >> 4;
    for (int wu = F.bid; wu < NB * 8 * 2; wu += F.G) {
        const int half = wu & 1, hd = (wu >> 1) & 7, b = wu >> 4;
        __syncthreads();
        if (F.tid < 15 * 32) { const int dr_ = F.tid >> 5, dc_ = F.tid & 31; ((LAS float*)(lds + AT_RPB))[F.tid] = dc_ < 31 ? a.in[12][hd * 465 + dr_ * 31 + dc_] : -1e30f; }
        at_stage(lds + AT_CK, 32, [=](int key) { return NT + b * 256 + key; }, (512 + hd * 64) * 2, P, wave, lane);
        at_stage(lds + AT_CV, 32, [=](int key) { return NT + b * 256 + key; }, (1024 + hd * 64) * 2, P, wave, lane);
        for (int un = 0; un < 9; ++un) {
            const bool lat = un < 8;
            int r = 0, n = 0, qrow, krow_lo = 0;
            if (lat) { const int rp = half * 8 + un; r = 2 * rp + (wave >> 2); n = wave & 3; qrow = b * 2048 + r * 64 + 16 * n + rho; krow_lo = min(max(2 * rp - 4, 0), 24); }
            else qrow = NT + b * 256 + half * 128 + 16 * wave + rho;
            const int r0 = min(max(r - 4, 0), 24), ro = r0 - krow_lo, kc0 = min(max(16 * n - 8, 0), 32);
            const int c = 16 * n + rho, c0 = min(max(c - 8, 0), 48);
            if (lat) at_stage(lds + AT_LAT, 72, [=](int key) { return b * 2048 + min(krow_lo + (key >> 6), 31) * 64 + (key & 63); }, (512 + hd * 64) * 2, P, wave, lane);
            const bf16x8 q0 = *(const bf16x8*)(P + (size_t)qrow * PP + hd * 64 + 8 * g), q1 = *(const bf16x8*)(P + (size_t)qrow * PP + hd * 64 + 32 + 8 * g);
            asm volatile("s_waitcnt vmcnt(0)" ::: "memory");
            __syncthreads();
            const int pk = 8 * (rho >> 2) + (rho & 3);
            float mxb[2] = {-1e30f, -1e30f}, smb[2] = {0.f, 0.f}; v4u pf[16];
            const LAS unsigned char* bp[8];
#pragma unroll
            for (int k = 0; k < 8; ++k) { const int kcol = kc0 + 8 * g + k; const int dc = ((unsigned)(kcol - c0) < 16u) ? min(max(kcol - c + 15, 0), 30) : 31; bp[k] = lds + AT_RPB + ((r0 - r + 7) * 32 + dc) * 4; }
            const LAS unsigned char* kpl[2][2]; const LAS unsigned char* kpc[2][2][2];
#pragma unroll
            for (int t = 0; t < 2; ++t)
#pragma unroll
                for (int hf = 0; hf < 2; ++hf) {
                    kpl[t][hf] = lds + AT_LAT + at_addr(ro * 64 + kc0 + pk + 4 * t, 4 * hf + g);
                    const unsigned ce = AT_CK + at_addr(pk + 4 * t, 4 * hf + g);
                    kpc[0][t][hf] = lds + ce; kpc[1][t][hf] = lds + (ce ^ 0x40u); }
#pragma unroll
            for (int blk = 0; blk < 2; ++blk) {
                if (blk == 0 && !lat) {
#pragma unroll
                    for (int i = 0; i < 8; ++i) pf[i] = (v4u){0u, 0u, 0u, 0u};
                    continue; }
                f32x4 s[16];
#pragma unroll
                for (int i = 0; i < 8; ++i)
#pragma unroll
                    for (int t = 0; t < 2; ++t) {
                        const bf16x8 k0 = blk == 0 ? *(const LAS bf16x8*)(kpl[t][0] + i * 8192) : *(const LAS bf16x8*)(kpc[i & 1][t][0] + i * 4096);
                        const bf16x8 k1 = blk == 0 ? *(const LAS bf16x8*)(kpl[t][1] + i * 8192) : *(const LAS bf16x8*)(kpc[i & 1][t][1] + i * 4096);
                        f32x4 acc = __builtin_amdgcn_mfma_f32_16x16x32_bf16(k0, q0, (f32x4){0.f, 0.f, 0.f, 0.f}, 0, 0, 0);
                        acc = __builtin_amdgcn_mfma_f32_16x16x32_bf16(k1, q1, acc, 0, 0, 0);
                        if (blk == 0) {
#pragma unroll
                            for (int jj = 0; jj < 4; ++jj) acc[jj] += *(const LAS float*)(bp[4 * t + jj] + i * 128);
                        }
                        s[2 * i + t] = acc;
                    }
                float mx = -1e30f;
#pragma unroll
                for (int i = 0; i < 16; ++i) mx = fmaxf(fmaxf(mx, fmaxf(s[i][0], s[i][1])), fmaxf(s[i][2], s[i][3]));
                mx = fmaxf(mx, __shfl_xor(mx, 16)); mx = fmaxf(mx, __shfl_xor(mx, 32));
                float sum = 0.f;
#pragma unroll
                for (int i = 0; i < 8; ++i) {
                    float e[8];
#pragma unroll
                    for (int t = 0; t < 2; ++t)
#pragma unroll
                        for (int jj = 0; jj < 4; ++jj) { e[4 * t + jj] = __expf(s[2 * i + t][jj] - mx); sum += e[4 * t + jj]; }
                    pf[8 * blk + i].x = pk_bf16(e[0], e[1]); pf[8 * blk + i].y = pk_bf16(e[2], e[3]); pf[8 * blk + i].z = pk_bf16(e[4], e[5]); pf[8 * blk + i].w = pk_bf16(e[6], e[7]);
                }
                sum += __shfl_xor(sum, 16); sum += __shfl_xor(sum, 32);
                mxb[blk] = mx; smb[blk] = sum;
            }
            __syncthreads();
            if (lat) at_stage(lds + AT_LAT, 72, [=](int key) { return b * 2048 + min(krow_lo + (key >> 6), 31) * 64 + (key & 63); }, (1024 + hd * 64) * 2, P, wave, lane);
            asm volatile("s_waitcnt vmcnt(0)" ::: "memory");
            __syncthreads();
            f32x4 o[2][4];
#pragma unroll
            for (int blk = 0; blk < 2; ++blk)
#pragma unroll
                for (int db = 0; db < 4; ++db) o[blk][db] = (f32x4){0.f, 0.f, 0.f, 0.f};
            const int tq = rho >> 2, tp = rho & 3;
            unsigned adl[8], adc[8];
#pragma unroll
            for (int db = 0; db < 4; ++db) { const int kl = ro * 64 + kc0 + 8 * g + tq, kc = 8 * g + tq;
                adl[2 * db] = (unsigned)(size_t)(lds + AT_LAT) + at_addr(kl, 2 * db + (tp >> 1)) + 8 * (tp & 1); adl[2 * db + 1] = (unsigned)(size_t)(lds + AT_LAT) + at_addr(kl + 4, 2 * db + (tp >> 1)) + 8 * (tp & 1);
                adc[2 * db] = (unsigned)(size_t)(lds + AT_CV) + at_addr(kc, 2 * db + (tp >> 1)) + 8 * (tp & 1); adc[2 * db + 1] = (unsigned)(size_t)(lds + AT_CV) + at_addr(kc + 4, 2 * db + (tp >> 1)) + 8 * (tp & 1); }
#define AT_PV_CHUNK(CH) do { if ((CH) >= 8 || lat) { s16x4 vr[8]; \
                if ((CH) < 8) at_tr8o<((CH) & 7) * 8192>(adl[0], adl[1], adl[2], adl[3], adl[4], adl[5], adl[6], adl[7], vr); \
                else if (((CH) & 1) == 0) at_tr8o<((CH) & 7) * 4096>(adc[0], adc[1], adc[2], adc[3], adc[4], adc[5], adc[6], adc[7], vr); \
                else at_tr8o<((CH) & 7) * 4096>(adc[0] ^ 0x40u, adc[1] ^ 0x40u, adc[2] ^ 0x40u, adc[3] ^ 0x40u, adc[4] ^ 0x40u, adc[5] ^ 0x40u, adc[6] ^ 0x40u, adc[7] ^ 0x40u, vr); \
                _Pragma("unroll") for (int db = 0; db < 4; ++db) { const bf16x8 vf = __builtin_shufflevector(vr[2 * db], vr[2 * db + 1], 0, 1, 2, 3, 4, 5, 6, 7); \
                    o[(CH) >> 3][db] = __builtin_amdgcn_mfma_f32_16x16x32_bf16(vf, __builtin_bit_cast(bf16x8, pf[CH]), o[(CH) >> 3][db], 0, 0, 0); } } } while (0)
            AT_PV_CHUNK(0); AT_PV_CHUNK(1); AT_PV_CHUNK(2); AT_PV_CHUNK(3); AT_PV_CHUNK(4); AT_PV_CHUNK(5); AT_PV_CHUNK(6); AT_PV_CHUNK(7);
            AT_PV_CHUNK(8); AT_PV_CHUNK(9); AT_PV_CHUNK(10); AT_PV_CHUNK(11); AT_PV_CHUNK(12); AT_PV_CHUNK(13); AT_PV_CHUNK(14); AT_PV_CHUNK(15);
#undef AT_PV_CHUNK
            const float mxa = fmaxf(mxb[0], mxb[1]), f0 = __expf(mxb[0] - mxa), f1 = __expf(mxb[1] - mxa);
            const float inv = 1.0f / (f0 * smb[0] + f1 * smb[1]), g0 = f0 * inv, g1 = f1 * inv;
#pragma unroll
            for (int db = 0; db < 4; ++db) { uint2 w; w.x = pk_bf16(o[0][db][0] * g0 + o[1][db][0] * g1, o[0][db][1] * g0 + o[1][db][1] * g1); w.y = pk_bf16(o[0][db][2] * g0 + o[1][db][2] * g1, o[0][db][3] * g0 + o[1][db][3] * g1);
                *(uint2*)(A2 + (size_t)qrow * D + hd * 64 + 16 * db + 4 * g) = w; }
            __syncthreads();
        }
    }
    const float* cw = a.in[13]; const float* cb = a.in[14];
    const int j0 = 8 * lane;
    float w0[8], w1[8], w2[8], bb[8];
#pragma unroll
    for (int q = 0; q < 8; ++q) { w0[q] = cw[j0 + q]; w1[q] = cw[512 + j0 + q]; w2[q] = cw[1024 + j0 + q]; bb[q] = cb[j0 + q]; }
    for (int blk = F.gw; blk < R / 6; blk += F.ngw) {
        const int row0 = 6 * blk;
        v4u pw[8], bgw[6];
#pragma unroll
        for (int k = 0; k < 8; ++k) { const int rr = row0 + k - 1; pw[k] = (rr >= 0 && rr < R) ? *(const v4u*)(P + (size_t)rr * PP + 2048 + j0) : (v4u){0u, 0u, 0u, 0u}; }
#pragma unroll
        for (int k = 0; k < 6; ++k) bgw[k] = *(const v4u*)(P + (size_t)(row0 + k) * PP + 1536 + j0);
#pragma unroll
        for (int k = 0; k < 6; ++k) {
            const int row = row0 + k; const bool latr = row < NT; const int t = latr ? (row & 2047) : ((row - NT) & 255), len = latr ? 2048 : 256;
            const v4u pm = t > 0 ? pw[k] : (v4u){0u, 0u, 0u, 0u}, pc = pw[k + 1], pn = (t + 1 < len) ? pw[k + 2] : (v4u){0u, 0u, 0u, 0u}, bgv = bgw[k];
            const unsigned am[4] = {pm.x, pm.y, pm.z, pm.w}, ac[4] = {pc.x, pc.y, pc.z, pc.w}, an[4] = {pn.x, pn.y, pn.z, pn.w}, ab[4] = {bgv.x, bgv.y, bgv.z, bgv.w};
            unsigned ow[4];
#pragma unroll
            for (int q = 0; q < 4; ++q) {
                const float lo = __uint_as_float(ab[q] << 16) * (bb[2 * q] + w0[2 * q] * __uint_as_float(am[q] << 16) + w1[2 * q] * __uint_as_float(ac[q] << 16) + w2[2 * q] * __uint_as_float(an[q] << 16));
                const float hi = __uint_as_float(ab[q] & 0xffff0000u) * (bb[2 * q + 1] + w0[2 * q + 1] * __uint_as_float(am[q] & 0xffff0000u) + w1[2 * q + 1] * __uint_as_float(ac[q] & 0xffff0000u) + w2[2 * q + 1] * __uint_as_float(an[q] & 0xffff0000u));
                ow[q] = pk_bf16(lo, hi);
            }
            *(v4u*)(A2 + (size_t)row * D + 512 + j0) = (v4u){ow[0], ow[1], ow[2], ow[3]};
        }
    }
}
template <int L>
struct EpiOutProj {
    static constexpr bool PERM = true;
    const float* baseL; const float* baseC; bf16* XB; const float* MODl;
    __device__ __forceinline__ void operator()(const f32x4 (&acc)[2][2][4][2], const pg8::Unit& u, int wr, int wc, int fr, int fq) const {
        const bool lat = u.pm < NT / 256;
        const int mb = lat ? (u.pm >> 3) : 16;
        const int row0 = u.pm * 256 + wr * 64 + fr, col0 = u.pn * 256 + wc * 32 + 8 * fq;
        const float* g1 = MODl + (size_t)mb * 6144 + 2 * D + col0;
        f32x4 gv[2][2];
#pragma unroll
        for (int bj = 0; bj < 2; ++bj)
#pragma unroll
            for (int n = 0; n < 2; ++n) gv[bj][n] = *(const f32x4*)(g1 + bj * 128 + 4 * n);
#pragma unroll
        for (int ai = 0; ai < 2; ++ai)
#pragma unroll
            for (int m = 0; m < 4; ++m) { const int row = row0 + ai * 128 + m * 16;
#pragma unroll
                for (int bj = 0; bj < 2; ++bj) {
                    f32x4 b0, b1;
                    if (L == 0) { const float* bp = (lat ? baseL + (size_t)row * D : baseC + (size_t)(row - NT) * D) + col0 + bj * 128; b0 = *(const f32x4*)bp; b1 = *(const f32x4*)(bp + 4); }
                    else { const v4u w = *(const v4u*)(XB + (size_t)row * D + col0 + bj * 128);
                        b0 = (f32x4){__uint_as_float(w.x << 16), __uint_as_float(w.x & 0xffff0000u), __uint_as_float(w.y << 16), __uint_as_float(w.y & 0xffff0000u)};
                        b1 = (f32x4){__uint_as_float(w.z << 16), __uint_as_float(w.z & 0xffff0000u), __uint_as_float(w.w << 16), __uint_as_float(w.w & 0xffff0000u)}; }
                    const f32x4 v0 = b0 + gv[bj][0] * acc[ai][bj][m][0], v1 = b1 + gv[bj][1] * acc[ai][bj][m][1];
                    v4u o; o.x = pg8::cvt_pk_bf16(v0[0], v0[1]); o.y = pg8::cvt_pk_bf16(v0[2], v0[3]); o.z = pg8::cvt_pk_bf16(v1[0], v1[1]); o.w = pg8::cvt_pk_bf16(v1[2], v1[3]);
                    *(v4u*)(XB + (size_t)row * D + col0 + bj * 128) = o; }
                asm volatile("" ::: "memory"); }
    }
};
template <int L>
__device__ __forceinline__ void p_outproj(const CAS Args& a, const Frame& F) {
    const int nc = L == 0 ? OUTP0_NC : 0;
    if (F.bid >= F.G - nc) { convert_experts(a, F, 0, 0, 2, (F.bid - (F.G - nc)) * NWAVES + F.wave, nc * NWAVES, CV_E0, CV_E1); return; }
    pg8::RectSched S{(const char*)(a.ws + (L == 0 ? WS_A2 : WS_A3)), (const char*)(a.ws + (L == 0 ? WS_WOUT0 : WS_WOUT1)), 2 * D, (L == 0 ? R : NT) / 256, D / 256, F.G - nc, F.bid, 0, 0, 0, 0};
    EpiOutProj<L> E{a.in[0], a.in[2], (bf16*)(a.ws + WS_XB), (const float*)(a.ws + WS_MOD) + (size_t)L * 17 * 6144};
    pg8::gemm_phase<2 * D, false>(F.ldsl, S, E, F.wave);
}
#define RS_STEP(half, m) do { const bool up = (F.lane & (m)) != 0; _Pragma("unroll") for (int i = 0; i < (half); ++i) { \
        const float keep = up ? part[i + (half)] : part[i]; const float send = up ? part[i] : part[i + (half)]; part[i] = keep + __shfl_xor(send, (m)); } } while (0)
constexpr int RT_WH = 0, RT_WL = 65536, RT_GS = 131072, RT_LG = 139264, RT_CNT = 155648;
__device__ __forceinline__ void p_norm2_router(const CAS Args& a, const Frame& F, int l) {
    unsigned char* H8 = (unsigned char*)(a.ws + WS_H); const bf16* XB = (const bf16*)(a.ws + WS_XB);
    unsigned* ctl = (unsigned*)(a.ws + WS_CTL);
    int* toklist = (int*)(a.ws + WS_TOKLIST); int* sel = (int*)(a.ws + WS_SEL); float* gatev = (float*)(a.ws + WS_GATEV);
    const float* wr = a.in[29] + (size_t)l * D * NE; const float* br = a.in[30] + l * NE;
    const float* GS2 = (const float*)(a.ws + WS_GS2) + (size_t)l * 17 * D; const float* MODl = (const float*)(a.ws + WS_MOD) + (size_t)l * 17 * 6144;
    const int rows = l == 0 ? R : NT, rpw = rows / F.G, row_lo = F.bid * rpw, nblk = rpw / 16;
    LAS unsigned char* lds = F.ldsl;
    const int lane = F.lane, wave = F.wave, rho = lane & 15, g = lane >> 4;
    const int b_first = row_batch(row_lo);
    __syncthreads();
    {
        f32x4 wv[16];
#pragma unroll
        for (int j = 0; j < 16; ++j) wv[j] = *(const f32x4*)(wr + 4 * (F.tid + 512 * j));
#pragma unroll
        for (int j = 0; j < 16; ++j) { const int i0 = 4 * (F.tid + 512 * j), k = i0 >> 5;
#pragma unroll
            for (int q = 0; q < 4; ++q) { const int e = (i0 & 31) + q; const float w = wv[j][q]; const bf16 hi = f2bf(w), lo = f2bf(w - bf2f(hi));
                const int off = e * 2048 + 16 * ((k >> 3) ^ (e & 15)) + 2 * (k & 7);
                *(LAS bf16*)(lds + RT_WH + off) = hi; *(LAS bf16*)(lds + RT_WL + off) = lo; } }
    }
    for (int i = F.tid; i < 2 * D; i += NWAVES * 64) { const int s = i >> 10, k = i & 1023; const int bb = s == 0 ? b_first : row_batch(row_lo + rpw - 1); ((LAS float*)(lds + RT_GS))[i] = GS2[bb * D + k]; }
    LAS unsigned* wcnt = (LAS unsigned*)(lds + RT_CNT); LAS unsigned* wbase = wcnt + 32; LAS unsigned* stmp = wcnt + 64;
    if (F.tid < NE) wcnt[F.tid] = 0u;
    __syncthreads();
    for (int blk = wave; blk < nblk; blk += NWAVES) {
        const int r0 = row_lo + 16 * blk, row = r0 + rho, bb = row_batch(r0);
        const bf16* xr = XB + (size_t)row * D + 8 * g;
        float ss = 0.f;
#pragma unroll
        for (int kh = 0; kh < 2; ++kh) {
            v4u xw[16];
#pragma unroll
            for (int ks = 0; ks < 16; ++ks) xw[ks] = *(const v4u*)(xr + 32 * (16 * kh + ks));
#pragma unroll
            for (int ks = 0; ks < 16; ++ks) { const unsigned u4[4] = {xw[ks].x, xw[ks].y, xw[ks].z, xw[ks].w};
#pragma unroll
                for (int q = 0; q < 4; ++q) { const float x0 = __uint_as_float(u4[q] << 16), x1 = __uint_as_float(u4[q] & 0xffff0000u); ss += x0 * x0 + x1 * x1; } }
            asm volatile("" ::: "memory");
        }
        ss += __shfl_xor(ss, 16); ss += __shfl_xor(ss, 32);
        const float rstd = rsqrtf(ss * (1.0f / D) + 1e-6f);
        const LAS float* gs = (const LAS float*)(lds + RT_GS) + (bb == b_first ? 0 : D) + 8 * g;
        const float* sh = MODl + (size_t)bb * 6144 + 3 * D + 8 * g;
        f32x4 acc[2] = {(f32x4){0.f, 0.f, 0.f, 0.f}, (f32x4){0.f, 0.f, 0.f, 0.f}};
        int offb[4];
#pragma unroll
        for (int b4 = 0; b4 < 4; ++b4) offb[b4] = rho * 2048 + (((4 * (b4 ^ ((rho >> 2) & 3))) + (g ^ (rho & 3))) << 4);
        for (int k4 = 0; k4 < 8; ++k4) {
            v4u xw[4]; f32x4 sv[4][2];
#pragma unroll
            for (int b4 = 0; b4 < 4; ++b4) { const int ks = 4 * k4 + b4; xw[b4] = *(const v4u*)(xr + 32 * ks); sv[b4][0] = *(const f32x4*)(sh + 32 * ks); sv[b4][1] = *(const f32x4*)(sh + 32 * ks + 4); }
#pragma unroll
            for (int b4 = 0; b4 < 4; ++b4) {
                const int ks = 4 * k4 + b4;
                const unsigned u4[4] = {xw[b4].x, xw[b4].y, xw[b4].z, xw[b4].w};
                const f32x4 g0 = *(const LAS f32x4*)(gs + 32 * ks), g1 = *(const LAS f32x4*)(gs + 32 * ks + 4);
                const f32x4 s0 = sv[b4][0], s1 = sv[b4][1];
                float hv[8];
#pragma unroll
                for (int q = 0; q < 4; ++q) { const float x0 = __uint_as_float(u4[q] << 16) * rstd, x1 = __uint_as_float(u4[q] & 0xffff0000u) * rstd;
                    const float gg0 = q < 2 ? g0[2 * q] : g1[2 * q - 4], gg1 = q < 2 ? g0[2 * q + 1] : g1[2 * q - 3], t0 = q < 2 ? s0[2 * q] : s1[2 * q - 4], t1 = q < 2 ? s0[2 * q + 1] : s1[2 * q - 3];
                    hv[2 * q] = x0 * gg0 + t0; hv[2 * q + 1] = x1 * gg1 + t1; }
                v4u hi, lo;
#pragma unroll
                for (int q = 0; q < 4; ++q) { const unsigned p = pk_bf16(hv[2 * q], hv[2 * q + 1]); ((unsigned*)&hi)[q] = p;
                    ((unsigned*)&lo)[q] = pk_bf16(hv[2 * q] - __uint_as_float(p << 16), hv[2 * q + 1] - __uint_as_float(p & 0xffff0000u)); }
                { uint2 f8; unsigned t0 = 0u, t1 = 0u; t0 = __builtin_amdgcn_cvt_pk_fp8_f32(hv[0], hv[1], t0, false); t0 = __builtin_amdgcn_cvt_pk_fp8_f32(hv[2], hv[3], t0, true);
                  t1 = __builtin_amdgcn_cvt_pk_fp8_f32(hv[4], hv[5], t1, false); t1 = __builtin_amdgcn_cvt_pk_fp8_f32(hv[6], hv[7], t1, true); f8.x = t0; f8.y = t1;
                  *(uint2*)(H8 + (size_t)row * D + 32 * ks + 8 * g) = f8; }
#pragma unroll
                for (int nt = 0; nt < 2; ++nt) { const int off = nt * 32768 + k4 * 256 + offb[b4];
                    const bf16x8 bh = *(const LAS bf16x8*)(lds + RT_WH + off), bl = *(const LAS bf16x8*)(lds + RT_WL + off);
                    acc[nt] = __builtin_amdgcn_mfma_f32_16x16x32_bf16(__builtin_bit_cast(bf16x8, hi), bh, acc[nt], 0, 0, 0);
                    acc[nt] = __builtin_amdgcn_mfma_f32_16x16x32_bf16(__builtin_bit_cast(bf16x8, lo), bh, acc[nt], 0, 0, 0);
                    acc[nt] = __builtin_amdgcn_mfma_f32_16x16x32_bf16(__builtin_bit_cast(bf16x8, hi), bl, acc[nt], 0, 0, 0); }
            }
        }
        LAS float* lg = (LAS float*)(lds + RT_LG + wave * 2048);
#pragma unroll
        for (int nt = 0; nt < 2; ++nt)
#pragma unroll
            for (int jj = 0; jj < 4; ++jj) lg[(4 * g + jj) * 32 + 16 * nt + rho] = acc[nt][jj] + br[16 * nt + rho];
        {
            float mine[8], allv[32];
#pragma unroll
            for (int q = 0; q < 8; ++q) { const f32x4 t = *(const LAS f32x4*)(lg + rho * 32 + 4 * q); allv[4 * q] = t[0]; allv[4 * q + 1] = t[1]; allv[4 * q + 2] = t[2]; allv[4 * q + 3] = t[3]; }
#pragma unroll
            for (int q = 0; q < 8; ++q) mine[q] = g == 0 ? allv[q] : g == 1 ? allv[8 + q] : g == 2 ? allv[16 + q] : allv[24 + q];
            LAS float* rs = lg;
#pragma unroll
            for (int q = 0; q < 8; ++q) { const int e = 8 * g + q; int rank = 0;
#pragma unroll
                for (int jx = 0; jx < 32; ++jx) rank += (allv[jx] > mine[q] || (allv[jx] == mine[q] && jx < e)) ? 1 : 0;
                if (rank < 4) { rs[(rho * 4 + rank) * 2] = mine[q]; ((LAS int*)rs)[(rho * 4 + rank) * 2 + 1] = e; } }
            if (lane < 16) {
                const f32x4 q0 = *(const LAS f32x4*)(rs + lane * 8), q1 = *(const LAS f32x4*)(rs + lane * 8 + 4);
                const float tv0 = q0[0], tv1 = q0[2], tv2 = q1[0], tv3 = q1[2]; const int ti[4] = {__float_as_int(q0[1]), __float_as_int(q0[3]), __float_as_int(q1[1]), __float_as_int(q1[3])};
                const float e1 = __expf(tv1 - tv0), e2 = __expf(tv2 - tv0), e3 = __expf(tv3 - tv0), inv = 1.0f / (1.0f + e1 + e2 + e3);
                const float gk[4] = {inv, e1 * inv, e2 * inv, e3 * inv};
                const int rl = 16 * blk + lane;
#pragma unroll
                for (int k = 0; k < 4; ++k) { const unsigned p = __hip_atomic_fetch_add(wcnt + ti[k], 1u, __ATOMIC_RELAXED, __HIP_MEMORY_SCOPE_WORKGROUP);
                    stmp[(rl * 4 + k) * 2] = (p << 5) | (unsigned)ti[k]; stmp[(rl * 4 + k) * 2 + 1] = __float_as_uint(gk[k]); }
            }
        }
    }
    __syncthreads();
    if (F.tid < NE) { const unsigned c = wcnt[F.tid]; wbase[F.tid] = c ? __hip_atomic_fetch_add(ctl + CW_CNT + (l * 32 + F.tid) * 64, c, RLX_AGENT) : 0u; }
    __syncthreads();
    for (int i = F.tid; i < rpw * 4; i += NWAVES * 64) { const int rl = i >> 2, k = i & 3, r = row_lo + rl; const unsigned pe = stmp[i * 2], e = pe & 31u, pos = wbase[e] + (pe >> 5);
        toklist[(size_t)e * CAP + pos] = r; sel[r * 4 + k] = (int)((pos << 5) | e); gatev[r * 4 + k] = __uint_as_float(stmp[i * 2 + 1]); }
}
struct MoeTab { int cnt[NE], base[NE + 1], tpre[NE + 1]; };
__device__ __forceinline__ void moe_tab_build(const CAS Args& a, const Frame& F, int l, LAS MoeTab* tb) {
    unsigned* ctl = (unsigned*)(a.ws + WS_CTL);
    __syncthreads();
    if (F.tid < NE) tb->cnt[F.tid] = (int)__hip_atomic_load(ctl + CW_CNT + (l * 32 + F.tid) * 64, RLX_AGENT);
    __syncthreads();
    if (F.tid == 0) { int bs = 0, tp = 0; for (int e = 0; e < NE; ++e) { const int c = tb->cnt[e]; tb->base[e] = bs; tb->tpre[e] = tp; bs += c; tp += (c + 255) >> 8; } tb->base[NE] = bs; tb->tpre[NE] = tp; }
    __syncthreads();
}
constexpr int MOE_UT_MAX = 64;
template <bool UP>
struct MoeSched {
    static constexpr bool GATHER = UP;
    const LAS MoeTab* tb; const LAS int* ut; const char* A; const char* WE; const int* toklist; int G, c;
    static constexpr int NN = UP ? 8 : 4;
    static __device__ __forceinline__ int rfl(int v) { return __builtin_amdgcn_readfirstlane(v); }
    static __device__ __forceinline__ const char* ufy(const char* p) { const unsigned long long v = (unsigned long long)p; const unsigned lo = __builtin_amdgcn_readfirstlane((unsigned)v), hi = __builtin_amdgcn_readfirstlane((unsigned)(v >> 32)); return (const char*)(((unsigned long long)hi << 32) | lo); }
    __device__ __forceinline__ bool unit_search(int i, int& pm, int& pn, int& e_, int& rows, int& base) const {
        const int nwg = tb->tpre[NE] * NN; const long L = (long)i * G + c; if (L >= nwg) return false;
        const int w = pg8::xcd_remap(L, nwg);
        int e = 0; while (e < NE - 1 && w >= tb->tpre[e + 1] * NN) ++e;
        const int tp0 = tb->tpre[e], tp1 = tb->tpre[e + 1];
        const int q = w - tp0 * NN, nte = tp1 - tp0;
        const int nig = 8 * NN, gid = q / nig, fm = gid * 8, gsz = (nte - fm) < 8 ? (nte - fm) : 8;
        pm = fm + ((q % nig) % gsz); pn = (q % nig) / gsz; e_ = e; rows = min(256, tb->cnt[e] - pm * 256); base = tb->base[e] + pm * 256;
        return true;
    }
    __device__ __forceinline__ void build(LAS int* utw, int tid) const {
        if (tid < MOE_UT_MAX) { int pm = -1, pn = 0, e = 0, rows = 0, base = 0; unit_search(tid, pm, pn, e, rows, base);
            utw[tid * 8 + 0] = pm; utw[tid * 8 + 1] = pn; utw[tid * 8 + 2] = e; utw[tid * 8 + 3] = rows; utw[tid * 8 + 4] = base; }
    }
    __device__ __forceinline__ bool unit(int i, pg8::Unit& u) const {
        if (i >= MOE_UT_MAX) return false;
        const LAS int* p = ut + i * 8; const int pm = rfl(p[0]); if (pm < 0) return false;
        u.pm = pm; u.pn = rfl(p[1]); u.e = rfl(p[2]); u.rows = rfl(p[3]); u.base = rfl(p[4]); u.newe = (i == 0) || (rfl(p[2 - 8]) != u.e);
        return true;
    }
    __device__ __forceinline__ bool bases(int i, const char*& a, const char*& b) const {
        pg8::Unit u; if (!unit(i, u)) return false;
        a = UP ? A : A + (size_t)u.base * D;
        b = WE + (size_t)u.e * 3072 * 1024 + (UP ? 0 : (size_t)2048 * 1024) + (size_t)u.pn * 256 * 1024;
        a = ufy(a); b = ufy(b);
        return true;
    }
    __device__ __forceinline__ void atoks(int i, const int (&rA)[2], int (&tok)[2][2]) const {
        pg8::Unit u; unit(i, u);
        const int* tl = toklist + (size_t)u.e * CAP + u.pm * 256;
#pragma unroll
        for (int h = 0; h < 2; ++h)
#pragma unroll
            for (int i2 = 0; i2 < 2; ++i2) { const int rr = h * 128 + rA[i2]; tok[h][i2] = tl[rr < u.rows ? rr : 0]; }
    }
    __device__ __forceinline__ void aoffs(int i, const int (&rA)[2], const unsigned (&voffA)[2], unsigned (&off)[2][2]) const {
        pg8::Unit u; unit(i, u);
        const int* tl = toklist + (size_t)u.e * CAP + u.pm * 256;
#pragma unroll
        for (int h = 0; h < 2; ++h)
#pragma unroll
            for (int i2 = 0; i2 < 2; ++i2) { const int rr = h * 128 + rA[i2]; const int tok = tl[rr < u.rows ? rr : 0]; off[h][i2] = (unsigned)tok * (unsigned)D + voffA[i2]; }
    }
};
struct EpiMoeUp {
    static constexpr bool PERM = true;
    bf16* ACT; const float* bgate; const float* bup; LAS float* btab;
    __device__ __forceinline__ void operator()(const f32x4 (&acc)[2][2][4][2], const pg8::Unit& u, int wr, int wc, int fr, int fq) const {
        const int col0 = u.pn * 128 + wc * 32 + 8 * fq, rl0 = wr * 64 + fr;
        if (u.newe) { const int tid = (wr * 4 + wc) * 64 + fr + 16 * fq;
            const f32x4 t = *(const f32x4*)((tid < 256 ? bgate : bup) + u.e * D + 4 * (tid & 255));
            *(LAS f32x4*)(btab + 4 * tid) = t;
            asm volatile("s_waitcnt lgkmcnt(0)" ::: "memory"); __builtin_amdgcn_s_barrier(); asm volatile("" ::: "memory"); }
        f32x2_t bg[2][2], bu[2][2];
#pragma unroll
        for (int n = 0; n < 2; ++n) { const f32x4 g4 = *(const LAS f32x4*)(btab + col0 + 4 * n), u4 = *(const LAS f32x4*)(btab + 1024 + col0 + 4 * n);
            bg[n][0] = (f32x2_t){g4[0], g4[1]}; bg[n][1] = (f32x2_t){g4[2], g4[3]};
            bu[n][0] = (f32x2_t){u4[0], u4[1]} * ACT8_SCALE + ACT8_SCALE; bu[n][1] = (f32x2_t){u4[2], u4[3]} * ACT8_SCALE + ACT8_SCALE; }
#pragma unroll
        for (int ai = 0; ai < 2; ++ai)
#pragma unroll
            for (int m = 0; m < 4; ++m) { const int rl = rl0 + ai * 128 + m * 16;
                f32x2_t o[2][2];
#pragma unroll
                for (int n = 0; n < 2; ++n)
#pragma unroll
                    for (int p = 0; p < 2; ++p) {
                        f32x2_t gg = (f32x2_t){acc[ai][0][m][n][2 * p], acc[ai][0][m][n][2 * p + 1]} * (1.0f / W8_SCALE) + bg[n][p];
                        gg.x = fminf(gg.x, 7.0f); gg.y = fminf(gg.y, 7.0f);
                        const f32x2_t tt = gg * (-1.702f * 1.44269504f);
                        f32x2_t dd; dd.x = __builtin_amdgcn_exp2f(tt.x); dd.y = __builtin_amdgcn_exp2f(tt.y); dd = dd + 1.0f;
                        f32x2_t rr; rr.x = __builtin_amdgcn_rcpf(dd.x); rr.y = __builtin_amdgcn_rcpf(dd.y);
                        f32x2_t uu = (f32x2_t){acc[ai][1][m][n][2 * p], acc[ai][1][m][n][2 * p + 1]} * (ACT8_SCALE / W8_SCALE) + bu[n][p];
                        uu.x = __builtin_amdgcn_fmed3f(uu.x, -6.0f * ACT8_SCALE, 8.0f * ACT8_SCALE); uu.y = __builtin_amdgcn_fmed3f(uu.y, -6.0f * ACT8_SCALE, 8.0f * ACT8_SCALE);
                        o[n][p] = (gg * rr) * uu;
                    }
                if (rl < u.rows) { uint2 w; unsigned w0 = 0u, w1 = 0u;
                    w0 = __builtin_amdgcn_cvt_pk_fp8_f32(o[0][0].x, o[0][0].y, w0, false); w0 = __builtin_amdgcn_cvt_pk_fp8_f32(o[0][1].x, o[0][1].y, w0, true);
                    w1 = __builtin_amdgcn_cvt_pk_fp8_f32(o[1][0].x, o[1][0].y, w1, false); w1 = __builtin_amdgcn_cvt_pk_fp8_f32(o[1][1].x, o[1][1].y, w1, true);
                    w.x = w0; w.y = w1;
                    *(uint2*)((unsigned char*)ACT + (size_t)(u.base + rl) * D + col0) = w; } }
    }
};
struct EpiMoeDown {
    static constexpr bool PERM = true;
    unsigned char* YB; const float* bdown; LAS float* btab;
    __device__ __forceinline__ void operator()(const f32x4 (&acc)[2][2][4][2], const pg8::Unit& u, int wr, int wc, int fr, int fq) const {
        const int col0 = u.pn * 256 + wc * 64 + 16 * fq, rl0 = wr * 64 + fr;
        if (u.newe) { const int tid = (wr * 4 + wc) * 64 + fr + 16 * fq;
            if (tid < 256) { const f32x4 t = *(const f32x4*)(bdown + u.e * D + 4 * tid); *(LAS f32x4*)(btab + 4 * tid) = t; }
            asm volatile("s_waitcnt lgkmcnt(0)" ::: "memory"); __builtin_amdgcn_s_barrier(); asm volatile("" ::: "memory"); }
        f32x4 bv[2][2];
#pragma unroll
        for (int bj = 0; bj < 2; ++bj)
#pragma unroll
            for (int n = 0; n < 2; ++n) bv[bj][n] = *(const LAS f32x4*)(btab + col0 + 8 * bj + 4 * n) * YB8_SCALE;
#pragma unroll
        for (int ai = 0; ai < 2; ++ai)
#pragma unroll
            for (int m = 0; m < 4; ++m) { const int rl = rl0 + ai * 128 + m * 16;
                if (rl < u.rows) { v4u w;
                    { const f32x4 v = acc[ai][0][m][0] * (YB8_SCALE / (W8_SCALE * ACT8_SCALE)) + bv[0][0]; w.x = pk4_fp8(v[0], v[1], v[2], v[3]); }
                    { const f32x4 v = acc[ai][0][m][1] * (YB8_SCALE / (W8_SCALE * ACT8_SCALE)) + bv[0][1]; w.y = pk4_fp8(v[0], v[1], v[2], v[3]); }
                    { const f32x4 v = acc[ai][1][m][0] * (YB8_SCALE / (W8_SCALE * ACT8_SCALE)) + bv[1][0]; w.z = pk4_fp8(v[0], v[1], v[2], v[3]); }
                    { const f32x4 v = acc[ai][1][m][1] * (YB8_SCALE / (W8_SCALE * ACT8_SCALE)) + bv[1][1]; w.w = pk4_fp8(v[0], v[1], v[2], v[3]); }
                    *(v4u*)(YB + (size_t)(u.base + rl) * D + col0) = w; } }
    }
};
constexpr int LDS_TAB = 131072;
__device__ __forceinline__ void p_moe_up(const CAS Args& a, const Frame& F, int l) {
    const int nc = l == 0 ? MOE_NC : 0;
    if (F.bid >= F.G - nc) { const int cw = (F.bid - (F.G - nc)) * NWAVES + F.wave; convert_experts(a, F, 0, 2, 3, cw, nc * NWAVES); convert_experts(a, F, 1, 0, 2, cw, nc * NWAVES, 0, CV_E3); return; }
    LAS MoeTab* tb = (LAS MoeTab*)(F.ldsl + LDS_TAB); moe_tab_build(a, F, l, tb);
    LAS int* utw = (LAS int*)(F.ldsl + LDS_TAB + 1024);
    MoeSched<true> S{tb, utw, (const char*)(a.ws + WS_H), (const char*)(a.ws + WS_WEXP) + (size_t)l * NE * 3072 * 1024, (const int*)(a.ws + WS_TOKLIST), F.G - nc, F.bid};
    S.build(utw, F.tid); __syncthreads();
    EpiMoeUp E{(bf16*)(a.ws + WS_ACT), a.in[32] + (size_t)l * NE * D, a.in[34] + (size_t)l * NE * D, (LAS float*)(F.ldsl + LDS_TAB + 4096)};
    pg8::gemm_phase<D, true>(F.ldsl, S, E, F.wave);
}
__device__ __forceinline__ void p_moe_down(const CAS Args& a, const Frame& F, int l) {
    const int nc = l == 0 ? MOE_NC : 0;
    if (F.bid >= F.G - nc) { const int cw = (F.bid - (F.G - nc)) * NWAVES + F.wave; convert_experts(a, F, 1, 2, 3, cw, nc * NWAVES); convert_experts(a, F, 1, 0, 2, cw, nc * NWAVES, CV_E3, CV_E2); return; }
    LAS MoeTab* tb = (LAS MoeTab*)(F.ldsl + LDS_TAB); moe_tab_build(a, F, l, tb);
    LAS int* utw = (LAS int*)(F.ldsl + LDS_TAB + 1024);
    MoeSched<false> S{tb, utw, (const char*)(a.ws + WS_ACT), (const char*)(a.ws + WS_WEXP) + (size_t)l * NE * 3072 * 1024, nullptr, F.G - nc, F.bid};
    S.build(utw, F.tid); __syncthreads();
    EpiMoeDown E{(unsigned char*)(a.ws + WS_YB), a.in[36] + (size_t)l * NE * D, (LAS float*)(F.ldsl + LDS_TAB + 4096)};
    pg8::gemm_phase<D, true>(F.ldsl, S, E, F.wave);
}
__device__ __forceinline__ void p_combine(const CAS Args& a, const Frame& F, int l) {
    const unsigned char* YB = (const unsigned char*)(a.ws + WS_YB); bf16* XB = (bf16*)(a.ws + WS_XB); bf16* H = (bf16*)(a.ws + WS_H);
    const int* sel = (const int*)(a.ws + WS_SEL); const float* gatev = (const float*)(a.ws + WS_GATEV);
    LAS MoeTab* tb = (LAS MoeTab*)(F.ldsl + LDS_TAB); moe_tab_build(a, F, l, tb);
    const int rows = l == 0 ? R : NT, lane = F.lane;
    for (int r = F.gw; r < rows; r += 2 * F.ngw) {
        v4u xw[2][2]; uint2 yw[2][4][2]; float gk[2][4];
#pragma unroll
        for (int t = 0; t < 2; ++t) { const int rr = r + t * F.ngw; if (rr < rows) {
#pragma unroll
            for (int jh = 0; jh < 2; ++jh) xw[t][jh] = *(const v4u*)(XB + (size_t)rr * D + 512 * jh + 8 * lane);
#pragma unroll
            for (int k = 0; k < 4; ++k) { const int sv = sel[rr * 4 + k]; gk[t][k] = gatev[rr * 4 + k]; const int e = sv & 31, pos = sv >> 5;
                const unsigned char* y = YB + (size_t)(tb->base[e] + pos) * D;
#pragma unroll
                for (int jh = 0; jh < 2; ++jh) yw[t][k][jh] = *(const uint2*)(y + 512 * jh + 8 * lane); } } }
#pragma unroll
        for (int t = 0; t < 2; ++t) { const int rr = r + t * F.ngw; if (rr < rows) {
            float m[16], v[16];
#pragma unroll
            for (int i = 0; i < 16; ++i) m[i] = 0.f;
#pragma unroll
            for (int k = 0; k < 4; ++k) { const float gg = gk[t][k] * (1.0f / YB8_SCALE);
#pragma unroll
                for (int jh = 0; jh < 2; ++jh) { const unsigned w2[2] = {yw[t][k][jh].x, yw[t][k][jh].y};
#pragma unroll
                    for (int q = 0; q < 2; ++q) { const f32x2_t lo = __builtin_amdgcn_cvt_pk_f32_fp8((int)w2[q], false), hi = __builtin_amdgcn_cvt_pk_f32_fp8((int)w2[q], true);
                        m[8 * jh + 4 * q] += gg * lo.x; m[8 * jh + 4 * q + 1] += gg * lo.y; m[8 * jh + 4 * q + 2] += gg * hi.x; m[8 * jh + 4 * q + 3] += gg * hi.y; } } }
#pragma unroll
            for (int jh = 0; jh < 2; ++jh) { const unsigned x4[4] = {xw[t][jh].x, xw[t][jh].y, xw[t][jh].z, xw[t][jh].w};
#pragma unroll
                for (int q = 0; q < 4; ++q) { v[8 * jh + 2 * q] = __uint_as_float(x4[q] << 16); v[8 * jh + 2 * q + 1] = __uint_as_float(x4[q] & 0xffff0000u); } }
            const float* g2 = mod_ptr(a, l, rr, 5);
#pragma unroll
            for (int jh = 0; jh < 2; ++jh)
#pragma unroll
                for (int q = 0; q < 2; ++q) { const f32x4 gg = *(const f32x4*)(g2 + 512 * jh + 8 * lane + 4 * q);
#pragma unroll
                    for (int c = 0; c < 4; ++c) v[8 * jh + 4 * q + c] += gg[c] * m[8 * jh + 4 * q + c]; }
            if (l == 0) {
#pragma unroll
                for (int jh = 0; jh < 2; ++jh) *(v4u*)(XB + (size_t)rr * D + 512 * jh + 8 * lane) = (v4u){pk_bf16(v[8 * jh], v[8 * jh + 1]), pk_bf16(v[8 * jh + 2], v[8 * jh + 3]), pk_bf16(v[8 * jh + 4], v[8 * jh + 5]), pk_bf16(v[8 * jh + 6], v[8 * jh + 7])};
                float s = 0.f;
#pragma unroll
                for (int i2 = 0; i2 < 16; ++i2) s += v[i2] * v[i2];
                const float rstd = rsqrtf(wave_sum(s) * (1.0f / D) + 1e-6f);
                const float* gp = a.in[6] + D; const float* shp = mod_ptr(a, 1, rr, 0); const float* scp = mod_ptr(a, 1, rr, 1);
#pragma unroll
                for (int jh = 0; jh < 2; ++jh) { float hv[8];
#pragma unroll
                    for (int q = 0; q < 2; ++q) { const int e0 = 512 * jh + 8 * lane + 4 * q; const f32x4 gg = *(const f32x4*)(gp + e0), ss = *(const f32x4*)(shp + e0), cc = *(const f32x4*)(scp + e0);
#pragma unroll
                        for (int c = 0; c < 4; ++c) hv[4 * q + c] = v[8 * jh + 4 * q + c] * rstd * gg[c] * (1.f + cc[c]) + ss[c]; }
                    *(v4u*)(H + (size_t)rr * D + 512 * jh + 8 * lane) = (v4u){pk_bf16(hv[0], hv[1]), pk_bf16(hv[2], hv[3]), pk_bf16(hv[4], hv[5]), pk_bf16(hv[6], hv[7])}; }
            } else {
#pragma unroll
                for (int jh = 0; jh < 2; ++jh)
#pragma unroll
                    for (int q = 0; q < 2; ++q) *(f32x4*)(a.out + (size_t)rr * D + 512 * jh + 8 * lane + 4 * q) = (f32x4){v[8 * jh + 4 * q], v[8 * jh + 4 * q + 1], v[8 * jh + 4 * q + 2], v[8 * jh + 4 * q + 3]};
            } } }
    }
}
struct EpiInProj1 {
    static constexpr bool PERM = true;
    bf16* Gt; bf16* U;
    __device__ __forceinline__ void operator()(const f32x4 (&acc)[2][2][4][2], const pg8::Unit& u, int wr, int wc, int fr, int fq) const {
        const int row0 = u.pm * 256 + wr * 64 + fr; const bool gate = u.pn < 4;
        bf16* dst = gate ? Gt : U; const int col0 = (u.pn & 3) * 256 + wc * 32 + 8 * fq;
#pragma unroll
        for (int ai = 0; ai < 2; ++ai)
#pragma unroll
            for (int m = 0; m < 4; ++m) { bf16* rowp = dst + (size_t)(row0 + ai * 128 + m * 16) * D + col0;
#pragma unroll
                for (int bj = 0; bj < 2; ++bj) { f32x4 v0 = acc[ai][bj][m][0], v1 = acc[ai][bj][m][1];
                    if (gate) {
#pragma unroll
                        for (int j = 0; j < 4; ++j) { const float x = v0[j]; v0[j] = x * __builtin_amdgcn_rcpf(1.0f + __expf(-1.5957691216f * (x + 0.044715f * x * x * x)));
                                                      const float y = v1[j]; v1[j] = y * __builtin_amdgcn_rcpf(1.0f + __expf(-1.5957691216f * (y + 0.044715f * y * y * y))); } }
                    v4u w; w.x = pg8::cvt_pk_bf16(v0[0], v0[1]); w.y = pg8::cvt_pk_bf16(v0[2], v0[3]); w.z = pg8::cvt_pk_bf16(v1[0], v1[1]); w.w = pg8::cvt_pk_bf16(v1[2], v1[3]);
                    *(v4u*)(rowp + bj * 128) = w; } }
    }
};
__device__ __forceinline__ void p_inproj1(const CAS Args& a, const Frame& F) {
    if (F.bid >= F.G - INP1_NC) { convert_experts(a, F, 1, 0, 2, (F.bid - (F.G - INP1_NC)) * NWAVES + F.wave, INP1_NC * NWAVES, CV_E2, NE); return; }
    pg8::RectSched S{(const char*)(a.ws + WS_H), (const char*)(a.ws + WS_WIN1), 2 * D, NT / 256, 8, F.G - INP1_NC, F.bid, NC / 256, 4, NT / 256, 4};
    EpiInProj1 E{(bf16*)(a.ws + WS_G), (bf16*)(a.ws + WS_U)};
    pg8::gemm_phase<2 * D, false>(F.ldsl, S, E, F.wave);
}
__device__ __forceinline__ void p_conv4(const CAS Args& a, const Frame& F) {
    const bf16* U = (const bf16*)(a.ws + WS_U); bf16* UC = (bf16*)(a.ws + WS_UC);
    for (int u = F.gw; u < (R / 8) * 2; u += F.ngw) {
        const int rb = u >> 1, ch0 = (u & 1) * 512 + 8 * F.lane, row0 = rb * 8;
        const bool lat = row0 < NT; const int t0 = lat ? (row0 & 2047) : ((row0 - NT) & 255), len = lat ? 2048 : 256;
        float cw[4][8], cbv[8];
#pragma unroll
        for (int q = 0; q < 8; ++q) { cbv[q] = a.in[18][ch0 + q];
#pragma unroll
            for (int k = 0; k < 4; ++k) cw[k][q] = a.in[17][k * D + ch0 + q]; }
        v4u uv[11];
#pragma unroll
        for (int k = 0; k < 11; ++k) { const int tt = t0 + k - 1; uv[k] = (tt >= 0 && tt < len) ? *(const v4u*)(U + (size_t)(row0 + k - 1) * D + ch0) : (v4u){0u, 0u, 0u, 0u}; }
#pragma unroll
        for (int i = 0; i < 8; ++i) {
            float acc[8];
#pragma unroll
            for (int q = 0; q < 8; ++q) acc[q] = cbv[q];
#pragma unroll
            for (int k = 0; k < 4; ++k) { const unsigned w[4] = {uv[i + k].x, uv[i + k].y, uv[i + k].z, uv[i + k].w};
#pragma unroll
                for (int q = 0; q < 4; ++q) { acc[2 * q] += cw[k][2 * q] * __uint_as_float(w[q] << 16); acc[2 * q + 1] += cw[k][2 * q + 1] * __uint_as_float(w[q] & 0xffff0000u); } }
            *(v4u*)(UC + (size_t)(row0 + i) * D + ch0) = (v4u){pk_bf16(acc[0], acc[1]), pk_bf16(acc[2], acc[3]), pk_bf16(acc[4], acc[5]), pk_bf16(acc[6], acc[7])};
        }
    }
}
constexpr int LR_A = 0, LR_SC = 65536, LR_AG = 131072, LR_CY = LR_AG + 8192;
__device__ __forceinline__ void p_lru(const CAS Args& a, const Frame& F) {
    const bf16* UC = (const bf16*)(a.ws + WS_UC); const bf16* WL = (const bf16*)(a.ws + WS_WLRU); const bf16* Gt = (const bf16*)(a.ws + WS_G);
    bf16* HF = (bf16*)(a.ws + WS_HF); bf16* A3 = (bf16*)(a.ws + WS_A3);
    LAS unsigned char* lds = F.ldsl;
    const int lane_ = F.lane, wave = F.wave, sub = wave & 3, th = wave >> 2;
    for (int wu = F.bid; wu < 256; wu += F.G) {
        const int b = wu >> 4, h = (wu >> 2) & 3, cg = wu & 3;
        for (int dir = 0; dir < 2; ++dir) {
            const int lane = lane_, rho = lane & 15, g = lane >> 4;
            bf16x8 bw[2][8];
#pragma unroll
            for (int n = 0; n < 2; ++n)
#pragma unroll
                for (int ks = 0; ks < 8; ++ks) bw[n][ks] = *(const bf16x8*)(WL + ((size_t)h * 1024 + (2 * dir + n) * 256 + cg * 64 + 16 * sub + rho) * 256 + 32 * ks + 8 * g);
            const int chc = h * 256 + cg * 64 + 16 * sub + rho;
            const float bav = (dir ? a.in[25] : a.in[20])[chc] * -1.44269504f, bxv = (dir ? a.in[27] : a.in[22])[chc] * -1.44269504f;
            const float lamv = (dir ? a.in[28] : a.in[23])[chc];
            const float L8 = -8.0f * log1pf(expf(-lamv)) * 1.44269504f;
            __syncthreads();
            if (wave == 0) ((LAS float*)(lds + LR_CY))[lane] = 0.f;
#define LR_GROW0(ck_) ((ck_) < 2 ? (size_t)(NT + b * 256 + 128 * (dir ? 1 - (ck_) : (ck_))) : (size_t)(b * 2048 + 128 * (dir ? 15 - ((ck_) - 2) : (ck_) - 2)))
#define LR_STAGE(ck_) do { const size_t g0_ = LR_GROW0(ck_); _Pragma("unroll") for (int p_ = 0; p_ < 8; ++p_) { const int pc_ = wave * 8 + p_, row_ = 2 * pc_ + (lane >> 5), c_ = (lane & 31) ^ (row_ & 15); \
                __builtin_amdgcn_global_load_lds((const unsigned*)((const char*)UC + (g0_ + row_) * (D * 2) + h * 512 + 16 * c_), (LAS unsigned*)(lds + LR_A + pc_ * 1024), 16, 0, 0); } } while (0)
            LR_STAGE(0);
            for (int ck = 0; ck < 18; ++ck) {
                const bool isctx = ck < 2;
                const size_t grow0 = LR_GROW0(ck);
                int lane = lane_; asm volatile("" : "+v"(lane)); const int rho = lane & 15, g = lane >> 4, chs = h * 256 + cg * 64 + lane, ucol = cg * 64 + 16 * sub + rho;
                asm volatile("s_waitcnt vmcnt(0)" ::: "memory");
                __syncthreads();
                const int row0 = dir ? 112 - 16 * wave : 16 * wave;
                v4u hfr[2] = {(v4u){0u, 0u, 0u, 0u}, (v4u){0u, 0u, 0u, 0u}}, gtr[2] = {(v4u){0u, 0u, 0u, 0u}, (v4u){0u, 0u, 0u, 0u}};
                if (dir && !isctx) {
#pragma unroll
                    for (int t = 0; t < 2; ++t) { const int tk = lane + 64 * t; const size_t gi = (grow0 + row0 + (tk >> 3)) * D + h * 256 + cg * 64 + 8 * (tk & 7);
                        hfr[t] = *(const v4u*)(HF + gi); gtr[t] = *(const v4u*)(Gt + gi); } }
                {
                    f32x4 acc[4][2];
#pragma unroll
                    for (int m = 0; m < 4; ++m)
#pragma unroll
                        for (int n = 0; n < 2; ++n) acc[m][n] = (f32x4){0.f, 0.f, 0.f, 0.f};
#pragma unroll
                    for (int ks = 0; ks < 8; ++ks)
#pragma unroll
                        for (int m = 0; m < 4; ++m) { const int rw = 64 * th + 16 * m + rho; const bf16x8 af = *(const LAS bf16x8*)(lds + LR_A + rw * 512 + (((4 * ks + g) ^ (rw & 15)) << 4));
#pragma unroll
                            for (int n = 0; n < 2; ++n) acc[m][n] = __builtin_amdgcn_mfma_f32_16x16x32_bf16(af, bw[n][ks], acc[m][n], 0, 0, 0);
                            if (m == 3 && (ks & 1)) asm volatile("" ::: "memory"); }
#pragma unroll
                    for (int m = 0; m < 4; ++m)
#pragma unroll
                        for (int p = 0; p < 2; ++p) {
                            const int row = 64 * th + 16 * m + 4 * g + 2 * p;
                            f32x2_t uc;
                            uc.x = bf2f(*(const LAS bf16*)(lds + LR_A + row * 512 + (((ucol >> 3) ^ (row & 15)) << 4) + 2 * (ucol & 7)));
                            uc.y = bf2f(*(const LAS bf16*)(lds + LR_A + (row + 1) * 512 + (((ucol >> 3) ^ ((row + 1) & 15)) << 4) + 2 * (ucol & 7)));
                            const f32x2_t xa = (f32x2_t){acc[m][0][2 * p], acc[m][0][2 * p + 1]} * -1.44269504f + bav, xx = (f32x2_t){acc[m][1][2 * p], acc[m][1][2 * p + 1]} * -1.44269504f + bxv;
                            f32x2_t da, dx; da.x = __builtin_amdgcn_exp2f(xa.x); da.y = __builtin_amdgcn_exp2f(xa.y); dx.x = __builtin_amdgcn_exp2f(xx.x); dx.y = __builtin_amdgcn_exp2f(xx.y);
                            da = da + 1.0f; dx = dx + 1.0f;
                            f32x2_t rr, ii; rr.x = __builtin_amdgcn_rcpf(da.x); rr.y = __builtin_amdgcn_rcpf(da.y); ii.x = __builtin_amdgcn_rcpf(dx.x); ii.y = __builtin_amdgcn_rcpf(dx.y);
                            const f32x2_t la = rr * L8;
                            f32x2_t av; av.x = __builtin_amdgcn_exp2f(la.x); av.y = __builtin_amdgcn_exp2f(la.y);
                            f32x2_t tt = 1.0f - av * av; tt.x = fmaxf(tt.x, 0.f); tt.y = fmaxf(tt.y, 0.f);
                            f32x2_t sq; sq.x = __builtin_amdgcn_sqrtf(tt.x); sq.y = __builtin_amdgcn_sqrtf(tt.y);
                            const f32x2_t bv = sq * ii * uc;
                            *(LAS f32x2_t*)(lds + LR_SC + (row * 64 + 16 * sub + rho) * 8) = (f32x2_t){av.x, bv.x};
                            *(LAS f32x2_t*)(lds + LR_SC + ((row + 1) * 64 + 16 * sub + rho) * 8) = (f32x2_t){av.y, bv.y};
                        }
                }
                __syncthreads();
                asm volatile("s_waitcnt vmcnt(0)" : "+v"(hfr[0]), "+v"(hfr[1]), "+v"(gtr[0]), "+v"(gtr[1]) :: "memory");
                if (ck + 1 < 18) LR_STAGE(ck + 1);
                f32x2_t ab[16];
                {
#pragma unroll
                    for (int q = 0; q < 16; ++q) { const int s = 16 * wave + q, row = dir ? 127 - s : s; ab[q] = *(const LAS f32x2_t*)(lds + LR_SC + (row * 64 + lane) * 8); }
                    float hl = 0.f, pr = 1.f;
#pragma unroll
                    for (int q = 0; q < 16; ++q) { hl = ab[q].x * hl + ab[q].y; pr *= ab[q].x; ab[q] = (f32x2_t){pr, hl}; }
                    *(LAS f32x2_t*)(lds + LR_AG + ((ck & 1) * 512 + wave * 64 + lane) * 8) = (f32x2_t){pr, hl};
                }
                asm volatile("s_waitcnt lgkmcnt(0)" ::: "memory"); __builtin_amdgcn_s_barrier(); asm volatile("" ::: "memory");
                {
                    float c = ((const LAS float*)(lds + LR_CY))[(ck & 1) * 64 + lane], cin = 0.f;
#pragma unroll
                    for (int w2 = 0; w2 < 8; ++w2) { if (w2 == wave) cin = c; const f32x2_t ag = *(const LAS f32x2_t*)(lds + LR_AG + ((ck & 1) * 512 + w2 * 64 + lane) * 8); c = ag.x * c + ag.y; }
                    if (wave == 0) ((LAS float*)(lds + LR_CY))[((ck + 1) & 1) * 64 + lane] = c;
                    if (!isctx) {
                        LAS unsigned char* scr = lds + LR_SC + row0 * 512;
                        if (dir) {
#pragma unroll
                            for (int t = 0; t < 2; ++t) { const int tk = lane + 64 * t; *(LAS v4u*)(scr + tk * 16) = hfr[t]; *(LAS v4u*)(scr + 2048 + tk * 16) = gtr[t]; }
                        }
#pragma unroll
                        for (int q = 0; q < 16; ++q) { const int tr = dir ? 15 - q : q;
                            float hv = ab[q].y + ab[q].x * cin;
                            if (dir) hv = (bf2f(*(const LAS bf16*)(scr + (tr * 64 + lane) * 2)) + hv) * bf2f(*(const LAS bf16*)(scr + 2048 + (tr * 64 + lane) * 2));
                            *(LAS bf16*)(scr + 4096 + (tr * 64 + lane) * 2) = f2bf(hv); }
                        bf16* dstp = dir ? A3 : HF;
#pragma unroll
                        for (int t = 0; t < 2; ++t) { const int tk = lane + 64 * t; const size_t gi = (grow0 + row0 + (tk >> 3)) * D + h * 256 + cg * 64 + 8 * (tk & 7);
                            *(v4u*)(dstp + gi) = *(const LAS v4u*)(scr + 4096 + tk * 16); }
                    }
                }
            }
#undef LR_STAGE
#undef LR_GROW0
        }
    }
}

constexpr int LDS_BYTES = 163840;
constexpr int NPHASE = 17;
template <unsigned KMASK>
__global__ void __launch_bounds__(NWAVES * 64, 2) fwd(Args kargs) {
    extern __shared__ __attribute__((aligned(16))) unsigned char lds[];
    const int wave_s = __builtin_amdgcn_readfirstlane((int)threadIdx.x >> 6);
    const int tid0 = wave_s * 64 + lane_id_fresh();
    volatile LAS unsigned* misc = (volatile LAS unsigned*)((LAS unsigned char*)lds + (LDS_BYTES - 64));
    if (tid0 < 16) misc[tid0] = 0u;
    __syncthreads();
    const int lo = kargs.ph_lo, hi = kargs.ph_hi;
    XcdBarrier bar; bar.bar = (unsigned*)(kargs.ws + WS_CTL) + CW_BAR + kargs.li * XCD_BAR_WORDS; bar.x = 0; bar.st = misc;
    if (hi - lo > 1) bar = xcd_barrier_post((unsigned*)(kargs.ws + WS_CTL) + CW_BAR + kargs.li * XCD_BAR_WORDS, misc, tid0);
#ifndef ONLY_PHASE
#define ONLY_PHASE -1
#endif
#ifndef PHASE_MASK
#define PHASE_MASK 0xFFFFFFFFu
#endif
#ifndef REPMASK
#define REPMASK 0u
#endif
#define PH(k, body) if constexpr (((KMASK >> (k)) & 1u) != 0u) if ((ONLY_PHASE < 0 || ONLY_PHASE == (k)) && ((PHASE_MASK >> (k)) & 1u) && lo <= (k) && (k) < hi) { \
        const CAS Args* ap_ = (const CAS Args*)__builtin_amdgcn_kernarg_segment_ptr(); asm volatile("" : "+s"(ap_)); const CAS Args& args = *ap_; \
        Frame F; F.lds = lds; F.ldsl = (LAS unsigned char*)lds; F.wave = wave_s; F.lane = lane_id_fresh(); \
        F.tid = F.wave * 64 + F.lane; F.G = gridDim.x; F.bid = blockIdx.x; F.gw = F.bid * NWAVES + F.wave; F.ngw = F.G * NWAVES; \
        if (((REPMASK >> (k)) & 1u) == 0u) { body; } else { int nrep_ = 2; asm volatile("" : "+s"(nrep_)); for (int rep_ = 0; rep_ < nrep_; ++rep_) { body; asm volatile("s_waitcnt vmcnt(0)" ::: "memory"); __syncthreads(); } } if ((k) + 1 < hi) xcd_barrier(bar, F.tid); else { asm volatile("s_waitcnt vmcnt(0)" ::: "memory"); __syncthreads(); } }
    PH(0, p0_prologue(args, F))
    PH(1, p_norm1_l0(args, F))
    PH(2, p_inproj0(args, F))
    PH(3, p_attn(args, F))
    PH(4, p_outproj<0>(args, F))
    PH(5, p_norm2_router(args, F, 0))
    PH(6, p_moe_up(args, F, 0))
    PH(7, p_moe_down(args, F, 0))
    PH(8, p_combine(args, F, 0))
    PH(9, p_inproj1(args, F))
    PH(10, p_conv4(args, F))
    PH(11, p_lru(args, F))
    PH(12, p_outproj<1>(args, F))
    PH(13, p_norm2_router(args, F, 1))
    PH(14, p_moe_up(args, F, 1))
    PH(15, p_moe_down(args, F, 1))
    PH(16, p_combine(args, F, 1))
#undef PH
}

constexpr unsigned MASK_A = (1u<<2)|(1u<<4)|(1u<<6)|(1u<<7)|(1u<<9)|(1u<<11)|(1u<<13)|(1u<<14), MASK_C = 1u << 3, MASK_D = 1u << 10, MASK_ALL = 0x1FFFFu, MASK_B = MASK_ALL & ~(MASK_A | MASK_C | MASK_D);
__host__ inline int kid_of(int p) { return ((MASK_A >> p) & 1u) ? 0 : ((MASK_C >> p) & 1u) ? 2 : ((MASK_D >> p) & 1u) ? 3 : 1; }
extern "C" void kernel_launch(void* const* d_in, const int* in_sizes, int n_in, void* d_out, int out_size, void* d_ws, size_t ws_size, hipStream_t stream) {
    static int grid = 0;
    if (grid == 0) {
        if (n_in != 37 || out_size != NT * D || ws_size < WS_END) { fprintf(stderr, "kernel_launch: unexpected shapes (n_in %d out %d ws %zu)\n", n_in, out_size, ws_size); grid = -1; return; }
        int dev = 0, cus = 0;
        if (hipGetDevice(&dev) != hipSuccess || hipDeviceGetAttribute(&cus, hipDeviceAttributeMultiprocessorCount, dev) != hipSuccess) { grid = -1; return; }
#ifndef MULTI_LAUNCH
        if (hipFuncSetAttribute((const void*)fwd<MASK_ALL>, hipFuncAttributeMaxDynamicSharedMemorySize, LDS_BYTES) != hipSuccess) { fprintf(stderr, "kernel_launch: hipFuncSetAttribute failed\n"); grid = -1; return; }
#else
        if (hipFuncSetAttribute((const void*)fwd<MASK_A>, hipFuncAttributeMaxDynamicSharedMemorySize, LDS_BYTES) != hipSuccess) { fprintf(stderr, "kernel_launch: hipFuncSetAttribute failed\n"); grid = -1; return; }
        if (hipFuncSetAttribute((const void*)fwd<MASK_B>, hipFuncAttributeMaxDynamicSharedMemorySize, LDS_BYTES) != hipSuccess) { fprintf(stderr, "kernel_launch: hipFuncSetAttribute failed\n"); grid = -1; return; }
        if (hipFuncSetAttribute((const void*)fwd<MASK_C>, hipFuncAttributeMaxDynamicSharedMemorySize, LDS_BYTES) != hipSuccess) { fprintf(stderr, "kernel_launch: hipFuncSetAttribute failed\n"); grid = -1; return; }
        if (hipFuncSetAttribute((const void*)fwd<MASK_D>, hipFuncAttributeMaxDynamicSharedMemorySize, LDS_BYTES) != hipSuccess) { fprintf(stderr, "kernel_launch: hipFuncSetAttribute failed\n"); grid = -1; return; }
#endif
        (void)hipGetLastError();
        grid = cus;
    }
    if (grid < 0) return;
    if (hipMemsetAsync((char*)d_ws + WS_CTL, 0, CTL_ZERO_BYTES, stream) != hipSuccess) return;
    Args a{};
    for (int i = 0; i < 37; ++i) a.in[i] = (const float*)d_in[i];
    a.out = (float*)d_out; a.ws = (unsigned char*)d_ws;
#ifdef MULTI_LAUNCH
    int p = 0, li = 0;
    while (p < NPHASE) {
        const int kid = kid_of(p); int q = p + 1;
        while (q < NPHASE && kid_of(q) == kid) ++q;
        a.ph_lo = p; a.ph_hi = q; a.li = li++;
        if (kid == 0) hipLaunchKernelGGL(fwd<MASK_A>, dim3(grid), dim3(NWAVES * 64), LDS_BYTES, stream, a);
        else if (kid == 1) hipLaunchKernelGGL(fwd<MASK_B>, dim3(grid), dim3(NWAVES * 64), LDS_BYTES, stream, a);
        else if (kid == 2) hipLaunchKernelGGL(fwd<MASK_C>, dim3(grid), dim3(NWAVES * 64), LDS_BYTES, stream, a);
        else hipLaunchKernelGGL(fwd<MASK_D>, dim3(grid), dim3(NWAVES * 64), LDS_BYTES, stream, a);
        p = q;
    }
#else
    a.ph_lo = 0; a.ph_hi = NPHASE; a.li = 0;
    hipLaunchKernelGGL(fwd<MASK_ALL>, dim3(grid), dim3(NWAVES * 64), LDS_BYTES, stream, a);
#endif
}
```

```cpp
#include <hip/hip_runtime.h>
#include <stdint.h>
#include <stdio.h>

constexpr int D = 1024, NB = 16, SEQ = 2048, NT = NB * SEQ, LC = 256, NC = NB * LC, R = NT + NC;
constexpr int NE = 32, CAP = R;
constexpr int NWAVES = 8;

typedef unsigned short bf16;
typedef short bf16x8 __attribute__((ext_vector_type(8)));
typedef float f32x4 __attribute__((ext_vector_type(4)));
typedef unsigned v4u __attribute__((ext_vector_type(4)));
#define LAS __attribute__((address_space(3)))
#define CAS __attribute__((address_space(4)))
#define RLX_AGENT __ATOMIC_RELAXED, __HIP_MEMORY_SCOPE_AGENT

constexpr size_t MiB = 1u << 20;
constexpr size_t WS_CTL = 0, CTL_ZERO_BYTES = 1 * MiB;
constexpr size_t WS_MOD = 1 * MiB;
constexpr size_t WS_WIN0 = 2 * MiB, WS_WOUT0 = 8 * MiB, WS_WIN1 = 10 * MiB, WS_WOUT1 = 14 * MiB, WS_WLRU = 16 * MiB;
constexpr size_t WS_TOKLIST = 18 * MiB;
constexpr size_t WS_SEL = 23 * MiB;
constexpr size_t WS_GATEV = 24 * MiB;
constexpr size_t WS_XC = 25 * MiB;
constexpr size_t WS_WEXP = 41 * MiB;
constexpr size_t WS_H = 233 * MiB;
constexpr size_t WS_P = 305 * MiB;
constexpr int PP = 2560;
constexpr size_t WS_A2 = 521 * MiB;
constexpr size_t WS_ACT = 593 * MiB;
constexpr size_t WS_YB = 305 * MiB;
constexpr size_t WS_G = 305 * MiB;
constexpr size_t WS_U = 369 * MiB;
constexpr size_t WS_UC = 441 * MiB;
constexpr size_t WS_AF = 513 * MiB;
constexpr size_t WS_AB = 657 * MiB;
constexpr size_t WS_HF = WS_AF;
constexpr size_t WS_A3 = WS_AB;
constexpr size_t WS_BF = 801 * MiB;
constexpr size_t WS_BB = 873 * MiB;
constexpr size_t WS_GS2 = 840 * MiB;
constexpr size_t WS_XB = 760 * MiB;
constexpr size_t WS_END = 945 * MiB;
constexpr int CW_BAR = 4096;
constexpr int CW_CNT = 65536;

__device__ __forceinline__ float bf2f(bf16 v) { return __uint_as_float(((unsigned)v) << 16); }
__device__ __forceinline__ bf16 f2bf(float f) { unsigned u = __float_as_uint(f); return (bf16)((u + 0x7fffu + ((u >> 16) & 1u)) >> 16); }
__device__ __forceinline__ unsigned pk2(float lo, float hi) { return (unsigned)f2bf(lo) | ((unsigned)f2bf(hi) << 16); }
__device__ __forceinline__ int lane_id_fresh() { int l; asm volatile("v_mbcnt_lo_u32_b32 %0, -1, 0\n\tv_mbcnt_hi_u32_b32 %0, -1, %0" : "=v"(l)); return l; }
__device__ __forceinline__ unsigned pk4_fp8(float a, float b, float c, float d) {
    a = fminf(fmaxf(a, -448.f), 448.f); b = fminf(fmaxf(b, -448.f), 448.f); c = fminf(fmaxf(c, -448.f), 448.f); d = fminf(fmaxf(d, -448.f), 448.f);
    unsigned w = 0u; w = __builtin_amdgcn_cvt_pk_fp8_f32(a, b, w, false); w = __builtin_amdgcn_cvt_pk_fp8_f32(c, d, w, true); return w;
}
constexpr float W8_SCALE = 32.0f, ACT8_SCALE = 4.0f, YB8_SCALE = 16.0f;
__device__ __forceinline__ float wave_sum(float v) {
#pragma unroll
    for (int o = 1; o < 64; o <<= 1) v += __shfl_xor(v, o);
    return v;
}
__device__ __forceinline__ float wave_max(float v) {
#pragma unroll
    for (int o = 1; o < 64; o <<= 1) v = fmaxf(v, __shfl_xor(v, o));
    return v;
}
__device__ __forceinline__ float sigmoidf_(float x) { return 1.0f / (1.0f + __expf(-x)); }
__device__ __forceinline__ float gelu_tanh(float x) { return 0.5f * x * (1.0f + tanhf(0.7978845608028654f * (x + 0.044715f * x * x * x))); }

#define XB_TMO      128
#define XB_XCNT(j)  (256  + 64 * (j))
#define XB_XSUB(j)  (1280 + 64 * (j))
#define XB_XGEN(j)  (2304 + 64 * (j))
#define XB_TOP      3328
#define XB_TOPGEN   3392
#define XCD_BAR_WORDS 3456
#define XB_SPIN_CAP (1u << 18)
__device__ __forceinline__ unsigned xb_ld(unsigned* p)              { return __hip_atomic_load(p, __ATOMIC_RELAXED, __HIP_MEMORY_SCOPE_AGENT); }
__device__ __forceinline__ unsigned xb_add(unsigned* p, unsigned v) { return __hip_atomic_fetch_add(p, v, __ATOMIC_RELAXED, __HIP_MEMORY_SCOPE_AGENT); }
__device__ __forceinline__ unsigned xb_xcc_id() { return (unsigned)__builtin_amdgcn_s_getreg((3 << 11) | 20) & 0xFu; }
#define XB_SPIN(cond, bar) do { unsigned _sp = 0; while (cond) { __builtin_amdgcn_s_sleep(1); \
    if ((++_sp & 255u) == 0u) { if (xb_ld(&(bar)[XB_TMO])) break; if (_sp > XB_SPIN_CAP) { atomicAdd(&(bar)[XB_TMO], 1u); break; } } } } while (0)
struct XcdBarrier { unsigned* bar; unsigned x; volatile LAS unsigned* st; };
__device__ __forceinline__ XcdBarrier xcd_barrier_post(unsigned* bar, volatile LAS unsigned* st, int tid) {
    XcdBarrier b; b.bar = bar; b.x = xb_xcc_id(); b.st = st;
    if (tid == 0) (void)xb_add(&bar[XB_XCNT(b.x)], 1u);
    return b;
}
__device__ __forceinline__ void xcd_barrier_complete(unsigned* bar, unsigned x, unsigned& nloc, unsigned& nx) {
    const unsigned G = gridDim.x * gridDim.y * gridDim.z;
    unsigned sum, cnt, mine, sp = 0u;
    for (;;) {
        sum = 0u; cnt = 0u; mine = 0u;
#pragma unroll
        for (unsigned j = 0; j < 16; ++j) { const unsigned c = xb_ld(&bar[XB_XCNT(j)]); sum += c; cnt += (c > 0u) ? 1u : 0u; mine = (j == x) ? c : mine; }
        if (sum == G) break;
        __builtin_amdgcn_s_sleep(1);
        if ((++sp & 255u) == 0u) { if (xb_ld(&bar[XB_TMO])) break; if (sp > XB_SPIN_CAP) { atomicAdd(&bar[XB_TMO], 1u); break; } }
    }
    nloc = mine > 0u ? mine : 1u; nx = cnt > 0u ? cnt : 1u;
}
__device__ __forceinline__ void xcd_barrier(const XcdBarrier& b, int tid) {
    asm volatile("s_waitcnt vmcnt(0)" ::: "memory");
    __syncthreads();
    if (tid == 0) {
        unsigned* bar = b.bar;
        __builtin_amdgcn_s_waitcnt(0);
        unsigned nloc = b.st[0], nx = b.st[1];
        if (nloc == 0u) { xcd_barrier_complete(bar, b.x, nloc, nx); b.st[0] = nloc; b.st[1] = nx; }
        const unsigned old = xb_add(&bar[XB_XSUB(b.x)], 1u);
        const unsigned gen = old / nloc;
        if (old + 1u == (gen + 1u) * nloc) {
            __builtin_amdgcn_fence(__ATOMIC_RELEASE, "agent");
            asm volatile("s_waitcnt vmcnt(0)" ::: "memory");
            const unsigned og = xb_add(&bar[XB_TOP], 1u);
            const unsigned tg = og / nx;
            if (og + 1u == (tg + 1u) * nx) xb_add(&bar[XB_TOPGEN], 1u);
            else XB_SPIN(xb_ld(&bar[XB_TOPGEN]) == tg, bar);
            __builtin_amdgcn_fence(__ATOMIC_ACQUIRE, "agent");
            xb_add(&bar[XB_XGEN(b.x)], 1u);
            asm volatile("s_waitcnt vmcnt(0)" ::: "memory");
        } else {
            XB_SPIN(xb_ld(&bar[XB_XGEN(b.x)]) == gen, bar);
            __builtin_amdgcn_fence(__ATOMIC_ACQUIRE, "agent");
            asm volatile("s_waitcnt vmcnt(0)" ::: "memory");
        }
    }
    __syncthreads();
}

struct Args { const float* in[37]; float* out; unsigned char* ws; int ph_lo, ph_hi, li, pad; };
struct Frame {
    unsigned char* lds;
    LAS unsigned char* ldsl;
    int tid, lane, wave, gw, ngw, G, bid;
};

template <int NS, class FA, class FB, class FS>
__device__ __forceinline__ void tile_gemm32(int K, FA arow, FB brow, FS store, int lane) {
    const int lr = lane & 15, lq = lane >> 4;
    const bf16* ap[2]; const bf16* bp[NS][2];
#pragma unroll
    for (int i = 0; i < 2; ++i) ap[i] = arow(16 * i + lr) + 8 * lq;
#pragma unroll
    for (int s = 0; s < NS; ++s)
#pragma unroll
        for (int j = 0; j < 2; ++j) bp[s][j] = brow(s, 16 * j + lr) + 8 * lq;
    f32x4 acc[NS][2][2];
#pragma unroll
    for (int s = 0; s < NS; ++s)
#pragma unroll
        for (int i = 0; i < 2; ++i)
#pragma unroll
            for (int j = 0; j < 2; ++j) acc[s][i][j] = (f32x4){0.f, 0.f, 0.f, 0.f};
#pragma nounroll
    for (int k0 = 0; k0 < K; k0 += 32) {
        bf16x8 a[2], b[NS][2];
#pragma unroll
        for (int i = 0; i < 2; ++i) a[i] = *(const bf16x8*)(ap[i] + k0);
#pragma unroll
        for (int s = 0; s < NS; ++s)
#pragma unroll
            for (int j = 0; j < 2; ++j) b[s][j] = *(const bf16x8*)(bp[s][j] + k0);
#pragma unroll
        for (int s = 0; s < NS; ++s)
#pragma unroll
            for (int i = 0; i < 2; ++i)
#pragma unroll
                for (int j = 0; j < 2; ++j) acc[s][i][j] = __builtin_amdgcn_mfma_f32_16x16x32_bf16(a[i], b[s][j], acc[s][i][j], 0, 0, 0);
    }
#pragma unroll
    for (int i = 0; i < 2; ++i)
#pragma unroll
        for (int j = 0; j < 2; ++j)
#pragma unroll
            for (int q = 0; q < 4; ++q) {
                float v[NS];
#pragma unroll
                for (int s = 0; s < NS; ++s) v[s] = acc[s][i][j][q];
                store(16 * i + 4 * lq + q, 16 * j + lr, v);
            }
}


namespace pg8 {
constexpr int BM = 256, BK = 64, HALF = 128, HTB = HALF * BK * 2, STAGE_BYTES = 8 * HTB;
__device__ __forceinline__ int lds_byte(int r, int c) { const int st = (r >> 4) * 2 + (c >> 5), rr = r & 15, cc = c & 31, ob = rr * 64 + cc * 2; return st * 1024 + (ob ^ (((ob >> 9) & 1) << 5)); }
__device__ __forceinline__ void stage_rc(int b, int& R_, int& C_) { const int st = b / 1024, sb = b % 1024, swz = sb ^ (((sb >> 9) & 1) << 5); R_ = (st >> 1) * 16 + swz / 64; C_ = (st & 1) * 32 + (swz % 64) / 2; }
__device__ __forceinline__ int perm32(int rho) { const int n = rho >> 4, i = rho & 15; return 8 * (i >> 2) + 4 * n + (i & 3); }
struct Unit { int pm, pn, e, rows, base, newe; };
typedef int v8i __attribute__((ext_vector_type(8)));
typedef int v4i __attribute__((ext_vector_type(4)));
__device__ __forceinline__ void mfma8(f32x4& acc, v8i a, v8i b, unsigned sc) {
    asm volatile("v_mfma_scale_f32_16x16x128_f8f6f4 %0, %1, %2, %0, %3, %3 op_sel_hi:[0,0,0]" : "+v"(acc) : "v"(a), "v"(b), "v"(sc));
}
__device__ __forceinline__ v8i cat8(bf16x8 a, bf16x8 b) { return __builtin_shufflevector(__builtin_bit_cast(v4i, a), __builtin_bit_cast(v4i, b), 0, 1, 2, 3, 4, 5, 6, 7); }
__device__ __forceinline__ unsigned cvt_pk_bf16(float lo, float hi) { unsigned r; asm volatile("v_cvt_pk_bf16_f32 %0, %1, %2" : "=v"(r) : "v"(lo), "v"(hi)); return r; }

template <int RB  , bool FP8, class Epi, class Sched>
__device__ __forceinline__ void gemm_phase(LAS unsigned char* lds, const Sched& S, const Epi& E, const int wave_id) {
    const int tid_ = wave_id * 64 + lane_id_fresh();
    const int tid = tid_, wid = wave_id, lane = tid & 63, wr = wid >> 2, wc = wid & 3, fr = lane & 15, fq = lane >> 4;
    constexpr int nt = RB / 128;
    unsigned voffA[2], voffB[2]; int rA[2];
#pragma unroll
    for (int i = 0; i < 2; ++i) { int R_, C_; stage_rc(tid * 16 + i * 8192, R_, C_); const int Rb = Epi::PERM ? ((R_ & ~31) + perm32(R_ & 31)) : R_;
        voffA[i] = Sched::GATHER ? (unsigned)C_ * 2u : (unsigned)(R_ * RB + C_ * 2); rA[i] = R_; voffB[i] = (unsigned)(Rb * RB + C_ * 2); }
    constexpr size_t kstep = (size_t)(BK * 2);
    constexpr size_t hstep = (size_t)HALF * RB;
    const unsigned ldsw = (unsigned)wid * 1024u;
    const int aoff = lds_byte(wr * 64 + fr, fq * 8), boff = lds_byte(wc * 32 + fr, fq * 8);
#define PG8_SA(b, h) (((b) * 2 + (h)) * HTB)
#define PG8_SB(b, h) ((4 + (b) * 2 + (h)) * HTB)
#define PG8_STAGE(bufoff, gbase, voff) do { _Pragma("unroll") for (int _i = 0; _i < 2; ++_i) \
        __builtin_amdgcn_global_load_lds((const unsigned*)((const char*)(gbase) + (voff)[_i]), (LAS unsigned*)(lds + (bufoff) + ldsw + _i * 8192), 16, 0, 0); } while (0)
#define PG8_STAGE_A(bufoff, ubase, uoff, h) do { if constexpr (Sched::GATHER) PG8_STAGE(bufoff, ubase, (uoff)[h]); else PG8_STAGE(bufoff, (ubase) + (h) * hstep, voffA); } while (0)
#define PG8_LDA(dst, b, h) do { _Pragma("unroll") for (int m = 0; m < 4; ++m) _Pragma("unroll") for (int k = 0; k < 2; ++k) dst[m][k] = *(const LAS bf16x8*)(lds + PG8_SA(b, h) + aoff + m * 2048 + k * 1024); } while (0)
#define PG8_LDB(dst, b, h) do { _Pragma("unroll") for (int n = 0; n < 2; ++n) _Pragma("unroll") for (int k = 0; k < 2; ++k) dst[n][k] = *(const LAS bf16x8*)(lds + PG8_SB(b, h) + boff + n * 2048 + k * 1024); } while (0)
#define PG8_MMA(ai, bj, At, Bt) do { __builtin_amdgcn_s_setprio(1); _Pragma("unroll") for (int m = 0; m < 4; ++m) _Pragma("unroll") for (int n = 0; n < 2; ++n) { \
        if constexpr (FP8) mfma8(acc[ai][bj][m][n], cat8(Bt[n][0], Bt[n][1]), cat8(At[m][0], At[m][1]), sc1); \
        else { _Pragma("unroll") for (int k = 0; k < 2; ++k) acc[ai][bj][m][n] = __builtin_amdgcn_mfma_f32_16x16x32_bf16(Bt[n][k], At[m][k], acc[ai][bj][m][n], 0, 0, 0); } } __builtin_amdgcn_s_setprio(0); } while (0)
#define PG8_WAIT_V(n) asm volatile("s_waitcnt vmcnt(" #n ")" ::: "memory")
#define PG8_WAIT_L(n) asm volatile("s_waitcnt lgkmcnt(" #n ")" ::: "memory")
#define PG8_BAR __builtin_amdgcn_s_barrier()
#define PG8_SCHED __builtin_amdgcn_sched_barrier(0)
#define PG8_KBODY(a1, a2, b2, off2) do { const char* _a1 = (a1); const char* _a2 = (a2); const char* _b2 = (b2); const char* _a3 = _a2 + kstep; const char* _b3 = _b2 + kstep; \
            asm volatile("" : "+s"(_a1), "+s"(_a2), "+s"(_b2), "+s"(_a3), "+s"(_b3));   \
            PG8_LDB(B0, 0, 0); PG8_LDB(B1, 0, 1); PG8_SCHED; PG8_LDA(At, 0, 0); PG8_STAGE_A(PG8_SA(1, 1), _a1, coff, 1); \
            PG8_WAIT_V(8); PG8_WAIT_L(0); PG8_BAR; PG8_MMA(0, 0, At, B0); PG8_MMA(0, 1, At, B1); PG8_BAR; PG8_SCHED; \
            PG8_LDA(At, 0, 1); PG8_STAGE(PG8_SB(0, 0), _b2, voffB); PG8_STAGE(PG8_SB(0, 1), _b2 + hstep, voffB); PG8_STAGE_A(PG8_SA(0, 0), _a2, off2, 0); \
            PG8_WAIT_V(8); PG8_WAIT_L(0); PG8_BAR; PG8_MMA(1, 0, At, B0); PG8_MMA(1, 1, At, B1); PG8_BAR; PG8_SCHED; \
            PG8_LDB(B0, 1, 0); PG8_LDB(B1, 1, 1); PG8_SCHED; PG8_LDA(At, 1, 0); PG8_STAGE_A(PG8_SA(0, 1), _a2, off2, 1); \
            PG8_WAIT_V(8); PG8_WAIT_L(0); PG8_BAR; PG8_MMA(0, 0, At, B0); PG8_MMA(0, 1, At, B1); PG8_BAR; PG8_SCHED; \
            PG8_LDA(At, 1, 1); PG8_STAGE(PG8_SB(1, 0), _b3, voffB); PG8_STAGE(PG8_SB(1, 1), _b3 + hstep, voffB); PG8_STAGE_A(PG8_SA(1, 0), _a3, off2, 0); \
            PG8_WAIT_V(8); PG8_WAIT_L(0); PG8_BAR; PG8_MMA(1, 0, At, B0); PG8_MMA(1, 1, At, B1); PG8_BAR; PG8_SCHED; } while (0)
    int ui = 0;
    const char* cA; const char* cB;
    if (!S.bases(0, cA, cB)) return;
    f32x4 acc[2][2][4][2];
#pragma unroll
    for (int a = 0; a < 2; ++a)
#pragma unroll
        for (int b = 0; b < 2; ++b)
#pragma unroll
            for (int m = 0; m < 4; ++m)
#pragma unroll
                for (int n = 0; n < 2; ++n) acc[a][b][m][n] = (f32x4){0.f, 0.f, 0.f, 0.f};
    bf16x8 At[4][2], B0[2][2], B1[2][2];
    unsigned sc1 = 0x7f7f7f7fu; asm volatile("" : "+v"(sc1));
    unsigned coff[2][2], noff[2][2];
    if constexpr (Sched::GATHER) S.aoffs(0, rA, voffA, coff);
    PG8_STAGE(PG8_SB(0, 0), cB, voffB); PG8_STAGE(PG8_SB(0, 1), cB + hstep, voffB); PG8_STAGE_A(PG8_SA(0, 0), cA, coff, 0); PG8_STAGE_A(PG8_SA(0, 1), cA, coff, 1);
    if (wr == 1) PG8_BAR;
    PG8_WAIT_V(2); PG8_BAR;
    PG8_STAGE(PG8_SB(1, 0), cB + kstep, voffB); PG8_STAGE_A(PG8_SA(1, 0), cA + kstep, coff, 0); PG8_STAGE(PG8_SB(1, 1), cB + hstep + kstep, voffB);
    PG8_WAIT_V(6); PG8_BAR;
    for (;;) {
        const char* nA; const char* nB;
        const bool has_next = S.bases(ui + 1, nA, nB);
        if (!has_next) { nA = cA; nB = cB; }
        int ntok[2][2];
        if constexpr (Sched::GATHER) { if (has_next) S.atoks(ui + 1, rA, ntok); }
#pragma nounroll
        for (int t = 0; t < nt - 2; t += 2) PG8_KBODY(cA + (size_t)(t + 1) * kstep, cA + (size_t)(t + 2) * kstep, cB + (size_t)(t + 2) * kstep, coff);
        if constexpr (Sched::GATHER) {
            if (has_next) { asm volatile("" : "+v"(ntok[0][0]), "+v"(ntok[0][1]), "+v"(ntok[1][0]), "+v"(ntok[1][1]));
#pragma unroll
                for (int h = 0; h < 2; ++h)
#pragma unroll
                    for (int i = 0; i < 2; ++i) noff[h][i] = (unsigned)ntok[h][i] * (unsigned)RB + voffA[i]; }
            else {
#pragma unroll
                for (int h = 0; h < 2; ++h)
#pragma unroll
                    for (int i = 0; i < 2; ++i) noff[h][i] = coff[h][i]; }
        }
        PG8_KBODY(cA + (size_t)(nt - 1) * kstep, nA, nB, noff);
        if (wr == 0) PG8_BAR;
        if constexpr (FP8) asm volatile("s_nop 15\n\ts_nop 3" ::: "memory");
        {
            const int t2 = lane_id_fresh();
            const int w2 = wave_id, l2 = t2 & 63;
            Unit cur; S.unit(ui, cur); E(acc, cur, w2 >> 2, w2 & 3, l2 & 15, l2 >> 4); }
        if (!has_next) break;
#pragma unroll
        for (int a = 0; a < 2; ++a)
#pragma unroll
            for (int b = 0; b < 2; ++b)
#pragma unroll
                for (int m = 0; m < 4; ++m)
#pragma unroll
                    for (int n = 0; n < 2; ++n) acc[a][b][m][n] = (f32x4){0.f, 0.f, 0.f, 0.f};
        cA = nA; cB = nB; ++ui;
        if constexpr (Sched::GATHER) {
#pragma unroll
            for (int h = 0; h < 2; ++h)
#pragma unroll
                for (int i = 0; i < 2; ++i) coff[h][i] = noff[h][i]; }
        if (wr == 1) PG8_BAR;
    }
    PG8_WAIT_V(0);
    PG8_BAR;
#undef PG8_SA
#undef PG8_SB
#undef PG8_STAGE
#undef PG8_STAGE_A
#undef PG8_KBODY
#undef PG8_LDA
#undef PG8_LDB
#undef PG8_MMA
#undef PG8_WAIT_V
#undef PG8_WAIT_L
#undef PG8_BAR
#undef PG8_SCHED
}
__device__ __forceinline__ int xcd_remap(long L, int nwg) { const int q = nwg / 8, r = nwg % 8, xcd = (int)(L % 8), off = (int)(L / 8); return (xcd < r ? xcd * (q + 1) : r * (q + 1) + (xcd - r) * q) + off; }
struct RectSched {
    static constexpr bool GATHER = false;
    const char* A; const char* B; int RB, nM, nN, G, c, nM2, nN2, pm2, pn2;
    __device__ __forceinline__ bool unit(int i, Unit& u) const {
        const int n1 = nM * nN, nwg = n1 + nM2 * nN2; const long L = (long)i * G + c; if (L >= nwg) return false;
        int w = xcd_remap(L, nwg); int rm = nM, rn = nN, pm0 = 0, pn0 = 0;
        if (w >= n1) { w -= n1; rm = nM2; rn = nN2; pm0 = pm2; pn0 = pn2; }
        const int nig = 8 * rn, gid = w / nig, fm = gid * 8, gsz = (rm - fm) < 8 ? (rm - fm) : 8;
        u.pm = pm0 + fm + ((w % nig) % gsz); u.pn = pn0 + (w % nig) / gsz; u.e = 0; u.rows = 256; u.base = u.pm * 256; u.newe = 0;
        return true;
    }
    __device__ __forceinline__ bool bases(int i, const char*& a, const char*& b) const {
        Unit u; if (!unit(i, u)) return false;
        a = A + (size_t)u.pm * 256 * RB; b = B + (size_t)u.pn * 256 * RB; return true;
    }
    __device__ __forceinline__ void aoffs(int, const int (&)[2], const unsigned (&)[2], unsigned (&)[2][2]) const {}
    __device__ __forceinline__ void atoks(int, const int (&)[2], int (&)[2][2]) const {}
};
}

template <class MapF>
__device__ __forceinline__ void transpose_item(const float* W, int K, int N, bf16* WT, MapF rowmap, float* scr, int item, int lane) {
    const int nblk = N / 32, kb = item / nblk, nb = item % nblk, k0 = 64 * kb, n0 = 32 * nb;
#pragma unroll 8
    for (int i = 0; i < 32; ++i) { const int kk = 2 * i + (lane >> 5); scr[kk * 33 + (lane & 31)] = W[(size_t)(k0 + kk) * N + n0 + (lane & 31)]; }
    asm volatile("s_waitcnt lgkmcnt(0)" ::: "memory");
    const int c = lane & 7;
#pragma unroll
    for (int j = 0; j < 4; ++j) { const int n = (lane >> 3) + 8 * j; const float* s = scr + (8 * c) * 33 + n;
        v4u o; o.x = pk2(s[0 * 33], s[1 * 33]); o.y = pk2(s[2 * 33], s[3 * 33]); o.z = pk2(s[4 * 33], s[5 * 33]); o.w = pk2(s[6 * 33], s[7 * 33]);
        *(v4u*)(WT + (size_t)rowmap(n0 + n) * K + k0 + 8 * c) = o; }
    asm volatile("s_waitcnt lgkmcnt(0)" ::: "memory");
}
constexpr int CV_E0 = 2, CV_E1 = 12, CV_E2 = 22, CV_E3 = 18, INP0_NC = 40, OUTP0_NC = 64, INP1_NC = 32, MOE_NC = 32;
__device__ __forceinline__ void item8_load(const float* W, int N, int item, int lane, f32x4 (&t)[16]) {
    const int nblk = N / 32, kb = item / nblk, nb = item % nblk, k0 = 128 * kb, n0 = 32 * nb;
    const int r8 = lane >> 3, c8 = lane & 7;
    const float* p = W + (size_t)(k0 + 16 * r8) * N + n0 + 4 * c8;
#pragma unroll
    for (int i = 0; i < 16; ++i) t[i] = __builtin_nontemporal_load((const f32x4*)(p + (size_t)i * N));
}
template <class MapF>
__device__ __forceinline__ void item8_store(const f32x4 (&t)[16], int K, int N, unsigned char* WT, MapF rowmap, int item, int lane) {
    const int nblk = N / 32, kb = item / nblk, nb = item % nblk, k0 = 128 * kb, n0 = 32 * nb;
    const int r8 = lane >> 3, c8 = lane & 7;
#pragma unroll
    for (int c = 0; c < 4; ++c) {
        v4u o;
        o.x = pk4_fp8(t[0][c] * W8_SCALE, t[1][c] * W8_SCALE, t[2][c] * W8_SCALE, t[3][c] * W8_SCALE);     o.y = pk4_fp8(t[4][c] * W8_SCALE, t[5][c] * W8_SCALE, t[6][c] * W8_SCALE, t[7][c] * W8_SCALE);
        o.z = pk4_fp8(t[8][c] * W8_SCALE, t[9][c] * W8_SCALE, t[10][c] * W8_SCALE, t[11][c] * W8_SCALE); o.w = pk4_fp8(t[12][c] * W8_SCALE, t[13][c] * W8_SCALE, t[14][c] * W8_SCALE, t[15][c] * W8_SCALE);
        *(v4u*)(WT + (size_t)rowmap(n0 + 4 * c8 + c) * K + k0 + 16 * r8) = o;
    }
}
struct ExpertConv {
    const CAS Args& a; int layer, wlo, nw, lane;
    static constexpr int IPM = 8 * 32;
    __device__ __forceinline__ void load(int it, f32x4 (&t)[16]) const {
        const int m = it / IPM, le = layer + m / nw, which = wlo + m % nw;
        item8_load((which == 0 ? a.in[31] : which == 1 ? a.in[33] : a.in[35]) + ((size_t)le << 20), D, it % IPM, lane, t); }
    __device__ __forceinline__ void store(int it, const f32x4 (&t)[16]) const {
        const int m = it / IPM, r = it % IPM, le = layer + m / nw, which = wlo + m % nw;
        unsigned char* dst = (unsigned char*)(a.ws + WS_WEXP) + (size_t)le * 3072 * 1024;
        if (which == 0) item8_store(t, D, D, dst, [](int n) { return ((n >> 7) << 8) + (n & 127); }, r, lane);
        else if (which == 1) item8_store(t, D, D, dst, [](int n) { return ((n >> 7) << 8) + 128 + (n & 127); }, r, lane);
        else item8_store(t, D, D, dst + (size_t)2048 * 1024,
            [](int f) { return (f & ~255) | (((f >> 3) & 1) << 7) | (((f >> 6) & 3) << 5) | (((f >> 4) & 3) << 3) | (f & 7); }, r, lane); }
};
__device__ __forceinline__ void convert_experts(const CAS Args& a, const Frame& F, int layer, int wlo, int whi, int gw, int ngw, int elo = 0, int ehi = NE) {
    const ExpertConv C{a, layer * NE + elo, wlo, whi - wlo, F.lane};
    const int total = (ehi - elo) * (whi - wlo) * ExpertConv::IPM;
    int it = gw; if (it >= total) return;
    f32x4 tA[16], tB[16];
    C.load(it, tA);
    for (;;) {
        int nit = it + ngw;
        if (nit < total) C.load(nit, tB);
        C.store(it, tA);
        if (nit >= total) break;
        it = nit; nit = it + ngw;
        if (nit < total) C.load(nit, tA);
        C.store(it, tB);
        if (nit >= total) break;
        it = nit;
    }
}
__device__ __forceinline__ void p0_prologue(const CAS Args& a, const Frame& F) {
    float* scr = (float*)(F.lds + F.wave * 8448);
    constexpr int I_IN0 = 16 * 96, I_O = 16 * 32, I_IN1 = 16 * 64, I_LRU1 = 4 * 8;
    constexpr int NSMALL = I_IN0 + I_O + I_IN1 + I_O + 16 * I_LRU1;
    for (int it = F.gw; it < NSMALL; it += F.ngw) {
        int r = it;
        if (r < I_IN0) {
            transpose_item(a.in[8], D, 3072, (bf16*)(a.ws + WS_WIN0), [](int f) {
                if (f < 2048) return (f & ~255) | (((f >> 5) & 1) << 7) | (((f >> 6) & 3) << 5) | (f & 31);
                if (f < 2560) { const int j = f - 2048; return (8 + (j >> 7)) * 256 + (j & 127); }
                const int j = f - 2560; return (8 + (j >> 7)) * 256 + 128 + (j & 127); }, scr, r, F.lane); continue; } r -= I_IN0;
        if (r < I_O) { transpose_item(a.in[9], D, D, (bf16*)(a.ws + WS_WOUT0), [](int n) { return n; }, scr, r, F.lane); continue; } r -= I_O;
        if (r < I_IN1) { transpose_item(a.in[15], D, 2048, (bf16*)(a.ws + WS_WIN1), [](int n) { return n; }, scr, r, F.lane); continue; } r -= I_IN1;
        if (r < I_O) { transpose_item(a.in[16], D, D, (bf16*)(a.ws + WS_WOUT1), [](int n) { return n; }, scr, r, F.lane); continue; } r -= I_O;
        const int gh = r / I_LRU1, rr = r % I_LRU1, g = gh >> 2, h = gh & 3;
        const float* W = (g == 0 ? a.in[19] : g == 1 ? a.in[21] : g == 2 ? a.in[24] : a.in[26]) + (size_t)h * 65536;
        transpose_item(W, 256, 256, (bf16*)(a.ws + WS_WLRU) + (size_t)h * 1024 * 256, [g](int n) { return g * 256 + n; }, scr, rr, F.lane);
    }
    __syncthreads();
    convert_experts(a, F, 0, 0, 2, F.gw, F.ngw, 0, CV_E0);
    __syncthreads();
    float* sc = (float*)F.lds;
    float* red = (float*)(F.lds + 17 * 1024 * 4);
    {
#pragma unroll
        for (int hbat = 0; hbat < 2; ++hbat) { float tv[17];
#pragma unroll
            for (int j = 0; j < 17; ++j) { const int i = F.tid + 512 * (17 * hbat + j); tv[j] = i < 16 * 1024 ? a.in[1][i] : a.in[3][i - 16 * 1024]; }
#pragma unroll
            for (int j = 0; j < 17; ++j) { const int i = F.tid + 512 * (17 * hbat + j); sc[i] = tv[j] / (1.0f + __expf(-tv[j])); } }
    }
    __syncthreads();
    float* MOD = (float*)(a.ws + WS_MOD);
    for (int u = F.bid; u < 192; u += F.G) {
        const int l = u / 96, n = (u % 96) * 64 + F.lane;
        const float* w = a.in[4] + (size_t)l * D * 6144 + n;
        float acc[17];
#pragma unroll
        for (int b = 0; b < 17; ++b) acc[b] = 0.f;
        float wa[32], wb[32];
        const int kw = F.wave * 128;
#define ADA_LD(dst, kk) do { _Pragma("unroll") for (int q = 0; q < 32; ++q) dst[q] = __builtin_nontemporal_load(w + (size_t)((kk) + q) * 6144); } while (0)
#define ADA_FMA(srcv, kk) do { _Pragma("unroll") for (int q = 0; q < 32; q += 4) _Pragma("unroll") for (int b = 0; b < 17; ++b) { const f32x4 s4 = *(const f32x4*)(sc + b * 1024 + (kk) + q); \
            acc[b] += s4[0] * srcv[q] + s4[1] * srcv[q + 1] + s4[2] * srcv[q + 2] + s4[3] * srcv[q + 3]; } } while (0)
        ADA_LD(wa, kw); ADA_LD(wb, kw + 32); ADA_FMA(wa, kw); ADA_LD(wa, kw + 64); ADA_FMA(wb, kw + 32); ADA_LD(wb, kw + 96); ADA_FMA(wa, kw + 64); ADA_FMA(wb, kw + 96);
#undef ADA_LD
#undef ADA_FMA
#pragma unroll
        for (int b = 0; b < 17; ++b) red[(F.wave * 17 + b) * 64 + F.lane] = acc[b];
        __syncthreads();
        for (int i = F.tid; i < 17 * 64; i += NWAVES * 64) {
            const int b = i / 64, ln = i % 64; float s = 0.f;
#pragma unroll
            for (int w8 = 0; w8 < 8; ++w8) s += red[(w8 * 17 + b) * 64 + ln];
            const int nn = (u % 96) * 64 + ln;
            MOD[((size_t)l * 17 + b) * 6144 + nn] = s + a.in[5][l * 6144 + nn];
        }
        __syncthreads();
    }
}

__device__ __forceinline__ void load_row16(const float* row, int lane, float (&v)[16]) {
#pragma unroll
    for (int j = 0; j < 4; ++j) { const f32x4 t = *(const f32x4*)(row + 256 * j + 4 * lane); v[4 * j] = t.x; v[4 * j + 1] = t.y; v[4 * j + 2] = t.z; v[4 * j + 3] = t.w; }
}
__device__ __forceinline__ void load_row16_bf16(const bf16* row, int lane, float (&v)[16]) {
#pragma unroll
    for (int j = 0; j < 4; ++j) { const uint2 t = *(const uint2*)(row + 256 * j + 4 * lane); v[4 * j] = __uint_as_float(t.x << 16); v[4 * j + 1] = __uint_as_float(t.x & 0xffff0000u); v[4 * j + 2] = __uint_as_float(t.y << 16); v[4 * j + 3] = __uint_as_float(t.y & 0xffff0000u); }
}
__device__ __forceinline__ void store_row16_bf16(bf16* row, int lane, const float (&v)[16]) {
#pragma unroll
    for (int j = 0; j < 4; ++j) { uint2 o; o.x = pk2(v[4 * j], v[4 * j + 1]); o.y = pk2(v[4 * j + 2], v[4 * j + 3]); *(uint2*)(row + 256 * j + 4 * lane) = o; }
}
__device__ __forceinline__ void store_row16_f32(float* row, int lane, const float (&v)[16]) {
#pragma unroll
    for (int j = 0; j < 4; ++j) *(f32x4*)(row + 256 * j + 4 * lane) = (f32x4){v[4 * j], v[4 * j + 1], v[4 * j + 2], v[4 * j + 3]};
}
template <bool FP8OUT = false>
__device__ __forceinline__ void norm_mod(const float (&v)[16], const float* g, const float* sh, const float* sc, bf16* out, int lane, float (&hv)[16]) {
    float s = 0.f;
#pragma unroll
    for (int i = 0; i < 16; ++i) s += v[i] * v[i];
    const float rstd = rsqrtf(wave_sum(s) * (1.0f / D) + 1e-6f);
#pragma unroll
    for (int j = 0; j < 4; ++j) {
        const int e = 256 * j + 4 * lane;
        const f32x4 gg = *(const f32x4*)(g + e), ss = *(const f32x4*)(sh + e), cc = *(const f32x4*)(sc + e);
        hv[4 * j] = v[4 * j] * rstd * gg.x * (1.f + cc.x) + ss.x; hv[4 * j + 1] = v[4 * j + 1] * rstd * gg.y * (1.f + cc.y) + ss.y;
        hv[4 * j + 2] = v[4 * j + 2] * rstd * gg.z * (1.f + cc.z) + ss.z; hv[4 * j + 3] = v[4 * j + 3] * rstd * gg.w * (1.f + cc.w) + ss.w;
        if (FP8OUT) *(unsigned*)((unsigned char*)out + e) = pk4_fp8(hv[4 * j], hv[4 * j + 1], hv[4 * j + 2], hv[4 * j + 3]);
        else { uint2 o; o.x = pk2(hv[4 * j], hv[4 * j + 1]); o.y = pk2(hv[4 * j + 2], hv[4 * j + 3]); *(uint2*)(out + e) = o; }
    }
}
__device__ __forceinline__ int row_batch(int r) { return r < NT ? (r >> 11) : 16; }
__device__ __forceinline__ const float* mod_ptr(const CAS Args& a, int l, int r, int chunk) { return (const float*)(a.ws + WS_MOD) + ((size_t)l * 17 + row_batch(r)) * 6144 + chunk * D; }

__device__ __forceinline__ void p_norm1_l0(const CAS Args& a, const Frame& F) {
    bf16* H = (bf16*)(a.ws + WS_H);
    { float* GS2 = (float*)(a.ws + WS_GS2); const float* MOD = (const float*)(a.ws + WS_MOD);
      for (int i = F.gw * 64 + F.lane; i < 2 * 17 * D; i += F.ngw * 64) { const int l = i / (17 * D), bb = (i / D) % 17, k = i % D; GS2[i] = a.in[7][l * D + k] * (1.0f + MOD[((size_t)l * 17 + bb) * 6144 + 4 * D + k]); } }
    for (int r = F.gw; r < R; r += 3 * F.ngw) {
        float v[3][16], hv[16];
#pragma unroll
        for (int k = 0; k < 3; ++k) { const int rr = r + k * F.ngw; if (rr < R) load_row16(rr < NT ? a.in[0] + (size_t)rr * D : a.in[2] + (size_t)(rr - NT) * D, F.lane, v[k]); }
#pragma unroll
        for (int k = 0; k < 3; ++k) { const int rr = r + k * F.ngw; if (rr < R) norm_mod(v[k], a.in[6], mod_ptr(a, 0, rr, 0), mod_ptr(a, 0, rr, 1), H + (size_t)rr * D, F.lane, hv); }
    }
}

struct EpiInProj0 {
    static constexpr bool PERM = true;
    bf16* P; const float* qg; const float* kg;
    __device__ __forceinline__ void operator()(const f32x4 (&acc)[2][2][4][2], const pg8::Unit& u, int wr, int wc, int fr, int fq) const {
        const int row0 = u.pm * 256 + wr * 64 + fr, pn = u.pn;
        if (pn < 4) {
            const float* g = pn < 2 ? qg : kg; const float sc = pn < 2 ? 0.125f : 1.0f;
            f32x4 gv[2][2];
#pragma unroll
            for (int bj = 0; bj < 2; ++bj)
#pragma unroll
                for (int n = 0; n < 2; ++n) gv[bj][n] = *(const f32x4*)(g + 32 * bj + 8 * fq + 4 * n);
#pragma unroll
            for (int ai = 0; ai < 2; ++ai)
#pragma unroll
                for (int m = 0; m < 4; ++m) {
                    float ss = 0.f;
#pragma unroll
                    for (int bj = 0; bj < 2; ++bj)
#pragma unroll
                        for (int n = 0; n < 2; ++n) { const f32x4 x = acc[ai][bj][m][n]; ss += (x[0] * x[0] + x[1] * x[1]) + (x[2] * x[2] + x[3] * x[3]); }
                    ss += __shfl_xor(ss, 16); ss += __shfl_xor(ss, 32);
                    const float rs = rsqrtf(ss * (1.0f / 64.0f) + 1e-6f) * sc;
                    bf16* rowp = P + (size_t)(row0 + ai * 128 + m * 16) * PP + pn * 256 + wc * 64 + 8 * fq;
#pragma unroll
                    for (int bj = 0; bj < 2; ++bj) { const f32x4 v0 = acc[ai][bj][m][0] * rs * gv[bj][0], v1 = acc[ai][bj][m][1] * rs * gv[bj][1];
                        v4u w; w.x = pg8::cvt_pk_bf16(v0[0], v0[1]); w.y = pg8::cvt_pk_bf16(v0[2], v0[3]); w.z = pg8::cvt_pk_bf16(v1[0], v1[1]); w.w = pg8::cvt_pk_bf16(v1[2], v1[3]);
                        *(v4u*)(rowp + 32 * bj) = w; }
                }
        } else if (pn < 8) {
#pragma unroll
            for (int ai = 0; ai < 2; ++ai)
#pragma unroll
                for (int m = 0; m < 4; ++m) { bf16* rowp = P + (size_t)(row0 + ai * 128 + m * 16) * PP + pn * 256 + wc * 64 + 8 * fq;
#pragma unroll
                    for (int bj = 0; bj < 2; ++bj) { const f32x4 v0 = acc[ai][bj][m][0], v1 = acc[ai][bj][m][1];
                        v4u w; w.x = pg8::cvt_pk_bf16(v0[0], v0[1]); w.y = pg8::cvt_pk_bf16(v0[2], v0[3]); w.z = pg8::cvt_pk_bf16(v1[0], v1[1]); w.w = pg8::cvt_pk_bf16(v1[2], v1[3]);
                        *(v4u*)(rowp + 32 * bj) = w; } }
        } else {
#pragma unroll
            for (int ai = 0; ai < 2; ++ai)
#pragma unroll
                for (int m = 0; m < 4; ++m) { bf16* rowp = P + (size_t)(row0 + ai * 128 + m * 16) * PP + 2048 + (pn - 8) * 128 + wc * 32 + 8 * fq;
                    const f32x4 v0 = acc[ai][0][m][0] * acc[ai][1][m][0], v1 = acc[ai][0][m][1] * acc[ai][1][m][1];
                    v4u w; w.x = pg8::cvt_pk_bf16(v0[0], v0[1]); w.y = pg8::cvt_pk_bf16(v0[2], v0[3]); w.z = pg8::cvt_pk_bf16(v1[0], v1[1]); w.w = pg8::cvt_pk_bf16(v1[2], v1[3]);
                    *(v4u*)rowp = w; }
        }
    }
};
__device__ __forceinline__ void p_inproj0(const CAS Args& a, const Frame& F) {
    if (F.bid >= F.G - INP0_NC) { convert_experts(a, F, 0, 0, 2, (F.bid - (F.G - INP0_NC)) * NWAVES + F.wave, INP0_NC * NWAVES, CV_E1, NE); return; }
    pg8::RectSched S{(const char*)(a.ws + WS_H), (const char*)(a.ws + WS_WIN0), 2 * D, R / 256, 3072 / 256, F.G - INP0_NC, F.bid, 0, 0, 0, 0};
    EpiInProj0 E{(bf16*)(a.ws + WS_P), a.in[10], a.in[11]};
    pg8::gemm_phase<2 * D, false>(F.ldsl, S, E, F.wave);
}
typedef __bf16 bf16x2_t __attribute__((ext_vector_type(2)));
typedef float f32x2_t __attribute__((ext_vector_type(2)));
typedef short s16x4 __attribute__((ext_vector_type(4)));
__device__ __forceinline__ unsigned pk_bf16(float a, float b) { f32x2_t v = {a, b}; bf16x2_t r = __builtin_convertvector(v, bf16x2_t); return __builtin_bit_cast(unsigned, r); }
constexpr int AT_LAT = 0, AT_CK = 576 * 128, AT_CV = AT_CK + 256 * 128, AT_RPB = AT_CV + 256 * 128;
__device__ __forceinline__ int at_swz(int key) { return (key ^ (key >> 3)) & 7; }
__device__ __forceinline__ unsigned at_addr(int key, int chunk) { return (unsigned)(key * 128 + ((chunk ^ at_swz(key)) << 4)); }
template <class RowF>
__device__ __forceinline__ void at_stage(LAS unsigned char* dst, int npieces, RowF rowf, int colbyte, const bf16* P, int wave, int lane) {
    for (int p = wave; p < npieces; p += NWAVES) {
        const int key = 8 * p + (lane >> 3), c = (lane & 7) ^ at_swz(key);
        const char* src = (const char*)P + (size_t)rowf(key) * (PP * 2) + colbyte + 16 * c;
        __builtin_amdgcn_global_load_lds((const unsigned*)src, (LAS unsigned*)(dst + p * 1024), 16, 0, 0);
    }
}
template <int OFF>
__device__ __forceinline__ void at_tr8o(unsigned a0, unsigned a1, unsigned a2, unsigned a3, unsigned a4, unsigned a5, unsigned a6, unsigned a7, s16x4 (&r)[8]) {
    asm volatile("ds_read_b64_tr_b16 %0, %8 offset:%16\n\tds_read_b64_tr_b16 %1, %9 offset:%16\n\tds_read_b64_tr_b16 %2, %10 offset:%16\n\tds_read_b64_tr_b16 %3, %11 offset:%16\n\t"
                 "ds_read_b64_tr_b16 %4, %12 offset:%16\n\tds_read_b64_tr_b16 %5, %13 offset:%16\n\tds_read_b64_tr_b16 %6, %14 offset:%16\n\tds_read_b64_tr_b16 %7, %15 offset:%16\n\ts_waitcnt lgkmcnt(0)"
                 : "=&v"(r[0]), "=&v"(r[1]), "=&v"(r[2]), "=&v"(r[3]), "=&v"(r[4]), "=&v"(r[5]), "=&v"(r[6]), "=&v"(r[7])
                 : "v"(a0), "v"(a1), "v"(a2), "v"(a3), "v"(a4), "v"(a5), "v"(a6), "v"(a7), "n"(OFF) : "memory");
}
__device__ __forceinline__ void at_tr8(unsigned a0, unsigned a1, unsigned a2, unsigned a3, unsigned a4, unsigned a5, unsigned a6, unsigned a7, s16x4 (&r)[8]) {
    asm volatile("ds_read_b64_tr_b16 %0, %8\n\tds_read_b64_tr_b16 %1, %9\n\tds_read_b64_tr_b16 %2, %10\n\tds_read_b64_tr_b16 %3, %11\n\t"
                 "ds_read_b64_tr_b16 %4, %12\n\tds_read_b64_tr_b16 %5, %13\n\tds_read_b64_tr_b16 %6, %14\n\tds_read_b64_tr_b16 %7, %15\n\ts_waitcnt lgkmcnt(0)"
                 : "=&v"(r[0]), "=&v"(r[1]), "=&v"(r[2]), "=&v"(r[3]), "=&v"(r[4]), "=&v"(r[5]), "=&v"(r[6]), "=&v"(r[7])
                 : "v"(a0), "v"(a1), "v"(a2), "v"(a3), "v"(a4), "v"(a5), "v"(a6), "v"(a7) : "memory");
}
__device__ __forceinline__ void p_attn(const CAS Args& a, const Frame& F) {
    const bf16* P = (const bf16*)(a.ws + WS_P); bf16* A2 = (bf16*)(a.ws + WS_A2);
    LAS unsigned char* lds = F.ldsl;
    const int lane = F.lane, wave = F.wave, rho = lane & 15, g = lane >> 4;
    for (int wu = F.bid; wu < NB * 8 * 2; wu += F.G) {
        const int half = wu & 1, hd = (wu >> 1) & 7, b = wu >> 4;
        __syncthreads();
        if (F.tid < 15 * 32) { const int dr_ = F.tid >> 5, dc_ = F.tid & 31; ((LAS float*)(lds + AT_RPB))[F.tid] = dc_ < 31 ? a.in[12][hd * 465 + dr_ * 31 + dc_] : -1e30f; }
        at_stage(lds + AT_CK, 32, [=](int key) { return NT + b * 256 + key; }, (512 + hd * 64) * 2, P, wave, lane);
        at_stage(lds + AT_CV, 32, [=](int key) { return NT + b * 256 + key; }, (1024 + hd * 64) * 2, P, wave, lane);
        for (int un = 0; un < 9; ++un) {
            const bool lat = un < 8;
            int r = 0, n = 0, qrow, krow_lo = 0;
            if (lat) { const int rp = half * 8 + un; r = 2 * rp + (wave >> 2); n = wave & 3; qrow = b * 2048 + r * 64 + 16 * n + rho; krow_lo = min(max(2 * rp - 4, 0), 24); }
            else qrow = NT + b * 256 + half * 128 + 16 * wave + rho;
            const int r0 = min(max(r - 4, 0), 24), ro = r0 - krow_lo, kc0 = min(max(16 * n - 8, 0), 32);
            const int c = 16 * n + rho, c0 = min(max(c - 8, 0), 48);
            if (lat) at_stage(lds + AT_LAT, 72, [=](int key) { return b * 2048 + min(krow_lo + (key >> 6), 31) * 64 + (key & 63); }, (512 + hd * 64) * 2, P, wave, lane);
            const bf16x8 q0 = *(const bf16x8*)(P + (size_t)qrow * PP + hd * 64 + 8 * g), q1 = *(const bf16x8*)(P + (size_t)qrow * PP + hd * 64 + 32 + 8 * g);
            asm volatile("s_waitcnt vmcnt(0)" ::: "memory");
            __syncthreads();
            const int pk = 8 * (rho >> 2) + (rho & 3);
            float mxb[2] = {-1e30f, -1e30f}, smb[2] = {0.f, 0.f}; v4u pf[16];
            const LAS unsigned char* bp[8];
#pragma unroll
            for (int k = 0; k < 8; ++k) { const int kcol = kc0 + 8 * g + k; const int dc = ((unsigned)(kcol - c0) < 16u) ? min(max(kcol - c + 15, 0), 30) : 31; bp[k] = lds + AT_RPB + ((r0 - r + 7) * 32 + dc) * 4; }
            const LAS unsigned char* kpl[2][2]; const LAS unsigned char* kpc[2][2][2];
#pragma unroll
            for (int t = 0; t < 2; ++t)
#pragma unroll
                for (int hf = 0; hf < 2; ++hf) {
                    kpl[t][hf] = lds + AT_LAT + at_addr(ro * 64 + kc0 + pk + 4 * t, 4 * hf + g);
                    const unsigned ce = AT_CK + at_addr(pk + 4 * t, 4 * hf + g);
                    kpc[0][t][hf] = lds + ce; kpc[1][t][hf] = lds + (ce ^ 0x40u); }
#pragma unroll
            for (int blk = 0; blk < 2; ++blk) {
                if (blk == 0 && !lat) {
#pragma unroll
                    for (int i = 0; i < 8; ++i) pf[i] = (v4u){0u, 0u, 0u, 0u};
                    continue; }
                f32x4 s[16];
#pragma unroll
                for (int i = 0; i < 8; ++i)
#pragma unroll
                    for (int t = 0; t < 2; ++t) {
                        const bf16x8 k0 = blk == 0 ? *(const LAS bf16x8*)(kpl[t][0] + i * 8192) : *(const LAS bf16x8*)(kpc[i & 1][t][0] + i * 4096);
                        const bf16x8 k1 = blk == 0 ? *(const LAS bf16x8*)(kpl[t][1] + i * 8192) : *(const LAS bf16x8*)(kpc[i & 1][t][1] + i * 4096);
                        f32x4 acc = __builtin_amdgcn_mfma_f32_16x16x32_bf16(k0, q0, (f32x4){0.f, 0.f, 0.f, 0.f}, 0, 0, 0);
                        acc = __builtin_amdgcn_mfma_f32_16x16x32_bf16(k1, q1, acc, 0, 0, 0);
                        if (blk == 0) {
#pragma unroll
                            for (int jj = 0; jj < 4; ++jj) acc[jj] += *(const LAS float*)(bp[4 * t + jj] + i * 128);
                        }
                        s[2 * i + t] = acc;
                    }
                float mx = -1e30f;
#pragma unroll
                for (int i = 0; i < 16; ++i) mx = fmaxf(fmaxf(mx, fmaxf(s[i][0], s[i][1])), fmaxf(s[i][2], s[i][3]));
                mx = fmaxf(mx, __shfl_xor(mx, 16)); mx = fmaxf(mx, __shfl_xor(mx, 32));
                float sum = 0.f;
#pragma unroll
                for (int i = 0; i < 8; ++i) {
                    float e[8];
#pragma unroll
                    for (int t = 0; t < 2; ++t)
#pragma unroll
                        for (int jj = 0; jj < 4; ++jj) { e[4 * t + jj] = __expf(s[2 * i + t][jj] - mx); sum += e[4 * t + jj]; }
                    pf[8 * blk + i].x = pk_bf16(e[0], e[1]); pf[8 * blk + i].y = pk_bf16(e[2], e[3]); pf[8 * blk + i].z = pk_bf16(e[4], e[5]); pf[8 * blk + i].w = pk_bf16(e[6], e[7]);
                }
                sum += __shfl_xor(sum, 16); sum += __shfl_xor(sum, 32);
                mxb[blk] = mx; smb[blk] = sum;
            }
            __syncthreads();
            if (lat) at_stage(lds + AT_LAT, 72, [=](int key) { return b * 2048 + min(krow_lo + (key >> 6), 31) * 64 + (key & 63); }, (1024 + hd * 64) * 2, P, wave, lane);
            asm volatile("s_waitcnt vmcnt(0)" ::: "memory");
            __syncthreads();
            f32x4 o[2][4];
#pragma unroll
            for (int blk = 0; blk < 2; ++blk)
#pragma unroll
                for (int db = 0; db < 4; ++db) o[blk][db] = (f32x4){0.f, 0.f, 0.f, 0.f};
            const int tq = rho >> 2, tp = rho & 3;
            unsigned adl[8], adc[8];
#pragma unroll
            for (int db = 0; db < 4; ++db) { const int kl = ro * 64 + kc0 + 8 * g + tq, kc = 8 * g + tq;
                adl[2 * db] = (unsigned)(size_t)(lds + AT_LAT) + at_addr(kl, 2 * db + (tp >> 1)) + 8 * (tp & 1); adl[2 * db + 1] = (unsigned)(size_t)(lds + AT_LAT) + at_addr(kl + 4, 2 * db + (tp >> 1)) + 8 * (tp & 1);
                adc[2 * db] = (unsigned)(size_t)(lds + AT_CV) + at_addr(kc, 2 * db + (tp >> 1)) + 8 * (tp & 1); adc[2 * db + 1] = (unsigned)(size_t)(lds + AT_CV) + at_addr(kc + 4, 2 * db + (tp >> 1)) + 8 * (tp & 1); }
#define AT_PV_CHUNK(CH) do { if ((CH) >= 8 || lat) { s16x4 vr[8]; \
                if ((CH) < 8) at_tr8o<((CH) & 7) * 8192>(adl[0], adl[1], adl[2], adl[3], adl[4], adl[5], adl[6], adl[7], vr); \
                else if (((CH) & 1) == 0) at_tr8o<((CH) & 7) * 4096>(adc[0], adc[1], adc[2], adc[3], adc[4], adc[5], adc[6], adc[7], vr); \
                else at_tr8o<((CH) & 7) * 4096>(adc[0] ^ 0x40u, adc[1] ^ 0x40u, adc[2] ^ 0x40u, adc[3] ^ 0x40u, adc[4] ^ 0x40u, adc[5] ^ 0x40u, adc[6] ^ 0x40u, adc[7] ^ 0x40u, vr); \
                _Pragma("unroll") for (int db = 0; db < 4; ++db) { const bf16x8 vf = __builtin_shufflevector(vr[2 * db], vr[2 * db + 1], 0, 1, 2, 3, 4, 5, 6, 7); \
                    o[(CH) >> 3][db] = __builtin_amdgcn_mfma_f32_16x16x32_bf16(vf, __builtin_bit_cast(bf16x8, pf[CH]), o[(CH) >> 3][db], 0, 0, 0); } } } while (0)
            AT_PV_CHUNK(0); AT_PV_CHUNK(1); AT_PV_CHUNK(2); AT_PV_CHUNK(3); AT_PV_CHUNK(4); AT_PV_CHUNK(5); AT_PV_CHUNK(6); AT_PV_CHUNK(7);
            AT_PV_CHUNK(8); AT_PV_CHUNK(9); AT_PV_CHUNK(10); AT_PV_CHUNK(11); AT_PV_CHUNK(12); AT_PV_CHUNK(13); AT_PV_CHUNK(14); AT_PV_CHUNK(15);
#undef AT_PV_CHUNK
            const float mxa = fmaxf(mxb[0], mxb[1]), f0 = __expf(mxb[0] - mxa), f1 = __expf(mxb[1] - mxa);
            const float inv = 1.0f / (f0 * smb[0] + f1 * smb[1]), g0 = f0 * inv, g1 = f1 * inv;
#pragma unroll
            for (int db = 0; db < 4; ++db) { uint2 w; w.x = pk_bf16(o[0][db][0] * g0 + o[1][db][0] * g1, o[0][db][1] * g0 + o[1][db][1] * g1); w.y = pk_bf16(o[0][db][2] * g0 + o[1][db][2] * g1, o[0][db][3] * g0 + o[1][db][3] * g1);
                *(uint2*)(A2 + (size_t)qrow * D + hd * 64 + 16 * db + 4 * g) = w; }
            __syncthreads();
        }
    }
    const float* cw = a.in[13]; const float* cb = a.in[14];
    const int j0 = 8 * lane;
    float w0[8], w1[8], w2[8], bb[8];
#pragma unroll
    for (int q = 0; q < 8; ++q) { w0[q] = cw[j0 + q]; w1[q] = cw[512 + j0 + q]; w2[q] = cw[1024 + j0 + q]; bb[q] = cb[j0 + q]; }
    for (int blk = F.gw; blk < R / 6; blk += F.ngw) {
        const int row0 = 6 * blk;
        v4u pw[8], bgw[6];
#pragma unroll
        for (int k = 0; k < 8; ++k) { const int rr = row0 + k - 1; pw[k] = (rr >= 0 && rr < R) ? *(const v4u*)(P + (size_t)rr * PP + 2048 + j0) : (v4u){0u, 0u, 0u, 0u}; }
#pragma unroll
        for (int k = 0; k < 6; ++k) bgw[k] = *(const v4u*)(P + (size_t)(row0 + k) * PP + 1536 + j0);
#pragma unroll
        for (int k = 0; k < 6; ++k) {
            const int row = row0 + k; const bool latr = row < NT; const int t = latr ? (row & 2047) : ((row - NT) & 255), len = latr ? 2048 : 256;
            const v4u pm = t > 0 ? pw[k] : (v4u){0u, 0u, 0u, 0u}, pc = pw[k + 1], pn = (t + 1 < len) ? pw[k + 2] : (v4u){0u, 0u, 0u, 0u}, bgv = bgw[k];
            const unsigned am[4] = {pm.x, pm.y, pm.z, pm.w}, ac[4] = {pc.x, pc.y, pc.z, pc.w}, an[4] = {pn.x, pn.y, pn.z, pn.w}, ab[4] = {bgv.x, bgv.y, bgv.z, bgv.w};
            unsigned ow[4];
#pragma unroll
            for (int q = 0; q < 4; ++q) {
                const float lo = __uint_as_float(ab[q] << 16) * (bb[2 * q] + w0[2 * q] * __uint_as_float(am[q] << 16) + w1[2 * q] * __uint_as_float(ac[q] << 16) + w2[2 * q] * __uint_as_float(an[q] << 16));
                const float hi = __uint_as_float(ab[q] & 0xffff0000u) * (bb[2 * q + 1] + w0[2 * q + 1] * __uint_as_float(am[q] & 0xffff0000u) + w1[2 * q + 1] * __uint_as_float(ac[q] & 0xffff0000u) + w2[2 * q + 1] * __uint_as_float(an[q] & 0xffff0000u));
                ow[q] = pk_bf16(lo, hi);
            }
            *(v4u*)(A2 + (size_t)row * D + 512 + j0) = (v4u){ow[0], ow[1], ow[2], ow[3]};
        }
    }
}
template <int L>
struct EpiOutProj {
    static constexpr bool PERM = true;
    const float* baseL; const float* baseC; bf16* XB; const float* MODl;
    __device__ __forceinline__ void operator()(const f32x4 (&acc)[2][2][4][2], const pg8::Unit& u, int wr, int wc, int fr, int fq) const {
        const bool lat = u.pm < NT / 256;
        const int mb = lat ? (u.pm >> 3) : 16;
        const int row0 = u.pm * 256 + wr * 64 + fr, col0 = u.pn * 256 + wc * 32 + 8 * fq;
        const float* g1 = MODl + (size_t)mb * 6144 + 2 * D + col0;
        f32x4 gv[2][2];
#pragma unroll
        for (int bj = 0; bj < 2; ++bj)
#pragma unroll
            for (int n = 0; n < 2; ++n) gv[bj][n] = *(const f32x4*)(g1 + bj * 128 + 4 * n);
#pragma unroll
        for (int ai = 0; ai < 2; ++ai)
#pragma unroll
            for (int m = 0; m < 4; ++m) { const int row = row0 + ai * 128 + m * 16;
#pragma unroll
                for (int bj = 0; bj < 2; ++bj) {
                    f32x4 b0, b1;
                    if (L == 0) { const float* bp = (lat ? baseL + (size_t)row * D : baseC + (size_t)(row - NT) * D) + col0 + bj * 128; b0 = *(const f32x4*)bp; b1 = *(const f32x4*)(bp + 4); }
                    else { const v4u w = *(const v4u*)(XB + (size_t)row * D + col0 + bj * 128);
                        b0 = (f32x4){__uint_as_float(w.x << 16), __uint_as_float(w.x & 0xffff0000u), __uint_as_float(w.y << 16), __uint_as_float(w.y & 0xffff0000u)};
                        b1 = (f32x4){__uint_as_float(w.z << 16), __uint_as_float(w.z & 0xffff0000u), __uint_as_float(w.w << 16), __uint_as_float(w.w & 0xffff0000u)}; }
                    const f32x4 v0 = b0 + gv[bj][0] * acc[ai][bj][m][0], v1 = b1 + gv[bj][1] * acc[ai][bj][m][1];
                    v4u o; o.x = pg8::cvt_pk_bf16(v0[0], v0[1]); o.y = pg8::cvt_pk_bf16(v0[2], v0[3]); o.z = pg8::cvt_pk_bf16(v1[0], v1[1]); o.w = pg8::cvt_pk_bf16(v1[2], v1[3]);
                    *(v4u*)(XB + (size_t)row * D + col0 + bj * 128) = o; }
                asm volatile("" ::: "memory"); }
    }
};
template <int L>
__device__ __forceinline__ void p_outproj(const CAS Args& a, const Frame& F) {
    const int nc = L == 0 ? OUTP0_NC : 0;
    if (F.bid >= F.G - nc) { convert_experts(a, F, 0, 0, 2, (F.bid - (F.G - nc)) * NWAVES + F.wave, nc * NWAVES, CV_E0, CV_E1); return; }
    pg8::RectSched S{(const char*)(a.ws + (L == 0 ? WS_A2 : WS_A3)), (const char*)(a.ws + (L == 0 ? WS_WOUT0 : WS_WOUT1)), 2 * D, (L == 0 ? R : NT) / 256, D / 256, F.G - nc, F.bid, 0, 0, 0, 0};
    EpiOutProj<L> E{a.in[0], a.in[2], (bf16*)(a.ws + WS_XB), (const float*)(a.ws + WS_MOD) + (size_t)L * 17 * 6144};
    pg8::gemm_phase<2 * D, false>(F.ldsl, S, E, F.wave);
}
#define RS_STEP(half, m) do { const bool up = (F.lane & (m)) != 0; _Pragma("unroll") for (int i = 0; i < (half); ++i) { \
        const float keep = up ? part[i + (half)] : part[i]; const float send = up ? part[i] : part[i + (half)]; part[i] = keep + __shfl_xor(send, (m)); } } while (0)
constexpr int RT_WH = 0, RT_WL = 65536, RT_GS = 131072, RT_LG = 139264, RT_CNT = 155648;
__device__ __forceinline__ void p_norm2_router(const CAS Args& a, const Frame& F, int l) {
    unsigned char* H8 = (unsigned char*)(a.ws + WS_H); const bf16* XB = (const bf16*)(a.ws + WS_XB);
    unsigned* ctl = (unsigned*)(a.ws + WS_CTL);
    int* toklist = (int*)(a.ws + WS_TOKLIST); int* sel = (int*)(a.ws + WS_SEL); float* gatev = (float*)(a.ws + WS_GATEV);
    const float* wr = a.in[29] + (size_t)l * D * NE; const float* br = a.in[30] + l * NE;
    const float* GS2 = (const float*)(a.ws + WS_GS2) + (size_t)l * 17 * D; const float* MODl = (const float*)(a.ws + WS_MOD) + (size_t)l * 17 * 6144;
    const int rows = l == 0 ? R : NT, rpw = rows / F.G, row_lo = F.bid * rpw, nblk = rpw / 16;
    LAS unsigned char* lds = F.ldsl;
    const int lane = F.lane, wave = F.wave, rho = lane & 15, g = lane >> 4;
    const int b_first = row_batch(row_lo);
    __syncthreads();
    {
        f32x4 wv[16];
#pragma unroll
        for (int j = 0; j < 16; ++j) wv[j] = *(const f32x4*)(wr + 4 * (F.tid + 512 * j));
#pragma unroll
        for (int j = 0; j < 16; ++j) { const int i0 = 4 * (F.tid + 512 * j), k = i0 >> 5;
#pragma unroll
            for (int q = 0; q < 4; ++q) { const int e = (i0 & 31) + q; const float w = wv[j][q]; const bf16 hi = f2bf(w), lo = f2bf(w - bf2f(hi));
                const int off = e * 2048 + 16 * ((k >> 3) ^ (e & 15)) + 2 * (k & 7);
                *(LAS bf16*)(lds + RT_WH + off) = hi; *(LAS bf16*)(lds + RT_WL + off) = lo; } }
    }
    for (int i = F.tid; i < 2 * D; i += NWAVES * 64) { const int s = i >> 10, k = i & 1023; const int bb = s == 0 ? b_first : row_batch(row_lo + rpw - 1); ((LAS float*)(lds + RT_GS))[i] = GS2[bb * D + k]; }
    LAS unsigned* wcnt = (LAS unsigned*)(lds + RT_CNT); LAS unsigned* wbase = wcnt + 32; LAS unsigned* stmp = wcnt + 64;
    if (F.tid < NE) wcnt[F.tid] = 0u;
    __syncthreads();
    for (int blk = wave; blk < nblk; blk += NWAVES) {
        const int r0 = row_lo + 16 * blk, row = r0 + rho, bb = row_batch(r0);
        const bf16* xr = XB + (size_t)row * D + 8 * g;
        float ss = 0.f;
#pragma unroll
        for (int kh = 0; kh < 2; ++kh) {
            v4u xw[16];
#pragma unroll
            for (int ks = 0; ks < 16; ++ks) xw[ks] = *(const v4u*)(xr + 32 * (16 * kh + ks));
#pragma unroll
            for (int ks = 0; ks < 16; ++ks) { const unsigned u4[4] = {xw[ks].x, xw[ks].y, xw[ks].z, xw[ks].w};
#pragma unroll
                for (int q = 0; q < 4; ++q) { const float x0 = __uint_as_float(u4[q] << 16), x1 = __uint_as_float(u4[q] & 0xffff0000u); ss += x0 * x0 + x1 * x1; } }
            asm volatile("" ::: "memory");
        }
        ss += __shfl_xor(ss, 16); ss += __shfl_xor(ss, 32);
        const float rstd = rsqrtf(ss * (1.0f / D) + 1e-6f);
        const LAS float* gs = (const LAS float*)(lds + RT_GS) + (bb == b_first ? 0 : D) + 8 * g;
        const float* sh = MODl + (size_t)bb * 6144 + 3 * D + 8 * g;
        f32x4 acc[2] = {(f32x4){0.f, 0.f, 0.f, 0.f}, (f32x4){0.f, 0.f, 0.f, 0.f}};
        int offb[4];
#pragma unroll
        for (int b4 = 0; b4 < 4; ++b4) offb[b4] = rho * 2048 + (((4 * (b4 ^ ((rho >> 2) & 3))) + (g ^ (rho & 3))) << 4);
        for (int k4 = 0; k4 < 8; ++k4) {
            v4u xw[4]; f32x4 sv[4][2];
#pragma unroll
            for (int b4 = 0; b4 < 4; ++b4) { const int ks = 4 * k4 + b4; xw[b4] = *(const v4u*)(xr + 32 * ks); sv[b4][0] = *(const f32x4*)(sh + 32 * ks); sv[b4][1] = *(const f32x4*)(sh + 32 * ks + 4); }
#pragma unroll
            for (int b4 = 0; b4 < 4; ++b4) {
                const int ks = 4 * k4 + b4;
                const unsigned u4[4] = {xw[b4].x, xw[b4].y, xw[b4].z, xw[b4].w};
                const f32x4 g0 = *(const LAS f32x4*)(gs + 32 * ks), g1 = *(const LAS f32x4*)(gs + 32 * ks + 4);
                const f32x4 s0 = sv[b4][0], s1 = sv[b4][1];
                float hv[8];
#pragma unroll
                for (int q = 0; q < 4; ++q) { const float x0 = __uint_as_float(u4[q] << 16) * rstd, x1 = __uint_as_float(u4[q] & 0xffff0000u) * rstd;
                    const float gg0 = q < 2 ? g0[2 * q] : g1[2 * q - 4], gg1 = q < 2 ? g0[2 * q + 1] : g1[2 * q - 3], t0 = q < 2 ? s0[2 * q] : s1[2 * q - 4], t1 = q < 2 ? s0[2 * q + 1] : s1[2 * q - 3];
                    hv[2 * q] = x0 * gg0 + t0; hv[2 * q + 1] = x1 * gg1 + t1; }
                v4u hi, lo;
#pragma unroll
                for (int q = 0; q < 4; ++q) { const unsigned p = pk_bf16(hv[2 * q], hv[2 * q + 1]); ((unsigned*)&hi)[q] = p;
                    ((unsigned*)&lo)[q] = pk_bf16(hv[2 * q] - __uint_as_float(p << 16), hv[2 * q + 1] - __uint_as_float(p & 0xffff0000u)); }
                { uint2 f8; unsigned t0 = 0u, t1 = 0u; t0 = __builtin_amdgcn_cvt_pk_fp8_f32(hv[0], hv[1], t0, false); t0 = __builtin_amdgcn_cvt_pk_fp8_f32(hv[2], hv[3], t0, true);
                  t1 = __builtin_amdgcn_cvt_pk_fp8_f32(hv[4], hv[5], t1, false); t1 = __builtin_amdgcn_cvt_pk_fp8_f32(hv[6], hv[7], t1, true); f8.x = t0; f8.y = t1;
                  *(uint2*)(H8 + (size_t)row * D + 32 * ks + 8 * g) = f8; }
#pragma unroll
                for (int nt = 0; nt < 2; ++nt) { const int off = nt * 32768 + k4 * 256 + offb[b4];
                    const bf16x8 bh = *(const LAS bf16x8*)(lds + RT_WH + off), bl = *(const LAS bf16x8*)(lds + RT_WL + off);
                    acc[nt] = __builtin_amdgcn_mfma_f32_16x16x32_bf16(__builtin_bit_cast(bf16x8, hi), bh, acc[nt], 0, 0, 0);
                    acc[nt] = __builtin_amdgcn_mfma_f32_16x16x32_bf16(__builtin_bit_cast(bf16x8, lo), bh, acc[nt], 0, 0, 0);
                    acc[nt] = __builtin_amdgcn_mfma_f32_16x16x32_bf16(__builtin_bit_cast(bf16x8, hi), bl, acc[nt], 0, 0, 0); }
            }
        }
        LAS float* lg = (LAS float*)(lds + RT_LG + wave * 2048);
#pragma unroll
        for (int nt = 0; nt < 2; ++nt)
#pragma unroll
            for (int jj = 0; jj < 4; ++jj) lg[(4 * g + jj) * 32 + 16 * nt + rho] = acc[nt][jj] + br[16 * nt + rho];
        {
            float mine[8], allv[32];
#pragma unroll
            for (int q = 0; q < 8; ++q) { const f32x4 t = *(const LAS f32x4*)(lg + rho * 32 + 4 * q); allv[4 * q] = t[0]; allv[4 * q + 1] = t[1]; allv[4 * q + 2] = t[2]; allv[4 * q + 3] = t[3]; }
#pragma unroll
            for (int q = 0; q < 8; ++q) mine[q] = g == 0 ? allv[q] : g == 1 ? allv[8 + q] : g == 2 ? allv[16 + q] : allv[24 + q];
            LAS float* rs = lg;
#pragma unroll
            for (int q = 0; q < 8; ++q) { const int e = 8 * g + q; int rank = 0;
#pragma unroll
                for (int jx = 0; jx < 32; ++jx) rank += (allv[jx] > mine[q] || (allv[jx] == mine[q] && jx < e)) ? 1 : 0;
                if (rank < 4) { rs[(rho * 4 + rank) * 2] = mine[q]; ((LAS int*)rs)[(rho * 4 + rank) * 2 + 1] = e; } }
            if (lane < 16) {
                const f32x4 q0 = *(const LAS f32x4*)(rs + lane * 8), q1 = *(const LAS f32x4*)(rs + lane * 8 + 4);
                const float tv0 = q0[0], tv1 = q0[2], tv2 = q1[0], tv3 = q1[2]; const int ti[4] = {__float_as_int(q0[1]), __float_as_int(q0[3]), __float_as_int(q1[1]), __float_as_int(q1[3])};
                const float e1 = __expf(tv1 - tv0), e2 = __expf(tv2 - tv0), e3 = __expf(tv3 - tv0), inv = 1.0f / (1.0f + e1 + e2 + e3);
                const float gk[4] = {inv, e1 * inv, e2 * inv, e3 * inv};
                const int rl = 16 * blk + lane;
#pragma unroll
                for (int k = 0; k < 4; ++k) { const unsigned p = __hip_atomic_fetch_add(wcnt + ti[k], 1u, __ATOMIC_RELAXED, __HIP_MEMORY_SCOPE_WORKGROUP);
                    stmp[(rl * 4 + k) * 2] = (p << 5) | (unsigned)ti[k]; stmp[(rl * 4 + k) * 2 + 1] = __float_as_uint(gk[k]); }
            }
        }
    }
    __syncthreads();
    if (F.tid < NE) { const unsigned c = wcnt[F.tid]; wbase[F.tid] = c ? __hip_atomic_fetch_add(ctl + CW_CNT + (l * 32 + F.tid) * 64, c, RLX_AGENT) : 0u; }
    __syncthreads();
    for (int i = F.tid; i < rpw * 4; i += NWAVES * 64) { const int rl = i >> 2, k = i & 3, r = row_lo + rl; const unsigned pe = stmp[i * 2], e = pe & 31u, pos = wbase[e] + (pe >> 5);
        toklist[(size_t)e * CAP + pos] = r; sel[r * 4 + k] = (int)((pos << 5) | e); gatev[r * 4 + k] = __uint_as_float(stmp[i * 2 + 1]); }
}
struct MoeTab { int cnt[NE], base[NE + 1], tpre[NE + 1]; };
__device__ __forceinline__ void moe_tab_build(const CAS Args& a, const Frame& F, int l, LAS MoeTab* tb) {
    unsigned* ctl = (unsigned*)(a.ws + WS_CTL);
    __syncthreads();
    if (F.tid < NE) tb->cnt[F.tid] = (int)__hip_atomic_load(ctl + CW_CNT + (l * 32 + F.tid) * 64, RLX_AGENT);
    __syncthreads();
    if (F.tid == 0) { int bs = 0, tp = 0; for (int e = 0; e < NE; ++e) { const int c = tb->cnt[e]; tb->base[e] = bs; tb->tpre[e] = tp; bs += c; tp += (c + 255) >> 8; } tb->base[NE] = bs; tb->tpre[NE] = tp; }
    __syncthreads();
}
constexpr int MOE_UT_MAX = 64;
template <bool UP>
struct MoeSched {
    static constexpr bool GATHER = UP;
    const LAS MoeTab* tb; const LAS int* ut; const char* A; const char* WE; const int* toklist; int G, c;
    static constexpr int NN = UP ? 8 : 4;
    static __device__ __forceinline__ int rfl(int v) { return __builtin_amdgcn_readfirstlane(v); }
    static __device__ __forceinline__ const char* ufy(const char* p) { const unsigned long long v = (unsigned long long)p; const unsigned lo = __builtin_amdgcn_readfirstlane((unsigned)v), hi = __builtin_amdgcn_readfirstlane((unsigned)(v >> 32)); return (const char*)(((unsigned long long)hi << 32) | lo); }
    __device__ __forceinline__ bool unit_search(int i, int& pm, int& pn, int& e_, int& rows, int& base) const {
        const int nwg = tb->tpre[NE] * NN; const long L = (long)i * G + c; if (L >= nwg) return false;
        const int w = pg8::xcd_remap(L, nwg);
        int e = 0; while (e < NE - 1 && w >= tb->tpre[e + 1] * NN) ++e;
        const int tp0 = tb->tpre[e], tp1 = tb->tpre[e + 1];
        const int q = w - tp0 * NN, nte = tp1 - tp0;
        const int nig = 8 * NN, gid = q / nig, fm = gid * 8, gsz = (nte - fm) < 8 ? (nte - fm) : 8;
        pm = fm + ((q % nig) % gsz); pn = (q % nig) / gsz; e_ = e; rows = min(256, tb->cnt[e] - pm * 256); base = tb->base[e] + pm * 256;
        return true;
    }
    __device__ __forceinline__ void build(LAS int* utw, int tid) const {
        if (tid < MOE_UT_MAX) { int pm = -1, pn = 0, e = 0, rows = 0, base = 0; unit_search(tid, pm, pn, e, rows, base);
            utw[tid * 8 + 0] = pm; utw[tid * 8 + 1] = pn; utw[tid * 8 + 2] = e; utw[tid * 8 + 3] = rows; utw[tid * 8 + 4] = base; }
    }
    __device__ __forceinline__ bool unit(int i, pg8::Unit& u) const {
        if (i >= MOE_UT_MAX) return false;
        const LAS int* p = ut + i * 8; const int pm = rfl(p[0]); if (pm < 0) return false;
        u.pm = pm; u.pn = rfl(p[1]); u.e = rfl(p[2]); u.rows = rfl(p[3]); u.base = rfl(p[4]); u.newe = (i == 0) || (rfl(p[2 - 8]) != u.e);
        return true;
    }
    __device__ __forceinline__ bool bases(int i, const char*& a, const char*& b) const {
        pg8::Unit u; if (!unit(i, u)) return false;
        a = UP ? A : A + (size_t)u.base * D;
        b = WE + (size_t)u.e * 3072 * 1024 + (UP ? 0 : (size_t)2048 * 1024) + (size_t)u.pn * 256 * 1024;
        a = ufy(a); b = ufy(b);
        return true;
    }
    __device__ __forceinline__ void atoks(int i, const int (&rA)[2], int (&tok)[2][2]) const {
        pg8::Unit u; unit(i, u);
        const int* tl = toklist + (size_t)u.e * CAP + u.pm * 256;
#pragma unroll
        for (int h = 0; h < 2; ++h)
#pragma unroll
            for (int i2 = 0; i2 < 2; ++i2) { const int rr = h * 128 + rA[i2]; tok[h][i2] = tl[rr < u.rows ? rr : 0]; }
    }
    __device__ __forceinline__ void aoffs(int i, const int (&rA)[2], const unsigned (&voffA)[2], unsigned (&off)[2][2]) const {
        pg8::Unit u; unit(i, u);
        const int* tl = toklist + (size_t)u.e * CAP + u.pm * 256;
#pragma unroll
        for (int h = 0; h < 2; ++h)
#pragma unroll
            for (int i2 = 0; i2 < 2; ++i2) { const int rr = h * 128 + rA[i2]; const int tok = tl[rr < u.rows ? rr : 0]; off[h][i2] = (unsigned)tok * (unsigned)D + voffA[i2]; }
    }
};
struct EpiMoeUp {
    static constexpr bool PERM = true;
    bf16* ACT; const float* bgate; const float* bup; LAS float* btab;
    __device__ __forceinline__ void operator()(const f32x4 (&acc)[2][2][4][2], const pg8::Unit& u, int wr, int wc, int fr, int fq) const {
        const int col0 = u.pn * 128 + wc * 32 + 8 * fq, rl0 = wr * 64 + fr;
        if (u.newe) { const int tid = (wr * 4 + wc) * 64 + fr + 16 * fq;
            const f32x4 t = *(const f32x4*)((tid < 256 ? bgate : bup) + u.e * D + 4 * (tid & 255));
            *(LAS f32x4*)(btab + 4 * tid) = t;
            asm volatile("s_waitcnt lgkmcnt(0)" ::: "memory"); __builtin_amdgcn_s_barrier(); asm volatile("" ::: "memory"); }
        f32x2_t bg[2][2], bu[2][2];
#pragma unroll
        for (int n = 0; n < 2; ++n) { const f32x4 g4 = *(const LAS f32x4*)(btab + col0 + 4 * n), u4 = *(const LAS f32x4*)(btab + 1024 + col0 + 4 * n);
            bg[n][0] = (f32x2_t){g4[0], g4[1]}; bg[n][1] = (f32x2_t){g4[2], g4[3]};
            bu[n][0] = (f32x2_t){u4[0], u4[1]} * ACT8_SCALE + ACT8_SCALE; bu[n][1] = (f32x2_t){u4[2], u4[3]} * ACT8_SCALE + ACT8_SCALE; }
#pragma unroll
        for (int ai = 0; ai < 2; ++ai)
#pragma unroll
            for (int m = 0; m < 4; ++m) { const int rl = rl0 + ai * 128 + m * 16;
                f32x2_t o[2][2];
#pragma unroll
                for (int n = 0; n < 2; ++n)
#pragma unroll
                    for (int p = 0; p < 2; ++p) {
                        f32x2_t gg = (f32x2_t){acc[ai][0][m][n][2 * p], acc[ai][0][m][n][2 * p + 1]} * (1.0f / W8_SCALE) + bg[n][p];
                        gg.x = fminf(gg.x, 7.0f); gg.y = fminf(gg.y, 7.0f);
                        const f32x2_t tt = gg * (-1.702f * 1.44269504f);
                        f32x2_t dd; dd.x = __builtin_amdgcn_exp2f(tt.x); dd.y = __builtin_amdgcn_exp2f(tt.y); dd = dd + 1.0f;
                        f32x2_t rr; rr.x = __builtin_amdgcn_rcpf(dd.x); rr.y = __builtin_amdgcn_rcpf(dd.y);
                        f32x2_t uu = (f32x2_t){acc[ai][1][m][n][2 * p], acc[ai][1][m][n][2 * p + 1]} * (ACT8_SCALE / W8_SCALE) + bu[n][p];
                        uu.x = __builtin_amdgcn_fmed3f(uu.x, -6.0f * ACT8_SCALE, 8.0f * ACT8_SCALE); uu.y = __builtin_amdgcn_fmed3f(uu.y, -6.0f * ACT8_SCALE, 8.0f * ACT8_SCALE);
                        o[n][p] = (gg * rr) * uu;
                    }
                if (rl < u.rows) { uint2 w; unsigned w0 = 0u, w1 = 0u;
                    w0 = __builtin_amdgcn_cvt_pk_fp8_f32(o[0][0].x, o[0][0].y, w0, false); w0 = __builtin_amdgcn_cvt_pk_fp8_f32(o[0][1].x, o[0][1].y, w0, true);
                    w1 = __builtin_amdgcn_cvt_pk_fp8_f32(o[1][0].x, o[1][0].y, w1, false); w1 = __builtin_amdgcn_cvt_pk_fp8_f32(o[1][1].x, o[1][1].y, w1, true);
                    w.x = w0; w.y = w1;
                    *(uint2*)((unsigned char*)ACT + (size_t)(u.base + rl) * D + col0) = w; } }
    }
};
struct EpiMoeDown {
    static constexpr bool PERM = true;
    unsigned char* YB; const float* bdown; LAS float* btab;
    __device__ __forceinline__ void operator()(const f32x4 (&acc)[2][2][4][2], const pg8::Unit& u, int wr, int wc, int fr, int fq) const {
        const int col0 = u.pn * 256 + wc * 64 + 16 * fq, rl0 = wr * 64 + fr;
        if (u.newe) { const int tid = (wr * 4 + wc) * 64 + fr + 16 * fq;
            if (tid < 256) { const f32x4 t = *(const f32x4*)(bdown + u.e * D + 4 * tid); *(LAS f32x4*)(btab + 4 * tid) = t; }
            asm volatile("s_waitcnt lgkmcnt(0)" ::: "memory"); __builtin_amdgcn_s_barrier(); asm volatile("" ::: "memory"); }
        f32x4 bv[2][2];
#pragma unroll
        for (int bj = 0; bj < 2; ++bj)
#pragma unroll
            for (int n = 0; n < 2; ++n) bv[bj][n] = *(const LAS f32x4*)(btab + col0 + 8 * bj + 4 * n) * YB8_SCALE;
#pragma unroll
        for (int ai = 0; ai < 2; ++ai)
#pragma unroll
            for (int m = 0; m < 4; ++m) { const int rl = rl0 + ai * 128 + m * 16;
                if (rl < u.rows) { v4u w;
                    { const f32x4 v = acc[ai][0][m][0] * (YB8_SCALE / (W8_SCALE * ACT8_SCALE)) + bv[0][0]; w.x = pk4_fp8(v[0], v[1], v[2], v[3]); }
                    { const f32x4 v = acc[ai][0][m][1] * (YB8_SCALE / (W8_SCALE * ACT8_SCALE)) + bv[0][1]; w.y = pk4_fp8(v[0], v[1], v[2], v[3]); }
                    { const f32x4 v = acc[ai][1][m][0] * (YB8_SCALE / (W8_SCALE * ACT8_SCALE)) + bv[1][0]; w.z = pk4_fp8(v[0], v[1], v[2], v[3]); }
                    { const f32x4 v = acc[ai][1][m][1] * (YB8_SCALE / (W8_SCALE * ACT8_SCALE)) + bv[1][1]; w.w = pk4_fp8(v[0], v[1], v[2], v[3]); }
                    *(v4u*)(YB + (size_t)(u.base + rl) * D + col0) = w; } }
    }
};
constexpr int LDS_TAB = 131072;
__device__ __forceinline__ void p_moe_up(const CAS Args& a, const Frame& F, int l) {
    const int nc = l == 0 ? MOE_NC : 0;
    if (F.bid >= F.G - nc) { const int cw = (F.bid - (F.G - nc)) * NWAVES + F.wave; convert_experts(a, F, 0, 2, 3, cw, nc * NWAVES); convert_experts(a, F, 1, 0, 2, cw, nc * NWAVES, 0, CV_E3); return; }
    LAS MoeTab* tb = (LAS MoeTab*)(F.ldsl + LDS_TAB); moe_tab_build(a, F, l, tb);
    LAS int* utw = (LAS int*)(F.ldsl + LDS_TAB + 1024);
    MoeSched<true> S{tb, utw, (const char*)(a.ws + WS_H), (const char*)(a.ws + WS_WEXP) + (size_t)l * NE * 3072 * 1024, (const int*)(a.ws + WS_TOKLIST), F.G - nc, F.bid};
    S.build(utw, F.tid); __syncthreads();
    EpiMoeUp E{(bf16*)(a.ws + WS_ACT), a.in[32] + (size_t)l * NE * D, a.in[34] + (size_t)l * NE * D, (LAS float*)(F.ldsl + LDS_TAB + 4096)};
    pg8::gemm_phase<D, true>(F.ldsl, S, E, F.wave);
}
__device__ __forceinline__ void p_moe_down(const CAS Args& a, const Frame& F, int l) {
    const int nc = l == 0 ? MOE_NC : 0;
    if (F.bid >= F.G - nc) { const int cw = (F.bid - (F.G - nc)) * NWAVES + F.wave; convert_experts(a, F, 1, 2, 3, cw, nc * NWAVES); convert_experts(a, F, 1, 0, 2, cw, nc * NWAVES, CV_E3, CV_E2); return; }
    LAS MoeTab* tb = (LAS MoeTab*)(F.ldsl + LDS_TAB); moe_tab_build(a, F, l, tb);
    LAS int* utw = (LAS int*)(F.ldsl + LDS_TAB + 1024);
    MoeSched<false> S{tb, utw, (const char*)(a.ws + WS_ACT), (const char*)(a.ws + WS_WEXP) + (size_t)l * NE * 3072 * 1024, nullptr, F.G - nc, F.bid};
    S.build(utw, F.tid); __syncthreads();
    EpiMoeDown E{(unsigned char*)(a.ws + WS_YB), a.in[36] + (size_t)l * NE * D, (LAS float*)(F.ldsl + LDS_TAB + 4096)};
    pg8::gemm_phase<D, true>(F.ldsl, S, E, F.wave);
}
__device__ __forceinline__ void p_combine(const CAS Args& a, const Frame& F, int l) {
    const unsigned char* YB = (const unsigned char*)(a.ws + WS_YB); bf16* XB = (bf16*)(a.ws + WS_XB); bf16* H = (bf16*)(a.ws + WS_H);
    const int* sel = (const int*)(a.ws + WS_SEL); const float* gatev = (const float*)(a.ws + WS_GATEV);
    LAS MoeTab* tb = (LAS MoeTab*)(F.ldsl + LDS_TAB); moe_tab_build(a, F, l, tb);
    const int rows = l == 0 ? R : NT, lane = F.lane;
    const int rpw = (((rows + F.ngw - 1) / F.ngw) + 1) & ~1, r_lo = F.gw * rpw, r_hi = min(rows, r_lo + rpw);
    float g2v[16], gpv[16], shv[16], scv[16]; int cb = -1;
    if (l == 0) {
#pragma unroll
        for (int jh = 0; jh < 2; ++jh)
#pragma unroll
            for (int q = 0; q < 2; ++q) { const f32x4 t = *(const f32x4*)(a.in[6] + D + 512 * jh + 8 * lane + 4 * q);
#pragma unroll
                for (int c = 0; c < 4; ++c) gpv[8 * jh + 4 * q + c] = t[c]; } }
    int sv[2][4]; float gk[2][4];
#pragma unroll
    for (int t = 0; t < 2; ++t)
#pragma unroll
        for (int k = 0; k < 4; ++k) { const int rr = min(r_lo + t, rows - 1); sv[t][k] = sel[rr * 4 + k]; gk[t][k] = gatev[rr * 4 + k]; }
    for (int r = r_lo; r < r_hi; r += 2) {
        v4u xw[2][2]; uint2 yw[2][4][2];
#pragma unroll
        for (int t = 0; t < 2; ++t) { const int rr = min(r + t, rows - 1);
#pragma unroll
            for (int jh = 0; jh < 2; ++jh) xw[t][jh] = *(const v4u*)(XB + (size_t)rr * D + 512 * jh + 8 * lane);
#pragma unroll
            for (int k = 0; k < 4; ++k) { const int e = sv[t][k] & 31, pos = sv[t][k] >> 5;
                const unsigned char* y = YB + (size_t)(tb->base[e] + pos) * D;
#pragma unroll
                for (int jh = 0; jh < 2; ++jh) yw[t][k][jh] = *(const uint2*)(y + 512 * jh + 8 * lane); } }
        int nsv[2][4]; float ngk[2][4];
#pragma unroll
        for (int t = 0; t < 2; ++t)
#pragma unroll
            for (int k = 0; k < 4; ++k) { const int rr = min(r + 2 + t, rows - 1); nsv[t][k] = sel[rr * 4 + k]; ngk[t][k] = gatev[rr * 4 + k]; }
        const int bq = row_batch(r);
        if (bq != cb) { cb = bq;
            const float* g2 = mod_ptr(a, l, r, 5); const float* shp = mod_ptr(a, 1, r, 0); const float* scp = mod_ptr(a, 1, r, 1);
#pragma unroll
            for (int jh = 0; jh < 2; ++jh)
#pragma unroll
                for (int q = 0; q < 2; ++q) { const int e0 = 512 * jh + 8 * lane + 4 * q; const f32x4 gg = *(const f32x4*)(g2 + e0);
#pragma unroll
                    for (int c = 0; c < 4; ++c) g2v[8 * jh + 4 * q + c] = gg[c];
                    if (l == 0) { const f32x4 ss = *(const f32x4*)(shp + e0), cc = *(const f32x4*)(scp + e0);
#pragma unroll
                        for (int c = 0; c < 4; ++c) { shv[8 * jh + 4 * q + c] = ss[c]; scv[8 * jh + 4 * q + c] = gpv[8 * jh + 4 * q + c] * (1.f + cc[c]); } } } }
#pragma unroll
        for (int t = 0; t < 2; ++t) { const int rr = r + t; if (rr < r_hi) {
            float m[16], v[16];
#pragma unroll
            for (int i = 0; i < 16; ++i) m[i] = 0.f;
#pragma unroll
            for (int k = 0; k < 4; ++k) { const float gg = gk[t][k] * (1.0f / YB8_SCALE);
#pragma unroll
                for (int jh = 0; jh < 2; ++jh) { const unsigned w2[2] = {yw[t][k][jh].x, yw[t][k][jh].y};
#pragma unroll
                    for (int q = 0; q < 2; ++q) { const f32x2_t lo = __builtin_amdgcn_cvt_pk_f32_fp8((int)w2[q], false), hi = __builtin_amdgcn_cvt_pk_f32_fp8((int)w2[q], true);
                        m[8 * jh + 4 * q] += gg * lo.x; m[8 * jh + 4 * q + 1] += gg * lo.y; m[8 * jh + 4 * q + 2] += gg * hi.x; m[8 * jh + 4 * q + 3] += gg * hi.y; } } }
#pragma unroll
            for (int jh = 0; jh < 2; ++jh) { const unsigned x4[4] = {xw[t][jh].x, xw[t][jh].y, xw[t][jh].z, xw[t][jh].w};
#pragma unroll
                for (int q = 0; q < 4; ++q) { v[8 * jh + 2 * q] = __uint_as_float(x4[q] << 16); v[8 * jh + 2 * q + 1] = __uint_as_float(x4[q] & 0xffff0000u); } }
#pragma unroll
            for (int i = 0; i < 16; ++i) v[i] += g2v[i] * m[i];
            if (l == 0) {
#pragma unroll
                for (int jh = 0; jh < 2; ++jh) *(v4u*)(XB + (size_t)rr * D + 512 * jh + 8 * lane) = (v4u){pk_bf16(v[8 * jh], v[8 * jh + 1]), pk_bf16(v[8 * jh + 2], v[8 * jh + 3]), pk_bf16(v[8 * jh + 4], v[8 * jh + 5]), pk_bf16(v[8 * jh + 6], v[8 * jh + 7])};
                float s = 0.f;
#pragma unroll
                for (int i2 = 0; i2 < 16; ++i2) s += v[i2] * v[i2];
                const float rstd = rsqrtf(wave_sum(s) * (1.0f / D) + 1e-6f);
#pragma unroll
                for (int jh = 0; jh < 2; ++jh) { float hv[8];
#pragma unroll
                    for (int c = 0; c < 8; ++c) hv[c] = v[8 * jh + c] * rstd * scv[8 * jh + c] + shv[8 * jh + c];
                    *(v4u*)(H + (size_t)rr * D + 512 * jh + 8 * lane) = (v4u){pk_bf16(hv[0], hv[1]), pk_bf16(hv[2], hv[3]), pk_bf16(hv[4], hv[5]), pk_bf16(hv[6], hv[7])}; }
            } else {
#pragma unroll
                for (int jh = 0; jh < 2; ++jh)
#pragma unroll
                    for (int q = 0; q < 2; ++q) *(f32x4*)(a.out + (size_t)rr * D + 512 * jh + 8 * lane + 4 * q) = (f32x4){v[8 * jh + 4 * q], v[8 * jh + 4 * q + 1], v[8 * jh + 4 * q + 2], v[8 * jh + 4 * q + 3]};
            } } }
#pragma unroll
        for (int t = 0; t < 2; ++t)
#pragma unroll
            for (int k = 0; k < 4; ++k) { sv[t][k] = nsv[t][k]; gk[t][k] = ngk[t][k]; }
    }
}
struct EpiInProj1 {
    static constexpr bool PERM = true;
    bf16* Gt; bf16* U;
    __device__ __forceinline__ void operator()(const f32x4 (&acc)[2][2][4][2], const pg8::Unit& u, int wr, int wc, int fr, int fq) const {
        const int row0 = u.pm * 256 + wr * 64 + fr; const bool gate = u.pn < 4;
        bf16* dst = gate ? Gt : U; const int col0 = (u.pn & 3) * 256 + wc * 32 + 8 * fq;
#pragma unroll
        for (int ai = 0; ai < 2; ++ai)
#pragma unroll
            for (int m = 0; m < 4; ++m) { bf16* rowp = dst + (size_t)(row0 + ai * 128 + m * 16) * D + col0;
#pragma unroll
                for (int bj = 0; bj < 2; ++bj) { f32x4 v0 = acc[ai][bj][m][0], v1 = acc[ai][bj][m][1];
                    if (gate) {
#pragma unroll
                        for (int j = 0; j < 4; ++j) { const float x = v0[j]; v0[j] = x * __builtin_amdgcn_rcpf(1.0f + __expf(-1.5957691216f * (x + 0.044715f * x * x * x)));
                                                      const float y = v1[j]; v1[j] = y * __builtin_amdgcn_rcpf(1.0f + __expf(-1.5957691216f * (y + 0.044715f * y * y * y))); } }
                    v4u w; w.x = pg8::cvt_pk_bf16(v0[0], v0[1]); w.y = pg8::cvt_pk_bf16(v0[2], v0[3]); w.z = pg8::cvt_pk_bf16(v1[0], v1[1]); w.w = pg8::cvt_pk_bf16(v1[2], v1[3]);
                    *(v4u*)(rowp + bj * 128) = w; } }
    }
};
__device__ __forceinline__ void p_inproj1(const CAS Args& a, const Frame& F) {
    if (F.bid >= F.G - INP1_NC) { convert_experts(a, F, 1, 0, 2, (F.bid - (F.G - INP1_NC)) * NWAVES + F.wave, INP1_NC * NWAVES, CV_E2, NE); return; }
    pg8::RectSched S{(const char*)(a.ws + WS_H), (const char*)(a.ws + WS_WIN1), 2 * D, NT / 256, 8, F.G - INP1_NC, F.bid, NC / 256, 4, NT / 256, 4};
    EpiInProj1 E{(bf16*)(a.ws + WS_G), (bf16*)(a.ws + WS_U)};
    pg8::gemm_phase<2 * D, false>(F.ldsl, S, E, F.wave);
}
__device__ __forceinline__ void p_conv4(const CAS Args& a, const Frame& F) {
    const bf16* U = (const bf16*)(a.ws + WS_U); bf16* UC = (bf16*)(a.ws + WS_UC);
    for (int u = F.gw; u < (R / 8) * 2; u += F.ngw) {
        const int rb = u >> 1, ch0 = (u & 1) * 512 + 8 * F.lane, row0 = rb * 8;
        const bool lat = row0 < NT; const int t0 = lat ? (row0 & 2047) : ((row0 - NT) & 255), len = lat ? 2048 : 256;
        float cw[4][8], cbv[8];
#pragma unroll
        for (int q = 0; q < 8; ++q) { cbv[q] = a.in[18][ch0 + q];
#pragma unroll
            for (int k = 0; k < 4; ++k) cw[k][q] = a.in[17][k * D + ch0 + q]; }
        v4u uv[11];
#pragma unroll
        for (int k = 0; k < 11; ++k) { const int tt = t0 + k - 1; uv[k] = (tt >= 0 && tt < len) ? *(const v4u*)(U + (size_t)(row0 + k - 1) * D + ch0) : (v4u){0u, 0u, 0u, 0u}; }
#pragma unroll
        for (int i = 0; i < 8; ++i) {
            float acc[8];
#pragma unroll
            for (int q = 0; q < 8; ++q) acc[q] = cbv[q];
#pragma unroll
            for (int k = 0; k < 4; ++k) { const unsigned w[4] = {uv[i + k].x, uv[i + k].y, uv[i + k].z, uv[i + k].w};
#pragma unroll
                for (int q = 0; q < 4; ++q) { acc[2 * q] += cw[k][2 * q] * __uint_as_float(w[q] << 16); acc[2 * q + 1] += cw[k][2 * q + 1] * __uint_as_float(w[q] & 0xffff0000u); } }
            *(v4u*)(UC + (size_t)(row0 + i) * D + ch0) = (v4u){pk_bf16(acc[0], acc[1]), pk_bf16(acc[2], acc[3]), pk_bf16(acc[4], acc[5]), pk_bf16(acc[6], acc[7])};
        }
    }
}
constexpr int LR_A = 0, LR_SC = 65536, LR_AG = 131072, LR_CY = LR_AG + 8192;
__device__ __forceinline__ void p_lru(const CAS Args& a, const Frame& F) {
    const bf16* UC = (const bf16*)(a.ws + WS_UC); const bf16* WL = (const bf16*)(a.ws + WS_WLRU); const bf16* Gt = (const bf16*)(a.ws + WS_G);
    bf16* HF = (bf16*)(a.ws + WS_HF); bf16* A3 = (bf16*)(a.ws + WS_A3);
    LAS unsigned char* lds = F.ldsl;
    const int lane_ = F.lane, wave = F.wave, sub = wave & 3, th = wave >> 2;
    for (int wu = F.bid; wu < 256; wu += F.G) {
        const int b = wu >> 4, h = (wu >> 2) & 3, cg = wu & 3;
        for (int dir = 0; dir < 2; ++dir) {
            const int lane = lane_, rho = lane & 15, g = lane >> 4;
            bf16x8 bw[2][8];
#pragma unroll
            for (int n = 0; n < 2; ++n)
#pragma unroll
                for (int ks = 0; ks < 8; ++ks) bw[n][ks] = *(const bf16x8*)(WL + ((size_t)h * 1024 + (2 * dir + n) * 256 + cg * 64 + 16 * sub + rho) * 256 + 32 * ks + 8 * g);
            const int chc = h * 256 + cg * 64 + 16 * sub + rho;
            const float bav = (dir ? a.in[25] : a.in[20])[chc] * -1.44269504f, bxv = (dir ? a.in[27] : a.in[22])[chc] * -1.44269504f;
            const float lamv = (dir ? a.in[28] : a.in[23])[chc];
            const float L8 = -8.0f * log1pf(expf(-lamv)) * 1.44269504f;
            __syncthreads();
            if (wave == 0) ((LAS float*)(lds + LR_CY))[lane] = 0.f;
#define LR_GROW0(ck_) ((ck_) < 2 ? (size_t)(NT + b * 256 + 128 * (dir ? 1 - (ck_) : (ck_))) : (size_t)(b * 2048 + 128 * (dir ? 15 - ((ck_) - 2) : (ck_) - 2)))
#define LR_STAGE(ck_) do { const size_t g0_ = LR_GROW0(ck_); _Pragma("unroll") for (int p_ = 0; p_ < 8; ++p_) { const int pc_ = wave * 8 + p_, row_ = 2 * pc_ + (lane >> 5), c_ = (lane & 31) ^ (row_ & 15); \
                __builtin_amdgcn_global_load_lds((const unsigned*)((const char*)UC + (g0_ + row_) * (D * 2) + h * 512 + 16 * c_), (LAS unsigned*)(lds + LR_A + pc_ * 1024), 16, 0, 0); } } while (0)
            LR_STAGE(0);
            for (int ck = 0; ck < 18; ++ck) {
                const bool isctx = ck < 2;
                const size_t grow0 = LR_GROW0(ck);
                int lane = lane_; asm volatile("" : "+v"(lane)); const int rho = lane & 15, g = lane >> 4, chs = h * 256 + cg * 64 + lane, ucol = cg * 64 + 16 * sub + rho;
                asm volatile("s_waitcnt vmcnt(0)" ::: "memory");
                __syncthreads();
                const int row0 = dir ? 112 - 16 * wave : 16 * wave;
                v4u hfr[2] = {(v4u){0u, 0u, 0u, 0u}, (v4u){0u, 0u, 0u, 0u}}, gtr[2] = {(v4u){0u, 0u, 0u, 0u}, (v4u){0u, 0u, 0u, 0u}};
                if (dir && !isctx) {
#pragma unroll
                    for (int t = 0; t < 2; ++t) { const int tk = lane + 64 * t; const size_t gi = (grow0 + row0 + (tk >> 3)) * D + h * 256 + cg * 64 + 8 * (tk & 7);
                        hfr[t] = *(const v4u*)(HF + gi); gtr[t] = *(const v4u*)(Gt + gi); } }
                {
                    f32x4 acc[4][2];
#pragma unroll
                    for (int m = 0; m < 4; ++m)
#pragma unroll
                        for (int n = 0; n < 2; ++n) acc[m][n] = (f32x4){0.f, 0.f, 0.f, 0.f};
#pragma unroll
                    for (int ks = 0; ks < 8; ++ks)
#pragma unroll
                        for (int m = 0; m < 4; ++m) { const int rw = 64 * th + 16 * m + rho; const bf16x8 af = *(const LAS bf16x8*)(lds + LR_A + rw * 512 + (((4 * ks + g) ^ (rw & 15)) << 4));
#pragma unroll
                            for (int n = 0; n < 2; ++n) acc[m][n] = __builtin_amdgcn_mfma_f32_16x16x32_bf16(af, bw[n][ks], acc[m][n], 0, 0, 0);
                            if (m == 3 && (ks & 1)) asm volatile("" ::: "memory"); }
#pragma unroll
                    for (int m = 0; m < 4; ++m)
#pragma unroll
                        for (int p = 0; p < 2; ++p) {
                            const int row = 64 * th + 16 * m + 4 * g + 2 * p;
                            f32x2_t uc;
                            uc.x = bf2f(*(const LAS bf16*)(lds + LR_A + row * 512 + (((ucol >> 3) ^ (row & 15)) << 4) + 2 * (ucol & 7)));
                            uc.y = bf2f(*(const LAS bf16*)(lds + LR_A + (row + 1) * 512 + (((ucol >> 3) ^ ((row + 1) & 15)) << 4) + 2 * (ucol & 7)));
                            const f32x2_t xa = (f32x2_t){acc[m][0][2 * p], acc[m][0][2 * p + 1]} * -1.44269504f + bav, xx = (f32x2_t){acc[m][1][2 * p], acc[m][1][2 * p + 1]} * -1.44269504f + bxv;
                            f32x2_t da, dx; da.x = __builtin_amdgcn_exp2f(xa.x); da.y = __builtin_amdgcn_exp2f(xa.y); dx.x = __builtin_amdgcn_exp2f(xx.x); dx.y = __builtin_amdgcn_exp2f(xx.y);
                            da = da + 1.0f; dx = dx + 1.0f;
                            f32x2_t rr, ii; rr.x = __builtin_amdgcn_rcpf(da.x); rr.y = __builtin_amdgcn_rcpf(da.y); ii.x = __builtin_amdgcn_rcpf(dx.x); ii.y = __builtin_amdgcn_rcpf(dx.y);
                            const f32x2_t la = rr * L8;
                            f32x2_t av; av.x = __builtin_amdgcn_exp2f(la.x); av.y = __builtin_amdgcn_exp2f(la.y);
                            f32x2_t tt = 1.0f - av * av; tt.x = fmaxf(tt.x, 0.f); tt.y = fmaxf(tt.y, 0.f);
                            f32x2_t sq; sq.x = __builtin_amdgcn_sqrtf(tt.x); sq.y = __builtin_amdgcn_sqrtf(tt.y);
                            const f32x2_t bv = sq * ii * uc;
                            *(LAS f32x2_t*)(lds + LR_SC + (row * 64 + 16 * sub + rho) * 8) = (f32x2_t){av.x, bv.x};
                            *(LAS f32x2_t*)(lds + LR_SC + ((row + 1) * 64 + 16 * sub + rho) * 8) = (f32x2_t){av.y, bv.y};
                        }
                }
                __syncthreads();
                asm volatile("s_waitcnt vmcnt(0)" : "+v"(hfr[0]), "+v"(hfr[1]), "+v"(gtr[0]), "+v"(gtr[1]) :: "memory");
                if (ck + 1 < 18) LR_STAGE(ck + 1);
                f32x2_t ab[16];
                {
#pragma unroll
                    for (int q = 0; q < 16; ++q) { const int s = 16 * wave + q, row = dir ? 127 - s : s; ab[q] = *(const LAS f32x2_t*)(lds + LR_SC + (row * 64 + lane) * 8); }
                    float hl = 0.f, pr = 1.f;
#pragma unroll
                    for (int q = 0; q < 16; ++q) { hl = ab[q].x * hl + ab[q].y; pr *= ab[q].x; ab[q] = (f32x2_t){pr, hl}; }
                    *(LAS f32x2_t*)(lds + LR_AG + ((ck & 1) * 512 + wave * 64 + lane) * 8) = (f32x2_t){pr, hl};
                }
                asm volatile("s_waitcnt lgkmcnt(0)" ::: "memory"); __builtin_amdgcn_s_barrier(); asm volatile("" ::: "memory");
                {
                    float c = ((const LAS float*)(lds + LR_CY))[(ck & 1) * 64 + lane], cin = 0.f;
#pragma unroll
                    for (int w2 = 0; w2 < 8; ++w2) { if (w2 == wave) cin = c; const f32x2_t ag = *(const LAS f32x2_t*)(lds + LR_AG + ((ck & 1) * 512 + w2 * 64 + lane) * 8); c = ag.x * c + ag.y; }
                    if (wave == 0) ((LAS float*)(lds + LR_CY))[((ck + 1) & 1) * 64 + lane] = c;
                    if (!isctx) {
                        LAS unsigned char* scr = lds + LR_SC + row0 * 512;
                        if (dir) {
#pragma unroll
                            for (int t = 0; t < 2; ++t) { const int tk = lane + 64 * t; *(LAS v4u*)(scr + tk * 16) = hfr[t]; *(LAS v4u*)(scr + 2048 + tk * 16) = gtr[t]; }
                        }
#pragma unroll
                        for (int q = 0; q < 16; ++q) { const int tr = dir ? 15 - q : q;
                            float hv = ab[q].y + ab[q].x * cin;
                            if (dir) hv = (bf2f(*(const LAS bf16*)(scr + (tr * 64 + lane) * 2)) + hv) * bf2f(*(const LAS bf16*)(scr + 2048 + (tr * 64 + lane) * 2));
                            *(LAS bf16*)(scr + 4096 + (tr * 64 + lane) * 2) = f2bf(hv); }
                        bf16* dstp = dir ? A3 : HF;
#pragma unroll
                        for (int t = 0; t < 2; ++t) { const int tk = lane + 64 * t; const size_t gi = (grow0 + row0 + (tk >> 3)) * D + h * 256 + cg * 64 + 8 * (tk & 7);
                            *(v4u*)(dstp + gi) = *(const LAS v4u*)(scr + 4096 + tk * 16); }
                    }
                }
            }
#undef LR_STAGE
#undef LR_GROW0
        }
    }
}

constexpr int LDS_BYTES = 163840;
constexpr int NPHASE = 17;
template <unsigned KMASK>
__global__ void __launch_bounds__(NWAVES * 64, 2) fwd(Args kargs) {
    extern __shared__ __attribute__((aligned(16))) unsigned char lds[];
    const int wave_s = __builtin_amdgcn_readfirstlane((int)threadIdx.x >> 6);
    const int tid0 = wave_s * 64 + lane_id_fresh();
    volatile LAS unsigned* misc = (volatile LAS unsigned*)((LAS unsigned char*)lds + (LDS_BYTES - 64));
    if (tid0 < 16) misc[tid0] = 0u;
    __syncthreads();
    const int lo = kargs.ph_lo, hi = kargs.ph_hi;
    XcdBarrier bar; bar.bar = (unsigned*)(kargs.ws + WS_CTL) + CW_BAR + kargs.li * XCD_BAR_WORDS; bar.x = 0; bar.st = misc;
    if (hi - lo > 1) bar = xcd_barrier_post((unsigned*)(kargs.ws + WS_CTL) + CW_BAR + kargs.li * XCD_BAR_WORDS, misc, tid0);
#ifndef ONLY_PHASE
#define ONLY_PHASE -1
#endif
#ifndef PHASE_MASK
#define PHASE_MASK 0xFFFFFFFFu
#endif
#ifndef REPMASK
#define REPMASK 0u
#endif
#define PH(k, body) if constexpr (((KMASK >> (k)) & 1u) != 0u) if ((ONLY_PHASE < 0 || ONLY_PHASE == (k)) && ((PHASE_MASK >> (k)) & 1u) && lo <= (k) && (k) < hi) { \
        const CAS Args* ap_ = (const CAS Args*)__builtin_amdgcn_kernarg_segment_ptr(); asm volatile("" : "+s"(ap_)); const CAS Args& args = *ap_; \
        Frame F; F.lds = lds; F.ldsl = (LAS unsigned char*)lds; F.wave = wave_s; F.lane = lane_id_fresh(); \
        F.tid = F.wave * 64 + F.lane; F.G = gridDim.x; F.bid = blockIdx.x; F.gw = F.bid * NWAVES + F.wave; F.ngw = F.G * NWAVES; \
        if (((REPMASK >> (k)) & 1u) == 0u) { body; } else { int nrep_ = 2; asm volatile("" : "+s"(nrep_)); for (int rep_ = 0; rep_ < nrep_; ++rep_) { body; asm volatile("s_waitcnt vmcnt(0)" ::: "memory"); __syncthreads(); } } if ((k) + 1 < hi) xcd_barrier(bar, F.tid); else { asm volatile("s_waitcnt vmcnt(0)" ::: "memory"); __syncthreads(); } }
    PH(0, p0_prologue(args, F))
    PH(1, p_norm1_l0(args, F))
    PH(2, p_inproj0(args, F))
    PH(3, p_attn(args, F))
    PH(4, p_outproj<0>(args, F))
    PH(5, p_norm2_router(args, F, 0))
    PH(6, p_moe_up(args, F, 0))
    PH(7, p_moe_down(args, F, 0))
    PH(8, p_combine(args, F, 0))
    PH(9, p_inproj1(args, F))
    PH(10, p_conv4(args, F))
    PH(11, p_lru(args, F))
    PH(12, p_outproj<1>(args, F))
    PH(13, p_norm2_router(args, F, 1))
    PH(14, p_moe_up(args, F, 1))
    PH(15, p_moe_down(args, F, 1))
    PH(16, p_combine(args, F, 1))
#undef PH
}

constexpr unsigned MASK_A = (1u<<2)|(1u<<4)|(1u<<6)|(1u<<7)|(1u<<9)|(1u<<11)|(1u<<13)|(1u<<14), MASK_C = 1u << 3, MASK_D = 1u << 10, MASK_ALL = 0x1FFFFu, MASK_B = MASK_ALL & ~(MASK_A | MASK_C | MASK_D);
__host__ inline int kid_of(int p) { return ((MASK_A >> p) & 1u) ? 0 : ((MASK_C >> p) & 1u) ? 2 : ((MASK_D >> p) & 1u) ? 3 : 1; }
extern "C" void kernel_launch(void* const* d_in, const int* in_sizes, int n_in, void* d_out, int out_size, void* d_ws, size_t ws_size, hipStream_t stream) {
    static int grid = 0;
    if (grid == 0) {
        if (n_in != 37 || out_size != NT * D || ws_size < WS_END) { fprintf(stderr, "kernel_launch: unexpected shapes (n_in %d out %d ws %zu)\n", n_in, out_size, ws_size); grid = -1; return; }
        int dev = 0, cus = 0;
        if (hipGetDevice(&dev) != hipSuccess || hipDeviceGetAttribute(&cus, hipDeviceAttributeMultiprocessorCount, dev) != hipSuccess) { grid = -1; return; }
#ifndef MULTI_LAUNCH
        if (hipFuncSetAttribute((const void*)fwd<MASK_ALL>, hipFuncAttributeMaxDynamicSharedMemorySize, LDS_BYTES) != hipSuccess) { fprintf(stderr, "kernel_launch: hipFuncSetAttribute failed\n"); grid = -1; return; }
#else
        if (hipFuncSetAttribute((const void*)fwd<MASK_A>, hipFuncAttributeMaxDynamicSharedMemorySize, LDS_BYTES) != hipSuccess) { fprintf(stderr, "kernel_launch: hipFuncSetAttribute failed\n"); grid = -1; return; }
        if (hipFuncSetAttribute((const void*)fwd<MASK_B>, hipFuncAttributeMaxDynamicSharedMemorySize, LDS_BYTES) != hipSuccess) { fprintf(stderr, "kernel_launch: hipFuncSetAttribute failed\n"); grid = -1; return; }
        if (hipFuncSetAttribute((const void*)fwd<MASK_C>, hipFuncAttributeMaxDynamicSharedMemorySize, LDS_BYTES) != hipSuccess) { fprintf(stderr, "kernel_launch: hipFuncSetAttribute failed\n"); grid = -1; return; }
        if (hipFuncSetAttribute((const void*)fwd<MASK_D>, hipFuncAttributeMaxDynamicSharedMemorySize, LDS_BYTES) != hipSuccess) { fprintf(stderr, "kernel_launch: hipFuncSetAttribute failed\n"); grid = -1; return; }
#endif
        (void)hipGetLastError();
        grid = cus;
    }
    if (grid < 0) return;
    if (hipMemsetAsync((char*)d_ws + WS_CTL, 0, CTL_ZERO_BYTES, stream) != hipSuccess) return;
    Args a{};
    for (int i = 0; i < 37; ++i) a.in[i] = (const float*)d_in[i];
    a.out = (float*)d_out; a.ws = (unsigned char*)d_ws;
#ifdef MULTI_LAUNCH
    int p = 0, li = 0;
    while (p < NPHASE) {
        const int kid = kid_of(p); int q = p + 1;
        while (q < NPHASE && kid_of(q) == kid) ++q;
        a.ph_lo = p; a.ph_hi = q; a.li = li++;
        if (kid == 0) hipLaunchKernelGGL(fwd<MASK_A>, dim3(grid), dim3(NWAVES * 64), LDS_BYTES, stream, a);
        else if (kid == 1) hipLaunchKernelGGL(fwd<MASK_B>, dim3(grid), dim3(NWAVES * 64), LDS_BYTES, stream, a);
        else if (kid == 2) hipLaunchKernelGGL(fwd<MASK_C>, dim3(grid), dim3(NWAVES * 64), LDS_BYTES, stream, a);
        else hipLaunchKernelGGL(fwd<MASK_D>, dim3(grid), dim3(NWAVES * 64), LDS_BYTES, stream, a);
        p = q;
    }
#else
    a.ph_lo = 0; a.ph_hi = NPHASE; a.li = 0;
    hipLaunchKernelGGL(fwd<MASK_ALL>, dim3(grid), dim3(NWAVES * 64), LDS_BYTES, stream, a);
#endif
}
```

```cpp
#include <hip/hip_runtime.h>
#include <stdint.h>
#include <stdio.h>

constexpr int D = 1024, NB = 16, SEQ = 2048, NT = NB * SEQ, LC = 256, NC = NB * LC, R = NT + NC;
constexpr int NE = 32, CAP = R;
constexpr int NWAVES = 8;

typedef unsigned short bf16;
typedef short bf16x8 __attribute__((ext_vector_type(8)));
typedef float f32x4 __attribute__((ext_vector_type(4)));
typedef unsigned v4u __attribute__((ext_vector_type(4)));
#define LAS __attribute__((address_space(3)))
#define CAS __attribute__((address_space(4)))
#define RLX_AGENT __ATOMIC_RELAXED, __HIP_MEMORY_SCOPE_AGENT

constexpr size_t MiB = 1u << 20;
constexpr size_t WS_CTL = 0, CTL_ZERO_BYTES = 1 * MiB;
constexpr size_t WS_MOD = 1 * MiB;
constexpr size_t WS_WIN0 = 2 * MiB, WS_WOUT0 = 8 * MiB, WS_WIN1 = 10 * MiB, WS_WOUT1 = 14 * MiB, WS_WLRU = 16 * MiB;
constexpr size_t WS_TOKLIST = 18 * MiB;
constexpr size_t WS_SEL = 23 * MiB;
constexpr size_t WS_GATEV = 24 * MiB;
constexpr size_t WS_XC = 25 * MiB;
constexpr size_t WS_WEXP = 41 * MiB;
constexpr size_t WS_H = 233 * MiB;
constexpr size_t WS_P = 305 * MiB;
constexpr int PP = 2560;
constexpr size_t WS_A2 = 521 * MiB;
constexpr size_t WS_ACT = 593 * MiB;
constexpr size_t WS_YB = 305 * MiB;
constexpr size_t WS_G = 305 * MiB;
constexpr size_t WS_U = 369 * MiB;
constexpr size_t WS_UC = 441 * MiB;
constexpr size_t WS_AF = 513 * MiB;
constexpr size_t WS_AB = 657 * MiB;
constexpr size_t WS_HF = WS_AF;
constexpr size_t WS_A3 = WS_AB;
constexpr size_t WS_BF = 801 * MiB;
constexpr size_t WS_BB = 873 * MiB;
constexpr size_t WS_GS2 = 840 * MiB;
constexpr size_t WS_XB = 760 * MiB;
constexpr size_t WS_END = 945 * MiB;
constexpr int CW_BAR = 4096;
constexpr int CW_CNT = 65536;

typedef __bf16 bf16x2_t __attribute__((ext_vector_type(2)));
typedef float f32x2_t __attribute__((ext_vector_type(2)));
__device__ __forceinline__ unsigned pk_bf16(float a, float b) { f32x2_t v = {a, b}; bf16x2_t r = __builtin_convertvector(v, bf16x2_t); return __builtin_bit_cast(unsigned, r); }
__device__ __forceinline__ float bf2f(bf16 v) { return __uint_as_float(((unsigned)v) << 16); }
__device__ __forceinline__ bf16 f2bf(float f) { unsigned u = __float_as_uint(f); return (bf16)((u + 0x7fffu + ((u >> 16) & 1u)) >> 16); }
__device__ __forceinline__ unsigned pk2(float lo, float hi) { return (unsigned)f2bf(lo) | ((unsigned)f2bf(hi) << 16); }
__device__ __forceinline__ int lane_id_fresh() { int l; asm volatile("v_mbcnt_lo_u32_b32 %0, -1, 0\n\tv_mbcnt_hi_u32_b32 %0, -1, %0" : "=v"(l)); return l; }
__device__ __forceinline__ unsigned pk4_fp8(float a, float b, float c, float d) {
    a = fminf(fmaxf(a, -448.f), 448.f); b = fminf(fmaxf(b, -448.f), 448.f); c = fminf(fmaxf(c, -448.f), 448.f); d = fminf(fmaxf(d, -448.f), 448.f);
    unsigned w = 0u; w = __builtin_amdgcn_cvt_pk_fp8_f32(a, b, w, false); w = __builtin_amdgcn_cvt_pk_fp8_f32(c, d, w, true); return w;
}
constexpr float W8_SCALE = 32.0f, ACT8_SCALE = 4.0f, YB8_SCALE = 16.0f;
__device__ __forceinline__ float wave_sum(float v) {
#pragma unroll
    for (int o = 1; o < 64; o <<= 1) v += __shfl_xor(v, o);
    return v;
}
__device__ __forceinline__ float wave_max(float v) {
#pragma unroll
    for (int o = 1; o < 64; o <<= 1) v = fmaxf(v, __shfl_xor(v, o));
    return v;
}
__device__ __forceinline__ float sigmoidf_(float x) { return 1.0f / (1.0f + __expf(-x)); }
__device__ __forceinline__ float gelu_tanh(float x) { return 0.5f * x * (1.0f + tanhf(0.7978845608028654f * (x + 0.044715f * x * x * x))); }

#define XB_TMO      128
#define XB_XCNT(j)  (256  + 64 * (j))
#define XB_XSUB(j)  (1280 + 64 * (j))
#define XB_XGEN(j)  (2304 + 64 * (j))
#define XB_TOP      3328
#define XB_TOPGEN   3392
#define XCD_BAR_WORDS 3456
#define XB_SPIN_CAP (1u << 18)
__device__ __forceinline__ unsigned xb_ld(unsigned* p)              { return __hip_atomic_load(p, __ATOMIC_RELAXED, __HIP_MEMORY_SCOPE_AGENT); }
__device__ __forceinline__ unsigned xb_add(unsigned* p, unsigned v) { return __hip_atomic_fetch_add(p, v, __ATOMIC_RELAXED, __HIP_MEMORY_SCOPE_AGENT); }
__device__ __forceinline__ unsigned xb_xcc_id() { return (unsigned)__builtin_amdgcn_s_getreg((3 << 11) | 20) & 0xFu; }
#define XB_SPIN(cond, bar) do { unsigned _sp = 0; while (cond) { __builtin_amdgcn_s_sleep(1); \
    if ((++_sp & 255u) == 0u) { if (xb_ld(&(bar)[XB_TMO])) break; if (_sp > XB_SPIN_CAP) { atomicAdd(&(bar)[XB_TMO], 1u); break; } } } } while (0)
struct XcdBarrier { unsigned* bar; unsigned x; volatile LAS unsigned* st; };
__device__ __forceinline__ XcdBarrier xcd_barrier_post(unsigned* bar, volatile LAS unsigned* st, int tid) {
    XcdBarrier b; b.bar = bar; b.x = xb_xcc_id(); b.st = st;
    if (tid == 0) (void)xb_add(&bar[XB_XCNT(b.x)], 1u);
    return b;
}
__device__ __forceinline__ void xcd_barrier_complete(unsigned* bar, unsigned x, unsigned& nloc, unsigned& nx) {
    const unsigned G = gridDim.x * gridDim.y * gridDim.z;
    unsigned sum, cnt, mine, sp = 0u;
    for (;;) {
        sum = 0u; cnt = 0u; mine = 0u;
#pragma unroll
        for (unsigned j = 0; j < 16; ++j) { const unsigned c = xb_ld(&bar[XB_XCNT(j)]); sum += c; cnt += (c > 0u) ? 1u : 0u; mine = (j == x) ? c : mine; }
        if (sum == G) break;
        __builtin_amdgcn_s_sleep(1);
        if ((++sp & 255u) == 0u) { if (xb_ld(&bar[XB_TMO])) break; if (sp > XB_SPIN_CAP) { atomicAdd(&bar[XB_TMO], 1u); break; } }
    }
    nloc = mine > 0u ? mine : 1u; nx = cnt > 0u ? cnt : 1u;
}
__device__ __forceinline__ void xcd_barrier(const XcdBarrier& b, int tid) {
    asm volatile("s_waitcnt vmcnt(0)" ::: "memory");
    __syncthreads();
    if (tid == 0) {
        unsigned* bar = b.bar;
        __builtin_amdgcn_s_waitcnt(0);
        unsigned nloc = b.st[0], nx = b.st[1];
        if (nloc == 0u) { xcd_barrier_complete(bar, b.x, nloc, nx); b.st[0] = nloc; b.st[1] = nx; }
        const unsigned old = xb_add(&bar[XB_XSUB(b.x)], 1u);
        const unsigned gen = old / nloc;
        if (old + 1u == (gen + 1u) * nloc) {
            __builtin_amdgcn_fence(__ATOMIC_RELEASE, "agent");
            asm volatile("s_waitcnt vmcnt(0)" ::: "memory");
            const unsigned og = xb_add(&bar[XB_TOP], 1u);
            const unsigned tg = og / nx;
            if (og + 1u == (tg + 1u) * nx) xb_add(&bar[XB_TOPGEN], 1u);
            else XB_SPIN(xb_ld(&bar[XB_TOPGEN]) == tg, bar);
            __builtin_amdgcn_fence(__ATOMIC_ACQUIRE, "agent");
            xb_add(&bar[XB_XGEN(b.x)], 1u);
            asm volatile("s_waitcnt vmcnt(0)" ::: "memory");
        } else {
            XB_SPIN(xb_ld(&bar[XB_XGEN(b.x)]) == gen, bar);
            __builtin_amdgcn_fence(__ATOMIC_ACQUIRE, "agent");
            asm volatile("s_waitcnt vmcnt(0)" ::: "memory");
        }
    }
    __syncthreads();
}

struct Args { const float* in[37]; float* out; unsigned char* ws; int ph_lo, ph_hi, li, pad; };
struct Frame {
    unsigned char* lds;
    LAS unsigned char* ldsl;
    int tid, lane, wave, gw, ngw, G, bid;
};

template <int NS, class FA, class FB, class FS>
__device__ __forceinline__ void tile_gemm32(int K, FA arow, FB brow, FS store, int lane) {
    const int lr = lane & 15, lq = lane >> 4;
    const bf16* ap[2]; const bf16* bp[NS][2];
#pragma unroll
    for (int i = 0; i < 2; ++i) ap[i] = arow(16 * i + lr) + 8 * lq;
#pragma unroll
    for (int s = 0; s < NS; ++s)
#pragma unroll
        for (int j = 0; j < 2; ++j) bp[s][j] = brow(s, 16 * j + lr) + 8 * lq;
    f32x4 acc[NS][2][2];
#pragma unroll
    for (int s = 0; s < NS; ++s)
#pragma unroll
        for (int i = 0; i < 2; ++i)
#pragma unroll
            for (int j = 0; j < 2; ++j) acc[s][i][j] = (f32x4){0.f, 0.f, 0.f, 0.f};
#pragma nounroll
    for (int k0 = 0; k0 < K; k0 += 32) {
        bf16x8 a[2], b[NS][2];
#pragma unroll
        for (int i = 0; i < 2; ++i) a[i] = *(const bf16x8*)(ap[i] + k0);
#pragma unroll
        for (int s = 0; s < NS; ++s)
#pragma unroll
            for (int j = 0; j < 2; ++j) b[s][j] = *(const bf16x8*)(bp[s][j] + k0);
#pragma unroll
        for (int s = 0; s < NS; ++s)
#pragma unroll
            for (int i = 0; i < 2; ++i)
#pragma unroll
                for (int j = 0; j < 2; ++j) acc[s][i][j] = __builtin_amdgcn_mfma_f32_16x16x32_bf16(a[i], b[s][j], acc[s][i][j], 0, 0, 0);
    }
#pragma unroll
    for (int i = 0; i < 2; ++i)
#pragma unroll
        for (int j = 0; j < 2; ++j)
#pragma unroll
            for (int q = 0; q < 4; ++q) {
                float v[NS];
#pragma unroll
                for (int s = 0; s < NS; ++s) v[s] = acc[s][i][j][q];
                store(16 * i + 4 * lq + q, 16 * j + lr, v);
            }
}


namespace pg8 {
constexpr int BM = 256, BK = 64, HALF = 128, HTB = HALF * BK * 2, STAGE_BYTES = 8 * HTB;
__device__ __forceinline__ int lds_byte(int r, int c) { const int st = (r >> 4) * 2 + (c >> 5), rr = r & 15, cc = c & 31, ob = rr * 64 + cc * 2; return st * 1024 + (ob ^ (((ob >> 9) & 1) << 5)); }
__device__ __forceinline__ void stage_rc(int b, int& R_, int& C_) { const int st = b / 1024, sb = b % 1024, swz = sb ^ (((sb >> 9) & 1) << 5); R_ = (st >> 1) * 16 + swz / 64; C_ = (st & 1) * 32 + (swz % 64) / 2; }
__device__ __forceinline__ int perm32(int rho) { const int n = rho >> 4, i = rho & 15; return 8 * (i >> 2) + 4 * n + (i & 3); }
struct Unit { int pm, pn, e, rows, base, newe; };
typedef int v8i __attribute__((ext_vector_type(8)));
typedef int v4i __attribute__((ext_vector_type(4)));
__device__ __forceinline__ void mfma8(f32x4& acc, v8i a, v8i b, unsigned sc) {
    asm volatile("v_mfma_scale_f32_16x16x128_f8f6f4 %0, %1, %2, %0, %3, %3 op_sel_hi:[0,0,0]" : "+v"(acc) : "v"(a), "v"(b), "v"(sc));
}
__device__ __forceinline__ v8i cat8(bf16x8 a, bf16x8 b) { return __builtin_shufflevector(__builtin_bit_cast(v4i, a), __builtin_bit_cast(v4i, b), 0, 1, 2, 3, 4, 5, 6, 7); }
__device__ __forceinline__ unsigned cvt_pk_bf16(float lo, float hi) { unsigned r; asm volatile("v_cvt_pk_bf16_f32 %0, %1, %2" : "=v"(r) : "v"(lo), "v"(hi)); return r; }

template <int RB  , bool FP8, class Epi, class Sched>
__device__ __forceinline__ void gemm_phase(LAS unsigned char* lds, const Sched& S, const Epi& E, const int wave_id) {
    const int tid_ = wave_id * 64 + lane_id_fresh();
    const int tid = tid_, wid = wave_id, lane = tid & 63, wr = wid >> 2, wc = wid & 3, fr = lane & 15, fq = lane >> 4;
    constexpr int nt = RB / 128;
    unsigned voffA[2], voffB[2]; int rA[2];
#pragma unroll
    for (int i = 0; i < 2; ++i) { int R_, C_; stage_rc(tid * 16 + i * 8192, R_, C_); const int Rb = Epi::PERM ? ((R_ & ~31) + perm32(R_ & 31)) : R_;
        voffA[i] = Sched::GATHER ? (unsigned)C_ * 2u : (unsigned)(R_ * RB + C_ * 2); rA[i] = R_; voffB[i] = (unsigned)(Rb * RB + C_ * 2); }
    constexpr size_t kstep = (size_t)(BK * 2);
    constexpr size_t hstep = (size_t)HALF * RB;
    const unsigned ldsw = (unsigned)wid * 1024u;
    const int aoff = lds_byte(wr * 64 + fr, fq * 8), boff = lds_byte(wc * 32 + fr, fq * 8);
#define PG8_SA(b, h) (((b) * 2 + (h)) * HTB)
#define PG8_SB(b, h) ((4 + (b) * 2 + (h)) * HTB)
#define PG8_STAGE(bufoff, gbase, voff) do { _Pragma("unroll") for (int _i = 0; _i < 2; ++_i) \
        __builtin_amdgcn_global_load_lds((const unsigned*)((const char*)(gbase) + (voff)[_i]), (LAS unsigned*)(lds + (bufoff) + ldsw + _i * 8192), 16, 0, 0); } while (0)
#define PG8_STAGE_A(bufoff, ubase, uoff, h) do { if constexpr (Sched::GATHER) PG8_STAGE(bufoff, ubase, (uoff)[h]); else PG8_STAGE(bufoff, (ubase) + (h) * hstep, voffA); } while (0)
#define PG8_LDA(dst, b, h) do { _Pragma("unroll") for (int m = 0; m < 4; ++m) _Pragma("unroll") for (int k = 0; k < 2; ++k) dst[m][k] = *(const LAS bf16x8*)(lds + PG8_SA(b, h) + aoff + m * 2048 + k * 1024); } while (0)
#define PG8_LDB(dst, b, h) do { _Pragma("unroll") for (int n = 0; n < 2; ++n) _Pragma("unroll") for (int k = 0; k < 2; ++k) dst[n][k] = *(const LAS bf16x8*)(lds + PG8_SB(b, h) + boff + n * 2048 + k * 1024); } while (0)
#define PG8_MMA(ai, bj, At, Bt) do { __builtin_amdgcn_s_setprio(1); _Pragma("unroll") for (int m = 0; m < 4; ++m) _Pragma("unroll") for (int n = 0; n < 2; ++n) { \
        if constexpr (FP8) mfma8(acc[ai][bj][m][n], cat8(Bt[n][0], Bt[n][1]), cat8(At[m][0], At[m][1]), sc1); \
        else { _Pragma("unroll") for (int k = 0; k < 2; ++k) acc[ai][bj][m][n] = __builtin_amdgcn_mfma_f32_16x16x32_bf16(Bt[n][k], At[m][k], acc[ai][bj][m][n], 0, 0, 0); } } __builtin_amdgcn_s_setprio(0); } while (0)
#define PG8_WAIT_V(n) asm volatile("s_waitcnt vmcnt(" #n ")" ::: "memory")
#define PG8_WAIT_L(n) asm volatile("s_waitcnt lgkmcnt(" #n ")" ::: "memory")
#define PG8_BAR __builtin_amdgcn_s_barrier()
#define PG8_SCHED __builtin_amdgcn_sched_barrier(0)
#define PG8_KBODY(a1, a2, b2, off2) do { const char* _a1 = (a1); const char* _a2 = (a2); const char* _b2 = (b2); const char* _a3 = _a2 + kstep; const char* _b3 = _b2 + kstep; \
            asm volatile("" : "+s"(_a1), "+s"(_a2), "+s"(_b2), "+s"(_a3), "+s"(_b3));   \
            PG8_LDB(B0, 0, 0); PG8_LDB(B1, 0, 1); PG8_SCHED; PG8_LDA(At, 0, 0); PG8_STAGE_A(PG8_SA(1, 1), _a1, coff, 1); \
            PG8_WAIT_V(8); PG8_WAIT_L(0); PG8_BAR; PG8_MMA(0, 0, At, B0); PG8_MMA(0, 1, At, B1); PG8_BAR; PG8_SCHED; \
            PG8_LDA(At, 0, 1); PG8_STAGE(PG8_SB(0, 0), _b2, voffB); PG8_STAGE(PG8_SB(0, 1), _b2 + hstep, voffB); PG8_STAGE_A(PG8_SA(0, 0), _a2, off2, 0); \
            PG8_WAIT_V(8); PG8_WAIT_L(0); PG8_BAR; PG8_MMA(1, 0, At, B0); PG8_MMA(1, 1, At, B1); PG8_BAR; PG8_SCHED; \
            PG8_LDB(B0, 1, 0); PG8_LDB(B1, 1, 1); PG8_SCHED; PG8_LDA(At, 1, 0); PG8_STAGE_A(PG8_SA(0, 1), _a2, off2, 1); \
            PG8_WAIT_V(8); PG8_WAIT_L(0); PG8_BAR; PG8_MMA(0, 0, At, B0); PG8_MMA(0, 1, At, B1); PG8_BAR; PG8_SCHED; \
            PG8_LDA(At, 1, 1); PG8_STAGE(PG8_SB(1, 0), _b3, voffB); PG8_STAGE(PG8_SB(1, 1), _b3 + hstep, voffB); PG8_STAGE_A(PG8_SA(1, 0), _a3, off2, 0); \
            PG8_WAIT_V(8); PG8_WAIT_L(0); PG8_BAR; PG8_MMA(1, 0, At, B0); PG8_MMA(1, 1, At, B1); PG8_BAR; PG8_SCHED; } while (0)
    int ui = 0;
    const char* cA; const char* cB;
    if (!S.bases(0, cA, cB)) return;
    f32x4 acc[2][2][4][2];
#pragma unroll
    for (int a = 0; a < 2; ++a)
#pragma unroll
        for (int b = 0; b < 2; ++b)
#pragma unroll
            for (int m = 0; m < 4; ++m)
#pragma unroll
                for (int n = 0; n < 2; ++n) acc[a][b][m][n] = (f32x4){0.f, 0.f, 0.f, 0.f};
    bf16x8 At[4][2], B0[2][2], B1[2][2];
    unsigned sc1 = 0x7f7f7f7fu; asm volatile("" : "+v"(sc1));
    unsigned coff[2][2], noff[2][2];
    if constexpr (Sched::GATHER) S.aoffs(0, rA, voffA, coff);
    PG8_STAGE(PG8_SB(0, 0), cB, voffB); PG8_STAGE(PG8_SB(0, 1), cB + hstep, voffB); PG8_STAGE_A(PG8_SA(0, 0), cA, coff, 0); PG8_STAGE_A(PG8_SA(0, 1), cA, coff, 1);
    if (wr == 1) PG8_BAR;
    PG8_WAIT_V(2); PG8_BAR;
    PG8_STAGE(PG8_SB(1, 0), cB + kstep, voffB); PG8_STAGE_A(PG8_SA(1, 0), cA + kstep, coff, 0); PG8_STAGE(PG8_SB(1, 1), cB + hstep + kstep, voffB);
    PG8_WAIT_V(6); PG8_BAR;
    for (;;) {
        const char* nA; const char* nB;
        const bool has_next = S.bases(ui + 1, nA, nB);
        if (!has_next) { nA = cA; nB = cB; }
        int ntok[2][2];
        if constexpr (Sched::GATHER) { if (has_next) S.atoks(ui + 1, rA, ntok); }
#pragma nounroll
        for (int t = 0; t < nt - 2; t += 2) PG8_KBODY(cA + (size_t)(t + 1) * kstep, cA + (size_t)(t + 2) * kstep, cB + (size_t)(t + 2) * kstep, coff);
        if constexpr (Sched::GATHER) {
            if (has_next) { asm volatile("" : "+v"(ntok[0][0]), "+v"(ntok[0][1]), "+v"(ntok[1][0]), "+v"(ntok[1][1]));
#pragma unroll
                for (int h = 0; h < 2; ++h)
#pragma unroll
                    for (int i = 0; i < 2; ++i) noff[h][i] = (unsigned)ntok[h][i] * (unsigned)RB + voffA[i]; }
            else {
#pragma unroll
                for (int h = 0; h < 2; ++h)
#pragma unroll
                    for (int i = 0; i < 2; ++i) noff[h][i] = coff[h][i]; }
        }
        PG8_KBODY(cA + (size_t)(nt - 1) * kstep, nA, nB, noff);
        if (wr == 0) PG8_BAR;
        if constexpr (FP8) asm volatile("s_nop 15\n\ts_nop 3" ::: "memory");
        {
            const int t2 = lane_id_fresh();
            const int w2 = wave_id, l2 = t2 & 63;
            Unit cur; S.unit(ui, cur); E(acc, cur, w2 >> 2, w2 & 3, l2 & 15, l2 >> 4); }
        if (!has_next) break;
#pragma unroll
        for (int a = 0; a < 2; ++a)
#pragma unroll
            for (int b = 0; b < 2; ++b)
#pragma unroll
                for (int m = 0; m < 4; ++m)
#pragma unroll
                    for (int n = 0; n < 2; ++n) acc[a][b][m][n] = (f32x4){0.f, 0.f, 0.f, 0.f};
        cA = nA; cB = nB; ++ui;
        if constexpr (Sched::GATHER) {
#pragma unroll
            for (int h = 0; h < 2; ++h)
#pragma unroll
                for (int i = 0; i < 2; ++i) coff[h][i] = noff[h][i]; }
        if (wr == 1) PG8_BAR;
    }
    PG8_WAIT_V(0);
    PG8_BAR;
#undef PG8_SA
#undef PG8_SB
#undef PG8_STAGE
#undef PG8_STAGE_A
#undef PG8_KBODY
#undef PG8_LDA
#undef PG8_LDB
#undef PG8_MMA
#undef PG8_WAIT_V
#undef PG8_WAIT_L
#undef PG8_BAR
#undef PG8_SCHED
}
__device__ __forceinline__ int xcd_remap(long L, int nwg) { const int q = nwg / 8, r = nwg % 8, xcd = (int)(L % 8), off = (int)(L / 8); return (xcd < r ? xcd * (q + 1) : r * (q + 1) + (xcd - r) * q) + off; }
struct RectSched {
    static constexpr bool GATHER = false;
    const char* A; const char* B; int RB, nM, nN, G, c, nM2, nN2, pm2, pn2;
    __device__ __forceinline__ bool unit(int i, Unit& u) const {
        const int n1 = nM * nN, nwg = n1 + nM2 * nN2; const long L = (long)i * G + c; if (L >= nwg) return false;
        int w = xcd_remap(L, nwg); int rm = nM, rn = nN, pm0 = 0, pn0 = 0;
        if (w >= n1) { w -= n1; rm = nM2; rn = nN2; pm0 = pm2; pn0 = pn2; }
        const int nig = 8 * rn, gid = w / nig, fm = gid * 8, gsz = (rm - fm) < 8 ? (rm - fm) : 8;
        u.pm = pm0 + fm + ((w % nig) % gsz); u.pn = pn0 + (w % nig) / gsz; u.e = 0; u.rows = 256; u.base = u.pm * 256; u.newe = 0;
        return true;
    }
    __device__ __forceinline__ bool bases(int i, const char*& a, const char*& b) const {
        Unit u; if (!unit(i, u)) return false;
        a = A + (size_t)u.pm * 256 * RB; b = B + (size_t)u.pn * 256 * RB; return true;
    }
    __device__ __forceinline__ void aoffs(int, const int (&)[2], const unsigned (&)[2], unsigned (&)[2][2]) const {}
    __device__ __forceinline__ void atoks(int, const int (&)[2], int (&)[2][2]) const {}
};
}

template <class MapF>
__device__ __forceinline__ void transpose_item(const float* W, int K, int N, bf16* WT, MapF rowmap, float* scr, int item, int lane) {
    const int nblk = N / 32, kb = item / nblk, nb = item % nblk, k0 = 64 * kb, n0 = 32 * nb;
#pragma unroll 8
    for (int i = 0; i < 32; ++i) { const int kk = 2 * i + (lane >> 5); scr[kk * 33 + (lane & 31)] = W[(size_t)(k0 + kk) * N + n0 + (lane & 31)]; }
    asm volatile("s_waitcnt lgkmcnt(0)" ::: "memory");
    const int c = lane & 7;
#pragma unroll
    for (int j = 0; j < 4; ++j) { const int n = (lane >> 3) + 8 * j; const float* s = scr + (8 * c) * 33 + n;
        v4u o; o.x = pk2(s[0 * 33], s[1 * 33]); o.y = pk2(s[2 * 33], s[3 * 33]); o.z = pk2(s[4 * 33], s[5 * 33]); o.w = pk2(s[6 * 33], s[7 * 33]);
        *(v4u*)(WT + (size_t)rowmap(n0 + n) * K + k0 + 8 * c) = o; }
    asm volatile("s_waitcnt lgkmcnt(0)" ::: "memory");
}
constexpr int CV_E0 = 2, CV_E1 = 12, CV_E2 = 22, CV_E3 = 18, INP0_NC = 40, OUTP0_NC = 64, INP1_NC = 32, MOE_NC = 32;
__device__ __forceinline__ void item8_load(const float* W, int N, int item, int lane, f32x4 (&t)[16]) {
    const int nblk = N / 32, kb = item / nblk, nb = item % nblk, k0 = 128 * kb, n0 = 32 * nb;
    const int r8 = lane >> 3, c8 = lane & 7;
    const float* p = W + (size_t)(k0 + 16 * r8) * N + n0 + 4 * c8;
#pragma unroll
    for (int i = 0; i < 16; ++i) t[i] = __builtin_nontemporal_load((const f32x4*)(p + (size_t)i * N));
}
template <class MapF>
__device__ __forceinline__ void item8_store(const f32x4 (&t)[16], int K, int N, unsigned char* WT, MapF rowmap, int item, int lane) {
    const int nblk = N / 32, kb = item / nblk, nb = item % nblk, k0 = 128 * kb, n0 = 32 * nb;
    const int r8 = lane >> 3, c8 = lane & 7;
#pragma unroll
    for (int c = 0; c < 4; ++c) {
        v4u o;
        o.x = pk4_fp8(t[0][c] * W8_SCALE, t[1][c] * W8_SCALE, t[2][c] * W8_SCALE, t[3][c] * W8_SCALE);     o.y = pk4_fp8(t[4][c] * W8_SCALE, t[5][c] * W8_SCALE, t[6][c] * W8_SCALE, t[7][c] * W8_SCALE);
        o.z = pk4_fp8(t[8][c] * W8_SCALE, t[9][c] * W8_SCALE, t[10][c] * W8_SCALE, t[11][c] * W8_SCALE); o.w = pk4_fp8(t[12][c] * W8_SCALE, t[13][c] * W8_SCALE, t[14][c] * W8_SCALE, t[15][c] * W8_SCALE);
        *(v4u*)(WT + (size_t)rowmap(n0 + 4 * c8 + c) * K + k0 + 16 * r8) = o;
    }
}
struct ExpertConv {
    const CAS Args& a; int layer, wlo, nw, lane;
    static constexpr int IPM = 8 * 32;
    __device__ __forceinline__ void load(int it, f32x4 (&t)[16]) const {
        const int m = it / IPM, le = layer + m / nw, which = wlo + m % nw;
        item8_load((which == 0 ? a.in[31] : which == 1 ? a.in[33] : a.in[35]) + ((size_t)le << 20), D, it % IPM, lane, t); }
    __device__ __forceinline__ void store(int it, const f32x4 (&t)[16]) const {
        const int m = it / IPM, r = it % IPM, le = layer + m / nw, which = wlo + m % nw;
        unsigned char* dst = (unsigned char*)(a.ws + WS_WEXP) + (size_t)le * 3072 * 1024;
        if (which == 0) item8_store(t, D, D, dst, [](int n) { return ((n >> 7) << 8) + (n & 127); }, r, lane);
        else if (which == 1) item8_store(t, D, D, dst, [](int n) { return ((n >> 7) << 8) + 128 + (n & 127); }, r, lane);
        else item8_store(t, D, D, dst + (size_t)2048 * 1024,
            [](int f) { return (f & ~255) | (((f >> 3) & 1) << 7) | (((f >> 6) & 3) << 5) | (((f >> 4) & 3) << 3) | (f & 7); }, r, lane); }
};
__device__ __forceinline__ void convert_experts(const CAS Args& a, const Frame& F, int layer, int wlo, int whi, int gw, int ngw, int elo = 0, int ehi = NE) {
    const ExpertConv C{a, layer * NE + elo, wlo, whi - wlo, F.lane};
    const int total = (ehi - elo) * (whi - wlo) * ExpertConv::IPM;
    int it = gw; if (it >= total) return;
    f32x4 tA[16], tB[16];
    C.load(it, tA);
    for (;;) {
        int nit = it + ngw;
        if (nit < total) C.load(nit, tB);
        C.store(it, tA);
        if (nit >= total) break;
        it = nit; nit = it + ngw;
        if (nit < total) C.load(nit, tA);
        C.store(it, tB);
        if (nit >= total) break;
        it = nit;
    }
}
__device__ __forceinline__ void p0_prologue(const CAS Args& a, const Frame& F) {
    float* scr = (float*)(F.lds + F.wave * 8448);
    constexpr int I_IN0 = 16 * 96, I_O = 16 * 32, I_IN1 = 16 * 64, I_LRU1 = 4 * 8;
    constexpr int NSMALL = I_IN0 + I_O + I_IN1 + I_O + 16 * I_LRU1;
    for (int it = F.gw; it < NSMALL; it += F.ngw) {
        int r = it;
        if (r < I_IN0) {
            transpose_item(a.in[8], D, 3072, (bf16*)(a.ws + WS_WIN0), [](int f) {
                if (f < 2048) return (f & ~255) | (((f >> 5) & 1) << 7) | (((f >> 6) & 3) << 5) | (f & 31);
                if (f < 2560) { const int j = f - 2048; return (8 + (j >> 7)) * 256 + (j & 127); }
                const int j = f - 2560; return (8 + (j >> 7)) * 256 + 128 + (j & 127); }, scr, r, F.lane); continue; } r -= I_IN0;
        if (r < I_O) { transpose_item(a.in[9], D, D, (bf16*)(a.ws + WS_WOUT0), [](int n) { return n; }, scr, r, F.lane); continue; } r -= I_O;
        if (r < I_IN1) { transpose_item(a.in[15], D, 2048, (bf16*)(a.ws + WS_WIN1), [](int n) { return n; }, scr, r, F.lane); continue; } r -= I_IN1;
        if (r < I_O) { transpose_item(a.in[16], D, D, (bf16*)(a.ws + WS_WOUT1), [](int n) { return n; }, scr, r, F.lane); continue; } r -= I_O;
        const int gh = r / I_LRU1, rr = r % I_LRU1, g = gh >> 2, h = gh & 3;
        const float* W = (g == 0 ? a.in[19] : g == 1 ? a.in[21] : g == 2 ? a.in[24] : a.in[26]) + (size_t)h * 65536;
        transpose_item(W, 256, 256, (bf16*)(a.ws + WS_WLRU) + (size_t)h * 1024 * 256, [g](int n) { return g * 256 + n; }, scr, rr, F.lane);
    }
    __syncthreads();
    convert_experts(a, F, 0, 0, 2, F.gw, F.ngw, 0, CV_E0);
    __syncthreads();
    float* sc = (float*)F.lds;
    float* red = (float*)(F.lds + 17 * 1024 * 4);
    {
#pragma unroll
        for (int hbat = 0; hbat < 2; ++hbat) { float tv[17];
#pragma unroll
            for (int j = 0; j < 17; ++j) { const int i = F.tid + 512 * (17 * hbat + j); tv[j] = i < 16 * 1024 ? a.in[1][i] : a.in[3][i - 16 * 1024]; }
#pragma unroll
            for (int j = 0; j < 17; ++j) { const int i = F.tid + 512 * (17 * hbat + j); sc[i] = tv[j] / (1.0f + __expf(-tv[j])); } }
    }
    __syncthreads();
    float* MOD = (float*)(a.ws + WS_MOD);
    for (int u = F.bid; u < 192; u += F.G) {
        const int l = u / 96, n = (u % 96) * 64 + F.lane;
        const float* w = a.in[4] + (size_t)l * D * 6144 + n;
        float acc[17];
#pragma unroll
        for (int b = 0; b < 17; ++b) acc[b] = 0.f;
        float wa[32], wb[32];
        const int kw = F.wave * 128;
#define ADA_LD(dst, kk) do { _Pragma("unroll") for (int q = 0; q < 32; ++q) dst[q] = __builtin_nontemporal_load(w + (size_t)((kk) + q) * 6144); } while (0)
#define ADA_FMA(srcv, kk) do { _Pragma("unroll") for (int q = 0; q < 32; q += 4) _Pragma("unroll") for (int b = 0; b < 17; ++b) { const f32x4 s4 = *(const f32x4*)(sc + b * 1024 + (kk) + q); \
            acc[b] += s4[0] * srcv[q] + s4[1] * srcv[q + 1] + s4[2] * srcv[q + 2] + s4[3] * srcv[q + 3]; } } while (0)
        ADA_LD(wa, kw); ADA_LD(wb, kw + 32); ADA_FMA(wa, kw); ADA_LD(wa, kw + 64); ADA_FMA(wb, kw + 32); ADA_LD(wb, kw + 96); ADA_FMA(wa, kw + 64); ADA_FMA(wb, kw + 96);
#undef ADA_LD
#undef ADA_FMA
#pragma unroll
        for (int b = 0; b < 17; ++b) red[(F.wave * 17 + b) * 64 + F.lane] = acc[b];
        __syncthreads();
        for (int i = F.tid; i < 17 * 64; i += NWAVES * 64) {
            const int b = i / 64, ln = i % 64; float s = 0.f;
#pragma unroll
            for (int w8 = 0; w8 < 8; ++w8) s += red[(w8 * 17 + b) * 64 + ln];
            const int nn = (u % 96) * 64 + ln;
            MOD[((size_t)l * 17 + b) * 6144 + nn] = s + a.in[5][l * 6144 + nn];
        }
        __syncthreads();
    }
}

__device__ __forceinline__ void load_row16(const float* row, int lane, float (&v)[16]) {
#pragma unroll
    for (int j = 0; j < 4; ++j) { const f32x4 t = *(const f32x4*)(row + 256 * j + 4 * lane); v[4 * j] = t.x; v[4 * j + 1] = t.y; v[4 * j + 2] = t.z; v[4 * j + 3] = t.w; }
}
__device__ __forceinline__ void load_row16_bf16(const bf16* row, int lane, float (&v)[16]) {
#pragma unroll
    for (int j = 0; j < 4; ++j) { const uint2 t = *(const uint2*)(row + 256 * j + 4 * lane); v[4 * j] = __uint_as_float(t.x << 16); v[4 * j + 1] = __uint_as_float(t.x & 0xffff0000u); v[4 * j + 2] = __uint_as_float(t.y << 16); v[4 * j + 3] = __uint_as_float(t.y & 0xffff0000u); }
}
__device__ __forceinline__ void store_row16_bf16(bf16* row, int lane, const float (&v)[16]) {
#pragma unroll
    for (int j = 0; j < 4; ++j) { uint2 o; o.x = pk2(v[4 * j], v[4 * j + 1]); o.y = pk2(v[4 * j + 2], v[4 * j + 3]); *(uint2*)(row + 256 * j + 4 * lane) = o; }
}
__device__ __forceinline__ void store_row16_f32(float* row, int lane, const float (&v)[16]) {
#pragma unroll
    for (int j = 0; j < 4; ++j) *(f32x4*)(row + 256 * j + 4 * lane) = (f32x4){v[4 * j], v[4 * j + 1], v[4 * j + 2], v[4 * j + 3]};
}
template <bool FP8OUT = false>
__device__ __forceinline__ void norm_mod(const float (&v)[16], const float* g, const float* sh, const float* sc, bf16* out, int lane, float (&hv)[16]) {
    float s = 0.f;
#pragma unroll
    for (int i = 0; i < 16; ++i) s += v[i] * v[i];
    const float rstd = rsqrtf(wave_sum(s) * (1.0f / D) + 1e-6f);
#pragma unroll
    for (int j = 0; j < 4; ++j) {
        const int e = 256 * j + 4 * lane;
        const f32x4 gg = *(const f32x4*)(g + e), ss = *(const f32x4*)(sh + e), cc = *(const f32x4*)(sc + e);
        hv[4 * j] = v[4 * j] * rstd * gg.x * (1.f + cc.x) + ss.x; hv[4 * j + 1] = v[4 * j + 1] * rstd * gg.y * (1.f + cc.y) + ss.y;
        hv[4 * j + 2] = v[4 * j + 2] * rstd * gg.z * (1.f + cc.z) + ss.z; hv[4 * j + 3] = v[4 * j + 3] * rstd * gg.w * (1.f + cc.w) + ss.w;
        if (FP8OUT) *(unsigned*)((unsigned char*)out + e) = pk4_fp8(hv[4 * j], hv[4 * j + 1], hv[4 * j + 2], hv[4 * j + 3]);
        else { uint2 o; o.x = pk2(hv[4 * j], hv[4 * j + 1]); o.y = pk2(hv[4 * j + 2], hv[4 * j + 3]); *(uint2*)(out + e) = o; }
    }
}
__device__ __forceinline__ int row_batch(int r) { return r < NT ? (r >> 11) : 16; }
__device__ __forceinline__ const float* mod_ptr(const CAS Args& a, int l, int r, int chunk) { return (const float*)(a.ws + WS_MOD) + ((size_t)l * 17 + row_batch(r)) * 6144 + chunk * D; }

__device__ __forceinline__ void p_norm1_l0(const CAS Args& a, const Frame& F) {
    bf16* H = (bf16*)(a.ws + WS_H);
    { float* GS2 = (float*)(a.ws + WS_GS2); const float* MOD = (const float*)(a.ws + WS_MOD);
      for (int i = F.gw * 64 + F.lane; i < 2 * 17 * D; i += F.ngw * 64) { const int l = i / (17 * D), bb = (i / D) % 17, k = i % D; GS2[i] = a.in[7][l * D + k] * (1.0f + MOD[((size_t)l * 17 + bb) * 6144 + 4 * D + k]); } }
    const int lane = F.lane, rpw = (R + F.ngw - 1) / F.ngw, r_lo = F.gw * rpw, r_hi = min(R, r_lo + rpw);
    float gsc[16], shv[16]; int cb = -1;
    for (int r = r_lo; r < r_hi; r += 3) {
        f32x4 xv[3][4];
#pragma unroll
        for (int k = 0; k < 3; ++k) { const int rr = min(r + k, R - 1); const float* row = rr < NT ? a.in[0] + (size_t)rr * D : a.in[2] + (size_t)(rr - NT) * D;
#pragma unroll
            for (int jh = 0; jh < 2; ++jh)
#pragma unroll
                for (int q = 0; q < 2; ++q) xv[k][2 * jh + q] = *(const f32x4*)(row + 512 * jh + 8 * lane + 4 * q); }
#pragma unroll
        for (int k = 0; k < 3; ++k) { const int rr = r + k; if (rr < r_hi) {
            const int bq = row_batch(rr);
            if (bq != cb) { cb = bq; const float* shp = mod_ptr(a, 0, rr, 0); const float* scp = mod_ptr(a, 0, rr, 1);
#pragma unroll
                for (int jh = 0; jh < 2; ++jh)
#pragma unroll
                    for (int q = 0; q < 2; ++q) { const int e0 = 512 * jh + 8 * lane + 4 * q; const f32x4 gg = *(const f32x4*)(a.in[6] + e0), ss = *(const f32x4*)(shp + e0), cc = *(const f32x4*)(scp + e0);
#pragma unroll
                        for (int c = 0; c < 4; ++c) { gsc[8 * jh + 4 * q + c] = gg[c] * (1.f + cc[c]); shv[8 * jh + 4 * q + c] = ss[c]; } } }
            float s = 0.f;
#pragma unroll
            for (int j = 0; j < 4; ++j)
#pragma unroll
                for (int c = 0; c < 4; ++c) s += xv[k][j][c] * xv[k][j][c];
            const float rstd = rsqrtf(wave_sum(s) * (1.0f / D) + 1e-6f);
#pragma unroll
            for (int jh = 0; jh < 2; ++jh) { float hv[8];
#pragma unroll
                for (int c = 0; c < 8; ++c) hv[c] = xv[k][2 * jh + (c >> 2)][c & 3] * rstd * gsc[8 * jh + c] + shv[8 * jh + c];
                *(v4u*)(H + (size_t)rr * D + 512 * jh + 8 * lane) = (v4u){pk_bf16(hv[0], hv[1]), pk_bf16(hv[2], hv[3]), pk_bf16(hv[4], hv[5]), pk_bf16(hv[6], hv[7])}; }
        } }
    }
}

struct EpiInProj0 {
    static constexpr bool PERM = true;
    bf16* P; const float* qg; const float* kg;
    __device__ __forceinline__ void operator()(const f32x4 (&acc)[2][2][4][2], const pg8::Unit& u, int wr, int wc, int fr, int fq) const {
        const int row0 = u.pm * 256 + wr * 64 + fr, pn = u.pn;
        if (pn < 4) {
            const float* g = pn < 2 ? qg : kg; const float sc = pn < 2 ? 0.125f : 1.0f;
            f32x4 gv[2][2];
#pragma unroll
            for (int bj = 0; bj < 2; ++bj)
#pragma unroll
                for (int n = 0; n < 2; ++n) gv[bj][n] = *(const f32x4*)(g + 32 * bj + 8 * fq + 4 * n);
#pragma unroll
            for (int ai = 0; ai < 2; ++ai)
#pragma unroll
                for (int m = 0; m < 4; ++m) {
                    float ss = 0.f;
#pragma unroll
                    for (int bj = 0; bj < 2; ++bj)
#pragma unroll
                        for (int n = 0; n < 2; ++n) { const f32x4 x = acc[ai][bj][m][n]; ss += (x[0] * x[0] + x[1] * x[1]) + (x[2] * x[2] + x[3] * x[3]); }
                    ss += __shfl_xor(ss, 16); ss += __shfl_xor(ss, 32);
                    const float rs = rsqrtf(ss * (1.0f / 64.0f) + 1e-6f) * sc;
                    bf16* rowp = P + (size_t)(row0 + ai * 128 + m * 16) * PP + pn * 256 + wc * 64 + 8 * fq;
#pragma unroll
                    for (int bj = 0; bj < 2; ++bj) { const f32x4 v0 = acc[ai][bj][m][0] * rs * gv[bj][0], v1 = acc[ai][bj][m][1] * rs * gv[bj][1];
                        v4u w; w.x = pg8::cvt_pk_bf16(v0[0], v0[1]); w.y = pg8::cvt_pk_bf16(v0[2], v0[3]); w.z = pg8::cvt_pk_bf16(v1[0], v1[1]); w.w = pg8::cvt_pk_bf16(v1[2], v1[3]);
                        *(v4u*)(rowp + 32 * bj) = w; }
                }
        } else if (pn < 8) {
#pragma unroll
            for (int ai = 0; ai < 2; ++ai)
#pragma unroll
                for (int m = 0; m < 4; ++m) { bf16* rowp = P + (size_t)(row0 + ai * 128 + m * 16) * PP + pn * 256 + wc * 64 + 8 * fq;
#pragma unroll
                    for (int bj = 0; bj < 2; ++bj) { const f32x4 v0 = acc[ai][bj][m][0], v1 = acc[ai][bj][m][1];
                        v4u w; w.x = pg8::cvt_pk_bf16(v0[0], v0[1]); w.y = pg8::cvt_pk_bf16(v0[2], v0[3]); w.z = pg8::cvt_pk_bf16(v1[0], v1[1]); w.w = pg8::cvt_pk_bf16(v1[2], v1[3]);
                        *(v4u*)(rowp + 32 * bj) = w; } }
        } else {
#pragma unroll
            for (int ai = 0; ai < 2; ++ai)
#pragma unroll
                for (int m = 0; m < 4; ++m) { bf16* rowp = P + (size_t)(row0 + ai * 128 + m * 16) * PP + 2048 + (pn - 8) * 128 + wc * 32 + 8 * fq;
                    const f32x4 v0 = acc[ai][0][m][0] * acc[ai][1][m][0], v1 = acc[ai][0][m][1] * acc[ai][1][m][1];
                    v4u w; w.x = pg8::cvt_pk_bf16(v0[0], v0[1]); w.y = pg8::cvt_pk_bf16(v0[2], v0[3]); w.z = pg8::cvt_pk_bf16(v1[0], v1[1]); w.w = pg8::cvt_pk_bf16(v1[2], v1[3]);
                    *(v4u*)rowp = w; }
        }
    }
};
__device__ __forceinline__ void p_inproj0(const CAS Args& a, const Frame& F) {
    if (F.bid >= F.G - INP0_NC) { convert_experts(a, F, 0, 0, 2, (F.bid - (F.G - INP0_NC)) * NWAVES + F.wave, INP0_NC * NWAVES, CV_E1, NE); return; }
    pg8::RectSched S{(const char*)(a.ws + WS_H), (const char*)(a.ws + WS_WIN0), 2 * D, R / 256, 3072 / 256, F.G - INP0_NC, F.bid, 0, 0, 0, 0};
    EpiInProj0 E{(bf16*)(a.ws + WS_P), a.in[10], a.in[11]};
    pg8::gemm_phase<2 * D, false>(F.ldsl, S, E, F.wave);
}
typedef short s16x4 __attribute__((ext_vector_type(4)));
constexpr int AT_LAT = 0, AT_CK = 576 * 128, AT_CV = AT_CK + 256 * 128, AT_RPB = AT_CV + 256 * 128;
__device__ __forceinline__ int at_swz(int key) { return (key ^ (key >> 3)) & 7; }
__device__ __forceinline__ unsigned at_addr(int key, int chunk) { return (unsigned)(key * 128 + ((chunk ^ at_swz(key)) << 4)); }
template <class RowF>
__device__ __forceinline__ void at_stage(LAS unsigned char* dst, int npieces, RowF rowf, int colbyte, const bf16* P, int wave, int lane) {
    for (int p = wave; p < npieces; p += NWAVES) {
        const int key = 8 * p + (lane >> 3), c = (lane & 7) ^ at_swz(key);
        const char* src = (const char*)P + (size_t)rowf(key) * (PP * 2) + colbyte + 16 * c;
        __builtin_amdgcn_global_load_lds((const unsigned*)src, (LAS unsigned*)(dst + p * 1024), 16, 0, 0);
    }
}
template <int OFF>
__device__ __forceinline__ void at_tr8o(unsigned a0, unsigned a1, unsigned a2, unsigned a3, unsigned a4, unsigned a5, unsigned a6, unsigned a7, s16x4 (&r)[8]) {
    asm volatile("ds_read_b64_tr_b16 %0, %8 offset:%16\n\tds_read_b64_tr_b16 %1, %9 offset:%16\n\tds_read_b64_tr_b16 %2, %10 offset:%16\n\tds_read_b64_tr_b16 %3, %11 offset:%16\n\t"
                 "ds_read_b64_tr_b16 %4, %12 offset:%16\n\tds_read_b64_tr_b16 %5, %13 offset:%16\n\tds_read_b64_tr_b16 %6, %14 offset:%16\n\tds_read_b64_tr_b16 %7, %15 offset:%16\n\ts_waitcnt lgkmcnt(0)"
                 : "=&v"(r[0]), "=&v"(r[1]), "=&v"(r[2]), "=&v"(r[3]), "=&v"(r[4]), "=&v"(r[5]), "=&v"(r[6]), "=&v"(r[7])
                 : "v"(a0), "v"(a1), "v"(a2), "v"(a3), "v"(a4), "v"(a5), "v"(a6), "v"(a7), "n"(OFF) : "memory");
}
__device__ __forceinline__ void at_tr8(unsigned a0, unsigned a1, unsigned a2, unsigned a3, unsigned a4, unsigned a5, unsigned a6, unsigned a7, s16x4 (&r)[8]) {
    asm volatile("ds_read_b64_tr_b16 %0, %8\n\tds_read_b64_tr_b16 %1, %9\n\tds_read_b64_tr_b16 %2, %10\n\tds_read_b64_tr_b16 %3, %11\n\t"
                 "ds_read_b64_tr_b16 %4, %12\n\tds_read_b64_tr_b16 %5, %13\n\tds_read_b64_tr_b16 %6, %14\n\tds_read_b64_tr_b16 %7, %15\n\ts_waitcnt lgkmcnt(0)"
                 : "=&v"(r[0]), "=&v"(r[1]), "=&v"(r[2]), "=&v"(r[3]), "=&v"(r[4]), "=&v"(r[5]), "=&v"(r[6]), "=&v"(r[7])
                 : "v"(a0), "v"(a1), "v"(a2), "v"(a3), "v"(a4), "v"(a5), "v"(a6), "v"(a7) : "memory");
}
__device__ __forceinline__ void p_attn(const CAS Args& a, const Frame& F) {
    const bf16* P = (const bf16*)(a.ws + WS_P); bf16* A2 = (bf16*)(a.ws + WS_A2);
    LAS unsigned char* lds = F.ldsl;
    const int lane = F.lane, wave = F.wave, rho = lane & 15, g = lane >> 4;
    for (int wu = F.bid; wu < NB * 8 * 2; wu += F.G) {
        const int half = wu & 1, hd = (wu >> 1) & 7, b = wu >> 4;
        __syncthreads();
        if (F.tid < 15 * 32) { const int dr_ = F.tid >> 5, dc_ = F.tid & 31; ((LAS float*)(lds + AT_RPB))[F.tid] = dc_ < 31 ? a.in[12][hd * 465 + dr_ * 31 + dc_] : -1e30f; }
        at_stage(lds + AT_CK, 32, [=](int key) { return NT + b * 256 + key; }, (512 + hd * 64) * 2, P, wave, lane);
        at_stage(lds + AT_CV, 32, [=](int key) { return NT + b * 256 + key; }, (1024 + hd * 64) * 2, P, wave, lane);
        for (int un = 0; un < 9; ++un) {
            const bool lat = un < 8;
            int r = 0, n = 0, qrow, krow_lo = 0;
            if (lat) { const int rp = half * 8 + un; r = 2 * rp + (wave >> 2); n = wave & 3; qrow = b * 2048 + r * 64 + 16 * n + rho; krow_lo = min(max(2 * rp - 4, 0), 24); }
            else qrow = NT + b * 256 + half * 128 + 16 * wave + rho;
            const int r0 = min(max(r - 4, 0), 24), ro = r0 - krow_lo, kc0 = min(max(16 * n - 8, 0), 32);
            const int c = 16 * n + rho, c0 = min(max(c - 8, 0), 48);
            if (lat) at_stage(lds + AT_LAT, 72, [=](int key) { return b * 2048 + min(krow_lo + (key >> 6), 31) * 64 + (key & 63); }, (512 + hd * 64) * 2, P, wave, lane);
            const bf16x8 q0 = *(const bf16x8*)(P + (size_t)qrow * PP + hd * 64 + 8 * g), q1 = *(const bf16x8*)(P + (size_t)qrow * PP + hd * 64 + 32 + 8 * g);
            asm volatile("s_waitcnt vmcnt(0)" ::: "memory");
            __syncthreads();
            const int pk = 8 * (rho >> 2) + (rho & 3);
            float mxb[2] = {-1e30f, -1e30f}, smb[2] = {0.f, 0.f}; v4u pf[16];
            const LAS unsigned char* bp[8];
#pragma unroll
            for (int k = 0; k < 8; ++k) { const int kcol = kc0 + 8 * g + k; const int dc = ((unsigned)(kcol - c0) < 16u) ? min(max(kcol - c + 15, 0), 30) : 31; bp[k] = lds + AT_RPB + ((r0 - r + 7) * 32 + dc) * 4; }
            const LAS unsigned char* kpl[2][2]; const LAS unsigned char* kpc[2][2][2];
#pragma unroll
            for (int t = 0; t < 2; ++t)
#pragma unroll
                for (int hf = 0; hf < 2; ++hf) {
                    kpl[t][hf] = lds + AT_LAT + at_addr(ro * 64 + kc0 + pk + 4 * t, 4 * hf + g);
                    const unsigned ce = AT_CK + at_addr(pk + 4 * t, 4 * hf + g);
                    kpc[0][t][hf] = lds + ce; kpc[1][t][hf] = lds + (ce ^ 0x40u); }
#pragma unroll
            for (int blk = 0; blk < 2; ++blk) {
                if (blk == 0 && !lat) {
#pragma unroll
                    for (int i = 0; i < 8; ++i) pf[i] = (v4u){0u, 0u, 0u, 0u};
                    continue; }
                f32x4 s[16];
#pragma unroll
                for (int i = 0; i < 8; ++i)
#pragma unroll
                    for (int t = 0; t < 2; ++t) {
                        const bf16x8 k0 = blk == 0 ? *(const LAS bf16x8*)(kpl[t][0] + i * 8192) : *(const LAS bf16x8*)(kpc[i & 1][t][0] + i * 4096);
                        const bf16x8 k1 = blk == 0 ? *(const LAS bf16x8*)(kpl[t][1] + i * 8192) : *(const LAS bf16x8*)(kpc[i & 1][t][1] + i * 4096);
                        f32x4 acc = __builtin_amdgcn_mfma_f32_16x16x32_bf16(k0, q0, (f32x4){0.f, 0.f, 0.f, 0.f}, 0, 0, 0);
                        acc = __builtin_amdgcn_mfma_f32_16x16x32_bf16(k1, q1, acc, 0, 0, 0);
                        if (blk == 0) {
#pragma unroll
                            for (int jj = 0; jj < 4; ++jj) acc[jj] += *(const LAS float*)(bp[4 * t + jj] + i * 128);
                        }
                        s[2 * i + t] = acc;
                    }
                float mx = -1e30f;
#pragma unroll
                for (int i = 0; i < 16; ++i) mx = fmaxf(fmaxf(mx, fmaxf(s[i][0], s[i][1])), fmaxf(s[i][2], s[i][3]));
                mx = fmaxf(mx, __shfl_xor(mx, 16)); mx = fmaxf(mx, __shfl_xor(mx, 32));
                float sum = 0.f;
#pragma unroll
                for (int i = 0; i < 8; ++i) {
                    float e[8];
#pragma unroll
                    for (int t = 0; t < 2; ++t)
#pragma unroll
                        for (int jj = 0; jj < 4; ++jj) { e[4 * t + jj] = __expf(s[2 * i + t][jj] - mx); sum += e[4 * t + jj]; }
                    pf[8 * blk + i].x = pk_bf16(e[0], e[1]); pf[8 * blk + i].y = pk_bf16(e[2], e[3]); pf[8 * blk + i].z = pk_bf16(e[4], e[5]); pf[8 * blk + i].w = pk_bf16(e[6], e[7]);
                }
                sum += __shfl_xor(sum, 16); sum += __shfl_xor(sum, 32);
                mxb[blk] = mx; smb[blk] = sum;
            }
            __syncthreads();
            if (lat) at_stage(lds + AT_LAT, 72, [=](int key) { return b * 2048 + min(krow_lo + (key >> 6), 31) * 64 + (key & 63); }, (1024 + hd * 64) * 2, P, wave, lane);
            asm volatile("s_waitcnt vmcnt(0)" ::: "memory");
            __syncthreads();
            f32x4 o[2][4];
#pragma unroll
            for (int blk = 0; blk < 2; ++blk)
#pragma unroll
                for (int db = 0; db < 4; ++db) o[blk][db] = (f32x4){0.f, 0.f, 0.f, 0.f};
            const int tq = rho >> 2, tp = rho & 3;
            unsigned adl[8], adc[8];
#pragma unroll
            for (int db = 0; db < 4; ++db) { const int kl = ro * 64 + kc0 + 8 * g + tq, kc = 8 * g + tq;
                adl[2 * db] = (unsigned)(size_t)(lds + AT_LAT) + at_addr(kl, 2 * db + (tp >> 1)) + 8 * (tp & 1); adl[2 * db + 1] = (unsigned)(size_t)(lds + AT_LAT) + at_addr(kl + 4, 2 * db + (tp >> 1)) + 8 * (tp & 1);
                adc[2 * db] = (unsigned)(size_t)(lds + AT_CV) + at_addr(kc, 2 * db + (tp >> 1)) + 8 * (tp & 1); adc[2 * db + 1] = (unsigned)(size_t)(lds + AT_CV) + at_addr(kc + 4, 2 * db + (tp >> 1)) + 8 * (tp & 1); }
#define AT_PV_CHUNK(CH) do { if ((CH) >= 8 || lat) { s16x4 vr[8]; \
                if ((CH) < 8) at_tr8o<((CH) & 7) * 8192>(adl[0], adl[1], adl[2], adl[3], adl[4], adl[5], adl[6], adl[7], vr); \
                else if (((CH) & 1) == 0) at_tr8o<((CH) & 7) * 4096>(adc[0], adc[1], adc[2], adc[3], adc[4], adc[5], adc[6], adc[7], vr); \
                else at_tr8o<((CH) & 7) * 4096>(adc[0] ^ 0x40u, adc[1] ^ 0x40u, adc[2] ^ 0x40u, adc[3] ^ 0x40u, adc[4] ^ 0x40u, adc[5] ^ 0x40u, adc[6] ^ 0x40u, adc[7] ^ 0x40u, vr); \
                _Pragma("unroll") for (int db = 0; db < 4; ++db) { const bf16x8 vf = __builtin_shufflevector(vr[2 * db], vr[2 * db + 1], 0, 1, 2, 3, 4, 5, 6, 7); \
                    o[(CH) >> 3][db] = __builtin_amdgcn_mfma_f32_16x16x32_bf16(vf, __builtin_bit_cast(bf16x8, pf[CH]), o[(CH) >> 3][db], 0, 0, 0); } } } while (0)
            AT_PV_CHUNK(0); AT_PV_CHUNK(1); AT_PV_CHUNK(2); AT_PV_CHUNK(3); AT_PV_CHUNK(4); AT_PV_CHUNK(5); AT_PV_CHUNK(6); AT_PV_CHUNK(7);
            AT_PV_CHUNK(8); AT_PV_CHUNK(9); AT_PV_CHUNK(10); AT_PV_CHUNK(11); AT_PV_CHUNK(12); AT_PV_CHUNK(13); AT_PV_CHUNK(14); AT_PV_CHUNK(15);
#undef AT_PV_CHUNK
            const float mxa = fmaxf(mxb[0], mxb[1]), f0 = __expf(mxb[0] - mxa), f1 = __expf(mxb[1] - mxa);
            const float inv = 1.0f / (f0 * smb[0] + f1 * smb[1]), g0 = f0 * inv, g1 = f1 * inv;
#pragma unroll
            for (int db = 0; db < 4; ++db) { uint2 w; w.x = pk_bf16(o[0][db][0] * g0 + o[1][db][0] * g1, o[0][db][1] * g0 + o[1][db][1] * g1); w.y = pk_bf16(o[0][db][2] * g0 + o[1][db][2] * g1, o[0][db][3] * g0 + o[1][db][3] * g1);
                *(uint2*)(A2 + (size_t)qrow * D + hd * 64 + 16 * db + 4 * g) = w; }
            __syncthreads();
        }
    }
    const float* cw = a.in[13]; const float* cb = a.in[14];
    const int j0 = 8 * lane;
    float w0[8], w1[8], w2[8], bb[8];
#pragma unroll
    for (int q = 0; q < 8; ++q) { w0[q] = cw[j0 + q]; w1[q] = cw[512 + j0 + q]; w2[q] = cw[1024 + j0 + q]; bb[q] = cb[j0 + q]; }
    for (int blk = F.gw; blk < R / 6; blk += F.ngw) {
        const int row0 = 6 * blk;
        v4u pw[8], bgw[6];
#pragma unroll
        for (int k = 0; k < 8; ++k) { const int rr = row0 + k - 1; pw[k] = (rr >= 0 && rr < R) ? *(const v4u*)(P + (size_t)rr * PP + 2048 + j0) : (v4u){0u, 0u, 0u, 0u}; }
#pragma unroll
        for (int k = 0; k < 6; ++k) bgw[k] = *(const v4u*)(P + (size_t)(row0 + k) * PP + 1536 + j0);
#pragma unroll
        for (int k = 0; k < 6; ++k) {
            const int row = row0 + k; const bool latr = row < NT; const int t = latr ? (row & 2047) : ((row - NT) & 255), len = latr ? 2048 : 256;
            const v4u pm = t > 0 ? pw[k] : (v4u){0u, 0u, 0u, 0u}, pc = pw[k + 1], pn = (t + 1 < len) ? pw[k + 2] : (v4u){0u, 0u, 0u, 0u}, bgv = bgw[k];
            const unsigned am[4] = {pm.x, pm.y, pm.z, pm.w}, ac[4] = {pc.x, pc.y, pc.z, pc.w}, an[4] = {pn.x, pn.y, pn.z, pn.w}, ab[4] = {bgv.x, bgv.y, bgv.z, bgv.w};
            unsigned ow[4];
#pragma unroll
            for (int q = 0; q < 4; ++q) {
                const float lo = __uint_as_float(ab[q] << 16) * (bb[2 * q] + w0[2 * q] * __uint_as_float(am[q] << 16) + w1[2 * q] * __uint_as_float(ac[q] << 16) + w2[2 * q] * __uint_as_float(an[q] << 16));
                const float hi = __uint_as_float(ab[q] & 0xffff0000u) * (bb[2 * q + 1] + w0[2 * q + 1] * __uint_as_float(am[q] & 0xffff0000u) + w1[2 * q + 1] * __uint_as_float(ac[q] & 0xffff0000u) + w2[2 * q + 1] * __uint_as_float(an[q] & 0xffff0000u));
                ow[q] = pk_bf16(lo, hi);
            }
            *(v4u*)(A2 + (size_t)row * D + 512 + j0) = (v4u){ow[0], ow[1], ow[2], ow[3]};
        }
    }
}
template <int L>
struct EpiOutProj {
    static constexpr bool PERM = true;
    const float* baseL; const float* baseC; bf16* XB; const float* MODl;
    __device__ __forceinline__ void operator()(const f32x4 (&acc)[2][2][4][2], const pg8::Unit& u, int wr, int wc, int fr, int fq) const {
        const bool lat = u.pm < NT / 256;
        const int mb = lat ? (u.pm >> 3) : 16;
        const int row0 = u.pm * 256 + wr * 64 + fr, col0 = u.pn * 256 + wc * 32 + 8 * fq;
        const float* g1 = MODl + (size_t)mb * 6144 + 2 * D + col0;
        f32x4 gv[2][2];
#pragma unroll
        for (int bj = 0; bj < 2; ++bj)
#pragma unroll
            for (int n = 0; n < 2; ++n) gv[bj][n] = *(const f32x4*)(g1 + bj * 128 + 4 * n);
#pragma unroll
        for (int ai = 0; ai < 2; ++ai)
#pragma unroll
            for (int m = 0; m < 4; ++m) { const int row = row0 + ai * 128 + m * 16;
#pragma unroll
                for (int bj = 0; bj < 2; ++bj) {
                    f32x4 b0, b1;
                    if (L == 0) { const float* bp = (lat ? baseL + (size_t)row * D : baseC + (size_t)(row - NT) * D) + col0 + bj * 128; b0 = *(const f32x4*)bp; b1 = *(const f32x4*)(bp + 4); }
                    else { const v4u w = *(const v4u*)(XB + (size_t)row * D + col0 + bj * 128);
                        b0 = (f32x4){__uint_as_float(w.x << 16), __uint_as_float(w.x & 0xffff0000u), __uint_as_float(w.y << 16), __uint_as_float(w.y & 0xffff0000u)};
                        b1 = (f32x4){__uint_as_float(w.z << 16), __uint_as_float(w.z & 0xffff0000u), __uint_as_float(w.w << 16), __uint_as_float(w.w & 0xffff0000u)}; }
                    const f32x4 v0 = b0 + gv[bj][0] * acc[ai][bj][m][0], v1 = b1 + gv[bj][1] * acc[ai][bj][m][1];
                    v4u o; o.x = pg8::cvt_pk_bf16(v0[0], v0[1]); o.y = pg8::cvt_pk_bf16(v0[2], v0[3]); o.z = pg8::cvt_pk_bf16(v1[0], v1[1]); o.w = pg8::cvt_pk_bf16(v1[2], v1[3]);
                    *(v4u*)(XB + (size_t)row * D + col0 + bj * 128) = o; }
                asm volatile("" ::: "memory"); }
    }
};
template <int L>
__device__ __forceinline__ void p_outproj(const CAS Args& a, const Frame& F) {
    const int nc = L == 0 ? OUTP0_NC : 0;
    if (F.bid >= F.G - nc) { convert_experts(a, F, 0, 0, 2, (F.bid - (F.G - nc)) * NWAVES + F.wave, nc * NWAVES, CV_E0, CV_E1); return; }
    pg8::RectSched S{(const char*)(a.ws + (L == 0 ? WS_A2 : WS_A3)), (const char*)(a.ws + (L == 0 ? WS_WOUT0 : WS_WOUT1)), 2 * D, (L == 0 ? R : NT) / 256, D / 256, F.G - nc, F.bid, 0, 0, 0, 0};
    EpiOutProj<L> E{a.in[0], a.in[2], (bf16*)(a.ws + WS_XB), (const float*)(a.ws + WS_MOD) + (size_t)L * 17 * 6144};
    pg8::gemm_phase<2 * D, false>(F.ldsl, S, E, F.wave);
}
#define RS_STEP(half, m) do { const bool up = (F.lane & (m)) != 0; _Pragma("unroll") for (int i = 0; i < (half); ++i) { \
        const float keep = up ? part[i + (half)] : part[i]; const float send = up ? part[i] : part[i + (half)]; part[i] = keep + __shfl_xor(send, (m)); } } while (0)
constexpr int RT_WH = 0, RT_WL = 65536, RT_GS = 131072, RT_LG = 139264, RT_CNT = 155648;
__device__ __forceinline__ void p_norm2_router(const CAS Args& a, const Frame& F, int l) {
    unsigned char* H8 = (unsigned char*)(a.ws + WS_H); const bf16* XB = (const bf16*)(a.ws + WS_XB);
    unsigned* ctl = (unsigned*)(a.ws + WS_CTL);
    int* toklist = (int*)(a.ws + WS_TOKLIST); int* sel = (int*)(a.ws + WS_SEL); float* gatev = (float*)(a.ws + WS_GATEV);
    const float* wr = a.in[29] + (size_t)l * D * NE; const float* br = a.in[30] + l * NE;
    const float* GS2 = (const float*)(a.ws + WS_GS2) + (size_t)l * 17 * D; const float* MODl = (const float*)(a.ws + WS_MOD) + (size_t)l * 17 * 6144;
    const int rows = l == 0 ? R : NT, rpw = rows / F.G, row_lo = F.bid * rpw, nblk = rpw / 16;
    LAS unsigned char* lds = F.ldsl;
    const int lane = F.lane, wave = F.wave, rho = lane & 15, g = lane >> 4;
    const int b_first = row_batch(row_lo);
    __syncthreads();
    {
        f32x4 wv[16];
#pragma unroll
        for (int j = 0; j < 16; ++j) wv[j] = *(const f32x4*)(wr + 4 * (F.tid + 512 * j));
#pragma unroll
        for (int j = 0; j < 16; ++j) { const int i0 = 4 * (F.tid + 512 * j), k = i0 >> 5;
#pragma unroll
            for (int q = 0; q < 4; ++q) { const int e = (i0 & 31) + q; const float w = wv[j][q]; const bf16 hi = f2bf(w), lo = f2bf(w - bf2f(hi));
                const int off = e * 2048 + 16 * ((k >> 3) ^ (e & 15)) + 2 * (k & 7);
                *(LAS bf16*)(lds + RT_WH + off) = hi; *(LAS bf16*)(lds + RT_WL + off) = lo; } }
    }
    for (int i = F.tid; i < 2 * D; i += NWAVES * 64) { const int s = i >> 10, k = i & 1023; const int bb = s == 0 ? b_first : row_batch(row_lo + rpw - 1); ((LAS float*)(lds + RT_GS))[i] = GS2[bb * D + k]; }
    LAS unsigned* wcnt = (LAS unsigned*)(lds + RT_CNT); LAS unsigned* wbase = wcnt + 32; LAS unsigned* stmp = wcnt + 64;
    if (F.tid < NE) wcnt[F.tid] = 0u;
    __syncthreads();
    for (int blk = wave; blk < nblk; blk += NWAVES) {
        const int r0 = row_lo + 16 * blk, row = r0 + rho, bb = row_batch(r0);
        const bf16* xr = XB + (size_t)row * D + 8 * g;
        float ss = 0.f;
#pragma unroll
        for (int kh = 0; kh < 2; ++kh) {
            v4u xw[16];
#pragma unroll
            for (int ks = 0; ks < 16; ++ks) xw[ks] = *(const v4u*)(xr + 32 * (16 * kh + ks));
#pragma unroll
            for (int ks = 0; ks < 16; ++ks) { const unsigned u4[4] = {xw[ks].x, xw[ks].y, xw[ks].z, xw[ks].w};
#pragma unroll
                for (int q = 0; q < 4; ++q) { const float x0 = __uint_as_float(u4[q] << 16), x1 = __uint_as_float(u4[q] & 0xffff0000u); ss += x0 * x0 + x1 * x1; } }
            asm volatile("" ::: "memory");
        }
        ss += __shfl_xor(ss, 16); ss += __shfl_xor(ss, 32);
        const float rstd = rsqrtf(ss * (1.0f / D) + 1e-6f);
        const LAS float* gs = (const LAS float*)(lds + RT_GS) + (bb == b_first ? 0 : D) + 8 * g;
        const float* sh = MODl + (size_t)bb * 6144 + 3 * D + 8 * g;
        f32x4 acc[2] = {(f32x4){0.f, 0.f, 0.f, 0.f}, (f32x4){0.f, 0.f, 0.f, 0.f}};
        int offb[4];
#pragma unroll
        for (int b4 = 0; b4 < 4; ++b4) offb[b4] = rho * 2048 + (((4 * (b4 ^ ((rho >> 2) & 3))) + (g ^ (rho & 3))) << 4);
        for (int k4 = 0; k4 < 8; ++k4) {
            v4u xw[4]; f32x4 sv[4][2];
#pragma unroll
            for (int b4 = 0; b4 < 4; ++b4) { const int ks = 4 * k4 + b4; xw[b4] = *(const v4u*)(xr + 32 * ks); sv[b4][0] = *(const f32x4*)(sh + 32 * ks); sv[b4][1] = *(const f32x4*)(sh + 32 * ks + 4); }
#pragma unroll
            for (int b4 = 0; b4 < 4; ++b4) {
                const int ks = 4 * k4 + b4;
                const unsigned u4[4] = {xw[b4].x, xw[b4].y, xw[b4].z, xw[b4].w};
                const f32x4 g0 = *(const LAS f32x4*)(gs + 32 * ks), g1 = *(const LAS f32x4*)(gs + 32 * ks + 4);
                const f32x4 s0 = sv[b4][0], s1 = sv[b4][1];
                float hv[8];
#pragma unroll
                for (int q = 0; q < 4; ++q) { const float x0 = __uint_as_float(u4[q] << 16) * rstd, x1 = __uint_as_float(u4[q] & 0xffff0000u) * rstd;
                    const float gg0 = q < 2 ? g0[2 * q] : g1[2 * q - 4], gg1 = q < 2 ? g0[2 * q + 1] : g1[2 * q - 3], t0 = q < 2 ? s0[2 * q] : s1[2 * q - 4], t1 = q < 2 ? s0[2 * q + 1] : s1[2 * q - 3];
                    hv[2 * q] = x0 * gg0 + t0; hv[2 * q + 1] = x1 * gg1 + t1; }
                v4u hi, lo;
#pragma unroll
                for (int q = 0; q < 4; ++q) { const unsigned p = pk_bf16(hv[2 * q], hv[2 * q + 1]); ((unsigned*)&hi)[q] = p;
                    ((unsigned*)&lo)[q] = pk_bf16(hv[2 * q] - __uint_as_float(p << 16), hv[2 * q + 1] - __uint_as_float(p & 0xffff0000u)); }
                { uint2 f8; unsigned t0 = 0u, t1 = 0u; t0 = __builtin_amdgcn_cvt_pk_fp8_f32(hv[0], hv[1], t0, false); t0 = __builtin_amdgcn_cvt_pk_fp8_f32(hv[2], hv[3], t0, true);
                  t1 = __builtin_amdgcn_cvt_pk_fp8_f32(hv[4], hv[5], t1, false); t1 = __builtin_amdgcn_cvt_pk_fp8_f32(hv[6], hv[7], t1, true); f8.x = t0; f8.y = t1;
                  *(uint2*)(H8 + (size_t)row * D + 32 * ks + 8 * g) = f8; }
#pragma unroll
                for (int nt = 0; nt < 2; ++nt) { const int off = nt * 32768 + k4 * 256 + offb[b4];
                    const bf16x8 bh = *(const LAS bf16x8*)(lds + RT_WH + off), bl = *(const LAS bf16x8*)(lds + RT_WL + off);
                    acc[nt] = __builtin_amdgcn_mfma_f32_16x16x32_bf16(__builtin_bit_cast(bf16x8, hi), bh, acc[nt], 0, 0, 0);
                    acc[nt] = __builtin_amdgcn_mfma_f32_16x16x32_bf16(__builtin_bit_cast(bf16x8, lo), bh, acc[nt], 0, 0, 0);
                    acc[nt] = __builtin_amdgcn_mfma_f32_16x16x32_bf16(__builtin_bit_cast(bf16x8, hi), bl, acc[nt], 0, 0, 0); }
            }
        }
        LAS float* lg = (LAS float*)(lds + RT_LG + wave * 2048);
#pragma unroll
        for (int nt = 0; nt < 2; ++nt)
#pragma unroll
            for (int jj = 0; jj < 4; ++jj) lg[(4 * g + jj) * 32 + 16 * nt + rho] = acc[nt][jj] + br[16 * nt + rho];
        {
            float mine[8], allv[32];
#pragma unroll
            for (int q = 0; q < 8; ++q) { const f32x4 t = *(const LAS f32x4*)(lg + rho * 32 + 4 * q); allv[4 * q] = t[0]; allv[4 * q + 1] = t[1]; allv[4 * q + 2] = t[2]; allv[4 * q + 3] = t[3]; }
#pragma unroll
            for (int q = 0; q < 8; ++q) mine[q] = g == 0 ? allv[q] : g == 1 ? allv[8 + q] : g == 2 ? allv[16 + q] : allv[24 + q];
            LAS float* rs = lg;
#pragma unroll
            for (int q = 0; q < 8; ++q) { const int e = 8 * g + q; int rank = 0;
#pragma unroll
                for (int jx = 0; jx < 32; ++jx) rank += (allv[jx] > mine[q] || (allv[jx] == mine[q] && jx < e)) ? 1 : 0;
                if (rank < 4) { rs[(rho * 4 + rank) * 2] = mine[q]; ((LAS int*)rs)[(rho * 4 + rank) * 2 + 1] = e; } }
            if (lane < 16) {
                const f32x4 q0 = *(const LAS f32x4*)(rs + lane * 8), q1 = *(const LAS f32x4*)(rs + lane * 8 + 4);
                const float tv0 = q0[0], tv1 = q0[2], tv2 = q1[0], tv3 = q1[2]; const int ti[4] = {__float_as_int(q0[1]), __float_as_int(q0[3]), __float_as_int(q1[1]), __float_as_int(q1[3])};
                const float e1 = __expf(tv1 - tv0), e2 = __expf(tv2 - tv0), e3 = __expf(tv3 - tv0), inv = 1.0f / (1.0f + e1 + e2 + e3);
                const float gk[4] = {inv, e1 * inv, e2 * inv, e3 * inv};
                const int rl = 16 * blk + lane;
#pragma unroll
                for (int k = 0; k < 4; ++k) { const unsigned p = __hip_atomic_fetch_add(wcnt + ti[k], 1u, __ATOMIC_RELAXED, __HIP_MEMORY_SCOPE_WORKGROUP);
                    stmp[(rl * 4 + k) * 2] = (p << 5) | (unsigned)ti[k]; stmp[(rl * 4 + k) * 2 + 1] = __float_as_uint(gk[k]); }
            }
        }
    }
    __syncthreads();
    if (F.tid < NE) { const unsigned c = wcnt[F.tid]; wbase[F.tid] = c ? __hip_atomic_fetch_add(ctl + CW_CNT + (l * 32 + F.tid) * 64, c, RLX_AGENT) : 0u; }
    __syncthreads();
    for (int i = F.tid; i < rpw * 4; i += NWAVES * 64) { const int rl = i >> 2, k = i & 3, r = row_lo + rl; const unsigned pe = stmp[i * 2], e = pe & 31u, pos = wbase[e] + (pe >> 5);
        toklist[(size_t)e * CAP + pos] = r; sel[r * 4 + k] = (int)((pos << 5) | e); gatev[r * 4 + k] = __uint_as_float(stmp[i * 2 + 1]); }
}
struct MoeTab { int cnt[NE], base[NE + 1], tpre[NE + 1]; };
__device__ __forceinline__ void moe_tab_build(const CAS Args& a, const Frame& F, int l, LAS MoeTab* tb) {
    unsigned* ctl = (unsigned*)(a.ws + WS_CTL);
    __syncthreads();
    if (F.tid < NE) tb->cnt[F.tid] = (int)__hip_atomic_load(ctl + CW_CNT + (l * 32 + F.tid) * 64, RLX_AGENT);
    __syncthreads();
    if (F.tid == 0) { int bs = 0, tp = 0; for (int e = 0; e < NE; ++e) { const int c = tb->cnt[e]; tb->base[e] = bs; tb->tpre[e] = tp; bs += c; tp += (c + 255) >> 8; } tb->base[NE] = bs; tb->tpre[NE] = tp; }
    __syncthreads();
}
constexpr int MOE_UT_MAX = 64;
template <bool UP>
struct MoeSched {
    static constexpr bool GATHER = UP;
    const LAS MoeTab* tb; const LAS int* ut; const char* A; const char* WE; const int* toklist; int G, c;
    static constexpr int NN = UP ? 8 : 4;
    static __device__ __forceinline__ int rfl(int v) { return __builtin_amdgcn_readfirstlane(v); }
    static __device__ __forceinline__ const char* ufy(const char* p) { const unsigned long long v = (unsigned long long)p; const unsigned lo = __builtin_amdgcn_readfirstlane((unsigned)v), hi = __builtin_amdgcn_readfirstlane((unsigned)(v >> 32)); return (const char*)(((unsigned long long)hi << 32) | lo); }
    __device__ __forceinline__ bool unit_search(int i, int& pm, int& pn, int& e_, int& rows, int& base) const {
        const int nwg = tb->tpre[NE] * NN; const long L = (long)i * G + c; if (L >= nwg) return false;
        const int w = pg8::xcd_remap(L, nwg);
        int e = 0; while (e < NE - 1 && w >= tb->tpre[e + 1] * NN) ++e;
        const int tp0 = tb->tpre[e], tp1 = tb->tpre[e + 1];
        const int q = w - tp0 * NN, nte = tp1 - tp0;
        const int nig = 8 * NN, gid = q / nig, fm = gid * 8, gsz = (nte - fm) < 8 ? (nte - fm) : 8;
        pm = fm + ((q % nig) % gsz); pn = (q % nig) / gsz; e_ = e; rows = min(256, tb->cnt[e] - pm * 256); base = tb->base[e] + pm * 256;
        return true;
    }
    __device__ __forceinline__ void build(LAS int* utw, int tid) const {
        if (tid < MOE_UT_MAX) { int pm = -1, pn = 0, e = 0, rows = 0, base = 0; unit_search(tid, pm, pn, e, rows, base);
            utw[tid * 8 + 0] = pm; utw[tid * 8 + 1] = pn; utw[tid * 8 + 2] = e; utw[tid * 8 + 3] = rows; utw[tid * 8 + 4] = base; }
    }
    __device__ __forceinline__ bool unit(int i, pg8::Unit& u) const {
        if (i >= MOE_UT_MAX) return false;
        const LAS int* p = ut + i * 8; const int pm = rfl(p[0]); if (pm < 0) return false;
        u.pm = pm; u.pn = rfl(p[1]); u.e = rfl(p[2]); u.rows = rfl(p[3]); u.base = rfl(p[4]); u.newe = (i == 0) || (rfl(p[2 - 8]) != u.e);
        return true;
    }
    __device__ __forceinline__ bool bases(int i, const char*& a, const char*& b) const {
        pg8::Unit u; if (!unit(i, u)) return false;
        a = UP ? A : A + (size_t)u.base * D;
        b = WE + (size_t)u.e * 3072 * 1024 + (UP ? 0 : (size_t)2048 * 1024) + (size_t)u.pn * 256 * 1024;
        a = ufy(a); b = ufy(b);
        return true;
    }
    __device__ __forceinline__ void atoks(int i, const int (&rA)[2], int (&tok)[2][2]) const {
        pg8::Unit u; unit(i, u);
        const int* tl = toklist + (size_t)u.e * CAP + u.pm * 256;
#pragma unroll
        for (int h = 0; h < 2; ++h)
#pragma unroll
            for (int i2 = 0; i2 < 2; ++i2) { const int rr = h * 128 + rA[i2]; tok[h][i2] = tl[rr < u.rows ? rr : 0]; }
    }
    __device__ __forceinline__ void aoffs(int i, const int (&rA)[2], const unsigned (&voffA)[2], unsigned (&off)[2][2]) const {
        pg8::Unit u; unit(i, u);
        const int* tl = toklist + (size_t)u.e * CAP + u.pm * 256;
#pragma unroll
        for (int h = 0; h < 2; ++h)
#pragma unroll
            for (int i2 = 0; i2 < 2; ++i2) { const int rr = h * 128 + rA[i2]; const int tok = tl[rr < u.rows ? rr : 0]; off[h][i2] = (unsigned)tok * (unsigned)D + voffA[i2]; }
    }
};
struct EpiMoeUp {
    static constexpr bool PERM = true;
    bf16* ACT; const float* bgate; const float* bup; LAS float* btab;
    __device__ __forceinline__ void operator()(const f32x4 (&acc)[2][2][4][2], const pg8::Unit& u, int wr, int wc, int fr, int fq) const {
        const int col0 = u.pn * 128 + wc * 32 + 8 * fq, rl0 = wr * 64 + fr;
        if (u.newe) { const int tid = (wr * 4 + wc) * 64 + fr + 16 * fq;
            const f32x4 t = *(const f32x4*)((tid < 256 ? bgate : bup) + u.e * D + 4 * (tid & 255));
            *(LAS f32x4*)(btab + 4 * tid) = t;
            asm volatile("s_waitcnt lgkmcnt(0)" ::: "memory"); __builtin_amdgcn_s_barrier(); asm volatile("" ::: "memory"); }
        f32x2_t bg[2][2], bu[2][2];
#pragma unroll
        for (int n = 0; n < 2; ++n) { const f32x4 g4 = *(const LAS f32x4*)(btab + col0 + 4 * n), u4 = *(const LAS f32x4*)(btab + 1024 + col0 + 4 * n);
            bg[n][0] = (f32x2_t){g4[0], g4[1]}; bg[n][1] = (f32x2_t){g4[2], g4[3]};
            bu[n][0] = (f32x2_t){u4[0], u4[1]} * ACT8_SCALE + ACT8_SCALE; bu[n][1] = (f32x2_t){u4[2], u4[3]} * ACT8_SCALE + ACT8_SCALE; }
#pragma unroll
        for (int ai = 0; ai < 2; ++ai)
#pragma unroll
            for (int m = 0; m < 4; ++m) { const int rl = rl0 + ai * 128 + m * 16;
                f32x2_t o[2][2];
#pragma unroll
                for (int n = 0; n < 2; ++n)
#pragma unroll
                    for (int p = 0; p < 2; ++p) {
                        f32x2_t gg = (f32x2_t){acc[ai][0][m][n][2 * p], acc[ai][0][m][n][2 * p + 1]} * (1.0f / W8_SCALE) + bg[n][p];
                        gg.x = fminf(gg.x, 7.0f); gg.y = fminf(gg.y, 7.0f);
                        const f32x2_t tt = gg * (-1.702f * 1.44269504f);
                        f32x2_t dd; dd.x = __builtin_amdgcn_exp2f(tt.x); dd.y = __builtin_amdgcn_exp2f(tt.y); dd = dd + 1.0f;
                        f32x2_t rr; rr.x = __builtin_amdgcn_rcpf(dd.x); rr.y = __builtin_amdgcn_rcpf(dd.y);
                        f32x2_t uu = (f32x2_t){acc[ai][1][m][n][2 * p], acc[ai][1][m][n][2 * p + 1]} * (ACT8_SCALE / W8_SCALE) + bu[n][p];
                        uu.x = __builtin_amdgcn_fmed3f(uu.x, -6.0f * ACT8_SCALE, 8.0f * ACT8_SCALE); uu.y = __builtin_amdgcn_fmed3f(uu.y, -6.0f * ACT8_SCALE, 8.0f * ACT8_SCALE);
                        o[n][p] = (gg * rr) * uu;
                    }
                if (rl < u.rows) { uint2 w; unsigned w0 = 0u, w1 = 0u;
                    w0 = __builtin_amdgcn_cvt_pk_fp8_f32(o[0][0].x, o[0][0].y, w0, false); w0 = __builtin_amdgcn_cvt_pk_fp8_f32(o[0][1].x, o[0][1].y, w0, true);
                    w1 = __builtin_amdgcn_cvt_pk_fp8_f32(o[1][0].x, o[1][0].y, w1, false); w1 = __builtin_amdgcn_cvt_pk_fp8_f32(o[1][1].x, o[1][1].y, w1, true);
                    w.x = w0; w.y = w1;
                    *(uint2*)((unsigned char*)ACT + (size_t)(u.base + rl) * D + col0) = w; } }
    }
};
struct EpiMoeDown {
    static constexpr bool PERM = true;
    unsigned char* YB; const float* bdown; LAS float* btab;
    __device__ __forceinline__ void operator()(const f32x4 (&acc)[2][2][4][2], const pg8::Unit& u, int wr, int wc, int fr, int fq) const {
        const int col0 = u.pn * 256 + wc * 64 + 16 * fq, rl0 = wr * 64 + fr;
        if (u.newe) { const int tid = (wr * 4 + wc) * 64 + fr + 16 * fq;
            if (tid < 256) { const f32x4 t = *(const f32x4*)(bdown + u.e * D + 4 * tid); *(LAS f32x4*)(btab + 4 * tid) = t; }
            asm volatile("s_waitcnt lgkmcnt(0)" ::: "memory"); __builtin_amdgcn_s_barrier(); asm volatile("" ::: "memory"); }
        f32x4 bv[2][2];
#pragma unroll
        for (int bj = 0; bj < 2; ++bj)
#pragma unroll
            for (int n = 0; n < 2; ++n) bv[bj][n] = *(const LAS f32x4*)(btab + col0 + 8 * bj + 4 * n) * YB8_SCALE;
#pragma unroll
        for (int ai = 0; ai < 2; ++ai)
#pragma unroll
            for (int m = 0; m < 4; ++m) { const int rl = rl0 + ai * 128 + m * 16;
                if (rl < u.rows) { v4u w;
                    { const f32x4 v = acc[ai][0][m][0] * (YB8_SCALE / (W8_SCALE * ACT8_SCALE)) + bv[0][0]; w.x = pk4_fp8(v[0], v[1], v[2], v[3]); }
                    { const f32x4 v = acc[ai][0][m][1] * (YB8_SCALE / (W8_SCALE * ACT8_SCALE)) + bv[0][1]; w.y = pk4_fp8(v[0], v[1], v[2], v[3]); }
                    { const f32x4 v = acc[ai][1][m][0] * (YB8_SCALE / (W8_SCALE * ACT8_SCALE)) + bv[1][0]; w.z = pk4_fp8(v[0], v[1], v[2], v[3]); }
                    { const f32x4 v = acc[ai][1][m][1] * (YB8_SCALE / (W8_SCALE * ACT8_SCALE)) + bv[1][1]; w.w = pk4_fp8(v[0], v[1], v[2], v[3]); }
                    *(v4u*)(YB + (size_t)(u.base + rl) * D + col0) = w; } }
    }
};
constexpr int LDS_TAB = 131072;
__device__ __forceinline__ void p_moe_up(const CAS Args& a, const Frame& F, int l) {
    const int nc = l == 0 ? MOE_NC : 0;
    if (F.bid >= F.G - nc) { const int cw = (F.bid - (F.G - nc)) * NWAVES + F.wave; convert_experts(a, F, 0, 2, 3, cw, nc * NWAVES); convert_experts(a, F, 1, 0, 2, cw, nc * NWAVES, 0, CV_E3); return; }
    LAS MoeTab* tb = (LAS MoeTab*)(F.ldsl + LDS_TAB); moe_tab_build(a, F, l, tb);
    LAS int* utw = (LAS int*)(F.ldsl + LDS_TAB + 1024);
    MoeSched<true> S{tb, utw, (const char*)(a.ws + WS_H), (const char*)(a.ws + WS_WEXP) + (size_t)l * NE * 3072 * 1024, (const int*)(a.ws + WS_TOKLIST), F.G - nc, F.bid};
    S.build(utw, F.tid); __syncthreads();
    EpiMoeUp E{(bf16*)(a.ws + WS_ACT), a.in[32] + (size_t)l * NE * D, a.in[34] + (size_t)l * NE * D, (LAS float*)(F.ldsl + LDS_TAB + 4096)};
    pg8::gemm_phase<D, true>(F.ldsl, S, E, F.wave);
}
__device__ __forceinline__ void p_moe_down(const CAS Args& a, const Frame& F, int l) {
    const int nc = l == 0 ? MOE_NC : 0;
    if (F.bid >= F.G - nc) { const int cw = (F.bid - (F.G - nc)) * NWAVES + F.wave; convert_experts(a, F, 1, 2, 3, cw, nc * NWAVES); convert_experts(a, F, 1, 0, 2, cw, nc * NWAVES, CV_E3, CV_E2); return; }
    LAS MoeTab* tb = (LAS MoeTab*)(F.ldsl + LDS_TAB); moe_tab_build(a, F, l, tb);
    LAS int* utw = (LAS int*)(F.ldsl + LDS_TAB + 1024);
    MoeSched<false> S{tb, utw, (const char*)(a.ws + WS_ACT), (const char*)(a.ws + WS_WEXP) + (size_t)l * NE * 3072 * 1024, nullptr, F.G - nc, F.bid};
    S.build(utw, F.tid); __syncthreads();
    EpiMoeDown E{(unsigned char*)(a.ws + WS_YB), a.in[36] + (size_t)l * NE * D, (LAS float*)(F.ldsl + LDS_TAB + 4096)};
    pg8::gemm_phase<D, true>(F.ldsl, S, E, F.wave);
}
__device__ __forceinline__ void p_combine(const CAS Args& a, const Frame& F, int l) {
    const unsigned char* YB = (const unsigned char*)(a.ws + WS_YB); bf16* XB = (bf16*)(a.ws + WS_XB); bf16* H = (bf16*)(a.ws + WS_H);
    const int* sel = (const int*)(a.ws + WS_SEL); const float* gatev = (const float*)(a.ws + WS_GATEV);
    LAS MoeTab* tb = (LAS MoeTab*)(F.ldsl + LDS_TAB); moe_tab_build(a, F, l, tb);
    const int rows = l == 0 ? R : NT, lane = F.lane;
    const int rpw = (((rows + F.ngw - 1) / F.ngw) + 1) & ~1, r_lo = F.gw * rpw, r_hi = min(rows, r_lo + rpw);
    float g2v[16], gpv[16], shv[16], scv[16]; int cb = -1;
    if (l == 0) {
#pragma unroll
        for (int jh = 0; jh < 2; ++jh)
#pragma unroll
            for (int q = 0; q < 2; ++q) { const f32x4 t = *(const f32x4*)(a.in[6] + D + 512 * jh + 8 * lane + 4 * q);
#pragma unroll
                for (int c = 0; c < 4; ++c) gpv[8 * jh + 4 * q + c] = t[c]; } }
    int sv[2][4]; float gk[2][4];
#pragma unroll
    for (int t = 0; t < 2; ++t)
#pragma unroll
        for (int k = 0; k < 4; ++k) { const int rr = min(r_lo + t, rows - 1); sv[t][k] = sel[rr * 4 + k]; gk[t][k] = gatev[rr * 4 + k]; }
    for (int r = r_lo; r < r_hi; r += 2) {
        v4u xw[2][2]; uint2 yw[2][4][2];
#pragma unroll
        for (int t = 0; t < 2; ++t) { const int rr = min(r + t, rows - 1);
#pragma unroll
            for (int jh = 0; jh < 2; ++jh) xw[t][jh] = *(const v4u*)(XB + (size_t)rr * D + 512 * jh + 8 * lane);
#pragma unroll
            for (int k = 0; k < 4; ++k) { const int e = sv[t][k] & 31, pos = sv[t][k] >> 5;
                const unsigned char* y = YB + (size_t)(tb->base[e] + pos) * D;
#pragma unroll
                for (int jh = 0; jh < 2; ++jh) yw[t][k][jh] = *(const uint2*)(y + 512 * jh + 8 * lane); } }
        int nsv[2][4]; float ngk[2][4];
#pragma unroll
        for (int t = 0; t < 2; ++t)
#pragma unroll
            for (int k = 0; k < 4; ++k) { const int rr = min(r + 2 + t, rows - 1); nsv[t][k] = sel[rr * 4 + k]; ngk[t][k] = gatev[rr * 4 + k]; }
        const int bq = row_batch(r);
        if (bq != cb) { cb = bq;
            const float* g2 = mod_ptr(a, l, r, 5); const float* shp = mod_ptr(a, 1, r, 0); const float* scp = mod_ptr(a, 1, r, 1);
#pragma unroll
            for (int jh = 0; jh < 2; ++jh)
#pragma unroll
                for (int q = 0; q < 2; ++q) { const int e0 = 512 * jh + 8 * lane + 4 * q; const f32x4 gg = *(const f32x4*)(g2 + e0);
#pragma unroll
                    for (int c = 0; c < 4; ++c) g2v[8 * jh + 4 * q + c] = gg[c];
                    if (l == 0) { const f32x4 ss = *(const f32x4*)(shp + e0), cc = *(const f32x4*)(scp + e0);
#pragma unroll
                        for (int c = 0; c < 4; ++c) { shv[8 * jh + 4 * q + c] = ss[c]; scv[8 * jh + 4 * q + c] = gpv[8 * jh + 4 * q + c] * (1.f + cc[c]); } } } }
#pragma unroll
        for (int t = 0; t < 2; ++t) { const int rr = r + t; if (rr < r_hi) {
            float m[16], v[16];
#pragma unroll
            for (int i = 0; i < 16; ++i) m[i] = 0.f;
#pragma unroll
            for (int k = 0; k < 4; ++k) { const float gg = gk[t][k] * (1.0f / YB8_SCALE);
#pragma unroll
                for (int jh = 0; jh < 2; ++jh) { const unsigned w2[2] = {yw[t][k][jh].x, yw[t][k][jh].y};
#pragma unroll
                    for (int q = 0; q < 2; ++q) { const f32x2_t lo = __builtin_amdgcn_cvt_pk_f32_fp8((int)w2[q], false), hi = __builtin_amdgcn_cvt_pk_f32_fp8((int)w2[q], true);
                        m[8 * jh + 4 * q] += gg * lo.x; m[8 * jh + 4 * q + 1] += gg * lo.y; m[8 * jh + 4 * q + 2] += gg * hi.x; m[8 * jh + 4 * q + 3] += gg * hi.y; } } }
#pragma unroll
            for (int jh = 0; jh < 2; ++jh) { const unsigned x4[4] = {xw[t][jh].x, xw[t][jh].y, xw[t][jh].z, xw[t][jh].w};
#pragma unroll
                for (int q = 0; q < 4; ++q) { v[8 * jh + 2 * q] = __uint_as_float(x4[q] << 16); v[8 * jh + 2 * q + 1] = __uint_as_float(x4[q] & 0xffff0000u); } }
#pragma unroll
            for (int i = 0; i < 16; ++i) v[i] += g2v[i] * m[i];
            if (l == 0) {
#pragma unroll
                for (int jh = 0; jh < 2; ++jh) *(v4u*)(XB + (size_t)rr * D + 512 * jh + 8 * lane) = (v4u){pk_bf16(v[8 * jh], v[8 * jh + 1]), pk_bf16(v[8 * jh + 2], v[8 * jh + 3]), pk_bf16(v[8 * jh + 4], v[8 * jh + 5]), pk_bf16(v[8 * jh + 6], v[8 * jh + 7])};
                float s = 0.f;
#pragma unroll
                for (int i2 = 0; i2 < 16; ++i2) s += v[i2] * v[i2];
                const float rstd = rsqrtf(wave_sum(s) * (1.0f / D) + 1e-6f);
#pragma unroll
                for (int jh = 0; jh < 2; ++jh) { float hv[8];
#pragma unroll
                    for (int c = 0; c < 8; ++c) hv[c] = v[8 * jh + c] * rstd * scv[8 * jh + c] + shv[8 * jh + c];
                    *(v4u*)(H + (size_t)rr * D + 512 * jh + 8 * lane) = (v4u){pk_bf16(hv[0], hv[1]), pk_bf16(hv[2], hv[3]), pk_bf16(hv[4], hv[5]), pk_bf16(hv[6], hv[7])}; }
            } else {
#pragma unroll
                for (int jh = 0; jh < 2; ++jh)
#pragma unroll
                    for (int q = 0; q < 2; ++q) *(f32x4*)(a.out + (size_t)rr * D + 512 * jh + 8 * lane + 4 * q) = (f32x4){v[8 * jh + 4 * q], v[8 * jh + 4 * q + 1], v[8 * jh + 4 * q + 2], v[8 * jh + 4 * q + 3]};
            } } }
#pragma unroll
        for (int t = 0; t < 2; ++t)
#pragma unroll
            for (int k = 0; k < 4; ++k) { sv[t][k] = nsv[t][k]; gk[t][k] = ngk[t][k]; }
    }
}
struct EpiInProj1 {
    static constexpr bool PERM = true;
    bf16* Gt; bf16* U;
    __device__ __forceinline__ void operator()(const f32x4 (&acc)[2][2][4][2], const pg8::Unit& u, int wr, int wc, int fr, int fq) const {
        const int row0 = u.pm * 256 + wr * 64 + fr; const bool gate = u.pn < 4;
        bf16* dst = gate ? Gt : U; const int col0 = (u.pn & 3) * 256 + wc * 32 + 8 * fq;
#pragma unroll
        for (int ai = 0; ai < 2; ++ai)
#pragma unroll
            for (int m = 0; m < 4; ++m) { bf16* rowp = dst + (size_t)(row0 + ai * 128 + m * 16) * D + col0;
#pragma unroll
                for (int bj = 0; bj < 2; ++bj) { f32x4 v0 = acc[ai][bj][m][0], v1 = acc[ai][bj][m][1];
                    if (gate) {
#pragma unroll
                        for (int j = 0; j < 4; ++j) { const float x = v0[j]; v0[j] = x * __builtin_amdgcn_rcpf(1.0f + __expf(-1.5957691216f * (x + 0.044715f * x * x * x)));
                                                      const float y = v1[j]; v1[j] = y * __builtin_amdgcn_rcpf(1.0f + __expf(-1.5957691216f * (y + 0.044715f * y * y * y))); } }
                    v4u w; w.x = pg8::cvt_pk_bf16(v0[0], v0[1]); w.y = pg8::cvt_pk_bf16(v0[2], v0[3]); w.z = pg8::cvt_pk_bf16(v1[0], v1[1]); w.w = pg8::cvt_pk_bf16(v1[2], v1[3]);
                    *(v4u*)(rowp + bj * 128) = w; } }
    }
};
__device__ __forceinline__ void p_inproj1(const CAS Args& a, const Frame& F) {
    if (F.bid >= F.G - INP1_NC) { convert_experts(a, F, 1, 0, 2, (F.bid - (F.G - INP1_NC)) * NWAVES + F.wave, INP1_NC * NWAVES, CV_E2, NE); return; }
    pg8::RectSched S{(const char*)(a.ws + WS_H), (const char*)(a.ws + WS_WIN1), 2 * D, NT / 256, 8, F.G - INP1_NC, F.bid, NC / 256, 4, NT / 256, 4};
    EpiInProj1 E{(bf16*)(a.ws + WS_G), (bf16*)(a.ws + WS_U)};
    pg8::gemm_phase<2 * D, false>(F.ldsl, S, E, F.wave);
}
__device__ __forceinline__ void p_conv4(const CAS Args& a, const Frame& F) {
    const bf16* U = (const bf16*)(a.ws + WS_U); bf16* UC = (bf16*)(a.ws + WS_UC);
    for (int u = F.gw; u < (R / 8) * 2; u += F.ngw) {
        const int rb = u >> 1, ch0 = (u & 1) * 512 + 8 * F.lane, row0 = rb * 8;
        const bool lat = row0 < NT; const int t0 = lat ? (row0 & 2047) : ((row0 - NT) & 255), len = lat ? 2048 : 256;
        float cw[4][8], cbv[8];
#pragma unroll
        for (int q = 0; q < 8; ++q) { cbv[q] = a.in[18][ch0 + q];
#pragma unroll
            for (int k = 0; k < 4; ++k) cw[k][q] = a.in[17][k * D + ch0 + q]; }
        v4u uv[11];
#pragma unroll
        for (int k = 0; k < 11; ++k) { const int tt = t0 + k - 1; uv[k] = (tt >= 0 && tt < len) ? *(const v4u*)(U + (size_t)(row0 + k - 1) * D + ch0) : (v4u){0u, 0u, 0u, 0u}; }
#pragma unroll
        for (int i = 0; i < 8; ++i) {
            float acc[8];
#pragma unroll
            for (int q = 0; q < 8; ++q) acc[q] = cbv[q];
#pragma unroll
            for (int k = 0; k < 4; ++k) { const unsigned w[4] = {uv[i + k].x, uv[i + k].y, uv[i + k].z, uv[i + k].w};
#pragma unroll
                for (int q = 0; q < 4; ++q) { acc[2 * q] += cw[k][2 * q] * __uint_as_float(w[q] << 16); acc[2 * q + 1] += cw[k][2 * q + 1] * __uint_as_float(w[q] & 0xffff0000u); } }
            *(v4u*)(UC + (size_t)(row0 + i) * D + ch0) = (v4u){pk_bf16(acc[0], acc[1]), pk_bf16(acc[2], acc[3]), pk_bf16(acc[4], acc[5]), pk_bf16(acc[6], acc[7])};
        }
    }
}
constexpr int LR_A = 0, LR_SC = 65536, LR_AG = 131072, LR_CY = LR_AG + 8192;
__device__ __forceinline__ void p_lru(const CAS Args& a, const Frame& F) {
    const bf16* UC = (const bf16*)(a.ws + WS_UC); const bf16* WL = (const bf16*)(a.ws + WS_WLRU); const bf16* Gt = (const bf16*)(a.ws + WS_G);
    bf16* HF = (bf16*)(a.ws + WS_HF); bf16* A3 = (bf16*)(a.ws + WS_A3);
    LAS unsigned char* lds = F.ldsl;
    const int lane_ = F.lane, wave = F.wave, sub = wave & 3, th = wave >> 2;
    for (int wu = F.bid; wu < 256; wu += F.G) {
        const int b = wu >> 4, h = (wu >> 2) & 3, cg = wu & 3;
        for (int dir = 0; dir < 2; ++dir) {
            const int lane = lane_, rho = lane & 15, g = lane >> 4;
            bf16x8 bw[2][8];
#pragma unroll
            for (int n = 0; n < 2; ++n)
#pragma unroll
                for (int ks = 0; ks < 8; ++ks) bw[n][ks] = *(const bf16x8*)(WL + ((size_t)h * 1024 + (2 * dir + n) * 256 + cg * 64 + 16 * sub + rho) * 256 + 32 * ks + 8 * g);
            const int chc = h * 256 + cg * 64 + 16 * sub + rho;
            const float bav = (dir ? a.in[25] : a.in[20])[chc] * -1.44269504f, bxv = (dir ? a.in[27] : a.in[22])[chc] * -1.44269504f;
            const float lamv = (dir ? a.in[28] : a.in[23])[chc];
            const float L8 = -8.0f * log1pf(expf(-lamv)) * 1.44269504f;
            __syncthreads();
            if (wave == 0) ((LAS float*)(lds + LR_CY))[lane] = 0.f;
#define LR_GROW0(ck_) ((ck_) < 2 ? (size_t)(NT + b * 256 + 128 * (dir ? 1 - (ck_) : (ck_))) : (size_t)(b * 2048 + 128 * (dir ? 15 - ((ck_) - 2) : (ck_) - 2)))
#define LR_STAGE(ck_) do { const size_t g0_ = LR_GROW0(ck_); _Pragma("unroll") for (int p_ = 0; p_ < 8; ++p_) { const int pc_ = wave * 8 + p_, row_ = 2 * pc_ + (lane >> 5), c_ = (lane & 31) ^ (row_ & 15); \
                __builtin_amdgcn_global_load_lds((const unsigned*)((const char*)UC + (g0_ + row_) * (D * 2) + h * 512 + 16 * c_), (LAS unsigned*)(lds + LR_A + pc_ * 1024), 16, 0, 0); } } while (0)
            LR_STAGE(0);
            for (int ck = 0; ck < 18; ++ck) {
                const bool isctx = ck < 2;
                const size_t grow0 = LR_GROW0(ck);
                int lane = lane_; asm volatile("" : "+v"(lane)); const int rho = lane & 15, g = lane >> 4, chs = h * 256 + cg * 64 + lane, ucol = cg * 64 + 16 * sub + rho;
                asm volatile("s_waitcnt vmcnt(0)" ::: "memory");
                __syncthreads();
                const int row0 = dir ? 112 - 16 * wave : 16 * wave;
                v4u hfr[2] = {(v4u){0u, 0u, 0u, 0u}, (v4u){0u, 0u, 0u, 0u}}, gtr[2] = {(v4u){0u, 0u, 0u, 0u}, (v4u){0u, 0u, 0u, 0u}};
                if (dir && !isctx) {
#pragma unroll
                    for (int t = 0; t < 2; ++t) { const int tk = lane + 64 * t; const size_t gi = (grow0 + row0 + (tk >> 3)) * D + h * 256 + cg * 64 + 8 * (tk & 7);
                        hfr[t] = *(const v4u*)(HF + gi); gtr[t] = *(const v4u*)(Gt + gi); } }
                {
                    f32x4 acc[4][2];
#pragma unroll
                    for (int m = 0; m < 4; ++m)
#pragma unroll
                        for (int n = 0; n < 2; ++n) acc[m][n] = (f32x4){0.f, 0.f, 0.f, 0.f};
#pragma unroll
                    for (int ks = 0; ks < 8; ++ks)
#pragma unroll
                        for (int m = 0; m < 4; ++m) { const int rw = 64 * th + 16 * m + rho; const bf16x8 af = *(const LAS bf16x8*)(lds + LR_A + rw * 512 + (((4 * ks + g) ^ (rw & 15)) << 4));
#pragma unroll
                            for (int n = 0; n < 2; ++n) acc[m][n] = __builtin_amdgcn_mfma_f32_16x16x32_bf16(af, bw[n][ks], acc[m][n], 0, 0, 0);
                            if (m == 3 && (ks & 1)) asm volatile("" ::: "memory"); }
#pragma unroll
                    for (int m = 0; m < 4; ++m)
#pragma unroll
                        for (int p = 0; p < 2; ++p) {
                            const int row = 64 * th + 16 * m + 4 * g + 2 * p;
                            f32x2_t uc;
                            uc.x = bf2f(*(const LAS bf16*)(lds + LR_A + row * 512 + (((ucol >> 3) ^ (row & 15)) << 4) + 2 * (ucol & 7)));
                            uc.y = bf2f(*(const LAS bf16*)(lds + LR_A + (row + 1) * 512 + (((ucol >> 3) ^ ((row + 1) & 15)) << 4) + 2 * (ucol & 7)));
                            const f32x2_t xa = (f32x2_t){acc[m][0][2 * p], acc[m][0][2 * p + 1]} * -1.44269504f + bav, xx = (f32x2_t){acc[m][1][2 * p], acc[m][1][2 * p + 1]} * -1.44269504f + bxv;
                            f32x2_t da, dx; da.x = __builtin_amdgcn_exp2f(xa.x); da.y = __builtin_amdgcn_exp2f(xa.y); dx.x = __builtin_amdgcn_exp2f(xx.x); dx.y = __builtin_amdgcn_exp2f(xx.y);
                            da = da + 1.0f; dx = dx + 1.0f;
                            f32x2_t rr, ii; rr.x = __builtin_amdgcn_rcpf(da.x); rr.y = __builtin_amdgcn_rcpf(da.y); ii.x = __builtin_amdgcn_rcpf(dx.x); ii.y = __builtin_amdgcn_rcpf(dx.y);
                            const f32x2_t la = rr * L8;
                            f32x2_t av; av.x = __builtin_amdgcn_exp2f(la.x); av.y = __builtin_amdgcn_exp2f(la.y);
                            f32x2_t tt = 1.0f - av * av; tt.x = fmaxf(tt.x, 0.f); tt.y = fmaxf(tt.y, 0.f);
                            f32x2_t sq; sq.x = __builtin_amdgcn_sqrtf(tt.x); sq.y = __builtin_amdgcn_sqrtf(tt.y);
                            const f32x2_t bv = sq * ii * uc;
                            *(LAS f32x2_t*)(lds + LR_SC + (row * 64 + 16 * sub + rho) * 8) = (f32x2_t){av.x, bv.x};
                            *(LAS f32x2_t*)(lds + LR_SC + ((row + 1) * 64 + 16 * sub + rho) * 8) = (f32x2_t){av.y, bv.y};
                        }
                }
                __syncthreads();
                asm volatile("s_waitcnt vmcnt(0)" : "+v"(hfr[0]), "+v"(hfr[1]), "+v"(gtr[0]), "+v"(gtr[1]) :: "memory");
                if (ck + 1 < 18) LR_STAGE(ck + 1);
                f32x2_t ab[16];
                {
#pragma unroll
                    for (int q = 0; q < 16; ++q) { const int s = 16 * wave + q, row = dir ? 127 - s : s; ab[q] = *(const LAS f32x2_t*)(lds + LR_SC + (row * 64 + lane) * 8); }
                    float hl = 0.f, pr = 1.f;
#pragma unroll
                    for (int q = 0; q < 16; ++q) { hl = ab[q].x * hl + ab[q].y; pr *= ab[q].x; ab[q] = (f32x2_t){pr, hl}; }
                    *(LAS f32x2_t*)(lds + LR_AG + ((ck & 1) * 512 + wave * 64 + lane) * 8) = (f32x2_t){pr, hl};
                }
                asm volatile("s_waitcnt lgkmcnt(0)" ::: "memory"); __builtin_amdgcn_s_barrier(); asm volatile("" ::: "memory");
                {
                    float c = ((const LAS float*)(lds + LR_CY))[(ck & 1) * 64 + lane], cin = 0.f;
#pragma unroll
                    for (int w2 = 0; w2 < 8; ++w2) { if (w2 == wave) cin = c; const f32x2_t ag = *(const LAS f32x2_t*)(lds + LR_AG + ((ck & 1) * 512 + w2 * 64 + lane) * 8); c = ag.x * c + ag.y; }
                    if (wave == 0) ((LAS float*)(lds + LR_CY))[((ck + 1) & 1) * 64 + lane] = c;
                    if (!isctx) {
                        LAS unsigned char* scr = lds + LR_SC + row0 * 512;
                        if (dir) {
#pragma unroll
                            for (int t = 0; t < 2; ++t) { const int tk = lane + 64 * t; *(LAS v4u*)(scr + tk * 16) = hfr[t]; *(LAS v4u*)(scr + 2048 + tk * 16) = gtr[t]; }
                        }
#pragma unroll
                        for (int q = 0; q < 16; ++q) { const int tr = dir ? 15 - q : q;
                            float hv = ab[q].y + ab[q].x * cin;
                            if (dir) hv = (bf2f(*(const LAS bf16*)(scr + (tr * 64 + lane) * 2)) + hv) * bf2f(*(const LAS bf16*)(scr + 2048 + (tr * 64 + lane) * 2));
                            *(LAS bf16*)(scr + 4096 + (tr * 64 + lane) * 2) = f2bf(hv); }
                        bf16* dstp = dir ? A3 : HF;
#pragma unroll
                        for (int t = 0; t < 2; ++t) { const int tk = lane + 64 * t; const size_t gi = (grow0 + row0 + (tk >> 3)) * D + h * 256 + cg * 64 + 8 * (tk & 7);
                            *(v4u*)(dstp + gi) = *(const LAS v4u*)(scr + 4096 + tk * 16); }
                    }
                }
            }
#undef LR_STAGE
#undef LR_GROW0
        }
    }
}

constexpr int LDS_BYTES = 163840;
constexpr int NPHASE = 17;
template <unsigned KMASK>
__global__ void __launch_bounds__(NWAVES * 64, 2) fwd(Args kargs) {
    extern __shared__ __attribute__((aligned(16))) unsigned char lds[];
    const int wave_s = __builtin_amdgcn_readfirstlane((int)threadIdx.x >> 6);
    const int tid0 = wave_s * 64 + lane_id_fresh();
    volatile LAS unsigned* misc = (volatile LAS unsigned*)((LAS unsigned char*)lds + (LDS_BYTES - 64));
    if (tid0 < 16) misc[tid0] = 0u;
    __syncthreads();
    const int lo = kargs.ph_lo, hi = kargs.ph_hi;
    XcdBarrier bar; bar.bar = (unsigned*)(kargs.ws + WS_CTL) + CW_BAR + kargs.li * XCD_BAR_WORDS; bar.x = 0; bar.st = misc;
    if (hi - lo > 1) bar = xcd_barrier_post((unsigned*)(kargs.ws + WS_CTL) + CW_BAR + kargs.li * XCD_BAR_WORDS, misc, tid0);
#ifndef ONLY_PHASE
#define ONLY_PHASE -1
#endif
#ifndef PHASE_MASK
#define PHASE_MASK 0xFFFFFFFFu
#endif
#ifndef REPMASK
#define REPMASK 0u
#endif
#define PH(k, body) if constexpr (((KMASK >> (k)) & 1u) != 0u) if ((ONLY_PHASE < 0 || ONLY_PHASE == (k)) && ((PHASE_MASK >> (k)) & 1u) && lo <= (k) && (k) < hi) { \
        const CAS Args* ap_ = (const CAS Args*)__builtin_amdgcn_kernarg_segment_ptr(); asm volatile("" : "+s"(ap_)); const CAS Args& args = *ap_; \
        Frame F; F.lds = lds; F.ldsl = (LAS unsigned char*)lds; F.wave = wave_s; F.lane = lane_id_fresh(); \
        F.tid = F.wave * 64 + F.lane; F.G = gridDim.x; F.bid = blockIdx.x; F.gw = F.bid * NWAVES + F.wave; F.ngw = F.G * NWAVES; \
        if (((REPMASK >> (k)) & 1u) == 0u) { body; } else { int nrep_ = 2; asm volatile("" : "+s"(nrep_)); for (int rep_ = 0; rep_ < nrep_; ++rep_) { body; asm volatile("s_waitcnt vmcnt(0)" ::: "memory"); __syncthreads(); } } if ((k) + 1 < hi) xcd_barrier(bar, F.tid); else { asm volatile("s_waitcnt vmcnt(0)" ::: "memory"); __syncthreads(); } }
    PH(0, p0_prologue(args, F))
    PH(1, p_norm1_l0(args, F))
    PH(2, p_inproj0(args, F))
    PH(3, p_attn(args, F))
    PH(4, p_outproj<0>(args, F))
    PH(5, p_norm2_router(args, F, 0))
    PH(6, p_moe_up(args, F, 0))
    PH(7, p_moe_down(args, F, 0))
    PH(8, p_combine(args, F, 0))
    PH(9, p_inproj1(args, F))
    PH(10, p_conv4(args, F))
    PH(11, p_lru(args, F))
    PH(12, p_outproj<1>(args, F))
    PH(13, p_norm2_router(args, F, 1))
    PH(14, p_moe_up(args, F, 1))
    PH(15, p_moe_down(args, F, 1))
    PH(16, p_combine(args, F, 1))
#undef PH
}

constexpr unsigned MASK_A = (1u<<2)|(1u<<4)|(1u<<6)|(1u<<7)|(1u<<9)|(1u<<11)|(1u<<13)|(1u<<14), MASK_C = 1u << 3, MASK_D = 1u << 10, MASK_ALL = 0x1FFFFu, MASK_B = MASK_ALL & ~(MASK_A | MASK_C | MASK_D);
__host__ inline int kid_of(int p) { return ((MASK_A >> p) & 1u) ? 0 : ((MASK_C >> p) & 1u) ? 2 : ((MASK_D >> p) & 1u) ? 3 : 1; }
extern "C" void kernel_launch(void* const* d_in, const int* in_sizes, int n_in, void* d_out, int out_size, void* d_ws, size_t ws_size, hipStream_t stream) {
    static int grid = 0;
    if (grid == 0) {
        if (n_in != 37 || out_size != NT * D || ws_size < WS_END) { fprintf(stderr, "kernel_launch: unexpected shapes (n_in %d out %d ws %zu)\n", n_in, out_size, ws_size); grid = -1; return; }
        int dev = 0, cus = 0;
        if (hipGetDevice(&dev) != hipSuccess || hipDeviceGetAttribute(&cus, hipDeviceAttributeMultiprocessorCount, dev) != hipSuccess) { grid = -1; return; }
#ifndef MULTI_LAUNCH
        if (hipFuncSetAttribute((const void*)fwd<MASK_ALL>, hipFuncAttributeMaxDynamicSharedMemorySize, LDS_BYTES) != hipSuccess) { fprintf(stderr, "kernel_launch: hipFuncSetAttribute failed\n"); grid = -1; return; }
#else
        if (hipFuncSetAttribute((const void*)fwd<MASK_A>, hipFuncAttributeMaxDynamicSharedMemorySize, LDS_BYTES) != hipSuccess) { fprintf(stderr, "kernel_launch: hipFuncSetAttribute failed\n"); grid = -1; return; }
        if (hipFuncSetAttribute((const void*)fwd<MASK_B>, hipFuncAttributeMaxDynamicSharedMemorySize, LDS_BYTES) != hipSuccess) { fprintf(stderr, "kernel_launch: hipFuncSetAttribute failed\n"); grid = -1; return; }
        if (hipFuncSetAttribute((const void*)fwd<MASK_C>, hipFuncAttributeMaxDynamicSharedMemorySize, LDS_BYTES) != hipSuccess) { fprintf(stderr, "kernel_launch: hipFuncSetAttribute failed\n"); grid = -1; return; }
        if (hipFuncSetAttribute((const void*)fwd<MASK_D>, hipFuncAttributeMaxDynamicSharedMemorySize, LDS_BYTES) != hipSuccess) { fprintf(stderr, "kernel_launch: hipFuncSetAttribute failed\n"); grid = -1; return; }
#endif
        (void)hipGetLastError();
        grid = cus;
    }
    if (grid < 0) return;
    if (hipMemsetAsync((char*)d_ws + WS_CTL, 0, CTL_ZERO_BYTES, stream) != hipSuccess) return;
    Args a{};
    for (int i = 0; i < 37; ++i) a.in[i] = (const float*)d_in[i];
    a.out = (float*)d_out; a.ws = (unsigned char*)d_ws;
#ifdef MULTI_LAUNCH
    int p = 0, li = 0;
    while (p < NPHASE) {
        const int kid = kid_of(p); int q = p + 1;
        while (q < NPHASE && kid_of(q) == kid) ++q;
        a.ph_lo = p; a.ph_hi = q; a.li = li++;
        if (kid == 0) hipLaunchKernelGGL(fwd<MASK_A>, dim3(grid), dim3(NWAVES * 64), LDS_BYTES, stream, a);
        else if (kid == 1) hipLaunchKernelGGL(fwd<MASK_B>, dim3(grid), dim3(NWAVES * 64), LDS_BYTES, stream, a);
        else if (kid == 2) hipLaunchKernelGGL(fwd<MASK_C>, dim3(grid), dim3(NWAVES * 64), LDS_BYTES, stream, a);
        else hipLaunchKernelGGL(fwd<MASK_D>, dim3(grid), dim3(NWAVES * 64), LDS_BYTES, stream, a);
        p = q;
    }
#else
    a.ph_lo = 0; a.ph_hi = NPHASE; a.li = 0;
    hipLaunchKernelGGL(fwd<MASK_ALL>, dim3(grid), dim3(NWAVES * 64), LDS_BYTES, stream, a);
#endif
}
```
